# Optimizing an MI355X kernel written in HIP

```python
import math
import jax, jax.numpy as jnp
from jax import lax
import numpy as np

D_MODEL = 1024
BATCH = 32
SEQ = 256
DEPTH = 2
DEC_BATCH = 4
DEC_SEQ = 4096
PAST_LEN = 512

GRID_W = 64
CHUNK = 64
SUB = 16
EPS = 1e-6
D_FF = 2816
N_DIR = 2
N_BRANCH = 3
M_HEADS = 4
M_DK = 64
M_DV = 128
G_HEADS = 4
G_DK = 64
G_DV = 128
G_RANK = 16
G_TEMP = 16.0
H_HEADS = 4
H_DE = 64
H_DV = 128
MIX_W = 512

IN_SIZES = (
    M_HEADS * M_DK, M_HEADS * M_DK, M_HEADS * M_DV, M_HEADS * M_DV, N_DIR * 2 * M_HEADS,
    G_HEADS * G_DK, G_HEADS * G_DK, G_HEADS * G_DV, G_HEADS * G_DV, N_DIR * G_RANK,
    H_HEADS * H_DE, N_DIR * H_HEADS * H_DE, H_HEADS * H_DV, H_HEADS * H_DV,
    N_BRANCH * D_MODEL,
)
IN_COLS = sum(IN_SIZES)

kernel_name = "bidir_mlstm_gla_hgrn2_prefix_diffusion_step"


def rmsnorm(x, w):
    x32 = x.astype(jnp.float32)
    y = x32 * lax.rsqrt(jnp.mean(x32 * x32, axis=-1, keepdims=True) + EPS)
    return y.astype(x.dtype) * w


def head_rmsnorm(x, w, n_heads):
    b, t, wd = x.shape
    xh = x.reshape(b, t, n_heads, wd // n_heads).astype(jnp.float32)
    xh = xh * lax.rsqrt(jnp.mean(xh * xh, axis=-1, keepdims=True) + EPS)
    return xh.reshape(b, t, wd) * w.astype(jnp.float32)


def to_heads(x, n_heads):
    b, t, _ = x.shape
    return x.reshape(b, t, n_heads, -1).transpose(0, 2, 1, 3)


def from_heads(x):
    b, h, t, d = x.shape
    return x.transpose(0, 2, 1, 3).reshape(b, t, h * d)


def dir_stack(fwd, bwd):
    return jnp.concatenate([fwd, jnp.flip(bwd, axis=2)], axis=1)


def dir_merge(o, n_heads):
    return o[:, :n_heads] + jnp.flip(o[:, n_heads:], axis=2)


def to_chunks(x):
    b, h, t = x.shape[:3]
    x = x.reshape(b, h, t // CHUNK, CHUNK, *x.shape[3:])
    return jnp.moveaxis(x, 2, 0)


def from_chunks(y):
    y = jnp.moveaxis(y, 0, 2)
    b, h, n, l = y.shape[:4]
    return y.reshape(b, h, n * l, *y.shape[4:])


def gated_linear_scan(q, k, v, log_a, s0):
    nb = CHUNK // SUB
    tri = jnp.tril(jnp.ones((SUB, SUB), bool))
    blk_lower = jnp.tril(jnp.ones((nb, nb), bool), -1)

    def step(s, inp):
        qc, kc, vc, la = inp
        b, h, l, dk = qc.shape
        dv = vc.shape[-1]
        g = jnp.cumsum(la, axis=2)
        o_inter = jnp.einsum('bhld,bhde->bhle', qc * jnp.exp(g), s)
        qs = qc.reshape(b, h, nb, SUB, dk)
        ks = kc.reshape(b, h, nb, SUB, dk)
        gs = g.reshape(b, h, nb, SUB, dk)
        vs = vc.reshape(b, h, nb, SUB, dv)
        g_end = gs[:, :, :, -1]
        q_off = qs[:, :, :, None] * jnp.exp(jnp.minimum(gs[:, :, :, None] - g_end[:, :, None, :, None], 0.0))
        k_off = ks * jnp.exp(g_end[:, :, :, None] - gs)
        a_off = jnp.einsum('bhijtd,bhjsd->bhijts', q_off, k_off) * blk_lower[:, :, None, None]
        o_off = jnp.einsum('bhijts,bhjse->bhite', a_off, vs)
        decay = jnp.exp(jnp.minimum(gs[:, :, :, :, None] - gs[:, :, :, None, :], 0.0))
        a_diag = jnp.einsum('bhntd,bhntsd,bhnsd->bhnts', qs, decay, ks) * tri
        o_diag = jnp.einsum('bhnts,bhnse->bhnte', a_diag, vs)
        o = o_inter + (o_off + o_diag).reshape(b, h, l, dv)
        g_last = g[:, :, -1]
        s_new = jnp.exp(g_last)[..., None] * s + jnp.einsum(
            'bhld,bhle->bhde', kc * jnp.exp(g_last[:, :, None] - g), vc)
        return s_new, o

    s_fin, o = lax.scan(step, s0, (to_chunks(q), to_chunks(k), to_chunks(v), to_chunks(log_a)))
    return from_chunks(o), s_fin


def mlstm_scan(q, k, v, log_i, log_f, c0, n0, m0):
    tri = jnp.tril(jnp.ones((CHUNK, CHUNK), bool))

    def step(carry, inp):
        c, n, m = carry
        qc, kc, vc, lic, lfc = inp
        b = jnp.cumsum(lfc, axis=-1)
        d = jnp.where(tri, b[..., :, None] - b[..., None, :] + lic[..., None, :], -jnp.inf)
        inter = b + m[..., None]
        m_t = jnp.maximum(inter, jnp.max(d, axis=-1))
        w = jnp.exp(d - m_t[..., None])
        sc = jnp.einsum('bhtd,bhsd->bhts', qc, kc) * w
        e_inter = jnp.exp(inter - m_t)
        num = jnp.einsum('bhts,bhse->bhte', sc, vc) + e_inter[..., None] * jnp.einsum('bhtd,bhde->bhte', qc, c)
        den = jnp.sum(sc, axis=-1) + e_inter * jnp.einsum('bhtd,bhd->bht', qc, n)
        h = num / jnp.maximum(jnp.abs(den), jnp.exp(-m_t))[..., None]
        b_last = b[..., -1]
        lw = b_last[..., None] - b + lic
        m_new = jnp.maximum(b_last + m, jnp.max(lw, axis=-1))
        ws = jnp.exp(lw - m_new[..., None])
        dec = jnp.exp(b_last + m - m_new)
        c_new = dec[..., None, None] * c + jnp.einsum('bhs,bhsd,bhse->bhde', ws, kc, vc)
        n_new = dec[..., None] * n + jnp.einsum('bhs,bhsd->bhd', ws, kc)
        return (c_new, n_new, m_new), h

    (c1, n1, m1), h = lax.scan(step, (c0, n0, m0), (to_chunks(q), to_chunks(k), to_chunks(v),
                                                  to_chunks(log_i), to_chunks(log_f)))
    return from_chunks(h), (c1, n1, m1)


def swiglu(h, w_in, w_out):
    gate, up = jnp.split(jnp.einsum('btd,df->btf', h, w_in), 2, axis=-1)
    return jnp.einsum('btf,fd->btd', jax.nn.silu(gate) * up, w_out)


def grid_position(n_tokens):
    rows = n_tokens // GRID_W
    quarter = D_MODEL // 4
    freqs = jnp.exp(-math.log(10000.0) * jnp.arange(quarter, dtype=jnp.float32) / quarter)
    r = jnp.arange(rows, dtype=jnp.float32)[:, None] * freqs
    cl = jnp.arange(GRID_W, dtype=jnp.float32)[:, None] * freqs
    r_emb = jnp.concatenate([jnp.sin(r), jnp.cos(r)], axis=-1)
    c_emb = jnp.concatenate([jnp.sin(cl), jnp.cos(cl)], axis=-1)
    emb = jnp.concatenate([jnp.broadcast_to(r_emb[:, None], (rows, GRID_W, D_MODEL // 2)),
                           jnp.broadcast_to(c_emb[None], (rows, GRID_W, D_MODEL // 2))], axis=-1)
    return emb.reshape(rows * GRID_W, D_MODEL)


def mixer(h, st, w_in, gate_bias_m, gla_w_up, gla_b, lb, head_norm, w_branch, w_out):
    f32 = jnp.float32
    b, t, _ = h.shape
    proj = jnp.einsum('btd,dc->btc', h, w_in).astype(f32)
    split_at = [int(s) for s in np.cumsum(IN_SIZES)[:-1]]
    (mq, mk, mv, mo, mif, gq, gk, gv, gr, glr, hq, hf, hv, hg, mg) = jnp.split(proj, split_at, axis=-1)
    c0, n0, m0, sg0, sh0 = [s.astype(f32) for s in st]

    q = to_heads(mq, M_HEADS) * (M_DK ** -0.5)
    k = to_heads(mk, M_HEADS)
    v = to_heads(mv, M_HEADS)
    gates = mif.reshape(b, t, N_DIR, 2, M_HEADS) + gate_bias_m.astype(f32)
    log_i = gates[:, :, :, 0].transpose(0, 2, 3, 1)
    log_f = jax.nn.log_sigmoid(gates[:, :, :, 1]).transpose(0, 2, 3, 1)
    h_m, (c1, n1, m1) = mlstm_scan(dir_stack(q, q), dir_stack(k, k), dir_stack(v, v),
                                   dir_stack(log_i[:, 0], log_i[:, 1]), dir_stack(log_f[:, 0], log_f[:, 1]),
                                   c0, n0, m0)
    y_m = jax.nn.sigmoid(mo) * head_rmsnorm(from_heads(dir_merge(h_m, M_HEADS)), head_norm[0], M_HEADS)

    q = to_heads(gq, G_HEADS) * (G_DK ** -0.5)
    k = to_heads(gk, G_HEADS)
    v = to_heads(gv, G_HEADS)
    la = jax.nn.log_sigmoid(jnp.einsum('btzr,zrc->btzc', glr.reshape(b, t, N_DIR, G_RANK), gla_w_up.astype(f32))
                            + gla_b.astype(f32)) / G_TEMP
    o_g, sg1 = gated_linear_scan(dir_stack(q, q), dir_stack(k, k), dir_stack(v, v),
                                 dir_stack(to_heads(la[:, :, 0], G_HEADS), to_heads(la[:, :, 1], G_HEADS)), sg0)
    y_g = jax.nn.silu(gr) * head_rmsnorm(from_heads(dir_merge(o_g, G_HEADS)), head_norm[1], G_HEADS)

    z = hf.reshape(b, t, N_DIR, H_HEADS * H_DE)
    lb = lb.astype(f32)
    log_fh = jnp.log(lb + (1.0 - lb) * jax.nn.sigmoid(z))
    key_h = (1.0 - lb) * jax.nn.sigmoid(-z)
    q = to_heads(hq, H_HEADS)
    i_v = to_heads(jax.nn.silu(hv), H_HEADS)
    o_h, sh1 = gated_linear_scan(dir_stack(q, q),
                                 dir_stack(to_heads(key_h[:, :, 0], H_HEADS), to_heads(key_h[:, :, 1], H_HEADS)),
                                 dir_stack(i_v, i_v),
                                 dir_stack(to_heads(log_fh[:, :, 0], H_HEADS), to_heads(log_fh[:, :, 1], H_HEADS)),
                                 sh0)
    y_h = jax.nn.silu(hg) * head_rmsnorm(from_heads(dir_merge(o_h, H_HEADS)), head_norm[2], H_HEADS)

    ys = jnp.stack([y_m, y_g, y_h], axis=2).astype(h.dtype)
    branch = jnp.einsum('btnc,ncd->btnd', ys, w_branch)
    merge_gate = jax.nn.sigmoid(mg).reshape(b, t, N_BRANCH, D_MODEL).astype(h.dtype)
    out = jnp.einsum('btd,de->bte', jnp.sum(merge_gate * branch, axis=2), w_out)
    return out.astype(h.dtype), (c1, n1, m1, sg1, sh1)


def trunk_layer(x, mod, pos, st, norm_pre, norm_post, w_ffn_in, w_ffn_out, w_in, gate_bias_m,
                gla_w_up, gla_b, lb, head_norm, w_branch, w_out):
    md = [mod[:, :, i] for i in range(9)]

    def modulate(x_, i, j):
        return rmsnorm(x_, norm_pre[j]) * (1.0 + md[i + 1]) + md[i]

    h = modulate(x, 0, 0)
    x = x + 0.5 * md[2] * rmsnorm(swiglu(h, w_ffn_in[0], w_ffn_out[0]), norm_post[0])
    h = modulate(x, 3, 1)
    if pos is not None:
        h = h + pos
    y, st = mixer(h, st, w_in, gate_bias_m, gla_w_up, gla_b, lb, head_norm, w_branch, w_out)
    x = x + md[5] * rmsnorm(y, norm_post[1])
    h = modulate(x, 6, 2)
    x = x + 0.5 * md[8] * rmsnorm(swiglu(h, w_ffn_in[1], w_ffn_out[1]), norm_post[2])
    return x, st


def setup_inputs(seed: int = 0) -> dict:
    key = jax.random.key(seed)
    ks = jax.random.split(key, 23)

    def nrm(k, shape, s):
        return jax.random.normal(k, shape, jnp.float32) * s

    gb = nrm(ks[16], (DEPTH, N_DIR, 2, M_HEADS), 1.0)
    mlstm_gate_bias = gb * jnp.array([0.1, 0.5], jnp.float32)[:, None] + jnp.array([0.0, 3.0], jnp.float32)[:, None]
    return {
        "x_prompt": nrm(ks[0], (BATCH, SEQ, D_MODEL), 1.0),
        "x_sample": nrm(ks[1], (DEC_BATCH, DEC_SEQ, D_MODEL), 1.0),
        "c": nrm(ks[2], (DEC_BATCH, D_MODEL), 1.0),
        "state_mlstm_C": nrm(ks[3], (DEC_BATCH, DEPTH, N_DIR, M_HEADS, M_DK, M_DV), 0.1),
        "state_mlstm_n": nrm(ks[4], (DEC_BATCH, DEPTH, N_DIR, M_HEADS, M_DK), 0.1),
        "state_mlstm_m": nrm(ks[5], (DEC_BATCH, DEPTH, N_DIR, M_HEADS), 0.5),
        "state_gla_S": nrm(ks[6], (DEC_BATCH, DEPTH, N_DIR, G_HEADS, G_DK, G_DV), 0.3),
        "state_hgrn_S": nrm(ks[7], (DEC_BATCH, DEPTH, N_DIR, H_HEADS, H_DE, H_DV), 0.3),
        "c_ctx": nrm(ks[8], (D_MODEL,), 1.0),
        "w_ada": nrm(ks[9], (DEPTH, D_MODEL, 9 * D_MODEL), 0.5 * D_MODEL ** -0.5),
        "b_ada": nrm(ks[10], (DEPTH, 9 * D_MODEL), 0.02),
        "norm_pre": 1.0 + nrm(ks[11], (DEPTH, 3, D_MODEL), 0.1),
        "norm_post": 1.0 + nrm(ks[12], (DEPTH, 3, D_MODEL), 0.1),
        "w_ffn_in": nrm(ks[13], (DEPTH, 2, D_MODEL, 2 * D_FF), D_MODEL ** -0.5),
        "w_ffn_out": nrm(ks[14], (DEPTH, 2, D_FF, D_MODEL), D_FF ** -0.5),
        "w_in": nrm(ks[15], (DEPTH, D_MODEL, IN_COLS), D_MODEL ** -0.5),
        "mlstm_gate_bias": mlstm_gate_bias,
        "gla_w_up": nrm(ks[17], (DEPTH, N_DIR, G_RANK, G_HEADS * G_DK), G_RANK ** -0.5),
        "gla_b": nrm(ks[18], (DEPTH, N_DIR, G_HEADS * G_DK), 0.1),
        "hgrn_gamma": nrm(ks[19], (DEPTH, H_HEADS * H_DE), 1.0),
        "head_norm": 1.0 + nrm(ks[20], (DEPTH, N_BRANCH, MIX_W), 0.1),
        "w_branch": nrm(ks[21], (DEPTH, N_BRANCH, MIX_W, D_MODEL), MIX_W ** -0.5),
        "w_out": nrm(ks[22], (DEPTH, D_MODEL, D_MODEL), D_MODEL ** -0.5),
    }


def reference(x_prompt, x_sample, c, state_mlstm_C, state_mlstm_n, state_mlstm_m, state_gla_S, state_hgrn_S,
              c_ctx, w_ada, b_ada, norm_pre, norm_post, w_ffn_in, w_ffn_out, w_in, mlstm_gate_bias,
              gla_w_up, gla_b, hgrn_gamma, head_norm, w_branch, w_out):
    f32 = jnp.float32
    bp = x_prompt.shape[0]
    bs, ts = x_sample.shape[:2]
    p_gamma = jax.nn.softmax(hgrn_gamma.astype(f32), axis=0)
    lb_all = jnp.cumsum(p_gamma, axis=0) - p_gamma[0]
    pos = grid_position(ts).astype(x_sample.dtype)
    silu_ctx = jax.nn.silu(c_ctx)[None]
    silu_c = jax.nn.silu(c)

    xp, xs = x_prompt, x_sample
    new_c, new_n, new_m, new_sg, new_sh = [], [], [], [], []
    for l in range(DEPTH):
        lp = (norm_pre[l], norm_post[l], w_ffn_in[l], w_ffn_out[l], w_in[l], mlstm_gate_bias[l],
              gla_w_up[l], gla_b[l], lb_all[l], head_norm[l], w_branch[l], w_out[l])
        mod_ctx = (silu_ctx @ w_ada[l] + b_ada[l]).reshape(1, 1, 9, D_MODEL)
        st0 = (jnp.zeros((bp, N_DIR * M_HEADS, M_DK, M_DV), f32),
               jnp.zeros((bp, N_DIR * M_HEADS, M_DK), f32),
               jnp.zeros((bp, N_DIR * M_HEADS), f32),
               jnp.zeros((bp, N_DIR * G_HEADS, G_DK, G_DV), f32),
               jnp.zeros((bp, N_DIR * H_HEADS, H_DE, H_DV), f32))
        xp, (c1, n1, m1, sg1, sh1) = trunk_layer(xp, mod_ctx, None, st0, *lp)
        new_c.append(c1.reshape(bp, N_DIR, M_HEADS, M_DK, M_DV))
        new_n.append(n1.reshape(bp, N_DIR, M_HEADS, M_DK))
        new_m.append(m1.reshape(bp, N_DIR, M_HEADS))
        new_sg.append(sg1.reshape(bp, N_DIR, G_HEADS, G_DK, G_DV))
        new_sh.append(sh1.reshape(bp, N_DIR, H_HEADS, H_DE, H_DV))
        mod_lat = (silu_c @ w_ada[l] + b_ada[l]).reshape(bs, 1, 9, D_MODEL)
        st_lat = (state_mlstm_C[:, l].reshape(bs, N_DIR * M_HEADS, M_DK, M_DV),
                  state_mlstm_n[:, l].reshape(bs, N_DIR * M_HEADS, M_DK),
                  state_mlstm_m[:, l].reshape(bs, N_DIR * M_HEADS),
                  state_gla_S[:, l].reshape(bs, N_DIR * G_HEADS, G_DK, G_DV),
                  state_hgrn_S[:, l].reshape(bs, N_DIR * H_HEADS, H_DE, H_DV))
        xs, _ = trunk_layer(xs, mod_lat, pos, st_lat, *lp)

    new_mlstm_C = jnp.stack(new_c, axis=1)
    new_mlstm_n = jnp.stack(new_n, axis=1)
    new_mlstm_m = jnp.stack(new_m, axis=1)
    new_gla_S = jnp.stack(new_sg, axis=1)
    new_hgrn_S = jnp.stack(new_sh, axis=1)
    return (xp, xs, new_mlstm_C, new_mlstm_n, new_mlstm_m, new_gla_S, new_hgrn_S)
```

```cpp
#include <hip/hip_runtime.h>
#include <hip/hip_cooperative_groups.h>
#include <cstdio>
#include <cstdint>
namespace cg = cooperative_groups;

namespace pg8 {
#define PG8_LAS __attribute__((address_space(3)))
typedef unsigned short bf16_t;
typedef short bf16x8 __attribute__((ext_vector_type(8)));
typedef float f32x4 __attribute__((ext_vector_type(4)));
typedef unsigned u32x4 __attribute__((ext_vector_type(4)));
typedef unsigned u32x2 __attribute__((ext_vector_type(2)));
constexpr int BM = 256, BK = 64, HALF = 128, HTB = HALF * BK * 2, STAGE_BYTES = 8 * HTB, NXCD = 8, WGM = 8;

__host__ __device__ __forceinline__ int lds_byte(int r, int c) { const int st = (r >> 4) * 2 + (c >> 5), rr = r & 15, cc = c & 31, ob = rr * 64 + cc * 2; return st * 1024 + (ob ^ (((ob >> 9) & 1) << 5)); }
__host__ __device__ __forceinline__ void stage_rc(int b, int& R, int& C) { const int st = b / 1024, sb = b % 1024, swz = sb ^ (((sb >> 9) & 1) << 5); R = (st >> 1) * 16 + swz / 64; C = (st & 1) * 32 + (swz % 64) / 2; }
__host__ __device__ __forceinline__ int perm32(int rho) { const int n = rho >> 4, i = rho & 15; return 8 * (i >> 2) + 4 * n + (i & 3); }

struct Unit { int pm, pn; };
template <int M_, int N_, int K_, int LDA_, int LDB_> struct GemmT { const bf16_t* A; const bf16_t* Bt; static constexpr int M = M_, N = N_, K = K_, lda = LDA_, ldb = LDB_; };

template <int M_, int N_, int ADIV, int AMUL> struct StaticOrderT {
    static constexpr int nM = M_ / BM, nN = N_ / BM, nwg = nM * nN;
    int G, c;
    __device__ void init(int G_, int c_) { G = G_; c = c_; }
    __device__ __forceinline__ bool next(int i, Unit& u) const {
        const int L = i * G + c; if (L >= nwg) return false;
        int wgid = L; { constexpr int q = nwg / NXCD, r = nwg % NXCD; const int xcd = wgid % NXCD, off = wgid / NXCD; wgid = (xcd < r ? xcd * (q + 1) : r * (q + 1) + (xcd - r) * q) + off; }
        constexpr int nig = WGM * nN; const int gid = wgid / nig, fm = gid * WGM, gsz = (nM - fm) < WGM ? (nM - fm) : WGM;
        u.pm = fm + ((wgid % nig) % gsz); u.pn = (wgid % nig) / gsz; return true;
    }
    __device__ __forceinline__ int a_off(const Unit& u) const { return ADIV > 0 ? (u.pn / (ADIV > 0 ? ADIV : 1)) * AMUL : 0; }
    __device__ __forceinline__ void a_ready(const Unit&) const {}
    __device__ __forceinline__ void done(const Unit&) const {}
};

template <class GT, class Epi, class Sched, bool ALIGN_EPI = false, bool SP2 = false>
__device__ __forceinline__ void gemm_phase(PG8_LAS unsigned char* lds, const GT g, const Sched& S, const Epi& E) {
    int tid_ = threadIdx.x; asm volatile("" : "+v"(tid_));
    const int tid = tid_, wid = __builtin_amdgcn_readfirstlane(tid >> 6), lane = tid & 63, wr = wid >> 2, wc = wid & 3, fr = lane & 15, fq = lane >> 4;
    constexpr int K = GT::K, nt = K / BK;
    unsigned voffA[2], voffB[2];
#pragma unroll
    for (int i = 0; i < 2; ++i) { int R, C; stage_rc(tid * 16 + i * 8192, R, C); const int Rb = Epi::PERM ? ((R & ~31) + perm32(R & 31)) : R;
        voffA[i] = (unsigned)(R * GT::lda + C) * 2u; voffB[i] = (unsigned)(Rb * GT::ldb + C) * 2u; }
    constexpr size_t kstep = (size_t)(BK * 2);
    constexpr size_t hstepA = (size_t)HALF * GT::lda * 2, hstepB = (size_t)HALF * GT::ldb * 2;
    constexpr size_t tstepA = 2 * hstepA, tstepB = 2 * hstepB;
    const unsigned ldsw = (unsigned)wid * 1024u;
    const int aoff = lds_byte(wr * 64 + fr, fq * 8), boff = lds_byte(wc * 32 + fr, fq * 8);
#define PG8_SA(b, h) (((b) * 2 + (h)) * HTB)
#define PG8_SB(b, h) ((4 + (b) * 2 + (h)) * HTB)
#define PG8_STAGE(bufoff, gbase, voff) do { _Pragma("unroll") for (int _i = 0; _i < 2; ++_i) \
        __builtin_amdgcn_global_load_lds((const unsigned*)((const char*)(gbase) + (voff)[_i]), (PG8_LAS unsigned*)(lds + (bufoff) + ldsw + _i * 8192), 16, 0, 0); } while (0)
#define PG8_LDA(dst, b, h) do { _Pragma("unroll") for (int m = 0; m < 4; ++m) _Pragma("unroll") for (int k = 0; k < 2; ++k) dst[m][k] = *(const PG8_LAS bf16x8*)(lds + PG8_SA(b, h) + aoff + m * 2048 + k * 1024); } while (0)
#define PG8_LDB(dst, b, h) do { _Pragma("unroll") for (int n = 0; n < 2; ++n) _Pragma("unroll") for (int k = 0; k < 2; ++k) dst[n][k] = *(const PG8_LAS bf16x8*)(lds + PG8_SB(b, h) + boff + n * 2048 + k * 1024); } while (0)
#define PG8_MMA(ai, bj, At, Bt) do { __builtin_amdgcn_s_setprio(1); _Pragma("unroll") for (int m = 0; m < 4; ++m) _Pragma("unroll") for (int n = 0; n < 2; ++n) _Pragma("unroll") for (int k = 0; k < 2; ++k) \
        acc[ai][bj][m][n] = __builtin_amdgcn_mfma_f32_16x16x32_bf16(Bt[n][k], At[m][k], acc[ai][bj][m][n], 0, 0, 0); __builtin_amdgcn_s_setprio(0); } while (0)
#define PG8_WAIT_V(n) asm volatile("s_waitcnt vmcnt(" #n ")" ::: "memory")
#define PG8_WAIT_L(n) asm volatile("s_waitcnt lgkmcnt(" #n ")" ::: "memory")
#define PG8_BAR __builtin_amdgcn_s_barrier()
#define PG8_SCHED __builtin_amdgcn_sched_barrier(0)
    Unit cur, nxt; int ui = 0;
    if (!S.next(0, cur)) return;
    f32x4 acc[2][2][4][2];
#pragma unroll
    for (int a = 0; a < 2; ++a)
#pragma unroll
        for (int b = 0; b < 2; ++b)
#pragma unroll
            for (int m = 0; m < 4; ++m)
#pragma unroll
                for (int n = 0; n < 2; ++n) acc[a][b][m][n] = (f32x4){0.f, 0.f, 0.f, 0.f};
    bf16x8 At[4][2], B0[2][2], B1[2][2];
    const char* cA = (const char*)g.A + (size_t)cur.pm * tstepA + (size_t)S.a_off(cur) * 2; const char* cB = (const char*)g.Bt + (size_t)cur.pn * tstepB;
    S.a_ready(cur);
    if constexpr (SP2) {
        PG8_STAGE(PG8_SB(0, 0), cB, voffB); PG8_STAGE(PG8_SB(0, 1), cB + hstepB, voffB); PG8_STAGE(PG8_SA(0, 0), cA, voffA); PG8_STAGE(PG8_SA(0, 1), cA + hstepA, voffA);
        if (wr == 1) PG8_BAR;
        PG8_WAIT_V(2); PG8_BAR;
        PG8_STAGE(PG8_SB(1, 0), cB + kstep, voffB); PG8_STAGE(PG8_SA(1, 0), cA + kstep, voffA); PG8_STAGE(PG8_SB(1, 1), cB + hstepB + kstep, voffB);
        PG8_WAIT_V(6); PG8_BAR;
    } else {
        PG8_STAGE(PG8_SB(0, 0), cB, voffB); PG8_STAGE(PG8_SA(0, 0), cA, voffA); PG8_STAGE(PG8_SB(0, 1), cB + hstepB, voffB); PG8_STAGE(PG8_SA(0, 1), cA + hstepA, voffA);
        if (wr == 1) PG8_BAR;
        PG8_WAIT_V(4); PG8_BAR;
        PG8_STAGE(PG8_SB(1, 0), cB + kstep, voffB); PG8_STAGE(PG8_SA(1, 0), cA + kstep, voffA); PG8_STAGE(PG8_SB(1, 1), cB + hstepB + kstep, voffB);
        PG8_WAIT_V(6); PG8_BAR;
    }
    for (;;) {
        const bool has_next = S.next(ui + 1, nxt);
        const char* nA = has_next ? (const char*)g.A + (size_t)nxt.pm * tstepA + (size_t)S.a_off(nxt) * 2 : cA; const char* nB = has_next ? (const char*)g.Bt + (size_t)nxt.pn * tstepB : cB;
        for (int t = 0; t < nt; t += 2) {
            const bool last = (t == nt - 2);
            const char* a1 = cA + (size_t)(t + 1) * kstep;
            const char* a2 = last ? nA : cA + (size_t)(t + 2) * kstep; const char* b2 = last ? nB : cB + (size_t)(t + 2) * kstep;
            const char* a3 = a2 + kstep; const char* b3 = b2 + kstep;
            if (last && has_next) S.a_ready(nxt);
            if constexpr (SP2) {
            PG8_LDB(B0, 0, 0); PG8_LDB(B1, 0, 1); PG8_SCHED; PG8_LDA(At, 0, 0); PG8_STAGE(PG8_SA(1, 1), a1 + hstepA, voffA);
            PG8_WAIT_V(8); PG8_WAIT_L(0); PG8_BAR; PG8_MMA(0, 0, At, B0); PG8_MMA(0, 1, At, B1); PG8_BAR; PG8_SCHED;
            PG8_LDA(At, 0, 1); PG8_STAGE(PG8_SB(0, 0), b2, voffB); PG8_STAGE(PG8_SB(0, 1), b2 + hstepB, voffB); PG8_STAGE(PG8_SA(0, 0), a2, voffA);
            PG8_WAIT_V(8); PG8_WAIT_L(0); PG8_BAR; PG8_MMA(1, 0, At, B0); PG8_MMA(1, 1, At, B1); PG8_BAR; PG8_SCHED;
            PG8_LDB(B0, 1, 0); PG8_LDB(B1, 1, 1); PG8_SCHED; PG8_LDA(At, 1, 0); PG8_STAGE(PG8_SA(0, 1), a2 + hstepA, voffA);
            PG8_WAIT_V(8); PG8_WAIT_L(0); PG8_BAR; PG8_MMA(0, 0, At, B0); PG8_MMA(0, 1, At, B1); PG8_BAR; PG8_SCHED;
            PG8_LDA(At, 1, 1); PG8_STAGE(PG8_SB(1, 0), b3, voffB); PG8_STAGE(PG8_SB(1, 1), b3 + hstepB, voffB); PG8_STAGE(PG8_SA(1, 0), a3, voffA);
            PG8_WAIT_V(8); PG8_WAIT_L(0); PG8_BAR; PG8_MMA(1, 0, At, B0); PG8_MMA(1, 1, At, B1); PG8_BAR; PG8_SCHED;
            } else {
            PG8_LDB(B0, 0, 0); PG8_SCHED; PG8_LDA(At, 0, 0); PG8_STAGE(PG8_SA(1, 1), a1 + hstepA, voffA);
            PG8_WAIT_L(8); PG8_BAR; PG8_WAIT_L(0); PG8_MMA(0, 0, At, B0); PG8_BAR; PG8_SCHED;
            PG8_LDB(B1, 0, 1); PG8_STAGE(PG8_SB(0, 0), b2, voffB);
            PG8_BAR; PG8_WAIT_L(0); PG8_MMA(0, 1, At, B1); PG8_BAR;
            PG8_LDA(At, 0, 1); PG8_STAGE(PG8_SA(0, 0), a2, voffA);
            PG8_BAR; PG8_WAIT_L(0); PG8_MMA(1, 0, At, B0); PG8_BAR; PG8_SCHED;
            PG8_STAGE(PG8_SB(0, 1), b2 + hstepB, voffB);
            PG8_WAIT_V(6); PG8_BAR; PG8_MMA(1, 1, At, B1); PG8_BAR;
            PG8_LDB(B0, 1, 0); PG8_SCHED; PG8_LDA(At, 1, 0); PG8_STAGE(PG8_SA(0, 1), a2 + hstepA, voffA);
            PG8_WAIT_L(8); PG8_BAR; PG8_WAIT_L(0); PG8_MMA(0, 0, At, B0); PG8_BAR; PG8_SCHED;
            PG8_LDB(B1, 1, 1); PG8_STAGE(PG8_SB(1, 0), b3, voffB);
            PG8_BAR; PG8_WAIT_L(0); PG8_MMA(0, 1, At, B1); PG8_BAR;
            PG8_LDA(At, 1, 1); PG8_STAGE(PG8_SA(1, 0), a3, voffA);
            PG8_BAR; PG8_WAIT_L(0); PG8_MMA(1, 0, At, B0); PG8_BAR; PG8_SCHED;
            PG8_STAGE(PG8_SB(1, 1), b3 + hstepB, voffB);
            PG8_WAIT_V(6); PG8_BAR; PG8_MMA(1, 1, At, B1); PG8_BAR;
            }
        }
        if constexpr (ALIGN_EPI) { if (wr == 0) PG8_BAR; }
        if constexpr (!Epi::AFTER_DRAIN) { E(acc, cur, wr, wc, fr, fq); S.done(cur); }
        if (!has_next) break;
#pragma unroll
        for (int a = 0; a < 2; ++a)
#pragma unroll
            for (int b = 0; b < 2; ++b)
#pragma unroll
                for (int m = 0; m < 4; ++m)
#pragma unroll
                    for (int n = 0; n < 2; ++n) acc[a][b][m][n] = (f32x4){0.f, 0.f, 0.f, 0.f};
        cur = nxt; cA = nA; cB = nB; ++ui;
        if constexpr (ALIGN_EPI) { if (wr == 1) PG8_BAR; }
    }
    PG8_WAIT_V(0);
    if constexpr (!ALIGN_EPI) { if (wr == 0) PG8_BAR; }
    PG8_BAR;
    if constexpr (Epi::AFTER_DRAIN) { E.fused(acc, cur, wr, wc, fr, fq, lds, wid, lane); S.done(cur); }
#undef PG8_SA
#undef PG8_SB
#undef PG8_STAGE
#undef PG8_LDA
#undef PG8_LDB
#undef PG8_MMA
#undef PG8_WAIT_V
#undef PG8_WAIT_L
#undef PG8_BAR
#undef PG8_SCHED
}
}

#define LAS __attribute__((address_space(3)))
typedef unsigned short bf16_t;
typedef short bf16x8 __attribute__((ext_vector_type(8)));
typedef float f32x4 __attribute__((ext_vector_type(4)));
typedef unsigned u32x4 __attribute__((ext_vector_type(4)));
typedef unsigned u32x2 __attribute__((ext_vector_type(2)));

constexpr int D = 1024, DFF = 2816, NFF2 = 5632, INC = 7984, PN = 5120, PREAL = 4912, MGN = 3072;
constexpr int MTOT = 24576, MLAT = 16384, GROWS = 8192;
constexpr float EPSN = 1e-6f;
constexpr size_t MiB = 1u << 20;
constexpr size_t WS_MOD = 1 * MiB, WS_MODP = 2 * MiB, WS_POS = 5 * MiB, WS_DEC = 6 * MiB, WS_SC = 7 * MiB;
constexpr size_t WS_W = 8 * MiB;
constexpr size_t W_FFIN = 0, W_FFOUT = W_FFIN + 2ull * NFF2 * D * 2, W_P = W_FFOUT + 2ull * D * DFF * 2, W_MG = W_P + (size_t)PN * D * 2,
                 W_B = W_MG + (size_t)MGN * D * 2, W_O3 = W_B + 3072ull * 512 * 2, W_END = W_O3 + 1024ull * 3072 * 2;
static_assert(W_END <= 58 * MiB, "weights region");
constexpr size_t WS_XN = 66 * MiB, WS_A = 114 * MiB, WS_BIG = 210 * MiB, WS_END = 370 * MiB;
constexpr size_t BIG_US = 80 * MiB, BIG_OB = 128 * MiB;
constexpr size_t OFF_YP = 0, OFF_YS = 8388608, OFF_C = 25165824, OFF_N = 29360128, OFF_M = 29392896, OFF_G = 29393408, OFF_H = 33587712;
constexpr int LDS_BYTES = 147456;

struct Args { const float* in[23]; float* out; unsigned char* ws; };
enum { I_XP = 0, I_XS, I_C, I_SC, I_SN, I_SM, I_SG, I_SH, I_CCTX, I_WADA, I_BADA, I_NPRE, I_NPOST, I_WFIN, I_WFOUT, I_WIN, I_GB, I_GWUP, I_GLB, I_HGAM, I_HN, I_WBR, I_WOUT };
__device__ __forceinline__ const float* inp(const Args& a, int i) { asm volatile("" : "+s"(i)); return a.in[i]; }

__device__ __forceinline__ unsigned f2bf(float f) { unsigned u = __float_as_uint(f); return (u + 0x7fffu + ((u >> 16) & 1u)) >> 16; }
__device__ __forceinline__ unsigned pk2(float lo, float hi) { return f2bf(lo) | (f2bf(hi) << 16); }
__device__ __forceinline__ float bf2f(bf16_t h) { return __uint_as_float(((unsigned)h) << 16); }
__device__ __forceinline__ float bflo(unsigned w) { return __uint_as_float(w << 16); }
__device__ __forceinline__ float bfhi(unsigned w) { return __uint_as_float(w & 0xffff0000u); }
__device__ __forceinline__ float sigmoidf_(float x) { return 1.0f / (1.0f + __expf(-x)); }
__device__ __forceinline__ float siluf_(float x) { return x / (1.0f + __expf(-x)); }
__device__ __forceinline__ float logsigf_(float x) { return fminf(x, 0.f) - __logf(1.0f + __expf(-fabsf(x))); }
__device__ __forceinline__ float wave_sum(float v) {
#pragma unroll
    for (int o = 1; o < 64; o <<= 1) v += __shfl_xor(v, o);
    return v;
}
#define LDS_WAIT() asm volatile("s_waitcnt lgkmcnt(0)" ::: "memory")

struct EpiBf16 {
    static constexpr bool PERM = true, AFTER_DRAIN = false;
    bf16_t* O; int ldc;
    __device__ __forceinline__ void operator()(const f32x4 (&acc)[2][2][4][2], const pg8::Unit& u, int wr, int wc, int fr, int fq) const {
        const int row0 = u.pm * 256 + wr * 64 + fr, col0 = u.pn * 256 + wc * 32 + 8 * fq;
#pragma unroll
        for (int ai = 0; ai < 2; ++ai)
#pragma unroll
            for (int m = 0; m < 4; ++m) { bf16_t* rowp = O + (size_t)(row0 + ai * 128 + m * 16) * ldc + col0;
#pragma unroll
                for (int bj = 0; bj < 2; ++bj) { const f32x4 v0 = acc[ai][bj][m][0], v1 = acc[ai][bj][m][1];
                    u32x4 w; w.x = pk2(v0[0], v0[1]); w.y = pk2(v0[2], v0[3]); w.z = pk2(v1[0], v1[1]); w.w = pk2(v1[2], v1[3]);
                    *(u32x4*)(rowp + bj * 128) = w; } }
    }
};
struct EpiGateMul {
    static constexpr bool PERM = true, AFTER_DRAIN = false;
    bf16_t* O; int ldc;
    __device__ __forceinline__ void operator()(const f32x4 (&acc)[2][2][4][2], const pg8::Unit& u, int wr, int wc, int fr, int fq) const {
        const int row0 = u.pm * 256 + wr * 64 + fr, col0 = u.pn * 256 + wc * 32 + 8 * fq;
#pragma unroll
        for (int ai = 0; ai < 2; ++ai)
#pragma unroll
            for (int m = 0; m < 4; ++m) { bf16_t* rowp = O + (size_t)(row0 + ai * 128 + m * 16) * ldc + col0;
#pragma unroll
                for (int bj = 0; bj < 2; ++bj) { const f32x4 v0 = acc[ai][bj][m][0], v1 = acc[ai][bj][m][1];
                    const u32x4 b = *(const u32x4*)(rowp + bj * 128);
                    u32x4 w; w.x = pk2(sigmoidf_(v0[0]) * bflo(b.x), sigmoidf_(v0[1]) * bfhi(b.x)); w.y = pk2(sigmoidf_(v0[2]) * bflo(b.y), sigmoidf_(v0[3]) * bfhi(b.y));
                    w.z = pk2(sigmoidf_(v1[0]) * bflo(b.z), sigmoidf_(v1[1]) * bfhi(b.z)); w.w = pk2(sigmoidf_(v1[2]) * bflo(b.w), sigmoidf_(v1[3]) * bfhi(b.w));
                    *(u32x4*)(rowp + bj * 128) = w; } }
    }
};
struct EpiSwiGLU {
    static constexpr bool PERM = true, AFTER_DRAIN = false;
    bf16_t* H; int ldh;
    __device__ __forceinline__ void operator()(const f32x4 (&acc)[2][2][4][2], const pg8::Unit& u, int wr, int wc, int fr, int fq) const {
        const int row0 = u.pm * 256 + wr * 64 + fr, col0 = (u.pn * 256 + wc * 32 + 8 * fq) >> 1;
#pragma unroll
        for (int ai = 0; ai < 2; ++ai)
#pragma unroll
            for (int m = 0; m < 4; ++m) { bf16_t* rowp = H + (size_t)(row0 + ai * 128 + m * 16) * ldh + col0;
#pragma unroll
                for (int bj = 0; bj < 2; ++bj) { const f32x4 g = acc[ai][bj][m][0], up = acc[ai][bj][m][1];
                    u32x2 w; w.x = pk2(siluf_(g[0]) * up[0], siluf_(g[1]) * up[1]); w.y = pk2(siluf_(g[2]) * up[2], siluf_(g[3]) * up[3]);
                    *(u32x2*)(rowp + bj * 64) = w; } }
    }
};
struct EpiF32 {
    static constexpr bool PERM = false, AFTER_DRAIN = false;
    float* Y; int ldc;
    __device__ __forceinline__ void operator()(const f32x4 (&acc)[2][2][4][2], const pg8::Unit& u, int wr, int wc, int fr, int fq) const {
        const int row0 = u.pm * 256 + wr * 64 + fr, col0 = u.pn * 256 + wc * 32 + 4 * fq;
#pragma unroll
        for (int ai = 0; ai < 2; ++ai)
#pragma unroll
            for (int m = 0; m < 4; ++m) { float* rowp = Y + (size_t)(row0 + ai * 128 + m * 16) * ldc + col0;
#pragma unroll
                for (int bj = 0; bj < 2; ++bj)
#pragma unroll
                    for (int n = 0; n < 2; ++n) *(f32x4*)(rowp + bj * 128 + n * 16) = acc[ai][bj][m][n]; }
    }
};

template <class Map>
__device__ __forceinline__ void transpose_item(const float* W, int K, int N, LAS float* scr, int item, int lane, const Map& map) {
    const int nblk = (N + 31) / 32, kb = item / nblk, nb = item % nblk, k0 = 64 * kb, n0 = 32 * nb;
    const int nn = n0 + (lane & 31); const bool ok = nn < N;
#pragma unroll 8
    for (int i = 0; i < 32; ++i) { const int kk = 2 * i + (lane >> 5); scr[kk * 33 + (lane & 31)] = ok ? W[(size_t)(k0 + kk) * N + nn] : 0.f; }
    LDS_WAIT(); asm volatile("" ::: "memory");
    const int c = lane & 7;
#pragma unroll
    for (int j = 0; j < 4; ++j) { const int n = (lane >> 3) + 8 * j; const LAS float* s = scr + (8 * c) * 33 + n;
        u32x4 o; o.x = pk2(s[0 * 33], s[1 * 33]); o.y = pk2(s[2 * 33], s[3 * 33]); o.z = pk2(s[4 * 33], s[5 * 33]); o.w = pk2(s[6 * 33], s[7 * 33]);
        if (n0 + n < N) map(n0 + n, k0 + 8 * c, o); }
    LDS_WAIT(); asm volatile("" ::: "memory");
}

__device__ __forceinline__ void convert_weights(const Args& a, LAS unsigned char* lds, int l, int gw, int NGW, int lane, int wave) {
    LAS float* scr = (LAS float*)(lds + wave * 16384);
    unsigned char* wb = a.ws + WS_W;
    constexpr int I_FI = 16 * 176, I_FO = 44 * 32, I_IN = 16 * 250, I_BR = 8 * 32, I_OU = 16 * 32;
    constexpr int NITEMS = 2 * I_FI + 2 * I_FO + I_IN + 3 * I_BR + I_OU;
    for (int it = gw; it < NITEMS; it += NGW) {
        int r = it;
        if (r < 2 * I_FI) { const int f = r / I_FI; r -= f * I_FI; bf16_t* dst = (bf16_t*)(wb + W_FFIN) + (size_t)f * NFF2 * D;
            transpose_item(inp(a, I_WFIN) + (size_t)(l * 2 + f) * D * NFF2, D, NFF2, scr, r, lane,
                [=](int n, int k, u32x4 o) { const int h = n < DFF ? n : n - DFF; const int row = 8 * (h >> 2) + (n < DFF ? 0 : 4) + (h & 3); *(u32x4*)(dst + (size_t)row * D + k) = o; });
            continue; }
        r -= 2 * I_FI;
        if (r < 2 * I_FO) { const int f = r / I_FO; r -= f * I_FO; bf16_t* dst = (bf16_t*)(wb + W_FFOUT) + (size_t)f * D * DFF;
            transpose_item(inp(a, I_WFOUT) + (size_t)(l * 2 + f) * DFF * D, DFF, D, scr, r, lane,
                [=](int n, int k, u32x4 o) { *(u32x4*)(dst + (size_t)n * DFF + k) = o; });
            continue; }
        r -= 2 * I_FO;
        if (r < I_IN) { bf16_t* dp = (bf16_t*)(wb + W_P); bf16_t* dm = (bf16_t*)(wb + W_MG);
            transpose_item(inp(a, I_WIN) + (size_t)l * D * INC, D, INC, scr, r, lane,
                [=](int n, int k, u32x4 o) { if (n < PREAL) *(u32x4*)(dp + (size_t)n * D + k) = o; else *(u32x4*)(dm + (size_t)(n - PREAL) * D + k) = o; });
            continue; }
        r -= I_IN;
        if (r < 3 * I_BR) { const int nb = r / I_BR; r -= nb * I_BR; bf16_t* dst = (bf16_t*)(wb + W_B) + (size_t)nb * 1024 * 512;
            transpose_item(inp(a, I_WBR) + (size_t)(l * 3 + nb) * 512 * D, 512, D, scr, r, lane,
                [=](int n, int k, u32x4 o) { *(u32x4*)(dst + (size_t)n * 512 + k) = o; });
            continue; }
        r -= 3 * I_BR;
        { bf16_t* dst = (bf16_t*)(wb + W_O3);
            transpose_item(inp(a, I_WOUT) + (size_t)l * D * D, D, D, scr, r, lane,
                [=](int n, int k, u32x4 o) { bf16_t* p = dst + (size_t)n * 3072 + k; *(u32x4*)p = o; *(u32x4*)(p + 1024) = o; *(u32x4*)(p + 2048) = o; }); }
    }
    { u32x4* z = (u32x4*)((bf16_t*)(wb + W_P) + (size_t)PREAL * D); const int nz = (PN - PREAL) * D * 2 / 16;
      for (int i = gw * 64 + lane; i < nz; i += NGW * 64) z[i] = (u32x4){0u, 0u, 0u, 0u}; }
}

__device__ __forceinline__ void ada_partial(const Args& a, int gw, int NGW, int lane) {
    float* modp = (float*)(a.ws + WS_MODP);
    for (int it = gw; it < 2 * 144 * 8; it += NGW) {
        const int ks = it & 7, cgp = (it >> 3) % 144, l = it / (8 * 144);
        const int col = cgp * 64 + lane;
        const float* w = inp(a, I_WADA) + ((size_t)l * D + ks * 128) * 9216 + col;
        float acc[5] = {0.f, 0.f, 0.f, 0.f, 0.f};
#pragma unroll 4
        for (int k = 0; k < 128; ++k) { const float wv = w[(size_t)k * 9216]; const int kk = ks * 128 + k;
            acc[0] += siluf_(inp(a, I_CCTX)[kk]) * wv;
#pragma unroll
            for (int i = 0; i < 4; ++i) acc[1 + i] += siluf_(inp(a, I_C)[i * D + kk]) * wv; }
#pragma unroll
        for (int i = 0; i < 5; ++i) modp[((size_t)(ks * 2 + l) * 5 + i) * 9216 + col] = acc[i];
    }
}

struct RowOp { int src_input, has_y; float coef; const float* npost; const float* mdg_base; int has_xn; const float* npre; const float* md_base; int si; int add_pos; };
__device__ __forceinline__ void rowwise(const Args& a, const RowOp& op, int r, int lane) {
    const bool lat = r < MLAT; const int cv = lat ? 1 + (r >> 12) : 0;
    const float* xs = op.src_input ? (lat ? inp(a, I_XS) + (size_t)r * D : inp(a, I_XP) + (size_t)(r - MLAT) * D)
                                   : (lat ? a.out + OFF_YS + (size_t)r * D : a.out + OFF_YP + (size_t)(r - MLAT) * D);
    float* xd = lat ? a.out + OFF_YS + (size_t)r * D : a.out + OFF_YP + (size_t)(r - MLAT) * D;
    f32x4 v[4];
#pragma unroll
    for (int j = 0; j < 4; ++j) v[j] = *(const f32x4*)(xs + 4 * lane + 256 * j);
    if (op.has_y) {
        const float* yr = (const float*)(a.ws + WS_A) + (size_t)r * D; f32x4 y[4]; float ss = 0.f;
#pragma unroll
        for (int j = 0; j < 4; ++j) { y[j] = *(const f32x4*)(yr + 4 * lane + 256 * j); ss += (y[j].x * y[j].x + y[j].y * y[j].y) + (y[j].z * y[j].z + y[j].w * y[j].w); }
        const float rr = rsqrtf(wave_sum(ss) * (1.f / D) + EPSN) * op.coef;
        const float* gp = op.mdg_base + (size_t)cv * 9216;
#pragma unroll
        for (int j = 0; j < 4; ++j) { const f32x4 w = *(const f32x4*)(op.npost + 4 * lane + 256 * j), gg = *(const f32x4*)(gp + 4 * lane + 256 * j);
            v[j] = v[j] + gg * (y[j] * rr) * w; *(f32x4*)(xd + 4 * lane + 256 * j) = v[j]; }
    }
    if (op.has_xn) {
        float ss = 0.f;
#pragma unroll
        for (int j = 0; j < 4; ++j) ss += (v[j].x * v[j].x + v[j].y * v[j].y) + (v[j].z * v[j].z + v[j].w * v[j].w);
        const float rr = rsqrtf(wave_sum(ss) * (1.f / D) + EPSN);
        const float* sh = op.md_base + (size_t)cv * 9216 + (size_t)op.si * D; const float* sc = sh + D;
        const float* pos = (const float*)(a.ws + WS_POS); const int t = r & 4095;
        bf16_t* xo = (bf16_t*)(a.ws + WS_XN) + (size_t)r * D;
#pragma unroll
        for (int j = 0; j < 4; ++j) { const int c = 4 * lane + 256 * j; const f32x4 w = *(const f32x4*)(op.npre + c), s1 = *(const f32x4*)(sc + c), s0 = *(const f32x4*)(sh + c);
            f32x4 o = (v[j] * rr) * w * (s1 + 1.0f) + s0;
            if (op.add_pos && lat) { const float* pp = (c < 512) ? pos + (size_t)(t >> 6) * 512 + c : pos + (size_t)(t & 63) * 512 + (c - 512); o = o + *(const f32x4*)pp; }
            u32x2 pk; pk.x = pk2(o.x, o.y); pk.y = pk2(o.z, o.w); *(u32x2*)(xo + c) = pk; }
    }
}

constexpr int C_MQ = 0, C_MK = 256, C_MV = 512, C_MO = 1024, C_MIF = 1536, C_GQ = 1552, C_GK = 1808, C_GV = 2064, C_GR = 2576, C_GLR = 3088, C_HQ = 3120, C_HF = 3376, C_HV = 3888, C_HG = 4400;

struct ItemInfo { int br, dir, head, seq, c, T, NC; };
__device__ __forceinline__ ItemInfo item_info(int g, int it) { ItemInfo I; const int hdb = it % 24, cgl = it / 24; I.br = hdb >> 3; I.dir = (hdb >> 2) & 1; I.head = hdb & 3;
    I.T = g < 2 ? 4096 : 256; I.NC = I.T >> 6; I.seq = cgl / I.NC; I.c = cgl % I.NC; return I; }
__device__ __forceinline__ int item_row(const ItemInfo& I, int s) { const int tau = I.c * 64 + s; return I.seq * I.T + (I.dir ? I.T - 1 - tau : tau); }
__device__ __forceinline__ float lb_of(const Args& a, int l, int ch) { if (l == 0) return 0.f; const float g0 = inp(a, I_HGAM)[ch], g1 = inp(a, I_HGAM)[256 + ch]; return 1.0f / (1.0f + expf(g0 - g1)); }

template <bool NEEDQ>
__device__ __forceinline__ void load_gated(const Args& a, const bf16_t* P, const ItemInfo& I, int l, int d, int sg, float (&qv)[8], float (&kv)[8], float (&la)[8]) {
    const int ch = I.head * 64 + d;
    if (I.br == 1) {
        float wup[16];
        const float* wp = inp(a, I_GWUP) + ((size_t)(l * 2 + I.dir) * 16) * 256 + ch;
#pragma unroll
        for (int r = 0; r < 16; ++r) wup[r] = wp[r * 256];
        const float gb = inp(a, I_GLB)[(l * 2 + I.dir) * 256 + ch];
#pragma unroll
        for (int i = 0; i < 8; ++i) { const bf16_t* pr = P + (size_t)item_row(I, 8 * sg + i) * PN;
            const u32x4 g0 = *(const u32x4*)(pr + C_GLR + I.dir * 16), g1 = *(const u32x4*)(pr + C_GLR + I.dir * 16 + 8);
            float z = gb;
            z += bflo(g0.x) * wup[0] + bfhi(g0.x) * wup[1] + bflo(g0.y) * wup[2] + bfhi(g0.y) * wup[3] + bflo(g0.z) * wup[4] + bfhi(g0.z) * wup[5] + bflo(g0.w) * wup[6] + bfhi(g0.w) * wup[7];
            z += bflo(g1.x) * wup[8] + bfhi(g1.x) * wup[9] + bflo(g1.y) * wup[10] + bfhi(g1.y) * wup[11] + bflo(g1.z) * wup[12] + bfhi(g1.z) * wup[13] + bflo(g1.w) * wup[14] + bfhi(g1.w) * wup[15];
            la[i] = logsigf_(z) * (1.0f / 16.0f);
            if (NEEDQ) qv[i] = bf2f(pr[C_GQ + ch]) * 0.125f; kv[i] = bf2f(pr[C_GK + ch]); }
    } else {
        const float lb = lb_of(a, l, ch);
#pragma unroll
        for (int i = 0; i < 8; ++i) { const bf16_t* pr = P + (size_t)item_row(I, 8 * sg + i) * PN;
            const float z = bf2f(pr[C_HF + I.dir * 256 + ch]); const float sg_ = sigmoidf_(z);
            la[i] = (lb == 0.f) ? logsigf_(z) : __logf(lb + (1.0f - lb) * sg_);
            if (NEEDQ) qv[i] = bf2f(pr[C_HQ + ch]) * 1.0f;
            kv[i] = (1.0f - lb) * (1.0f - sg_); }
    }
}
template <bool NEEDQ>
__device__ __forceinline__ void load_mlstm(const Args& a, const bf16_t* P, const ItemInfo& I, int l, int d, int sg, float (&qv)[8], float (&kv)[8], float (&lf)[8], float (&li)[8]) {
    const float bi = inp(a, I_GB)[((l * 2 + I.dir) * 2 + 0) * 4 + I.head], bf_ = inp(a, I_GB)[((l * 2 + I.dir) * 2 + 1) * 4 + I.head];
#pragma unroll
    for (int i = 0; i < 8; ++i) { const bf16_t* pr = P + (size_t)item_row(I, 8 * sg + i) * PN;
        li[i] = bf2f(pr[C_MIF + I.dir * 8 + I.head]) + bi; lf[i] = logsigf_(bf2f(pr[C_MIF + I.dir * 8 + 4 + I.head]) + bf_);
        if (NEEDQ) qv[i] = bf2f(pr[C_MQ + I.head * 64 + d]) * 0.125f; kv[i] = bf2f(pr[C_MK + I.head * 64 + d]); }
}
__device__ __forceinline__ void stage_vT(const bf16_t* P, const ItemInfo& I, LAS bf16_t* Y, int pitch, int tid) {
    const int s = tid >> 3, eg = tid & 7; const int vb = I.br == 0 ? C_MV : (I.br == 1 ? C_GV : C_HV);
    const bf16_t* pv = P + (size_t)item_row(I, s) * PN + vb + I.head * 128 + 16 * eg;
    const u32x4 v0 = *(const u32x4*)pv, v1 = *(const u32x4*)(pv + 8);
    const unsigned wds[8] = {v0.x, v0.y, v0.z, v0.w, v1.x, v1.y, v1.z, v1.w};
#pragma unroll
    for (int i = 0; i < 8; ++i) { float x0 = bflo(wds[i]), x1 = bfhi(wds[i]); if (I.br == 2) { x0 = siluf_(x0); x1 = siluf_(x1); }
        Y[(16 * eg + 2 * i) * pitch + s] = (bf16_t)f2bf(x0); Y[(16 * eg + 2 * i + 1) * pitch + s] = (bf16_t)f2bf(x1); }
}
__device__ __forceinline__ bf16x8 ldfrag(const LAS bf16_t* T, int pitch, int row0, int k0, int lane) { return *(const LAS bf16x8*)(T + (row0 + (lane & 15)) * pitch + k0 + 8 * (lane >> 4)); }

__device__ __forceinline__ void scan_s1(const Args& a, LAS unsigned char* lds, int l, int g, int it) {
    int tid_ = threadIdx.x; asm volatile("" : "+v"(tid_)); const int tid = tid_, d = tid & 63, lane = d, sg = __builtin_amdgcn_readfirstlane(tid >> 6);
    const ItemInfo I = item_info(g, it);
    const bf16_t* P = (const bf16_t*)(a.ws + WS_BIG);
    bf16_t* US = (bf16_t*)(a.ws + WS_BIG + BIG_US) + (size_t)it * 8192;
    float* DEC = (float*)(a.ws + WS_DEC) + (size_t)it * 64; float* SC = (float*)(a.ws + WS_SC) + (size_t)it * 4;
    LAS bf16_t* XT = (LAS bf16_t*)lds;
    LAS bf16_t* YV = (LAS bf16_t*)(lds + 9216);
    LAS float* TOT = (LAS float*)(lds + 9216 + 20736);
    LAS float* TMX = TOT + 512;
    float qv[8], kv[8], x0[8], x1[8];
    if (I.br == 0) {
        load_mlstm<false>(a, P, I, l, d, sg, qv, kv, x0, x1);
        float run = 0.f;
#pragma unroll
        for (int i = 0; i < 8; ++i) { run += x0[i]; x0[i] = run; }
        TOT[sg * 64 + d] = run; LDS_WAIT(); __syncthreads();
        float pre = 0.f, tot = 0.f;
#pragma unroll
        for (int w = 0; w < 8; ++w) { const float t = TOT[w * 64 + d]; if (w < sg) pre += t; tot += t; }
        float mx = -3.0e38f;
#pragma unroll
        for (int i = 0; i < 8; ++i) { x0[i] = tot - (pre + x0[i]) + x1[i]; mx = fmaxf(mx, x0[i]); }
        TMX[sg * 64 + d] = mx; LDS_WAIT(); __syncthreads();
        float mlw = -3.0e38f;
#pragma unroll
        for (int w = 0; w < 8; ++w) mlw = fmaxf(mlw, TMX[w * 64 + d]);
#pragma unroll
        for (int i = 0; i < 8; ++i) kv[i] *= __expf(x0[i] - mlw);
        if (tid == 0) { SC[0] = mlw; SC[1] = tot; }
        for (int idx = tid; idx < 16 * 64; idx += 512) YV[(128 + (idx >> 6)) * 72 + (idx & 63)] = (bf16_t)((idx >> 6) == 0 ? 0x3F80 : 0);
    } else {
        load_gated<false>(a, P, I, l, d, sg, qv, kv, x0);
        float run = 0.f;
#pragma unroll
        for (int i = 0; i < 8; ++i) { run += x0[i]; x0[i] = run; }
        TOT[sg * 64 + d] = run; LDS_WAIT(); __syncthreads();
        float pre = 0.f, tot = 0.f;
#pragma unroll
        for (int w = 0; w < 8; ++w) { const float t = TOT[w * 64 + d]; if (w < sg) pre += t; tot += t; }
#pragma unroll
        for (int i = 0; i < 8; ++i) kv[i] *= __expf(tot - (pre + x0[i]));
        if (sg == 0) DEC[d] = __expf(tot);
    }
    { u32x4 w; w.x = pk2(kv[0], kv[1]); w.y = pk2(kv[2], kv[3]); w.z = pk2(kv[4], kv[5]); w.w = pk2(kv[6], kv[7]); *(LAS u32x4*)(XT + d * 72 + 8 * sg) = w; }
    stage_vT(P, I, YV, 72, tid);
    LDS_WAIT(); __syncthreads();
    f32x4 acc[4];
#pragma unroll
    for (int mt = 0; mt < 4; ++mt) acc[mt] = (f32x4){0.f, 0.f, 0.f, 0.f};
#pragma unroll
    for (int ks = 0; ks < 2; ++ks) { const bf16x8 b = ldfrag(YV, 72, 16 * sg, 32 * ks, lane);
#pragma unroll
        for (int mt = 0; mt < 4; ++mt) acc[mt] = __builtin_amdgcn_mfma_f32_16x16x32_bf16(ldfrag(XT, 72, 16 * mt, 32 * ks, lane), b, acc[mt], 0, 0, 0); }
    { const int e = 16 * sg + (lane & 15);
#pragma unroll
      for (int mt = 0; mt < 4; ++mt) { u32x2 o; o.x = pk2(acc[mt][0], acc[mt][1]); o.y = pk2(acc[mt][2], acc[mt][3]); *(u32x2*)(US + e * 64 + 16 * mt + 4 * (lane >> 4)) = o; } }
    if (I.br == 0 && sg < 4) {
        f32x4 an = (f32x4){0.f, 0.f, 0.f, 0.f};
#pragma unroll
        for (int ks = 0; ks < 2; ++ks) an = __builtin_amdgcn_mfma_f32_16x16x32_bf16(ldfrag(XT, 72, 16 * sg, 32 * ks, lane), ldfrag(YV, 72, 128, 32 * ks, lane), an, 0, 0, 0);
        if ((lane & 15) == 0) { const int d0 = 16 * sg + 4 * (lane >> 4); DEC[d0] = an[0]; DEC[d0 + 1] = an[1]; DEC[d0 + 2] = an[2]; DEC[d0 + 3] = an[3]; }
    }
    __syncthreads();
}

__device__ __forceinline__ void scan_s2(const Args& a, int l, int g) {
    const int T = g < 2 ? 4096 : 256, NC = T >> 6, nseq = g < 2 ? 2 : 32, nslot = nseq * 24 * 1024;
    bf16_t* USb = (bf16_t*)(a.ws + WS_BIG + BIG_US); float* DECb = (float*)(a.ws + WS_DEC); float* SCb = (float*)(a.ws + WS_SC);
    int tid_ = threadIdx.x; asm volatile("" : "+v"(tid_));
    for (int slot = blockIdx.x * 512 + tid_; slot < nslot; slot += gridDim.x * 512) {
        const int sub = slot & 1023, stream = slot >> 10, hdb = stream % 24, seq = stream / 24, br = hdb >> 3, dir = (hdb >> 2) & 1, head = hdb & 3;
        const int e = sub >> 3, d0 = (sub & 7) * 8;
        float S[8], nst[8], mst = 0.f;
#pragma unroll
        for (int i = 0; i < 8; ++i) { S[i] = 0.f; nst[i] = 0.f; }
        if (g < 2) { const int b = g * 2 + seq; const size_t sidx = (size_t)((b * 2 + l) * 2 + dir) * 4 + head;
            const float* sp = (br == 0 ? inp(a, I_SC) : (br == 1 ? inp(a, I_SG) : inp(a, I_SH))) + sidx * 8192;
#pragma unroll
            for (int i = 0; i < 8; ++i) S[i] = sp[(d0 + i) * 128 + e];
            if (br == 0) { mst = inp(a, I_SM)[sidx];
#pragma unroll
                for (int i = 0; i < 8; ++i) nst[i] = inp(a, I_SN)[sidx * 64 + d0 + i]; } }
        const bool nrow = (br == 0) && (e == 0);
        for (int c = 0; c < NC; ++c) {
            const size_t it = (size_t)(seq * NC + c) * 24 + hdb;
            bf16_t* p = USb + it * 8192 + e * 64 + d0; float* dec = DECb + it * 64 + d0; float* sc = SCb + it * 4;
            const u32x4 u = *(const u32x4*)p;
            const float uu[8] = {bflo(u.x), bfhi(u.x), bflo(u.y), bfhi(u.y), bflo(u.z), bfhi(u.z), bflo(u.w), bfhi(u.w)};
            { u32x4 w; w.x = pk2(S[0], S[1]); w.y = pk2(S[2], S[3]); w.z = pk2(S[4], S[5]); w.w = pk2(S[6], S[7]); *(u32x4*)p = w; }
            if (br == 0) {
                const float mlw = sc[0], bl = sc[1]; const float mn = fmaxf(bl + mst, mlw); const float fa = __expf(bl + mst - mn), fb = __expf(mlw - mn);
                if (nrow) { const f32x4 n0 = *(const f32x4*)dec, n1 = *(const f32x4*)(dec + 4);
                    *(f32x4*)dec = (f32x4){nst[0], nst[1], nst[2], nst[3]}; *(f32x4*)(dec + 4) = (f32x4){nst[4], nst[5], nst[6], nst[7]};
                    const float nn[8] = {n0.x, n0.y, n0.z, n0.w, n1.x, n1.y, n1.z, n1.w};
#pragma unroll
                    for (int i = 0; i < 8; ++i) nst[i] = fa * nst[i] + fb * nn[i];
                    if (d0 == 0) sc[2] = mst; }
#pragma unroll
                for (int i = 0; i < 8; ++i) S[i] = fa * S[i] + fb * uu[i];
                mst = mn;
            } else {
                const f32x4 q0 = *(const f32x4*)dec, q1 = *(const f32x4*)(dec + 4); const float dd[8] = {q0.x, q0.y, q0.z, q0.w, q1.x, q1.y, q1.z, q1.w};
#pragma unroll
                for (int i = 0; i < 8; ++i) S[i] = dd[i] * S[i] + uu[i];
            }
        }
        if (g == 2) { const size_t sidx = (size_t)((seq * 2 + l) * 2 + dir) * 4 + head;
            float* op = a.out + (br == 0 ? OFF_C : (br == 1 ? OFF_G : OFF_H)) + sidx * 8192;
#pragma unroll
            for (int i = 0; i < 8; ++i) op[(d0 + i) * 128 + e] = S[i];
            if (nrow) {
#pragma unroll
                for (int i = 0; i < 8; ++i) a.out[OFF_N + sidx * 64 + d0 + i] = nst[i];
                if (d0 == 0) a.out[OFF_M + sidx] = mst; } }
    }
}

constexpr int S3_QO = 0, S3_KO = 23040, S3_G = 41472, S3_XA = 57856, S3_YV = 75264, S3_TOT = 114432, S3_VEC = 116480;
__device__ __forceinline__ void scan_s3(const Args& a, LAS unsigned char* lds, int l, int g, int it) {
    int tid_ = threadIdx.x; asm volatile("" : "+v"(tid_)); const int tid = tid_, d = tid & 63, lane = d, sg = __builtin_amdgcn_readfirstlane(tid >> 6);
    const ItemInfo I = item_info(g, it);
    const bf16_t* P = (const bf16_t*)(a.ws + WS_BIG);
    const bf16_t* US = (const bf16_t*)(a.ws + WS_BIG + BIG_US) + (size_t)it * 8192;
    const float* DEC = (const float*)(a.ws + WS_DEC) + (size_t)it * 64; const float* SC = (const float*)(a.ws + WS_SC) + (size_t)it * 4;
    bf16_t* Od = I.dir == 0 ? (bf16_t*)(a.ws + WS_A) + (size_t)g * GROWS * 1536 : (bf16_t*)(a.ws + WS_BIG + BIG_OB);
    LAS bf16_t* QO = (LAS bf16_t*)(lds + S3_QO); LAS bf16_t* KO = (LAS bf16_t*)(lds + S3_KO); LAS float* G = (LAS float*)(lds + S3_G);
    LAS bf16_t* XA = (LAS bf16_t*)(lds + S3_XA); LAS bf16_t* YV = (LAS bf16_t*)(lds + S3_YV); LAS float* TOT = (LAS float*)(lds + S3_TOT);
    LAS float* Bv = (LAS float*)(lds + S3_VEC); LAS float* LIv = Bv + 64; LAS float* MT = Bv + 128; LAS float* EI = Bv + 192;
    float qv[8], kv[8], x0[8], x1[8];
    stage_vT(P, I, YV, 136, tid);
    { const int e = tid >> 2, part = tid & 3; const u32x4 s0 = *(const u32x4*)(US + e * 64 + 16 * part), s1 = *(const u32x4*)(US + e * 64 + 16 * part + 8);
      *(LAS u32x4*)(YV + e * 136 + 64 + 16 * part) = s0; *(LAS u32x4*)(YV + e * 136 + 64 + 16 * part + 8) = s1; }
    const int bi = sg >> 1;
    f32x4 acc[4];
#pragma unroll
    for (int nt = 0; nt < 4; ++nt) acc[nt] = (f32x4){0.f, 0.f, 0.f, 0.f};
    if (I.br != 0) {
        load_gated<true>(a, P, I, l, d, sg, qv, kv, x0);
        float run = 0.f;
#pragma unroll
        for (int i = 0; i < 8; ++i) { run += x0[i]; x0[i] = run; }
        TOT[sg * 64 + d] = run; LDS_WAIT(); __syncthreads();
        float pre = 0.f;
#pragma unroll
        for (int w = 0; w < 8; ++w) { const float t = TOT[w * 64 + d]; if (w < sg) pre += t; }
#pragma unroll
        for (int i = 0; i < 8; ++i) { x0[i] += pre; const int s = 8 * sg + i; G[s * 64 + d] = x0[i]; XA[s * 136 + 64 + d] = (bf16_t)f2bf(qv[i] * __expf(x0[i])); }
        LDS_WAIT(); __syncthreads();
        const float gs = bi ? G[(16 * bi - 1) * 64 + d] : 0.f, geo = G[(16 * bi + 15) * 64 + d];
        float gej[3];
#pragma unroll
        for (int j = 0; j < 3; ++j) gej[j] = G[(16 * j + 15) * 64 + d];
#pragma unroll
        for (int i = 0; i < 8; ++i) { const int tt = 8 * (sg & 1) + i;
            QO[(6 + bi) * 1152 + tt * 72 + d] = (bf16_t)f2bf(qv[i] * __expf(x0[i] - gs));
            KO[(4 + bi) * 1152 + tt * 72 + d] = (bf16_t)f2bf(kv[i] * __expf(fminf(gs - x0[i], 80.f)));
            KO[bi * 1152 + tt * 72 + d] = (bf16_t)f2bf(kv[i] * __expf(geo - x0[i]));
#pragma unroll
            for (int j = 0; j < 3; ++j) if (j < bi) QO[(bi * (bi - 1) / 2 + j) * 1152 + tt * 72 + d] = (bf16_t)f2bf(qv[i] * __expf(fminf(x0[i] - gej[j], 0.f))); }
        LDS_WAIT(); __syncthreads();
#pragma unroll
        for (int jj = 0; jj < 2; ++jj) { const int j = 2 * (sg & 1) + jj; f32x4 t = (f32x4){0.f, 0.f, 0.f, 0.f};
            if (j <= bi) { const int qt = (j == bi) ? 6 + bi : bi * (bi - 1) / 2 + j, kt = (j == bi) ? 4 + bi : j;
#pragma unroll
                for (int ks = 0; ks < 2; ++ks) t = __builtin_amdgcn_mfma_f32_16x16x32_bf16(ldfrag(QO + qt * 1152, 72, 0, 32 * ks, lane), ldfrag(KO + kt * 1152, 72, 0, 32 * ks, lane), t, 0, 0, 0); }
#pragma unroll
            for (int r = 0; r < 4; ++r) { const int tl = 4 * (lane >> 4) + r, sl = lane & 15; float v = t[r]; if (j == bi && sl > tl) v = 0.f;
                XA[(16 * bi + tl) * 136 + 16 * j + sl] = (bf16_t)f2bf(v); } }
        LDS_WAIT(); __syncthreads();
    } else {
        load_mlstm<true>(a, P, I, l, d, sg, qv, kv, x0, x1);
        float run = 0.f;
#pragma unroll
        for (int i = 0; i < 8; ++i) { run += x0[i]; x0[i] = run; }
        TOT[sg * 64 + d] = run;
        for (int idx = tid; idx < 16 * 128; idx += 512) { const int r = idx >> 7, k = idx & 127; YV[(128 + r) * 136 + k] = (bf16_t)(r == 0 ? (k < 64 ? 0x3F80u : f2bf(DEC[k - 64])) : 0u); }
        LDS_WAIT(); __syncthreads();
        float pre = 0.f;
#pragma unroll
        for (int w = 0; w < 8; ++w) { const float t = TOT[w * 64 + d]; if (w < sg) pre += t; }
#pragma unroll
        for (int i = 0; i < 8; ++i) { x0[i] += pre; const int s = 8 * sg + i; if (d == 0) { Bv[s] = x0[i]; LIv[s] = x1[i]; }
            QO[s * 72 + d] = (bf16_t)f2bf(qv[i]); KO[s * 72 + d] = (bf16_t)f2bf(kv[i]); }
        LDS_WAIT(); __syncthreads();
        if (tid < 64) { float rn = -3.0e38f; for (int s = 0; s <= tid; ++s) rn = fmaxf(rn, LIv[s] - Bv[s]);
            const float bt = Bv[tid], inter = bt + SC[2], mt = fmaxf(inter, bt + rn); MT[tid] = mt; EI[tid] = __expf(inter - mt); }
        f32x4 t2[2];
#pragma unroll
        for (int jj = 0; jj < 2; ++jj) { const int j = 2 * (sg & 1) + jj; t2[jj] = (f32x4){0.f, 0.f, 0.f, 0.f};
            if (j <= bi) {
#pragma unroll
                for (int ks = 0; ks < 2; ++ks) t2[jj] = __builtin_amdgcn_mfma_f32_16x16x32_bf16(ldfrag(QO, 72, 16 * bi, 32 * ks, lane), ldfrag(KO, 72, 16 * j, 32 * ks, lane), t2[jj], 0, 0, 0); } }
        LDS_WAIT(); __syncthreads();
#pragma unroll
        for (int jj = 0; jj < 2; ++jj) { const int j = 2 * (sg & 1) + jj;
#pragma unroll
            for (int r = 0; r < 4; ++r) { const int t = 16 * bi + 4 * (lane >> 4) + r, s = 16 * j + (lane & 15); float v = 0.f;
                if (s <= t) v = t2[jj][r] * __expf(Bv[t] - Bv[s] + LIv[s] - MT[t]);
                XA[t * 136 + s] = (bf16_t)f2bf(v); } }
#pragma unroll
        for (int i = 0; i < 8; ++i) { const int s = 8 * sg + i; XA[s * 136 + 64 + d] = (bf16_t)f2bf(qv[i] * EI[s]); }
        LDS_WAIT(); __syncthreads();
    }
    f32x4 accd[4];
#pragma unroll
    for (int nt = 0; nt < 4; ++nt) accd[nt] = (f32x4){0.f, 0.f, 0.f, 0.f};
#pragma unroll
    for (int ks = 0; ks < 4; ++ks) { const bf16x8 av = ldfrag(YV, 136, 16 * sg, 32 * ks, lane);
        bf16x8 ad = av; if (I.br == 0) ad = ldfrag(YV, 136, 128, 32 * ks, lane);
#pragma unroll
        for (int nt = 0; nt < 4; ++nt) { const bf16x8 bx = ldfrag(XA, 136, 16 * nt, 32 * ks, lane);
            acc[nt] = __builtin_amdgcn_mfma_f32_16x16x32_bf16(av, bx, acc[nt], 0, 0, 0);
            if (I.br == 0) accd[nt] = __builtin_amdgcn_mfma_f32_16x16x32_bf16(ad, bx, accd[nt], 0, 0, 0); } }
    const int ecol = I.br * 512 + I.head * 128 + 16 * sg + 4 * (lane >> 4);
#pragma unroll
    for (int nt = 0; nt < 4; ++nt) { const int t = 16 * nt + (lane & 15); f32x4 o = acc[nt];
        if (I.br == 0) { const float den = __shfl(accd[nt][0], lane & 15); const float dn = fmaxf(fabsf(den), __expf(-MT[t])); o = o * (1.0f / dn); }
        u32x2 w; w.x = pk2(o[0], o[1]); w.y = pk2(o[2], o[3]);
        *(u32x2*)(Od + (size_t)item_row(I, t) * 1536 + ecol) = w; }
    __syncthreads();
}

__device__ __forceinline__ void headnorm_row(const Args& a, int l, int g, int lr, int lane) {
    const bf16_t* P = (const bf16_t*)(a.ws + WS_BIG) + (size_t)lr * PN;
    bf16_t* of = (bf16_t*)(a.ws + WS_A) + ((size_t)g * GROWS + lr) * 1536; const bf16_t* ob = (const bf16_t*)(a.ws + WS_BIG + BIG_OB) + (size_t)lr * 1536;
#pragma unroll
    for (int br = 0; br < 3; ++br) { const int c = br * 512 + 8 * lane;
        const u32x4 f = *(const u32x4*)(of + c), b = *(const u32x4*)(ob + c);
        float o[8] = {bflo(f.x) + bflo(b.x), bfhi(f.x) + bfhi(b.x), bflo(f.y) + bflo(b.y), bfhi(f.y) + bfhi(b.y), bflo(f.z) + bflo(b.z), bfhi(f.z) + bfhi(b.z), bflo(f.w) + bflo(b.w), bfhi(f.w) + bfhi(b.w)};
        float ss = 0.f;
#pragma unroll
        for (int i = 0; i < 8; ++i) ss += o[i] * o[i];
        ss += __shfl_xor(ss, 1); ss += __shfl_xor(ss, 2); ss += __shfl_xor(ss, 4); ss += __shfl_xor(ss, 8);
        const float rr = rsqrtf(ss * (1.0f / 128.0f) + EPSN);
        const u32x4 gt = *(const u32x4*)(P + (br == 0 ? C_MO : (br == 1 ? C_GR : C_HG)) + 8 * lane);
        const float gv[8] = {bflo(gt.x), bfhi(gt.x), bflo(gt.y), bfhi(gt.y), bflo(gt.z), bfhi(gt.z), bflo(gt.w), bfhi(gt.w)};
        const float* hn = inp(a, I_HN) + (size_t)(l * 3 + br) * 512 + 8 * lane;
        const f32x4 h0 = *(const f32x4*)hn, h1 = *(const f32x4*)(hn + 4); const float hw[8] = {h0.x, h0.y, h0.z, h0.w, h1.x, h1.y, h1.z, h1.w};
        float y[8];
#pragma unroll
        for (int i = 0; i < 8; ++i) { const float gg = br == 0 ? sigmoidf_(gv[i]) : siluf_(gv[i]); y[i] = gg * (o[i] * rr) * hw[i]; }
        u32x4 w; w.x = pk2(y[0], y[1]); w.y = pk2(y[2], y[3]); w.z = pk2(y[4], y[5]); w.w = pk2(y[6], y[7]); *(u32x4*)(of + c) = w; }
}

template <int M_, int N_, int K_, int LDA_, int LDB_, int ADIV, int AMUL, class Epi>
__device__ __forceinline__ void run_gemm(LAS unsigned char* lds, const bf16_t* A, const bf16_t* Bt, const Epi& E) {
    typedef pg8::GemmT<M_, N_, K_, LDA_, LDB_> GT; GT g{A, Bt}; pg8::StaticOrderT<M_, N_, ADIV, AMUL> S; S.init((int)gridDim.x, (int)blockIdx.x);
    pg8::gemm_phase<GT, Epi, pg8::StaticOrderT<M_, N_, ADIV, AMUL>, true, true>((PG8_LAS unsigned char*)lds, g, S, E);
}

__global__ void __launch_bounds__(512, 2) mk_fwd(Args a) {
    extern __shared__ __attribute__((aligned(16))) unsigned char lds_raw[];
    LAS unsigned char* lds = (LAS unsigned char*)lds_raw;
    cg::grid_group grid = cg::this_grid();
    const int tid = threadIdx.x, lane = tid & 63, wave = __builtin_amdgcn_readfirstlane(tid >> 6);
    const int G = gridDim.x, gw = blockIdx.x * 8 + wave, NGW = G * 8;
    unsigned char* ws = a.ws;
    float* mod = (float*)(ws + WS_MOD);
    bf16_t* XN = (bf16_t*)(ws + WS_XN); bf16_t* BIG = (bf16_t*)(ws + WS_BIG); float* Y = (float*)(ws + WS_A); bf16_t* YS = (bf16_t*)(ws + WS_A);
    unsigned char* wb = ws + WS_W;

#ifndef SKIP_PRO
    convert_weights(a, lds, 0, gw, NGW, lane, wave);
    ada_partial(a, gw, NGW, lane);
    { float* pos = (float*)(ws + WS_POS);
      for (int i = blockIdx.x * 512 + tid; i < 64 * 512; i += G * 512) { const int v = i >> 9, j = i & 511, fi = j & 255;
          const float fr = expf((-9.210340371976184f * (float)fi) / 256.0f); const float ang = (float)v * fr; pos[i] = j < 256 ? sinf(ang) : cosf(ang); } }
    grid.sync();
    { const float* modp = (const float*)(ws + WS_MODP);
      for (int i = blockIdx.x * 512 + tid; i < 2 * 5 * 9216; i += G * 512) { const int col = i % 9216, l = i / (5 * 9216); float s = inp(a, I_BADA)[l * 9216 + col];
#pragma unroll
          for (int ks = 0; ks < 8; ++ks) s += modp[(size_t)ks * (2 * 5 * 9216) + i]; mod[i] = s; } }
    grid.sync();
    { RowOp op{}; op.src_input = 1; op.has_y = 0; op.has_xn = 1; op.npre = inp(a, I_NPRE); op.md_base = mod; op.si = 0; op.add_pos = 0;
      for (int r = gw; r < MTOT; r += NGW) rowwise(a, op, r, lane); }
    grid.sync();
#endif

    for (int l = 0; l < 2; ++l) {
        const float* modl = mod + (size_t)l * 5 * 9216;
        for (int st = 0; st < 25; ++st) {
            int tid = threadIdx.x; asm volatile("" : "+v"(tid));
            const int lane = tid & 63, wave = __builtin_amdgcn_readfirstlane(tid >> 6), gw = blockIdx.x * 8 + wave;
            const int kind = (st == 0 || st == 22) ? 0 : (st == 1 || st == 20 || st == 23) ? 1 : (st == 2 || st == 21 || st == 24) ? 2 : (st == 18) ? 3 : (st == 19) ? 4 : 5 + ((st - 3) % 5);
            const int g = (st >= 3 && st < 18) ? (st - 3) / 5 : 0;
            switch (kind) {
            case 0: {
#ifndef SKIP_G0
                const int f = st == 0 ? 0 : 1; EpiSwiGLU E{BIG, DFF};
                run_gemm<MTOT, NFF2, D, D, D, 0, 0>(lds, XN, (const bf16_t*)(wb + W_FFIN) + (size_t)f * NFF2 * D, E);
#endif
                break; }
            case 1: {
#ifndef SKIP_G1
                EpiF32 E{Y, D};
                if (st == 20) run_gemm<MTOT, D, 3072, 3072, 3072, 0, 0>(lds, BIG, (const bf16_t*)(wb + W_O3), E);
                else run_gemm<MTOT, D, DFF, DFF, DFF, 0, 0>(lds, BIG, (const bf16_t*)(wb + W_FFOUT) + (size_t)(st == 1 ? 0 : 1) * D * DFF, E);
#endif
                break; }
            case 2: {
#ifndef SKIP_ROW
                RowOp op{}; op.has_y = 1; op.mdg_base = modl + (st == 2 ? 2 : st == 21 ? 5 : 8) * D; op.coef = st == 21 ? 1.0f : 0.5f;
                op.npost = inp(a, I_NPOST) + (size_t)(l * 3 + (st == 2 ? 0 : st == 21 ? 1 : 2)) * D; op.src_input = (l == 0 && st == 2) ? 1 : 0;
                if (st == 2) { op.has_xn = 1; op.npre = inp(a, I_NPRE) + (size_t)(l * 3 + 1) * D; op.md_base = modl; op.si = 3; op.add_pos = 1; }
                else if (st == 21) { op.has_xn = 1; op.npre = inp(a, I_NPRE) + (size_t)(l * 3 + 2) * D; op.md_base = modl; op.si = 6; op.add_pos = 0; }
                else { op.has_xn = (l == 0) ? 1 : 0; op.npre = inp(a, I_NPRE) + (size_t)3 * D; op.md_base = mod + (size_t)5 * 9216; op.si = 0; op.add_pos = 0; }
                for (int r = gw; r < MTOT; r += NGW) rowwise(a, op, r, lane);
                if (st == 24 && l == 0) { __syncthreads(); convert_weights(a, lds, 1, gw, NGW, lane, wave); }
#endif
                break; }
            case 3: {
#ifndef SKIP_G3
                EpiBf16 E{BIG, 3072};
                run_gemm<MTOT, 3072, 512, 1536, 512, 4, 512>(lds, YS, (const bf16_t*)(wb + W_B), E);
#endif
                break; }
            case 4: {
#ifndef SKIP_G4
                EpiGateMul E{BIG, 3072};
                run_gemm<MTOT, MGN, D, D, D, 0, 0>(lds, XN, (const bf16_t*)(wb + W_MG), E);
#endif
                break; }
            case 5: {
#ifndef SKIP_G3
                EpiBf16 E{BIG, PN};
                run_gemm<GROWS, PN, D, D, D, 0, 0>(lds, XN + (size_t)g * GROWS * D, (const bf16_t*)(wb + W_P), E);
#endif
                break; }
            case 6: {
#ifndef SKIP_S1
                for (int it = blockIdx.x; it < 3072; it += G) scan_s1(a, lds, l, g, it);
#endif
                break; }
            case 7: {
#ifndef SKIP_S2
                scan_s2(a, l, g);
#endif
                break; }
            case 8: {
#ifndef SKIP_S3
                for (int it = blockIdx.x; it < 3072; it += G) scan_s3(a, lds, l, g, it);
#endif
                break; }
            default: {
#ifndef SKIP_HN
                for (int lr = gw; lr < GROWS; lr += NGW) headnorm_row(a, l, g, lr, lane);
#endif
                break; }
            }
            grid.sync();
        }
    }
}

extern "C" void kernel_launch(void* const* d_in, const int* in_sizes, int n_in, void* d_out, int out_size, void* d_ws, size_t ws_size, hipStream_t stream) {
    static int grid = 0;
    if (grid == 0) {
        if (n_in != 23 || ws_size < WS_END) { fprintf(stderr, "kernel_launch: unexpected n_in %d / ws_size %zu (need %zu)\n", n_in, ws_size, (size_t)WS_END); grid = -1; return; }
        int dev = 0, cus = 0, per_cu = 0;
        hipGetDevice(&dev); hipDeviceGetAttribute(&cus, hipDeviceAttributeMultiprocessorCount, dev);
        hipFuncSetAttribute((const void*)mk_fwd, hipFuncAttributeMaxDynamicSharedMemorySize, LDS_BYTES);
        hipOccupancyMaxActiveBlocksPerMultiprocessor(&per_cu, (const void*)mk_fwd, 512, LDS_BYTES);
        (void)hipGetLastError();
        if (per_cu < 1) per_cu = 1;
        grid = cus;
    }
    if (grid < 0) return;
    Args a{};
    for (int i = 0; i < 23; ++i) a.in[i] = (const float*)d_in[i];
    a.out = (float*)d_out; a.ws = (unsigned char*)d_ws;
    void* args[] = {&a};
    hipError_t e = hipLaunchCooperativeKernel((const void*)mk_fwd, dim3(grid), dim3(512), args, LDS_BYTES, stream);
    if (e != hipSuccess) fprintf(stderr, "cooperative launch failed: %s (grid %d)\n", hipGetErrorString(e), grid);
}
```

```cpp
#include <hip/hip_runtime.h>
#include <hip/hip_cooperative_groups.h>
#include <cstdio>
#include <cstdint>
namespace cg = cooperative_groups;

namespace pg8 {
#define PG8_LAS __attribute__((address_space(3)))
typedef unsigned short bf16_t;
typedef short bf16x8 __attribute__((ext_vector_type(8)));
typedef float f32x4 __attribute__((ext_vector_type(4)));
typedef unsigned u32x4 __attribute__((ext_vector_type(4)));
typedef unsigned u32x2 __attribute__((ext_vector_type(2)));
constexpr int BM = 256, BK = 64, HALF = 128, HTB = HALF * BK * 2, STAGE_BYTES = 8 * HTB, NXCD = 8, WGM = 8;

__host__ __device__ __forceinline__ int lds_byte(int r, int c) { const int st = (r >> 4) * 2 + (c >> 5), rr = r & 15, cc = c & 31, ob = rr * 64 + cc * 2; return st * 1024 + (ob ^ (((ob >> 9) & 1) << 5)); }
__host__ __device__ __forceinline__ void stage_rc(int b, int& R, int& C) { const int st = b / 1024, sb = b % 1024, swz = sb ^ (((sb >> 9) & 1) << 5); R = (st >> 1) * 16 + swz / 64; C = (st & 1) * 32 + (swz % 64) / 2; }
__host__ __device__ __forceinline__ int perm32(int rho) { const int n = rho >> 4, i = rho & 15; return 8 * (i >> 2) + 4 * n + (i & 3); }

struct Unit { int pm, pn; };
template <int M_, int N_, int K_, int LDA_, int LDB_> struct GemmT { const bf16_t* A; const bf16_t* Bt; static constexpr int M = M_, N = N_, K = K_, lda = LDA_, ldb = LDB_; };

template <int M_, int N_, int ADIV, int AMUL> struct StaticOrderT {
    static constexpr int nM = M_ / BM, nN = N_ / BM, nwg = nM * nN;
    int G, c;
    __device__ void init(int G_, int c_) { G = G_; c = c_; }
    __device__ __forceinline__ bool next(int i, Unit& u) const {
        const int L = i * G + c; if (L >= nwg) return false;
        int wgid = L; { constexpr int q = nwg / NXCD, r = nwg % NXCD; const int xcd = wgid % NXCD, off = wgid / NXCD; wgid = (xcd < r ? xcd * (q + 1) : r * (q + 1) + (xcd - r) * q) + off; }
        constexpr int nig = WGM * nN; const int gid = wgid / nig, fm = gid * WGM, gsz = (nM - fm) < WGM ? (nM - fm) : WGM;
        u.pm = fm + ((wgid % nig) % gsz); u.pn = (wgid % nig) / gsz; return true;
    }
    __device__ __forceinline__ int a_off(const Unit& u) const { return ADIV > 0 ? (u.pn / (ADIV > 0 ? ADIV : 1)) * AMUL : 0; }
    __device__ __forceinline__ void a_ready(const Unit&) const {}
    __device__ __forceinline__ void done(const Unit&) const {}
};

template <class GT, class Epi, class Sched, bool ALIGN_EPI = false, bool SP2 = false>
__device__ __forceinline__ void gemm_phase(PG8_LAS unsigned char* lds, const GT g, const Sched& S, const Epi& E) {
    int tid_ = threadIdx.x; asm volatile("" : "+v"(tid_));
    const int tid = tid_, wid = __builtin_amdgcn_readfirstlane(tid >> 6), lane = tid & 63, wr = wid >> 2, wc = wid & 3, fr = lane & 15, fq = lane >> 4;
    constexpr int K = GT::K, nt = K / BK;
    unsigned voffA[2], voffB[2];
#pragma unroll
    for (int i = 0; i < 2; ++i) { int R, C; stage_rc(tid * 16 + i * 8192, R, C); const int Rb = Epi::PERM ? ((R & ~31) + perm32(R & 31)) : R;
        voffA[i] = (unsigned)(R * GT::lda + C) * 2u; voffB[i] = (unsigned)(Rb * GT::ldb + C) * 2u; }
    constexpr size_t kstep = (size_t)(BK * 2);
    constexpr size_t hstepA = (size_t)HALF * GT::lda * 2, hstepB = (size_t)HALF * GT::ldb * 2;
    constexpr size_t tstepA = 2 * hstepA, tstepB = 2 * hstepB;
    const unsigned ldsw = (unsigned)wid * 1024u;
    const int aoff = lds_byte(wr * 64 + fr, fq * 8), boff = lds_byte(wc * 32 + fr, fq * 8);
#define PG8_SA(b, h) (((b) * 2 + (h)) * HTB)
#define PG8_SB(b, h) ((4 + (b) * 2 + (h)) * HTB)
#define PG8_STAGE(bufoff, gbase, voff) do { _Pragma("unroll") for (int _i = 0; _i < 2; ++_i) \
        __builtin_amdgcn_global_load_lds((const unsigned*)((const char*)(gbase) + (voff)[_i]), (PG8_LAS unsigned*)(lds + (bufoff) + ldsw + _i * 8192), 16, 0, 0); } while (0)
#define PG8_LDA(dst, b, h) do { _Pragma("unroll") for (int m = 0; m < 4; ++m) _Pragma("unroll") for (int k = 0; k < 2; ++k) dst[m][k] = *(const PG8_LAS bf16x8*)(lds + PG8_SA(b, h) + aoff + m * 2048 + k * 1024); } while (0)
#define PG8_LDB(dst, b, h) do { _Pragma("unroll") for (int n = 0; n < 2; ++n) _Pragma("unroll") for (int k = 0; k < 2; ++k) dst[n][k] = *(const PG8_LAS bf16x8*)(lds + PG8_SB(b, h) + boff + n * 2048 + k * 1024); } while (0)
#define PG8_MMA(ai, bj, At, Bt) do { __builtin_amdgcn_s_setprio(1); _Pragma("unroll") for (int m = 0; m < 4; ++m) _Pragma("unroll") for (int n = 0; n < 2; ++n) _Pragma("unroll") for (int k = 0; k < 2; ++k) \
        acc[ai][bj][m][n] = __builtin_amdgcn_mfma_f32_16x16x32_bf16(Bt[n][k], At[m][k], acc[ai][bj][m][n], 0, 0, 0); __builtin_amdgcn_s_setprio(0); } while (0)
#define PG8_WAIT_V(n) asm volatile("s_waitcnt vmcnt(" #n ")" ::: "memory")
#define PG8_WAIT_L(n) asm volatile("s_waitcnt lgkmcnt(" #n ")" ::: "memory")
#define PG8_BAR __builtin_amdgcn_s_barrier()
#define PG8_SCHED __builtin_amdgcn_sched_barrier(0)
    Unit cur, nxt; int ui = 0;
    if (!S.next(0, cur)) return;
    f32x4 acc[2][2][4][2];
#pragma unroll
    for (int a = 0; a < 2; ++a)
#pragma unroll
        for (int b = 0; b < 2; ++b)
#pragma unroll
            for (int m = 0; m < 4; ++m)
#pragma unroll
                for (int n = 0; n < 2; ++n) acc[a][b][m][n] = (f32x4){0.f, 0.f, 0.f, 0.f};
    bf16x8 At[4][2], B0[2][2], B1[2][2];
    const char* cA = (const char*)g.A + (size_t)cur.pm * tstepA + (size_t)S.a_off(cur) * 2; const char* cB = (const char*)g.Bt + (size_t)cur.pn * tstepB;
    S.a_ready(cur);
    if constexpr (SP2) {
        PG8_STAGE(PG8_SB(0, 0), cB, voffB); PG8_STAGE(PG8_SB(0, 1), cB + hstepB, voffB); PG8_STAGE(PG8_SA(0, 0), cA, voffA); PG8_STAGE(PG8_SA(0, 1), cA + hstepA, voffA);
        if (wr == 1) PG8_BAR;
        PG8_WAIT_V(2); PG8_BAR;
        PG8_STAGE(PG8_SB(1, 0), cB + kstep, voffB); PG8_STAGE(PG8_SA(1, 0), cA + kstep, voffA); PG8_STAGE(PG8_SB(1, 1), cB + hstepB + kstep, voffB);
        PG8_WAIT_V(6); PG8_BAR;
    } else {
        PG8_STAGE(PG8_SB(0, 0), cB, voffB); PG8_STAGE(PG8_SA(0, 0), cA, voffA); PG8_STAGE(PG8_SB(0, 1), cB + hstepB, voffB); PG8_STAGE(PG8_SA(0, 1), cA + hstepA, voffA);
        if (wr == 1) PG8_BAR;
        PG8_WAIT_V(4); PG8_BAR;
        PG8_STAGE(PG8_SB(1, 0), cB + kstep, voffB); PG8_STAGE(PG8_SA(1, 0), cA + kstep, voffA); PG8_STAGE(PG8_SB(1, 1), cB + hstepB + kstep, voffB);
        PG8_WAIT_V(6); PG8_BAR;
    }
    for (;;) {
        const bool has_next = S.next(ui + 1, nxt);
        const char* nA = has_next ? (const char*)g.A + (size_t)nxt.pm * tstepA + (size_t)S.a_off(nxt) * 2 : cA; const char* nB = has_next ? (const char*)g.Bt + (size_t)nxt.pn * tstepB : cB;
        for (int t = 0; t < nt; t += 2) {
            const bool last = (t == nt - 2);
            const char* a1 = cA + (size_t)(t + 1) * kstep;
            const char* a2 = last ? nA : cA + (size_t)(t + 2) * kstep; const char* b2 = last ? nB : cB + (size_t)(t + 2) * kstep;
            const char* a3 = a2 + kstep; const char* b3 = b2 + kstep;
            if (last && has_next) S.a_ready(nxt);
            if constexpr (SP2) {
            PG8_LDB(B0, 0, 0); PG8_LDB(B1, 0, 1); PG8_SCHED; PG8_LDA(At, 0, 0); PG8_STAGE(PG8_SA(1, 1), a1 + hstepA, voffA);
            PG8_WAIT_V(8); PG8_WAIT_L(0); PG8_BAR; PG8_MMA(0, 0, At, B0); PG8_MMA(0, 1, At, B1); PG8_BAR; PG8_SCHED;
            PG8_LDA(At, 0, 1); PG8_STAGE(PG8_SB(0, 0), b2, voffB); PG8_STAGE(PG8_SB(0, 1), b2 + hstepB, voffB); PG8_STAGE(PG8_SA(0, 0), a2, voffA);
            PG8_WAIT_V(8); PG8_WAIT_L(0); PG8_BAR; PG8_MMA(1, 0, At, B0); PG8_MMA(1, 1, At, B1); PG8_BAR; PG8_SCHED;
            PG8_LDB(B0, 1, 0); PG8_LDB(B1, 1, 1); PG8_SCHED; PG8_LDA(At, 1, 0); PG8_STAGE(PG8_SA(0, 1), a2 + hstepA, voffA);
            PG8_WAIT_V(8); PG8_WAIT_L(0); PG8_BAR; PG8_MMA(0, 0, At, B0); PG8_MMA(0, 1, At, B1); PG8_BAR; PG8_SCHED;
            PG8_LDA(At, 1, 1); PG8_STAGE(PG8_SB(1, 0), b3, voffB); PG8_STAGE(PG8_SB(1, 1), b3 + hstepB, voffB); PG8_STAGE(PG8_SA(1, 0), a3, voffA);
            PG8_WAIT_V(8); PG8_WAIT_L(0); PG8_BAR; PG8_MMA(1, 0, At, B0); PG8_MMA(1, 1, At, B1); PG8_BAR; PG8_SCHED;
            } else {
            PG8_LDB(B0, 0, 0); PG8_SCHED; PG8_LDA(At, 0, 0); PG8_STAGE(PG8_SA(1, 1), a1 + hstepA, voffA);
            PG8_WAIT_L(8); PG8_BAR; PG8_WAIT_L(0); PG8_MMA(0, 0, At, B0); PG8_BAR; PG8_SCHED;
            PG8_LDB(B1, 0, 1); PG8_STAGE(PG8_SB(0, 0), b2, voffB);
            PG8_BAR; PG8_WAIT_L(0); PG8_MMA(0, 1, At, B1); PG8_BAR;
            PG8_LDA(At, 0, 1); PG8_STAGE(PG8_SA(0, 0), a2, voffA);
            PG8_BAR; PG8_WAIT_L(0); PG8_MMA(1, 0, At, B0); PG8_BAR; PG8_SCHED;
            PG8_STAGE(PG8_SB(0, 1), b2 + hstepB, voffB);
            PG8_WAIT_V(6); PG8_BAR; PG8_MMA(1, 1, At, B1); PG8_BAR;
            PG8_LDB(B0, 1, 0); PG8_SCHED; PG8_LDA(At, 1, 0); PG8_STAGE(PG8_SA(0, 1), a2 + hstepA, voffA);
            PG8_WAIT_L(8); PG8_BAR; PG8_WAIT_L(0); PG8_MMA(0, 0, At, B0); PG8_BAR; PG8_SCHED;
            PG8_LDB(B1, 1, 1); PG8_STAGE(PG8_SB(1, 0), b3, voffB);
            PG8_BAR; PG8_WAIT_L(0); PG8_MMA(0, 1, At, B1); PG8_BAR;
            PG8_LDA(At, 1, 1); PG8_STAGE(PG8_SA(1, 0), a3, voffA);
            PG8_BAR; PG8_WAIT_L(0); PG8_MMA(1, 0, At, B0); PG8_BAR; PG8_SCHED;
            PG8_STAGE(PG8_SB(1, 1), b3 + hstepB, voffB);
            PG8_WAIT_V(6); PG8_BAR; PG8_MMA(1, 1, At, B1); PG8_BAR;
            }
        }
        if constexpr (ALIGN_EPI) { if (wr == 0) PG8_BAR; }
        if constexpr (!Epi::AFTER_DRAIN) { E(acc, cur, wr, wc, fr, fq); S.done(cur); }
        if (!has_next) break;
#pragma unroll
        for (int a = 0; a < 2; ++a)
#pragma unroll
            for (int b = 0; b < 2; ++b)
#pragma unroll
                for (int m = 0; m < 4; ++m)
#pragma unroll
                    for (int n = 0; n < 2; ++n) acc[a][b][m][n] = (f32x4){0.f, 0.f, 0.f, 0.f};
        cur = nxt; cA = nA; cB = nB; ++ui;
        if constexpr (ALIGN_EPI) { if (wr == 1) PG8_BAR; }
    }
    PG8_WAIT_V(0);
    if constexpr (!ALIGN_EPI) { if (wr == 0) PG8_BAR; }
    PG8_BAR;
    if constexpr (Epi::AFTER_DRAIN) { E.fused(acc, cur, wr, wc, fr, fq, lds, wid, lane); S.done(cur); }
#undef PG8_SA
#undef PG8_SB
#undef PG8_STAGE
#undef PG8_LDA
#undef PG8_LDB
#undef PG8_MMA
#undef PG8_WAIT_V
#undef PG8_WAIT_L
#undef PG8_BAR
#undef PG8_SCHED
}
}

#define LAS __attribute__((address_space(3)))
typedef unsigned short bf16_t;
typedef short bf16x8 __attribute__((ext_vector_type(8)));
typedef float f32x4 __attribute__((ext_vector_type(4)));
typedef unsigned u32x4 __attribute__((ext_vector_type(4)));
typedef unsigned u32x2 __attribute__((ext_vector_type(2)));

constexpr int D = 1024, DFF = 2816, NFF2 = 5632, INC = 7984, PN = 5120, PREAL = 4912, MGN = 3072;
constexpr int MTOT = 24576, MLAT = 16384, GROWS = 8192;
constexpr float EPSN = 1e-6f;
constexpr size_t MiB = 1u << 20;
constexpr size_t WS_MOD = 1 * MiB, WS_MODP = 2 * MiB, WS_POS = 5 * MiB, WS_DEC = 6 * MiB, WS_SC = 7 * MiB;
constexpr size_t WS_W = 8 * MiB;
constexpr size_t W_FFIN = 0, W_FFOUT = W_FFIN + 2ull * NFF2 * D * 2, W_P = W_FFOUT + 2ull * D * DFF * 2, W_MG = W_P + (size_t)PN * D * 2,
                 W_B = W_MG + (size_t)MGN * D * 2, W_O3 = W_B + 3072ull * 512 * 2, W_END = W_O3 + 1024ull * 3072 * 2;
static_assert(W_END <= 58 * MiB, "weights region");
constexpr size_t WS_XN = 66 * MiB, WS_A = 114 * MiB, WS_BIG = 210 * MiB, WS_END = 370 * MiB;
constexpr size_t BIG_US = 80 * MiB, BIG_OB = 128 * MiB;
constexpr size_t OFF_YP = 0, OFF_YS = 8388608, OFF_C = 25165824, OFF_N = 29360128, OFF_M = 29392896, OFF_G = 29393408, OFF_H = 33587712;
constexpr int LDS_BYTES = 147456;

struct Args { const float* in[23]; float* out; unsigned char* ws; };
enum { I_XP = 0, I_XS, I_C, I_SC, I_SN, I_SM, I_SG, I_SH, I_CCTX, I_WADA, I_BADA, I_NPRE, I_NPOST, I_WFIN, I_WFOUT, I_WIN, I_GB, I_GWUP, I_GLB, I_HGAM, I_HN, I_WBR, I_WOUT };
__device__ __forceinline__ const float* inp(const Args& a, int i) { asm volatile("" : "+s"(i)); return a.in[i]; }

__device__ __forceinline__ unsigned f2bf(float f) { unsigned u = __float_as_uint(f); return (u + 0x7fffu + ((u >> 16) & 1u)) >> 16; }
__device__ __forceinline__ unsigned pk2(float lo, float hi) { return f2bf(lo) | (f2bf(hi) << 16); }
__device__ __forceinline__ float bf2f(bf16_t h) { return __uint_as_float(((unsigned)h) << 16); }
__device__ __forceinline__ float bflo(unsigned w) { return __uint_as_float(w << 16); }
__device__ __forceinline__ float bfhi(unsigned w) { return __uint_as_float(w & 0xffff0000u); }
__device__ __forceinline__ float sigmoidf_(float x) { return 1.0f / (1.0f + __expf(-x)); }
__device__ __forceinline__ float siluf_(float x) { return x / (1.0f + __expf(-x)); }
__device__ __forceinline__ float logsigf_(float x) { return fminf(x, 0.f) - __logf(1.0f + __expf(-fabsf(x))); }
__device__ __forceinline__ float wave_sum(float v) {
#pragma unroll
    for (int o = 1; o < 64; o <<= 1) v += __shfl_xor(v, o);
    return v;
}
#define LDS_WAIT() asm volatile("s_waitcnt lgkmcnt(0)" ::: "memory")

#define XB_TMO      128
#define XB_XCNT(j)  (256  + 64 * (j))
#define XB_XSUB(j)  (1280 + 64 * (j))
#define XB_XGEN(j)  (2304 + 64 * (j))
#define XB_TOP      3328
#define XB_TOPGEN   3392
#define XCD_BAR_WORDS 3456
#define XB_SPIN_CAP (1u << 18)

__device__ __forceinline__ unsigned xb_ld(unsigned* p)              { return __hip_atomic_load(p, __ATOMIC_RELAXED, __HIP_MEMORY_SCOPE_AGENT); }
__device__ __forceinline__ unsigned xb_add(unsigned* p, unsigned v) { return __hip_atomic_fetch_add(p, v, __ATOMIC_RELAXED, __HIP_MEMORY_SCOPE_AGENT); }
__device__ __forceinline__ unsigned xb_xcc_id() { return (unsigned)__builtin_amdgcn_s_getreg((3 << 11) | 20) & 0xFu; }
#define XB_SPIN(cond, bar) do { unsigned _sp = 0; while (cond) { __builtin_amdgcn_s_sleep(1); \
    if ((++_sp & 255u) == 0u) { if (xb_ld(&(bar)[XB_TMO])) break; if (_sp > XB_SPIN_CAP) { atomicAdd(&(bar)[XB_TMO], 1u); break; } } } } while (0)

struct XcdBarrier {
    unsigned* bar; unsigned x;
    volatile LAS unsigned* st;
};

__device__ __forceinline__ XcdBarrier xcd_barrier_post(unsigned* bar, volatile LAS unsigned* st) {
    XcdBarrier b; b.bar = bar; b.x = xb_xcc_id(); b.st = st;
    if (threadIdx.x == 0) (void)xb_add(&bar[XB_XCNT(b.x)], 1u);
    return b;
}
__device__ __forceinline__ void xcd_barrier_complete(unsigned* bar, unsigned x, unsigned& nloc, unsigned& nx) {
    const unsigned G = gridDim.x * gridDim.y * gridDim.z;
    unsigned sum, cnt, mine, sp = 0u;
    for (;;) {
        sum = 0u; cnt = 0u; mine = 0u;
#pragma unroll
        for (unsigned j = 0; j < 16; ++j) { const unsigned c = xb_ld(&bar[XB_XCNT(j)]); sum += c; cnt += (c > 0u) ? 1u : 0u; mine = (j == x) ? c : mine; }
        if (sum == G) break;
        __builtin_amdgcn_s_sleep(1);
        if ((++sp & 255u) == 0u) { if (xb_ld(&bar[XB_TMO])) break; if (sp > XB_SPIN_CAP) { atomicAdd(&bar[XB_TMO], 1u); break; } }
    }
    nloc = mine > 0u ? mine : 1u; nx = cnt > 0u ? cnt : 1u;
}

__device__ __attribute__((noinline)) void xcd_barrier_ni(unsigned* bar_, unsigned st_off) {
    XcdBarrier b; b.bar = bar_; b.x = xb_xcc_id(); b.st = (volatile LAS unsigned*)(size_t)st_off;
    asm volatile("s_waitcnt vmcnt(0)" ::: "memory");
    __syncthreads();
    if (threadIdx.x == 0) {
        unsigned* bar = b.bar;
        __builtin_amdgcn_s_waitcnt(0);
        unsigned nloc = b.st[0], nx = b.st[1];
        if (nloc == 0u) { xcd_barrier_complete(bar, b.x, nloc, nx); b.st[0] = nloc; b.st[1] = nx; }
        const unsigned old = xb_add(&bar[XB_XSUB(b.x)], 1u);
        const unsigned gen = old / nloc;
        if (old + 1u == (gen + 1u) * nloc) {
            __builtin_amdgcn_fence(__ATOMIC_RELEASE, "agent");
            asm volatile("s_waitcnt vmcnt(0)" ::: "memory");
            const unsigned og = xb_add(&bar[XB_TOP], 1u);
            const unsigned tg = og / nx;
            if (og + 1u == (tg + 1u) * nx) xb_add(&bar[XB_TOPGEN], 1u);
            else XB_SPIN(xb_ld(&bar[XB_TOPGEN]) == tg, bar);
            __builtin_amdgcn_fence(__ATOMIC_ACQUIRE, "agent");
            xb_add(&bar[XB_XGEN(b.x)], 1u);
            asm volatile("s_waitcnt vmcnt(0)" ::: "memory");
        } else {
            XB_SPIN(xb_ld(&bar[XB_XGEN(b.x)]) == gen, bar);
            __builtin_amdgcn_fence(__ATOMIC_ACQUIRE, "agent");
            asm volatile("s_waitcnt vmcnt(0)" ::: "memory");
        }
    }
    __syncthreads();
}


struct EpiBf16 {
    static constexpr bool PERM = true, AFTER_DRAIN = false;
    bf16_t* O; int ldc;
    __device__ __forceinline__ void operator()(const f32x4 (&acc)[2][2][4][2], const pg8::Unit& u, int wr, int wc, int fr, int fq) const {
        const int row0 = u.pm * 256 + wr * 64 + fr, col0 = u.pn * 256 + wc * 32 + 8 * fq;
#pragma unroll
        for (int ai = 0; ai < 2; ++ai)
#pragma unroll
            for (int m = 0; m < 4; ++m) { bf16_t* rowp = O + (size_t)(row0 + ai * 128 + m * 16) * ldc + col0;
#pragma unroll
                for (int bj = 0; bj < 2; ++bj) { const f32x4 v0 = acc[ai][bj][m][0], v1 = acc[ai][bj][m][1];
                    u32x4 w; w.x = pk2(v0[0], v0[1]); w.y = pk2(v0[2], v0[3]); w.z = pk2(v1[0], v1[1]); w.w = pk2(v1[2], v1[3]);
                    *(u32x4*)(rowp + bj * 128) = w; } }
    }
};
struct EpiGateMul {
    static constexpr bool PERM = true, AFTER_DRAIN = false;
    bf16_t* O; int ldc;
    __device__ __forceinline__ void operator()(const f32x4 (&acc)[2][2][4][2], const pg8::Unit& u, int wr, int wc, int fr, int fq) const {
        const int row0 = u.pm * 256 + wr * 64 + fr, col0 = u.pn * 256 + wc * 32 + 8 * fq;
#pragma unroll
        for (int ai = 0; ai < 2; ++ai)
#pragma unroll
            for (int m = 0; m < 4; ++m) { bf16_t* rowp = O + (size_t)(row0 + ai * 128 + m * 16) * ldc + col0;
#pragma unroll
                for (int bj = 0; bj < 2; ++bj) { const f32x4 v0 = acc[ai][bj][m][0], v1 = acc[ai][bj][m][1];
                    const u32x4 b = *(const u32x4*)(rowp + bj * 128);
                    u32x4 w; w.x = pk2(sigmoidf_(v0[0]) * bflo(b.x), sigmoidf_(v0[1]) * bfhi(b.x)); w.y = pk2(sigmoidf_(v0[2]) * bflo(b.y), sigmoidf_(v0[3]) * bfhi(b.y));
                    w.z = pk2(sigmoidf_(v1[0]) * bflo(b.z), sigmoidf_(v1[1]) * bfhi(b.z)); w.w = pk2(sigmoidf_(v1[2]) * bflo(b.w), sigmoidf_(v1[3]) * bfhi(b.w));
                    *(u32x4*)(rowp + bj * 128) = w; } }
    }
};
struct EpiSwiGLU {
    static constexpr bool PERM = true, AFTER_DRAIN = false;
    bf16_t* H; int ldh;
    __device__ __forceinline__ void operator()(const f32x4 (&acc)[2][2][4][2], const pg8::Unit& u, int wr, int wc, int fr, int fq) const {
        const int row0 = u.pm * 256 + wr * 64 + fr, col0 = (u.pn * 256 + wc * 32 + 8 * fq) >> 1;
#pragma unroll
        for (int ai = 0; ai < 2; ++ai)
#pragma unroll
            for (int m = 0; m < 4; ++m) { bf16_t* rowp = H + (size_t)(row0 + ai * 128 + m * 16) * ldh + col0;
#pragma unroll
                for (int bj = 0; bj < 2; ++bj) { const f32x4 g = acc[ai][bj][m][0], up = acc[ai][bj][m][1];
                    u32x2 w; w.x = pk2(siluf_(g[0]) * up[0], siluf_(g[1]) * up[1]); w.y = pk2(siluf_(g[2]) * up[2], siluf_(g[3]) * up[3]);
                    *(u32x2*)(rowp + bj * 64) = w; } }
    }
};
struct EpiF32 {
    static constexpr bool PERM = false, AFTER_DRAIN = false;
    float* Y; int ldc;
    __device__ __forceinline__ void operator()(const f32x4 (&acc)[2][2][4][2], const pg8::Unit& u, int wr, int wc, int fr, int fq) const {
        const int row0 = u.pm * 256 + wr * 64 + fr, col0 = u.pn * 256 + wc * 32 + 4 * fq;
#pragma unroll
        for (int ai = 0; ai < 2; ++ai)
#pragma unroll
            for (int m = 0; m < 4; ++m) { float* rowp = Y + (size_t)(row0 + ai * 128 + m * 16) * ldc + col0;
#pragma unroll
                for (int bj = 0; bj < 2; ++bj)
#pragma unroll
                    for (int n = 0; n < 2; ++n) *(f32x4*)(rowp + bj * 128 + n * 16) = acc[ai][bj][m][n]; }
    }
};

template <class Map>
__device__ __forceinline__ void transpose_item(const float* W, int K, int N, LAS float* scr, int item, int lane, const Map& map) {
    const int nblk = (N + 31) / 32, kb = item / nblk, nb = item % nblk, k0 = 64 * kb, n0 = 32 * nb;
    const int nn = n0 + (lane & 31); const bool ok = nn < N;
#pragma unroll 8
    for (int i = 0; i < 32; ++i) { const int kk = 2 * i + (lane >> 5); scr[kk * 33 + (lane & 31)] = ok ? W[(size_t)(k0 + kk) * N + nn] : 0.f; }
    LDS_WAIT(); asm volatile("" ::: "memory");
    const int c = lane & 7;
#pragma unroll
    for (int j = 0; j < 4; ++j) { const int n = (lane >> 3) + 8 * j; const LAS float* s = scr + (8 * c) * 33 + n;
        u32x4 o; o.x = pk2(s[0 * 33], s[1 * 33]); o.y = pk2(s[2 * 33], s[3 * 33]); o.z = pk2(s[4 * 33], s[5 * 33]); o.w = pk2(s[6 * 33], s[7 * 33]);
        if (n0 + n < N) map(n0 + n, k0 + 8 * c, o); }
    LDS_WAIT(); asm volatile("" ::: "memory");
}

__device__ __forceinline__ void convert_weights(const Args& a, LAS unsigned char* lds, int l, int gw, int NGW, int lane, int wave) {
    LAS float* scr = (LAS float*)(lds + wave * 16384);
    unsigned char* wb = a.ws + WS_W;
    constexpr int I_FI = 16 * 176, I_FO = 44 * 32, I_IN = 16 * 250, I_BR = 8 * 32, I_OU = 16 * 32;
    constexpr int NITEMS = 2 * I_FI + 2 * I_FO + I_IN + 3 * I_BR + I_OU;
    for (int it = gw; it < NITEMS; it += NGW) {
        int r = it;
        if (r < 2 * I_FI) { const int f = r / I_FI; r -= f * I_FI; bf16_t* dst = (bf16_t*)(wb + W_FFIN) + (size_t)f * NFF2 * D;
            transpose_item(inp(a, I_WFIN) + (size_t)(l * 2 + f) * D * NFF2, D, NFF2, scr, r, lane,
                [=](int n, int k, u32x4 o) { const int h = n < DFF ? n : n - DFF; const int row = 8 * (h >> 2) + (n < DFF ? 0 : 4) + (h & 3); *(u32x4*)(dst + (size_t)row * D + k) = o; });
            continue; }
        r -= 2 * I_FI;
        if (r < 2 * I_FO) { const int f = r / I_FO; r -= f * I_FO; bf16_t* dst = (bf16_t*)(wb + W_FFOUT) + (size_t)f * D * DFF;
            transpose_item(inp(a, I_WFOUT) + (size_t)(l * 2 + f) * DFF * D, DFF, D, scr, r, lane,
                [=](int n, int k, u32x4 o) { *(u32x4*)(dst + (size_t)n * DFF + k) = o; });
            continue; }
        r -= 2 * I_FO;
        if (r < I_IN) { bf16_t* dp = (bf16_t*)(wb + W_P); bf16_t* dm = (bf16_t*)(wb + W_MG);
            transpose_item(inp(a, I_WIN) + (size_t)l * D * INC, D, INC, scr, r, lane,
                [=](int n, int k, u32x4 o) { if (n < PREAL) *(u32x4*)(dp + (size_t)n * D + k) = o; else *(u32x4*)(dm + (size_t)(n - PREAL) * D + k) = o; });
            continue; }
        r -= I_IN;
        if (r < 3 * I_BR) { const int nb = r / I_BR; r -= nb * I_BR; bf16_t* dst = (bf16_t*)(wb + W_B) + (size_t)nb * 1024 * 512;
            transpose_item(inp(a, I_WBR) + (size_t)(l * 3 + nb) * 512 * D, 512, D, scr, r, lane,
                [=](int n, int k, u32x4 o) { *(u32x4*)(dst + (size_t)n * 512 + k) = o; });
            continue; }
        r -= 3 * I_BR;
        { bf16_t* dst = (bf16_t*)(wb + W_O3);
            transpose_item(inp(a, I_WOUT) + (size_t)l * D * D, D, D, scr, r, lane,
                [=](int n, int k, u32x4 o) { bf16_t* p = dst + (size_t)n * 3072 + k; *(u32x4*)p = o; *(u32x4*)(p + 1024) = o; *(u32x4*)(p + 2048) = o; }); }
    }
    { u32x4* z = (u32x4*)((bf16_t*)(wb + W_P) + (size_t)PREAL * D); const int nz = (PN - PREAL) * D * 2 / 16;
      for (int i = gw * 64 + lane; i < nz; i += NGW * 64) z[i] = (u32x4){0u, 0u, 0u, 0u}; }
}

__device__ __forceinline__ void ada_partial(const Args& a, int gw, int NGW, int lane) {
    float* modp = (float*)(a.ws + WS_MODP);
    for (int it = gw; it < 2 * 144 * 8; it += NGW) {
        const int ks = it & 7, cgp = (it >> 3) % 144, l = it / (8 * 144);
        const int col = cgp * 64 + lane;
        const float* w = inp(a, I_WADA) + ((size_t)l * D + ks * 128) * 9216 + col;
        float acc[5] = {0.f, 0.f, 0.f, 0.f, 0.f};
#pragma unroll 4
        for (int k = 0; k < 128; ++k) { const float wv = w[(size_t)k * 9216]; const int kk = ks * 128 + k;
            acc[0] += siluf_(inp(a, I_CCTX)[kk]) * wv;
#pragma unroll
            for (int i = 0; i < 4; ++i) acc[1 + i] += siluf_(inp(a, I_C)[i * D + kk]) * wv; }
#pragma unroll
        for (int i = 0; i < 5; ++i) modp[((size_t)(ks * 2 + l) * 5 + i) * 9216 + col] = acc[i];
    }
}

struct RowOp { int src_input, has_y; float coef; const float* npost; const float* mdg_base; int has_xn; const float* npre; const float* md_base; int si; int add_pos; };
__device__ __forceinline__ void rowwise(const Args& a, const RowOp& op, int r, int lane) {
    const bool lat = r < MLAT; const int cv = lat ? 1 + (r >> 12) : 0;
    const float* xs = op.src_input ? (lat ? inp(a, I_XS) + (size_t)r * D : inp(a, I_XP) + (size_t)(r - MLAT) * D)
                                   : (lat ? a.out + OFF_YS + (size_t)r * D : a.out + OFF_YP + (size_t)(r - MLAT) * D);
    float* xd = lat ? a.out + OFF_YS + (size_t)r * D : a.out + OFF_YP + (size_t)(r - MLAT) * D;
    f32x4 v[4];
#pragma unroll
    for (int j = 0; j < 4; ++j) v[j] = *(const f32x4*)(xs + 4 * lane + 256 * j);
    if (op.has_y) {
        const float* yr = (const float*)(a.ws + WS_A) + (size_t)r * D; f32x4 y[4]; float ss = 0.f;
#pragma unroll
        for (int j = 0; j < 4; ++j) { y[j] = *(const f32x4*)(yr + 4 * lane + 256 * j); ss += (y[j].x * y[j].x + y[j].y * y[j].y) + (y[j].z * y[j].z + y[j].w * y[j].w); }
        const float rr = rsqrtf(wave_sum(ss) * (1.f / D) + EPSN) * op.coef;
        const float* gp = op.mdg_base + (size_t)cv * 9216;
#pragma unroll
        for (int j = 0; j < 4; ++j) { const f32x4 w = *(const f32x4*)(op.npost + 4 * lane + 256 * j), gg = *(const f32x4*)(gp + 4 * lane + 256 * j);
            v[j] = v[j] + gg * (y[j] * rr) * w; *(f32x4*)(xd + 4 * lane + 256 * j) = v[j]; }
    }
    if (op.has_xn) {
        float ss = 0.f;
#pragma unroll
        for (int j = 0; j < 4; ++j) ss += (v[j].x * v[j].x + v[j].y * v[j].y) + (v[j].z * v[j].z + v[j].w * v[j].w);
        const float rr = rsqrtf(wave_sum(ss) * (1.f / D) + EPSN);
        const float* sh = op.md_base + (size_t)cv * 9216 + (size_t)op.si * D; const float* sc = sh + D;
        const float* pos = (const float*)(a.ws + WS_POS); const int t = r & 4095;
        bf16_t* xo = (bf16_t*)(a.ws + WS_XN) + (size_t)r * D;
#pragma unroll
        for (int j = 0; j < 4; ++j) { const int c = 4 * lane + 256 * j; const f32x4 w = *(const f32x4*)(op.npre + c), s1 = *(const f32x4*)(sc + c), s0 = *(const f32x4*)(sh + c);
            f32x4 o = (v[j] * rr) * w * (s1 + 1.0f) + s0;
            if (op.add_pos && lat) { const float* pp = (c < 512) ? pos + (size_t)(t >> 6) * 512 + c : pos + (size_t)(t & 63) * 512 + (c - 512); o = o + *(const f32x4*)pp; }
            u32x2 pk; pk.x = pk2(o.x, o.y); pk.y = pk2(o.z, o.w); *(u32x2*)(xo + c) = pk; }
    }
}

constexpr int C_MQ = 0, C_MK = 256, C_MV = 512, C_MO = 1024, C_MIF = 1536, C_GQ = 1552, C_GK = 1808, C_GV = 2064, C_GR = 2576, C_GLR = 3088, C_HQ = 3120, C_HF = 3376, C_HV = 3888, C_HG = 4400;

struct ItemInfo { int br, dir, head, seq, c, T, NC; };
__device__ __forceinline__ ItemInfo item_info(int g, int it) { ItemInfo I; const int hdb = it % 24, cgl = it / 24; I.br = hdb >> 3; I.dir = (hdb >> 2) & 1; I.head = hdb & 3;
    I.T = g < 2 ? 4096 : 256; I.NC = I.T >> 6; I.seq = cgl / I.NC; I.c = cgl % I.NC; return I; }
__device__ __forceinline__ int item_row(const ItemInfo& I, int s) { const int tau = I.c * 64 + s; return I.seq * I.T + (I.dir ? I.T - 1 - tau : tau); }
__device__ __forceinline__ float lb_of(const Args& a, int l, int ch) { if (l == 0) return 0.f; const float g0 = inp(a, I_HGAM)[ch], g1 = inp(a, I_HGAM)[256 + ch]; return 1.0f / (1.0f + expf(g0 - g1)); }

template <bool NEEDQ>
__device__ __forceinline__ void load_gated(const Args& a, const bf16_t* P, const ItemInfo& I, int l, int d, int sg, float (&qv)[8], float (&kv)[8], float (&la)[8]) {
    const int ch = I.head * 64 + d;
    if (I.br == 1) {
        float wup[16];
        const float* wp = inp(a, I_GWUP) + ((size_t)(l * 2 + I.dir) * 16) * 256 + ch;
#pragma unroll
        for (int r = 0; r < 16; ++r) wup[r] = wp[r * 256];
        const float gb = inp(a, I_GLB)[(l * 2 + I.dir) * 256 + ch];
#pragma unroll
        for (int i = 0; i < 8; ++i) { const bf16_t* pr = P + (size_t)item_row(I, 8 * sg + i) * PN;
            const u32x4 g0 = *(const u32x4*)(pr + C_GLR + I.dir * 16), g1 = *(const u32x4*)(pr + C_GLR + I.dir * 16 + 8);
            float z = gb;
            z += bflo(g0.x) * wup[0] + bfhi(g0.x) * wup[1] + bflo(g0.y) * wup[2] + bfhi(g0.y) * wup[3] + bflo(g0.z) * wup[4] + bfhi(g0.z) * wup[5] + bflo(g0.w) * wup[6] + bfhi(g0.w) * wup[7];
            z += bflo(g1.x) * wup[8] + bfhi(g1.x) * wup[9] + bflo(g1.y) * wup[10] + bfhi(g1.y) * wup[11] + bflo(g1.z) * wup[12] + bfhi(g1.z) * wup[13] + bflo(g1.w) * wup[14] + bfhi(g1.w) * wup[15];
            la[i] = logsigf_(z) * (1.0f / 16.0f);
            if (NEEDQ) qv[i] = bf2f(pr[C_GQ + ch]) * 0.125f; kv[i] = bf2f(pr[C_GK + ch]); }
    } else {
        const float lb = lb_of(a, l, ch);
#pragma unroll
        for (int i = 0; i < 8; ++i) { const bf16_t* pr = P + (size_t)item_row(I, 8 * sg + i) * PN;
            const float z = bf2f(pr[C_HF + I.dir * 256 + ch]); const float sg_ = sigmoidf_(z);
            la[i] = (lb == 0.f) ? logsigf_(z) : __logf(lb + (1.0f - lb) * sg_);
            if (NEEDQ) qv[i] = bf2f(pr[C_HQ + ch]) * 1.0f;
            kv[i] = (1.0f - lb) * (1.0f - sg_); }
    }
}
template <bool NEEDQ>
__device__ __forceinline__ void load_mlstm(const Args& a, const bf16_t* P, const ItemInfo& I, int l, int d, int sg, float (&qv)[8], float (&kv)[8], float (&lf)[8], float (&li)[8]) {
    const float bi = inp(a, I_GB)[((l * 2 + I.dir) * 2 + 0) * 4 + I.head], bf_ = inp(a, I_GB)[((l * 2 + I.dir) * 2 + 1) * 4 + I.head];
#pragma unroll
    for (int i = 0; i < 8; ++i) { const bf16_t* pr = P + (size_t)item_row(I, 8 * sg + i) * PN;
        li[i] = bf2f(pr[C_MIF + I.dir * 8 + I.head]) + bi; lf[i] = logsigf_(bf2f(pr[C_MIF + I.dir * 8 + 4 + I.head]) + bf_);
        if (NEEDQ) qv[i] = bf2f(pr[C_MQ + I.head * 64 + d]) * 0.125f; kv[i] = bf2f(pr[C_MK + I.head * 64 + d]); }
}
__device__ __forceinline__ void stage_vT(const bf16_t* P, const ItemInfo& I, LAS bf16_t* Y, int pitch, int tid) {
    const int s = tid >> 3, eg = tid & 7; const int vb = I.br == 0 ? C_MV : (I.br == 1 ? C_GV : C_HV);
    const bf16_t* pv = P + (size_t)item_row(I, s) * PN + vb + I.head * 128 + 16 * eg;
    const u32x4 v0 = *(const u32x4*)pv, v1 = *(const u32x4*)(pv + 8);
    const unsigned wds[8] = {v0.x, v0.y, v0.z, v0.w, v1.x, v1.y, v1.z, v1.w};
#pragma unroll
    for (int i = 0; i < 8; ++i) { float x0 = bflo(wds[i]), x1 = bfhi(wds[i]); if (I.br == 2) { x0 = siluf_(x0); x1 = siluf_(x1); }
        Y[(16 * eg + 2 * i) * pitch + s] = (bf16_t)f2bf(x0); Y[(16 * eg + 2 * i + 1) * pitch + s] = (bf16_t)f2bf(x1); }
}
__device__ __forceinline__ bf16x8 ldfrag(const LAS bf16_t* T, int pitch, int row0, int k0, int lane) { return *(const LAS bf16x8*)(T + (row0 + (lane & 15)) * pitch + k0 + 8 * (lane >> 4)); }

__device__ __forceinline__ void scan_s1(const Args& a, LAS unsigned char* lds, int l, int g, int it) {
    int tid_ = threadIdx.x; asm volatile("" : "+v"(tid_)); const int tid = tid_, d = tid & 63, lane = d, sg = __builtin_amdgcn_readfirstlane(tid >> 6);
    const ItemInfo I = item_info(g, it);
    const bf16_t* P = (const bf16_t*)(a.ws + WS_BIG);
    bf16_t* US = (bf16_t*)(a.ws + WS_BIG + BIG_US) + (size_t)it * 8192;
    float* DEC = (float*)(a.ws + WS_DEC) + (size_t)it * 64; float* SC = (float*)(a.ws + WS_SC) + (size_t)it * 4;
    LAS bf16_t* XT = (LAS bf16_t*)lds;
    LAS bf16_t* YV = (LAS bf16_t*)(lds + 9216);
    LAS float* TOT = (LAS float*)(lds + 9216 + 20736);
    LAS float* TMX = TOT + 512;
    float qv[8], kv[8], x0[8], x1[8];
    if (I.br == 0) {
        load_mlstm<false>(a, P, I, l, d, sg, qv, kv, x0, x1);
        float run = 0.f;
#pragma unroll
        for (int i = 0; i < 8; ++i) { run += x0[i]; x0[i] = run; }
        TOT[sg * 64 + d] = run; LDS_WAIT(); __syncthreads();
        float pre = 0.f, tot = 0.f;
#pragma unroll
        for (int w = 0; w < 8; ++w) { const float t = TOT[w * 64 + d]; if (w < sg) pre += t; tot += t; }
        float mx = -3.0e38f;
#pragma unroll
        for (int i = 0; i < 8; ++i) { x0[i] = tot - (pre + x0[i]) + x1[i]; mx = fmaxf(mx, x0[i]); }
        TMX[sg * 64 + d] = mx; LDS_WAIT(); __syncthreads();
        float mlw = -3.0e38f;
#pragma unroll
        for (int w = 0; w < 8; ++w) mlw = fmaxf(mlw, TMX[w * 64 + d]);
#pragma unroll
        for (int i = 0; i < 8; ++i) kv[i] *= __expf(x0[i] - mlw);
        if (tid == 0) { SC[0] = mlw; SC[1] = tot; }
        for (int idx = tid; idx < 16 * 64; idx += 512) YV[(128 + (idx >> 6)) * 72 + (idx & 63)] = (bf16_t)((idx >> 6) == 0 ? 0x3F80 : 0);
    } else {
        load_gated<false>(a, P, I, l, d, sg, qv, kv, x0);
        float run = 0.f;
#pragma unroll
        for (int i = 0; i < 8; ++i) { run += x0[i]; x0[i] = run; }
        TOT[sg * 64 + d] = run; LDS_WAIT(); __syncthreads();
        float pre = 0.f, tot = 0.f;
#pragma unroll
        for (int w = 0; w < 8; ++w) { const float t = TOT[w * 64 + d]; if (w < sg) pre += t; tot += t; }
#pragma unroll
        for (int i = 0; i < 8; ++i) kv[i] *= __expf(tot - (pre + x0[i]));
        if (sg == 0) DEC[d] = __expf(tot);
    }
    { u32x4 w; w.x = pk2(kv[0], kv[1]); w.y = pk2(kv[2], kv[3]); w.z = pk2(kv[4], kv[5]); w.w = pk2(kv[6], kv[7]); *(LAS u32x4*)(XT + d * 72 + 8 * sg) = w; }
    stage_vT(P, I, YV, 72, tid);
    LDS_WAIT(); __syncthreads();
    f32x4 acc[4];
#pragma unroll
    for (int mt = 0; mt < 4; ++mt) acc[mt] = (f32x4){0.f, 0.f, 0.f, 0.f};
#pragma unroll
    for (int ks = 0; ks < 2; ++ks) { const bf16x8 b = ldfrag(YV, 72, 16 * sg, 32 * ks, lane);
#pragma unroll
        for (int mt = 0; mt < 4; ++mt) acc[mt] = __builtin_amdgcn_mfma_f32_16x16x32_bf16(ldfrag(XT, 72, 16 * mt, 32 * ks, lane), b, acc[mt], 0, 0, 0); }
    { const int e = 16 * sg + (lane & 15);
#pragma unroll
      for (int mt = 0; mt < 4; ++mt) { u32x2 o; o.x = pk2(acc[mt][0], acc[mt][1]); o.y = pk2(acc[mt][2], acc[mt][3]); *(u32x2*)(US + e * 64 + 16 * mt + 4 * (lane >> 4)) = o; } }
    if (I.br == 0 && sg < 4) {
        f32x4 an = (f32x4){0.f, 0.f, 0.f, 0.f};
#pragma unroll
        for (int ks = 0; ks < 2; ++ks) an = __builtin_amdgcn_mfma_f32_16x16x32_bf16(ldfrag(XT, 72, 16 * sg, 32 * ks, lane), ldfrag(YV, 72, 128, 32 * ks, lane), an, 0, 0, 0);
        if ((lane & 15) == 0) { const int d0 = 16 * sg + 4 * (lane >> 4); DEC[d0] = an[0]; DEC[d0 + 1] = an[1]; DEC[d0 + 2] = an[2]; DEC[d0 + 3] = an[3]; }
    }
    __syncthreads();
}

__device__ __forceinline__ void scan_s2(const Args& a, int l, int g) {
    const int T = g < 2 ? 4096 : 256, NC = T >> 6, nseq = g < 2 ? 2 : 32, nslot = nseq * 24 * 1024;
    bf16_t* USb = (bf16_t*)(a.ws + WS_BIG + BIG_US); float* DECb = (float*)(a.ws + WS_DEC); float* SCb = (float*)(a.ws + WS_SC);
    int tid_ = threadIdx.x; asm volatile("" : "+v"(tid_));
    for (int slot = blockIdx.x * 512 + tid_; slot < nslot; slot += gridDim.x * 512) {
        const int sub = slot & 1023, stream = slot >> 10, hdb = stream % 24, seq = stream / 24, br = hdb >> 3, dir = (hdb >> 2) & 1, head = hdb & 3;
        const int e = sub >> 3, d0 = (sub & 7) * 8;
        float S[8], nst[8], mst = 0.f;
#pragma unroll
        for (int i = 0; i < 8; ++i) { S[i] = 0.f; nst[i] = 0.f; }
        if (g < 2) { const int b = g * 2 + seq; const size_t sidx = (size_t)((b * 2 + l) * 2 + dir) * 4 + head;
            const float* sp = (br == 0 ? inp(a, I_SC) : (br == 1 ? inp(a, I_SG) : inp(a, I_SH))) + sidx * 8192;
#pragma unroll
            for (int i = 0; i < 8; ++i) S[i] = sp[(d0 + i) * 128 + e];
            if (br == 0) { mst = inp(a, I_SM)[sidx];
#pragma unroll
                for (int i = 0; i < 8; ++i) nst[i] = inp(a, I_SN)[sidx * 64 + d0 + i]; } }
        const bool nrow = (br == 0) && (e == 0);
        for (int c = 0; c < NC; ++c) {
            const size_t it = (size_t)(seq * NC + c) * 24 + hdb;
            bf16_t* p = USb + it * 8192 + e * 64 + d0; float* dec = DECb + it * 64 + d0; float* sc = SCb + it * 4;
            const u32x4 u = *(const u32x4*)p;
            const float uu[8] = {bflo(u.x), bfhi(u.x), bflo(u.y), bfhi(u.y), bflo(u.z), bfhi(u.z), bflo(u.w), bfhi(u.w)};
            { u32x4 w; w.x = pk2(S[0], S[1]); w.y = pk2(S[2], S[3]); w.z = pk2(S[4], S[5]); w.w = pk2(S[6], S[7]); *(u32x4*)p = w; }
            if (br == 0) {
                const float mlw = sc[0], bl = sc[1]; const float mn = fmaxf(bl + mst, mlw); const float fa = __expf(bl + mst - mn), fb = __expf(mlw - mn);
                if (nrow) { const f32x4 n0 = *(const f32x4*)dec, n1 = *(const f32x4*)(dec + 4);
                    *(f32x4*)dec = (f32x4){nst[0], nst[1], nst[2], nst[3]}; *(f32x4*)(dec + 4) = (f32x4){nst[4], nst[5], nst[6], nst[7]};
                    const float nn[8] = {n0.x, n0.y, n0.z, n0.w, n1.x, n1.y, n1.z, n1.w};
#pragma unroll
                    for (int i = 0; i < 8; ++i) nst[i] = fa * nst[i] + fb * nn[i];
                    if (d0 == 0) sc[2] = mst; }
#pragma unroll
                for (int i = 0; i < 8; ++i) S[i] = fa * S[i] + fb * uu[i];
                mst = mn;
            } else {
                const f32x4 q0 = *(const f32x4*)dec, q1 = *(const f32x4*)(dec + 4); const float dd[8] = {q0.x, q0.y, q0.z, q0.w, q1.x, q1.y, q1.z, q1.w};
#pragma unroll
                for (int i = 0; i < 8; ++i) S[i] = dd[i] * S[i] + uu[i];
            }
        }
        if (g == 2) { const size_t sidx = (size_t)((seq * 2 + l) * 2 + dir) * 4 + head;
            float* op = a.out + (br == 0 ? OFF_C : (br == 1 ? OFF_G : OFF_H)) + sidx * 8192;
#pragma unroll
            for (int i = 0; i < 8; ++i) op[(d0 + i) * 128 + e] = S[i];
            if (nrow) {
#pragma unroll
                for (int i = 0; i < 8; ++i) a.out[OFF_N + sidx * 64 + d0 + i] = nst[i];
                if (d0 == 0) a.out[OFF_M + sidx] = mst; } }
    }
}

constexpr int S3_QO = 0, S3_KO = 23040, S3_G = 41472, S3_XA = 57856, S3_YV = 75264, S3_TOT = 114432, S3_VEC = 116480;
__device__ __forceinline__ void scan_s3(const Args& a, LAS unsigned char* lds, int l, int g, int it) {
    int tid_ = threadIdx.x; asm volatile("" : "+v"(tid_)); const int tid = tid_, d = tid & 63, lane = d, sg = __builtin_amdgcn_readfirstlane(tid >> 6);
    const ItemInfo I = item_info(g, it);
    const bf16_t* P = (const bf16_t*)(a.ws + WS_BIG);
    const bf16_t* US = (const bf16_t*)(a.ws + WS_BIG + BIG_US) + (size_t)it * 8192;
    const float* DEC = (const float*)(a.ws + WS_DEC) + (size_t)it * 64; const float* SC = (const float*)(a.ws + WS_SC) + (size_t)it * 4;
    bf16_t* Od = I.dir == 0 ? (bf16_t*)(a.ws + WS_A) + (size_t)g * GROWS * 1536 : (bf16_t*)(a.ws + WS_BIG + BIG_OB);
    LAS bf16_t* QO = (LAS bf16_t*)(lds + S3_QO); LAS bf16_t* KO = (LAS bf16_t*)(lds + S3_KO); LAS float* G = (LAS float*)(lds + S3_G);
    LAS bf16_t* XA = (LAS bf16_t*)(lds + S3_XA); LAS bf16_t* YV = (LAS bf16_t*)(lds + S3_YV); LAS float* TOT = (LAS float*)(lds + S3_TOT);
    LAS float* Bv = (LAS float*)(lds + S3_VEC); LAS float* LIv = Bv + 64; LAS float* MT = Bv + 128; LAS float* EI = Bv + 192;
    float qv[8], kv[8], x0[8], x1[8];
    stage_vT(P, I, YV, 136, tid);
    { const int e = tid >> 2, part = tid & 3; const u32x4 s0 = *(const u32x4*)(US + e * 64 + 16 * part), s1 = *(const u32x4*)(US + e * 64 + 16 * part + 8);
      *(LAS u32x4*)(YV + e * 136 + 64 + 16 * part) = s0; *(LAS u32x4*)(YV + e * 136 + 64 + 16 * part + 8) = s1; }
    const int bi = sg >> 1;
    f32x4 acc[4];
#pragma unroll
    for (int nt = 0; nt < 4; ++nt) acc[nt] = (f32x4){0.f, 0.f, 0.f, 0.f};
    if (I.br != 0) {
        load_gated<true>(a, P, I, l, d, sg, qv, kv, x0);
        float run = 0.f;
#pragma unroll
        for (int i = 0; i < 8; ++i) { run += x0[i]; x0[i] = run; }
        TOT[sg * 64 + d] = run; LDS_WAIT(); __syncthreads();
        float pre = 0.f;
#pragma unroll
        for (int w = 0; w < 8; ++w) { const float t = TOT[w * 64 + d]; if (w < sg) pre += t; }
#pragma unroll
        for (int i = 0; i < 8; ++i) { x0[i] += pre; const int s = 8 * sg + i; G[s * 64 + d] = x0[i]; XA[s * 136 + 64 + d] = (bf16_t)f2bf(qv[i] * __expf(x0[i])); }
        LDS_WAIT(); __syncthreads();
        const float gs = bi ? G[(16 * bi - 1) * 64 + d] : 0.f, geo = G[(16 * bi + 15) * 64 + d];
        float gej[3];
#pragma unroll
        for (int j = 0; j < 3; ++j) gej[j] = G[(16 * j + 15) * 64 + d];
#pragma unroll
        for (int i = 0; i < 8; ++i) { const int tt = 8 * (sg & 1) + i;
            QO[(6 + bi) * 1152 + tt * 72 + d] = (bf16_t)f2bf(qv[i] * __expf(x0[i] - gs));
            KO[(4 + bi) * 1152 + tt * 72 + d] = (bf16_t)f2bf(kv[i] * __expf(fminf(gs - x0[i], 80.f)));
            KO[bi * 1152 + tt * 72 + d] = (bf16_t)f2bf(kv[i] * __expf(geo - x0[i]));
#pragma unroll
            for (int j = 0; j < 3; ++j) if (j < bi) QO[(bi * (bi - 1) / 2 + j) * 1152 + tt * 72 + d] = (bf16_t)f2bf(qv[i] * __expf(fminf(x0[i] - gej[j], 0.f))); }
        LDS_WAIT(); __syncthreads();
#pragma unroll
        for (int jj = 0; jj < 2; ++jj) { const int j = 2 * (sg & 1) + jj; f32x4 t = (f32x4){0.f, 0.f, 0.f, 0.f};
            if (j <= bi) { const int qt = (j == bi) ? 6 + bi : bi * (bi - 1) / 2 + j, kt = (j == bi) ? 4 + bi : j;
#pragma unroll
                for (int ks = 0; ks < 2; ++ks) t = __builtin_amdgcn_mfma_f32_16x16x32_bf16(ldfrag(QO + qt * 1152, 72, 0, 32 * ks, lane), ldfrag(KO + kt * 1152, 72, 0, 32 * ks, lane), t, 0, 0, 0); }
#pragma unroll
            for (int r = 0; r < 4; ++r) { const int tl = 4 * (lane >> 4) + r, sl = lane & 15; float v = t[r]; if (j == bi && sl > tl) v = 0.f;
                XA[(16 * bi + tl) * 136 + 16 * j + sl] = (bf16_t)f2bf(v); } }
        LDS_WAIT(); __syncthreads();
    } else {
        load_mlstm<true>(a, P, I, l, d, sg, qv, kv, x0, x1);
        float run = 0.f;
#pragma unroll
        for (int i = 0; i < 8; ++i) { run += x0[i]; x0[i] = run; }
        TOT[sg * 64 + d] = run;
        for (int idx = tid; idx < 16 * 128; idx += 512) { const int r = idx >> 7, k = idx & 127; YV[(128 + r) * 136 + k] = (bf16_t)(r == 0 ? (k < 64 ? 0x3F80u : f2bf(DEC[k - 64])) : 0u); }
        LDS_WAIT(); __syncthreads();
        float pre = 0.f;
#pragma unroll
        for (int w = 0; w < 8; ++w) { const float t = TOT[w * 64 + d]; if (w < sg) pre += t; }
#pragma unroll
        for (int i = 0; i < 8; ++i) { x0[i] += pre; const int s = 8 * sg + i; if (d == 0) { Bv[s] = x0[i]; LIv[s] = x1[i]; }
            QO[s * 72 + d] = (bf16_t)f2bf(qv[i]); KO[s * 72 + d] = (bf16_t)f2bf(kv[i]); }
        LDS_WAIT(); __syncthreads();
        if (tid < 64) { float rn = -3.0e38f; for (int s = 0; s <= tid; ++s) rn = fmaxf(rn, LIv[s] - Bv[s]);
            const float bt = Bv[tid], inter = bt + SC[2], mt = fmaxf(inter, bt + rn); MT[tid] = mt; EI[tid] = __expf(inter - mt); }
        f32x4 t2[2];
#pragma unroll
        for (int jj = 0; jj < 2; ++jj) { const int j = 2 * (sg & 1) + jj; t2[jj] = (f32x4){0.f, 0.f, 0.f, 0.f};
            if (j <= bi) {
#pragma unroll
                for (int ks = 0; ks < 2; ++ks) t2[jj] = __builtin_amdgcn_mfma_f32_16x16x32_bf16(ldfrag(QO, 72, 16 * bi, 32 * ks, lane), ldfrag(KO, 72, 16 * j, 32 * ks, lane), t2[jj], 0, 0, 0); } }
        LDS_WAIT(); __syncthreads();
#pragma unroll
        for (int jj = 0; jj < 2; ++jj) { const int j = 2 * (sg & 1) + jj;
#pragma unroll
            for (int r = 0; r < 4; ++r) { const int t = 16 * bi + 4 * (lane >> 4) + r, s = 16 * j + (lane & 15); float v = 0.f;
                if (s <= t) v = t2[jj][r] * __expf(Bv[t] - Bv[s] + LIv[s] - MT[t]);
                XA[t * 136 + s] = (bf16_t)f2bf(v); } }
#pragma unroll
        for (int i = 0; i < 8; ++i) { const int s = 8 * sg + i; XA[s * 136 + 64 + d] = (bf16_t)f2bf(qv[i] * EI[s]); }
        LDS_WAIT(); __syncthreads();
    }
    f32x4 accd[4];
#pragma unroll
    for (int nt = 0; nt < 4; ++nt) accd[nt] = (f32x4){0.f, 0.f, 0.f, 0.f};
#pragma unroll
    for (int ks = 0; ks < 4; ++ks) { const bf16x8 av = ldfrag(YV, 136, 16 * sg, 32 * ks, lane);
        bf16x8 ad = av; if (I.br == 0) ad = ldfrag(YV, 136, 128, 32 * ks, lane);
#pragma unroll
        for (int nt = 0; nt < 4; ++nt) { const bf16x8 bx = ldfrag(XA, 136, 16 * nt, 32 * ks, lane);
            acc[nt] = __builtin_amdgcn_mfma_f32_16x16x32_bf16(av, bx, acc[nt], 0, 0, 0);
            if (I.br == 0) accd[nt] = __builtin_amdgcn_mfma_f32_16x16x32_bf16(ad, bx, accd[nt], 0, 0, 0); } }
    const int ecol = I.br * 512 + I.head * 128 + 16 * sg + 4 * (lane >> 4);
#pragma unroll
    for (int nt = 0; nt < 4; ++nt) { const int t = 16 * nt + (lane & 15); f32x4 o = acc[nt];
        if (I.br == 0) { const float den = __shfl(accd[nt][0], lane & 15); const float dn = fmaxf(fabsf(den), __expf(-MT[t])); o = o * (1.0f / dn); }
        u32x2 w; w.x = pk2(o[0], o[1]); w.y = pk2(o[2], o[3]);
        *(u32x2*)(Od + (size_t)item_row(I, t) * 1536 + ecol) = w; }
    __syncthreads();
}

__device__ __forceinline__ void headnorm_row(const Args& a, int l, int g, int lr, int lane) {
    const bf16_t* P = (const bf16_t*)(a.ws + WS_BIG) + (size_t)lr * PN;
    bf16_t* of = (bf16_t*)(a.ws + WS_A) + ((size_t)g * GROWS + lr) * 1536; const bf16_t* ob = (const bf16_t*)(a.ws + WS_BIG + BIG_OB) + (size_t)lr * 1536;
#pragma unroll
    for (int br = 0; br < 3; ++br) { const int c = br * 512 + 8 * lane;
        const u32x4 f = *(const u32x4*)(of + c), b = *(const u32x4*)(ob + c);
        float o[8] = {bflo(f.x) + bflo(b.x), bfhi(f.x) + bfhi(b.x), bflo(f.y) + bflo(b.y), bfhi(f.y) + bfhi(b.y), bflo(f.z) + bflo(b.z), bfhi(f.z) + bfhi(b.z), bflo(f.w) + bflo(b.w), bfhi(f.w) + bfhi(b.w)};
        float ss = 0.f;
#pragma unroll
        for (int i = 0; i < 8; ++i) ss += o[i] * o[i];
        ss += __shfl_xor(ss, 1); ss += __shfl_xor(ss, 2); ss += __shfl_xor(ss, 4); ss += __shfl_xor(ss, 8);
        const float rr = rsqrtf(ss * (1.0f / 128.0f) + EPSN);
        const u32x4 gt = *(const u32x4*)(P + (br == 0 ? C_MO : (br == 1 ? C_GR : C_HG)) + 8 * lane);
        const float gv[8] = {bflo(gt.x), bfhi(gt.x), bflo(gt.y), bfhi(gt.y), bflo(gt.z), bfhi(gt.z), bflo(gt.w), bfhi(gt.w)};
        const float* hn = inp(a, I_HN) + (size_t)(l * 3 + br) * 512 + 8 * lane;
        const f32x4 h0 = *(const f32x4*)hn, h1 = *(const f32x4*)(hn + 4); const float hw[8] = {h0.x, h0.y, h0.z, h0.w, h1.x, h1.y, h1.z, h1.w};
        float y[8];
#pragma unroll
        for (int i = 0; i < 8; ++i) { const float gg = br == 0 ? sigmoidf_(gv[i]) : siluf_(gv[i]); y[i] = gg * (o[i] * rr) * hw[i]; }
        u32x4 w; w.x = pk2(y[0], y[1]); w.y = pk2(y[2], y[3]); w.z = pk2(y[4], y[5]); w.w = pk2(y[6], y[7]); *(u32x4*)(of + c) = w; }
}

#ifndef REP_S1
#define REP_S1 1
#endif
#ifndef REP_S3
#define REP_S3 1
#endif
#ifndef REP_G
#define REP_G 1
#endif
template <int M_, int N_, int K_, int LDA_, int LDB_, int ADIV, int AMUL, class Epi>
__device__ __forceinline__ void run_gemm(LAS unsigned char* lds, const bf16_t* A, const bf16_t* Bt, const Epi& E) {
    typedef pg8::GemmT<M_, N_, K_, LDA_, LDB_> GT; GT g{A, Bt}; pg8::StaticOrderT<M_, N_, ADIV, AMUL> S; S.init((int)gridDim.x, (int)blockIdx.x);
    pg8::gemm_phase<GT, Epi, pg8::StaticOrderT<M_, N_, ADIV, AMUL>, true, true>((PG8_LAS unsigned char*)lds, g, S, E);
}

__global__ void __launch_bounds__(512, 2) mk_fwd(Args a) {
    extern __shared__ __attribute__((aligned(16))) unsigned char lds_raw[];
    LAS unsigned char* lds = (LAS unsigned char*)lds_raw;
    cg::grid_group grid = cg::this_grid();
    for (int u = threadIdx.x; u < (LDS_BYTES - 131072) / 4; u += 512) ((LAS unsigned*)(lds + 131072))[u] = 0u;
    __syncthreads();
    (void)xcd_barrier_post((unsigned*)a.ws, (volatile LAS unsigned*)(lds + 131072 + 352));
    const int tid = threadIdx.x, lane = tid & 63, wave = __builtin_amdgcn_readfirstlane(tid >> 6);
    const int G = gridDim.x, gw = blockIdx.x * 8 + wave, NGW = G * 8;
    unsigned char* ws = a.ws;
    float* mod = (float*)(ws + WS_MOD);

#ifndef SKIP_PRO
    convert_weights(a, lds, 0, gw, NGW, lane, wave);
    ada_partial(a, gw, NGW, lane);
    { float* pos = (float*)(ws + WS_POS);
      for (int i = blockIdx.x * 512 + tid; i < 64 * 512; i += G * 512) { const int v = i >> 9, j = i & 511, fi = j & 255;
          const float fr = expf((-9.210340371976184f * (float)fi) / 256.0f); const float ang = (float)v * fr; pos[i] = j < 256 ? sinf(ang) : cosf(ang); } }
    grid.sync();
    { const float* modp = (const float*)(ws + WS_MODP);
      for (int i = blockIdx.x * 512 + tid; i < 2 * 5 * 9216; i += G * 512) { const int col = i % 9216, l = i / (5 * 9216); float s = inp(a, I_BADA)[l * 9216 + col];
#pragma unroll
          for (int ks = 0; ks < 8; ++ks) s += modp[(size_t)ks * (2 * 5 * 9216) + i]; mod[i] = s; } }
    xcd_barrier_ni((unsigned*)a.ws, 131072 + 352);
    { RowOp op{}; op.src_input = 1; op.has_y = 0; op.has_xn = 1; op.npre = inp(a, I_NPRE); op.md_base = mod; op.si = 0; op.add_pos = 0;
      for (int r = gw; r < MTOT; r += NGW) rowwise(a, op, r, lane); }
    xcd_barrier_ni((unsigned*)a.ws, 131072 + 352);
#endif

    for (int l = 0; l < 2; ++l) {
        for (int st = 0; st < 25; ++st) {
            int tid = threadIdx.x; asm volatile("" : "+v"(tid));
            const int lane = tid & 63, wave = __builtin_amdgcn_readfirstlane(tid >> 6), gw = blockIdx.x * 8 + wave;
            unsigned char* ws = a.ws; asm volatile("" : "+s"(ws));
            float* mod = (float*)(ws + WS_MOD); const float* modl = mod + (size_t)l * 5 * 9216;
            bf16_t* XN = (bf16_t*)(ws + WS_XN); bf16_t* BIG = (bf16_t*)(ws + WS_BIG); float* Y = (float*)(ws + WS_A); bf16_t* YS = (bf16_t*)(ws + WS_A);
            unsigned char* wb = ws + WS_W; const int G = gridDim.x, NGW = G * 8;
            const int kind = (st == 0 || st == 22) ? 0 : (st == 1 || st == 20 || st == 23) ? 1 : (st == 2 || st == 21 || st == 24) ? 2 : (st == 18) ? 3 : (st == 19) ? 4 : 5 + ((st - 3) % 5);
            const int g = (st >= 3 && st < 18) ? (st - 3) / 5 : 0;
            switch (kind) {
            case 0: {
#ifndef SKIP_G0
                const int f = st == 0 ? 0 : 1; EpiSwiGLU E{BIG, DFF};
                for (int rep = 0; rep < REP_G; ++rep) run_gemm<MTOT, NFF2, D, D, D, 0, 0>(lds, XN, (const bf16_t*)(wb + W_FFIN) + (size_t)f * NFF2 * D, E);
#endif
                break; }
            case 1: {
#ifndef SKIP_G1
                EpiF32 E{Y, D};
                for (int rep = 0; rep < REP_G; ++rep)
                if (st == 20) run_gemm<MTOT, D, 3072, 3072, 3072, 0, 0>(lds, BIG, (const bf16_t*)(wb + W_O3), E);
                else run_gemm<MTOT, D, DFF, DFF, DFF, 0, 0>(lds, BIG, (const bf16_t*)(wb + W_FFOUT) + (size_t)(st == 1 ? 0 : 1) * D * DFF, E);
#endif
                break; }
            case 2: {
#ifndef SKIP_ROW
                RowOp op{}; op.has_y = 1; op.mdg_base = modl + (st == 2 ? 2 : st == 21 ? 5 : 8) * D; op.coef = st == 21 ? 1.0f : 0.5f;
                op.npost = inp(a, I_NPOST) + (size_t)(l * 3 + (st == 2 ? 0 : st == 21 ? 1 : 2)) * D; op.src_input = (l == 0 && st == 2) ? 1 : 0;
                if (st == 2) { op.has_xn = 1; op.npre = inp(a, I_NPRE) + (size_t)(l * 3 + 1) * D; op.md_base = modl; op.si = 3; op.add_pos = 1; }
                else if (st == 21) { op.has_xn = 1; op.npre = inp(a, I_NPRE) + (size_t)(l * 3 + 2) * D; op.md_base = modl; op.si = 6; op.add_pos = 0; }
                else { op.has_xn = (l == 0) ? 1 : 0; op.npre = inp(a, I_NPRE) + (size_t)3 * D; op.md_base = mod + (size_t)5 * 9216; op.si = 0; op.add_pos = 0; }
                for (int r = gw; r < MTOT; r += NGW) rowwise(a, op, r, lane);
                if (st == 24 && l == 0) { __syncthreads(); convert_weights(a, lds, 1, gw, NGW, lane, wave); }
#endif
                break; }
            case 3: {
#ifndef SKIP_G3
                EpiBf16 E{BIG, 3072};
                for (int rep = 0; rep < REP_G; ++rep) run_gemm<MTOT, 3072, 512, 1536, 512, 4, 512>(lds, YS, (const bf16_t*)(wb + W_B), E);
#endif
                break; }
            case 4: {
#ifndef SKIP_G4
                EpiGateMul E{BIG, 3072};
                run_gemm<MTOT, MGN, D, D, D, 0, 0>(lds, XN, (const bf16_t*)(wb + W_MG), E);
#endif
                break; }
            case 5: {
#ifndef SKIP_G3
                EpiBf16 E{BIG, PN};
                for (int rep = 0; rep < REP_G; ++rep) run_gemm<GROWS, PN, D, D, D, 0, 0>(lds, XN + (size_t)g * GROWS * D, (const bf16_t*)(wb + W_P), E);
#endif
                break; }
            case 6: {
#ifndef SKIP_S1
                for (int rep = 0; rep < REP_S1; ++rep) for (int it = blockIdx.x; it < 3072; it += G) scan_s1(a, lds, l, g, it);
#endif
                break; }
            case 7: {
#ifndef SKIP_S2
                scan_s2(a, l, g);
#endif
                break; }
            case 8: {
#ifndef SKIP_S3
                for (int rep = 0; rep < REP_S3; ++rep) for (int it = blockIdx.x; it < 3072; it += G) scan_s3(a, lds, l, g, it);
#endif
                break; }
            default: {
#ifndef SKIP_HN
                for (int lr = gw; lr < GROWS; lr += NGW) headnorm_row(a, l, g, lr, lane);
#endif
                break; }
            }
            xcd_barrier_ni((unsigned*)a.ws, 131072 + 352);
#ifdef EXTRA_SYNC
            xcd_barrier_ni((unsigned*)a.ws, 131072 + 352);
#endif
        }
    }
}

extern "C" void kernel_launch(void* const* d_in, const int* in_sizes, int n_in, void* d_out, int out_size, void* d_ws, size_t ws_size, hipStream_t stream) {
    static int grid = 0;
    if (grid == 0) {
        if (n_in != 23 || ws_size < WS_END) { fprintf(stderr, "kernel_launch: unexpected n_in %d / ws_size %zu (need %zu)\n", n_in, ws_size, (size_t)WS_END); grid = -1; return; }
        int dev = 0, cus = 0, per_cu = 0;
        hipGetDevice(&dev); hipDeviceGetAttribute(&cus, hipDeviceAttributeMultiprocessorCount, dev);
        hipFuncSetAttribute((const void*)mk_fwd, hipFuncAttributeMaxDynamicSharedMemorySize, LDS_BYTES);
        hipOccupancyMaxActiveBlocksPerMultiprocessor(&per_cu, (const void*)mk_fwd, 512, LDS_BYTES);
        (void)hipGetLastError();
        if (per_cu < 1) per_cu = 1;
        grid = cus;
    }
    if (grid < 0) return;
    if (hipMemsetAsync(d_ws, 0, 16384, stream) != hipSuccess) { fprintf(stderr, "memset failed\n"); return; }
    Args a{};
    for (int i = 0; i < 23; ++i) a.in[i] = (const float*)d_in[i];
    a.out = (float*)d_out; a.ws = (unsigned char*)d_ws;
    void* args[] = {&a};
    hipError_t e = hipLaunchCooperativeKernel((const void*)mk_fwd, dim3(grid), dim3(512), args, LDS_BYTES, stream);
    if (e != hipSuccess) fprintf(stderr, "cooperative launch failed: %s (grid %d)\n", hipGetErrorString(e), grid);
}
```

```cpp
#include <hip/hip_runtime.h>
#include <hip/hip_cooperative_groups.h>
#include <cstdio>
#include <cstdint>
namespace cg = cooperative_groups;

namespace pg8 {
#define PG8_LAS __attribute__((address_space(3)))
typedef unsigned short bf16_t;
typedef short bf16x8 __attribute__((ext_vector_type(8)));
typedef float f32x4 __attribute__((ext_vector_type(4)));
typedef unsigned u32x4 __attribute__((ext_vector_type(4)));
typedef unsigned u32x2 __attribute__((ext_vector_type(2)));
constexpr int BM = 256, BK = 64, HALF = 128, HTB = HALF * BK * 2, STAGE_BYTES = 8 * HTB, NXCD = 8, WGM = 8;

__host__ __device__ __forceinline__ int lds_byte(int r, int c) { const int st = (r >> 4) * 2 + (c >> 5), rr = r & 15, cc = c & 31, ob = rr * 64 + cc * 2; return st * 1024 + (ob ^ (((ob >> 9) & 1) << 5)); }
__host__ __device__ __forceinline__ void stage_rc(int b, int& R, int& C) { const int st = b / 1024, sb = b % 1024, swz = sb ^ (((sb >> 9) & 1) << 5); R = (st >> 1) * 16 + swz / 64; C = (st & 1) * 32 + (swz % 64) / 2; }
__host__ __device__ __forceinline__ int perm32(int rho) { const int n = rho >> 4, i = rho & 15; return 8 * (i >> 2) + 4 * n + (i & 3); }

struct Unit { int pm, pn; };
template <int M_, int N_, int K_, int LDA_, int LDB_> struct GemmT { const bf16_t* A; const bf16_t* Bt; static constexpr int M = M_, N = N_, K = K_, lda = LDA_, ldb = LDB_; };

template <int M_, int N_, int ADIV, int AMUL> struct StaticOrderT {
    static constexpr int nM = M_ / BM, nN = N_ / BM, nwg = nM * nN;
    int G, c;
    __device__ void init(int G_, int c_) { G = G_; c = c_; }
    __device__ __forceinline__ bool next(int i, Unit& u) const {
        const int L = i * G + c; if (L >= nwg) return false;
        int wgid = L; { constexpr int q = nwg / NXCD, r = nwg % NXCD; const int xcd = wgid % NXCD, off = wgid / NXCD; wgid = (xcd < r ? xcd * (q + 1) : r * (q + 1) + (xcd - r) * q) + off; }
        constexpr int nig = WGM * nN; const int gid = wgid / nig, fm = gid * WGM, gsz = (nM - fm) < WGM ? (nM - fm) : WGM;
        u.pm = fm + ((wgid % nig) % gsz); u.pn = (wgid % nig) / gsz; return true;
    }
    __device__ __forceinline__ int a_off(const Unit& u) const { return ADIV > 0 ? (u.pn / (ADIV > 0 ? ADIV : 1)) * AMUL : 0; }
    __device__ __forceinline__ void a_ready(const Unit&) const {}
    __device__ __forceinline__ void done(const Unit&) const {}
};

template <class GT, class Epi, class Sched, bool ALIGN_EPI = false, bool SP2 = false>
__device__ __forceinline__ void gemm_phase(PG8_LAS unsigned char* lds, const GT g, const Sched& S, const Epi& E) {
    int tid_ = threadIdx.x; asm volatile("" : "+v"(tid_));
    const int tid = tid_, wid = __builtin_amdgcn_readfirstlane(tid >> 6), lane = tid & 63, wr = wid >> 2, wc = wid & 3, fr = lane & 15, fq = lane >> 4;
    constexpr int K = GT::K, nt = K / BK;
    unsigned voffA[2], voffB[2];
#pragma unroll
    for (int i = 0; i < 2; ++i) { int R, C; stage_rc(tid * 16 + i * 8192, R, C); const int Rb = Epi::PERM ? ((R & ~31) + perm32(R & 31)) : R;
        voffA[i] = (unsigned)(R * GT::lda + C) * 2u; voffB[i] = (unsigned)(Rb * GT::ldb + C) * 2u; }
    constexpr size_t kstep = (size_t)(BK * 2);
    constexpr size_t hstepA = (size_t)HALF * GT::lda * 2, hstepB = (size_t)HALF * GT::ldb * 2;
    constexpr size_t tstepA = 2 * hstepA, tstepB = 2 * hstepB;
    const unsigned ldsw = (unsigned)wid * 1024u;
    const int aoff = lds_byte(wr * 64 + fr, fq * 8), boff = lds_byte(wc * 32 + fr, fq * 8);
#define PG8_SA(b, h) (((b) * 2 + (h)) * HTB)
#define PG8_SB(b, h) ((4 + (b) * 2 + (h)) * HTB)
#define PG8_STAGE(bufoff, gbase, voff) do { _Pragma("unroll") for (int _i = 0; _i < 2; ++_i) \
        __builtin_amdgcn_global_load_lds((const unsigned*)((const char*)(gbase) + (voff)[_i]), (PG8_LAS unsigned*)(lds + (bufoff) + ldsw + _i * 8192), 16, 0, 0); } while (0)
#define PG8_LDA(dst, b, h) do { _Pragma("unroll") for (int m = 0; m < 4; ++m) _Pragma("unroll") for (int k = 0; k < 2; ++k) dst[m][k] = *(const PG8_LAS bf16x8*)(lds + PG8_SA(b, h) + aoff + m * 2048 + k * 1024); } while (0)
#define PG8_LDB(dst, b, h) do { _Pragma("unroll") for (int n = 0; n < 2; ++n) _Pragma("unroll") for (int k = 0; k < 2; ++k) dst[n][k] = *(const PG8_LAS bf16x8*)(lds + PG8_SB(b, h) + boff + n * 2048 + k * 1024); } while (0)
#define PG8_MMA(ai, bj, At, Bt) do { __builtin_amdgcn_s_setprio(1); _Pragma("unroll") for (int m = 0; m < 4; ++m) _Pragma("unroll") for (int n = 0; n < 2; ++n) _Pragma("unroll") for (int k = 0; k < 2; ++k) \
        acc[ai][bj][m][n] = __builtin_amdgcn_mfma_f32_16x16x32_bf16(Bt[n][k], At[m][k], acc[ai][bj][m][n], 0, 0, 0); __builtin_amdgcn_s_setprio(0); } while (0)
#define PG8_WAIT_V(n) asm volatile("s_waitcnt vmcnt(" #n ")" ::: "memory")
#define PG8_WAIT_L(n) asm volatile("s_waitcnt lgkmcnt(" #n ")" ::: "memory")
#define PG8_BAR __builtin_amdgcn_s_barrier()
#define PG8_SCHED __builtin_amdgcn_sched_barrier(0)
    Unit cur, nxt; int ui = 0;
    if (!S.next(0, cur)) return;
    f32x4 acc[2][2][4][2];
#pragma unroll
    for (int a = 0; a < 2; ++a)
#pragma unroll
        for (int b = 0; b < 2; ++b)
#pragma unroll
            for (int m = 0; m < 4; ++m)
#pragma unroll
                for (int n = 0; n < 2; ++n) acc[a][b][m][n] = (f32x4){0.f, 0.f, 0.f, 0.f};
    bf16x8 At[4][2], B0[2][2], B1[2][2];
    const char* cA = (const char*)g.A + (size_t)cur.pm * tstepA + (size_t)S.a_off(cur) * 2; const char* cB = (const char*)g.Bt + (size_t)cur.pn * tstepB;
    S.a_ready(cur);
    if constexpr (SP2) {
        PG8_STAGE(PG8_SB(0, 0), cB, voffB); PG8_STAGE(PG8_SB(0, 1), cB + hstepB, voffB); PG8_STAGE(PG8_SA(0, 0), cA, voffA); PG8_STAGE(PG8_SA(0, 1), cA + hstepA, voffA);
        if (wr == 1) PG8_BAR;
        PG8_WAIT_V(2); PG8_BAR;
        PG8_STAGE(PG8_SB(1, 0), cB + kstep, voffB); PG8_STAGE(PG8_SA(1, 0), cA + kstep, voffA); PG8_STAGE(PG8_SB(1, 1), cB + hstepB + kstep, voffB);
        PG8_WAIT_V(6); PG8_BAR;
    } else {
        PG8_STAGE(PG8_SB(0, 0), cB, voffB); PG8_STAGE(PG8_SA(0, 0), cA, voffA); PG8_STAGE(PG8_SB(0, 1), cB + hstepB, voffB); PG8_STAGE(PG8_SA(0, 1), cA + hstepA, voffA);
        if (wr == 1) PG8_BAR;
        PG8_WAIT_V(4); PG8_BAR;
        PG8_STAGE(PG8_SB(1, 0), cB + kstep, voffB); PG8_STAGE(PG8_SA(1, 0), cA + kstep, voffA); PG8_STAGE(PG8_SB(1, 1), cB + hstepB + kstep, voffB);
        PG8_WAIT_V(6); PG8_BAR;
    }
    for (;;) {
        const bool has_next = S.next(ui + 1, nxt);
        const char* nA = has_next ? (const char*)g.A + (size_t)nxt.pm * tstepA + (size_t)S.a_off(nxt) * 2 : cA; const char* nB = has_next ? (const char*)g.Bt + (size_t)nxt.pn * tstepB : cB;
        for (int t = 0; t < nt; t += 2) {
            const bool last = (t == nt - 2);
            const char* a1 = cA + (size_t)(t + 1) * kstep;
            const char* a2 = last ? nA : cA + (size_t)(t + 2) * kstep; const char* b2 = last ? nB : cB + (size_t)(t + 2) * kstep;
            const char* a3 = a2 + kstep; const char* b3 = b2 + kstep;
            if (last && has_next) S.a_ready(nxt);
            if constexpr (SP2) {
            PG8_LDB(B0, 0, 0); PG8_LDB(B1, 0, 1); PG8_SCHED; PG8_LDA(At, 0, 0); PG8_STAGE(PG8_SA(1, 1), a1 + hstepA, voffA);
            PG8_WAIT_V(8); PG8_WAIT_L(0); PG8_BAR; PG8_MMA(0, 0, At, B0); PG8_MMA(0, 1, At, B1); PG8_BAR; PG8_SCHED;
            PG8_LDA(At, 0, 1); PG8_STAGE(PG8_SB(0, 0), b2, voffB); PG8_STAGE(PG8_SB(0, 1), b2 + hstepB, voffB); PG8_STAGE(PG8_SA(0, 0), a2, voffA);
            PG8_WAIT_V(8); PG8_WAIT_L(0); PG8_BAR; PG8_MMA(1, 0, At, B0); PG8_MMA(1, 1, At, B1); PG8_BAR; PG8_SCHED;
            PG8_LDB(B0, 1, 0); PG8_LDB(B1, 1, 1); PG8_SCHED; PG8_LDA(At, 1, 0); PG8_STAGE(PG8_SA(0, 1), a2 + hstepA, voffA);
            PG8_WAIT_V(8); PG8_WAIT_L(0); PG8_BAR; PG8_MMA(0, 0, At, B0); PG8_MMA(0, 1, At, B1); PG8_BAR; PG8_SCHED;
            PG8_LDA(At, 1, 1); PG8_STAGE(PG8_SB(1, 0), b3, voffB); PG8_STAGE(PG8_SB(1, 1), b3 + hstepB, voffB); PG8_STAGE(PG8_SA(1, 0), a3, voffA);
            PG8_WAIT_V(8); PG8_WAIT_L(0); PG8_BAR; PG8_MMA(1, 0, At, B0); PG8_MMA(1, 1, At, B1); PG8_BAR; PG8_SCHED;
            } else {
            PG8_LDB(B0, 0, 0); PG8_SCHED; PG8_LDA(At, 0, 0); PG8_STAGE(PG8_SA(1, 1), a1 + hstepA, voffA);
            PG8_WAIT_L(8); PG8_BAR; PG8_WAIT_L(0); PG8_MMA(0, 0, At, B0); PG8_BAR; PG8_SCHED;
            PG8_LDB(B1, 0, 1); PG8_STAGE(PG8_SB(0, 0), b2, voffB);
            PG8_BAR; PG8_WAIT_L(0); PG8_MMA(0, 1, At, B1); PG8_BAR;
            PG8_LDA(At, 0, 1); PG8_STAGE(PG8_SA(0, 0), a2, voffA);
            PG8_BAR; PG8_WAIT_L(0); PG8_MMA(1, 0, At, B0); PG8_BAR; PG8_SCHED;
            PG8_STAGE(PG8_SB(0, 1), b2 + hstepB, voffB);
            PG8_WAIT_V(6); PG8_BAR; PG8_MMA(1, 1, At, B1); PG8_BAR;
            PG8_LDB(B0, 1, 0); PG8_SCHED; PG8_LDA(At, 1, 0); PG8_STAGE(PG8_SA(0, 1), a2 + hstepA, voffA);
            PG8_WAIT_L(8); PG8_BAR; PG8_WAIT_L(0); PG8_MMA(0, 0, At, B0); PG8_BAR; PG8_SCHED;
            PG8_LDB(B1, 1, 1); PG8_STAGE(PG8_SB(1, 0), b3, voffB);
            PG8_BAR; PG8_WAIT_L(0); PG8_MMA(0, 1, At, B1); PG8_BAR;
            PG8_LDA(At, 1, 1); PG8_STAGE(PG8_SA(1, 0), a3, voffA);
            PG8_BAR; PG8_WAIT_L(0); PG8_MMA(1, 0, At, B0); PG8_BAR; PG8_SCHED;
            PG8_STAGE(PG8_SB(1, 1), b3 + hstepB, voffB);
            PG8_WAIT_V(6); PG8_BAR; PG8_MMA(1, 1, At, B1); PG8_BAR;
            }
        }
        if constexpr (ALIGN_EPI) { if (wr == 0) PG8_BAR; }
        if constexpr (!Epi::AFTER_DRAIN) { E(acc, cur, wr, wc, fr, fq); S.done(cur); }
        if (!has_next) break;
#pragma unroll
        for (int a = 0; a < 2; ++a)
#pragma unroll
            for (int b = 0; b < 2; ++b)
#pragma unroll
                for (int m = 0; m < 4; ++m)
#pragma unroll
                    for (int n = 0; n < 2; ++n) acc[a][b][m][n] = (f32x4){0.f, 0.f, 0.f, 0.f};
        cur = nxt; cA = nA; cB = nB; ++ui;
        if constexpr (ALIGN_EPI) { if (wr == 1) PG8_BAR; }
    }
    PG8_WAIT_V(0);
    if constexpr (!ALIGN_EPI) { if (wr == 0) PG8_BAR; }
    PG8_BAR;
    if constexpr (Epi::AFTER_DRAIN) { E.fused(acc, cur, wr, wc, fr, fq, lds, wid, lane); S.done(cur); }
#undef PG8_SA
#undef PG8_SB
#undef PG8_STAGE
#undef PG8_LDA
#undef PG8_LDB
#undef PG8_MMA
#undef PG8_WAIT_V
#undef PG8_WAIT_L
#undef PG8_BAR
#undef PG8_SCHED
}
}

#define LAS __attribute__((address_space(3)))
typedef unsigned short bf16_t;
typedef short bf16x8 __attribute__((ext_vector_type(8)));
typedef float f32x4 __attribute__((ext_vector_type(4)));
typedef unsigned u32x4 __attribute__((ext_vector_type(4)));
typedef unsigned u32x2 __attribute__((ext_vector_type(2)));

constexpr int D = 1024, DFF = 2816, NFF2 = 5632, INC = 7984, PN = 5120, PREAL = 4912, MGN = 3072;
constexpr int MTOT = 24576, MLAT = 16384, GROWS = 8192;
constexpr float EPSN = 1e-6f;
constexpr size_t MiB = 1u << 20;
constexpr size_t WS_MOD = 1 * MiB, WS_MODP = 2 * MiB, WS_POS = 5 * MiB, WS_DEC = 6 * MiB, WS_SC = 7 * MiB;
constexpr size_t WS_W = 8 * MiB;
constexpr size_t W_FFIN = 0, W_FFOUT = W_FFIN + 2ull * NFF2 * D * 2, W_P = W_FFOUT + 2ull * D * DFF * 2, W_MG = W_P + (size_t)PN * D * 2,
                 W_B = W_MG + (size_t)MGN * D * 2, W_O3 = W_B + 3072ull * 512 * 2, W_END = W_O3 + 1024ull * 3072 * 2;
static_assert(W_END <= 58 * MiB, "weights region");
constexpr size_t WS_XN = 66 * MiB, WS_A = 114 * MiB, WS_BIG = 210 * MiB, WS_END = 370 * MiB;
constexpr size_t BIG_US = 80 * MiB, BIG_OB = 128 * MiB;
constexpr size_t OFF_YP = 0, OFF_YS = 8388608, OFF_C = 25165824, OFF_N = 29360128, OFF_M = 29392896, OFF_G = 29393408, OFF_H = 33587712;
constexpr int LDS_BYTES = 147456;

struct Args { const float* in[23]; float* out; unsigned char* ws; };
enum { I_XP = 0, I_XS, I_C, I_SC, I_SN, I_SM, I_SG, I_SH, I_CCTX, I_WADA, I_BADA, I_NPRE, I_NPOST, I_WFIN, I_WFOUT, I_WIN, I_GB, I_GWUP, I_GLB, I_HGAM, I_HN, I_WBR, I_WOUT };
__device__ __forceinline__ const float* inp(const Args& a, int i) { asm volatile("" : "+s"(i)); return a.in[i]; }

__device__ __forceinline__ unsigned f2bf(float f) { unsigned u = __float_as_uint(f); return (u + 0x7fffu + ((u >> 16) & 1u)) >> 16; }
__device__ __forceinline__ unsigned pk2(float lo, float hi) { return f2bf(lo) | (f2bf(hi) << 16); }
__device__ __forceinline__ float bf2f(bf16_t h) { return __uint_as_float(((unsigned)h) << 16); }
__device__ __forceinline__ float bflo(unsigned w) { return __uint_as_float(w << 16); }
__device__ __forceinline__ float bfhi(unsigned w) { return __uint_as_float(w & 0xffff0000u); }
__device__ __forceinline__ float sigmoidf_(float x) { return 1.0f / (1.0f + __expf(-x)); }
__device__ __forceinline__ float siluf_(float x) { return x / (1.0f + __expf(-x)); }
__device__ __forceinline__ float logsigf_(float x) { return fminf(x, 0.f) - __logf(1.0f + __expf(-fabsf(x))); }
__device__ __forceinline__ float wave_sum(float v) {
#pragma unroll
    for (int o = 1; o < 64; o <<= 1) v += __shfl_xor(v, o);
    return v;
}
#define LDS_WAIT() asm volatile("s_waitcnt lgkmcnt(0)" ::: "memory")

#define XB_TMO      128
#define XB_XCNT(j)  (256  + 64 * (j))
#define XB_XSUB(j)  (1280 + 64 * (j))
#define XB_XGEN(j)  (2304 + 64 * (j))
#define XB_TOP      3328
#define XB_TOPGEN   3392
#define XCD_BAR_WORDS 3456
#define XB_SPIN_CAP (1u << 18)

__device__ __forceinline__ unsigned xb_ld(unsigned* p)              { return __hip_atomic_load(p, __ATOMIC_RELAXED, __HIP_MEMORY_SCOPE_AGENT); }
__device__ __forceinline__ unsigned xb_add(unsigned* p, unsigned v) { return __hip_atomic_fetch_add(p, v, __ATOMIC_RELAXED, __HIP_MEMORY_SCOPE_AGENT); }
__device__ __forceinline__ unsigned xb_xcc_id() { return (unsigned)__builtin_amdgcn_s_getreg((3 << 11) | 20) & 0xFu; }
#define XB_SPIN(cond, bar) do { unsigned _sp = 0; while (cond) { __builtin_amdgcn_s_sleep(1); \
    if ((++_sp & 255u) == 0u) { if (xb_ld(&(bar)[XB_TMO])) break; if (_sp > XB_SPIN_CAP) { atomicAdd(&(bar)[XB_TMO], 1u); break; } } } } while (0)

struct XcdBarrier {
    unsigned* bar; unsigned x;
    volatile LAS unsigned* st;
};

__device__ __forceinline__ XcdBarrier xcd_barrier_post(unsigned* bar, volatile LAS unsigned* st) {
    XcdBarrier b; b.bar = bar; b.x = xb_xcc_id(); b.st = st;
    if (threadIdx.x == 0) (void)xb_add(&bar[XB_XCNT(b.x)], 1u);
    return b;
}
__device__ __forceinline__ void xcd_barrier_complete(unsigned* bar, unsigned x, unsigned& nloc, unsigned& nx) {
    const unsigned G = gridDim.x * gridDim.y * gridDim.z;
    unsigned sum, cnt, mine, sp = 0u;
    for (;;) {
        sum = 0u; cnt = 0u; mine = 0u;
#pragma unroll
        for (unsigned j = 0; j < 16; ++j) { const unsigned c = xb_ld(&bar[XB_XCNT(j)]); sum += c; cnt += (c > 0u) ? 1u : 0u; mine = (j == x) ? c : mine; }
        if (sum == G) break;
        __builtin_amdgcn_s_sleep(1);
        if ((++sp & 255u) == 0u) { if (xb_ld(&bar[XB_TMO])) break; if (sp > XB_SPIN_CAP) { atomicAdd(&bar[XB_TMO], 1u); break; } }
    }
    nloc = mine > 0u ? mine : 1u; nx = cnt > 0u ? cnt : 1u;
}

__device__ __attribute__((noinline)) void xcd_barrier_ni(unsigned* bar_, unsigned st_off) {
    XcdBarrier b; b.bar = bar_; b.x = xb_xcc_id(); b.st = (volatile LAS unsigned*)(size_t)st_off;
    asm volatile("s_waitcnt vmcnt(0)" ::: "memory");
    __syncthreads();
    if (threadIdx.x == 0) {
        unsigned* bar = b.bar;
        __builtin_amdgcn_s_waitcnt(0);
        unsigned nloc = b.st[0], nx = b.st[1];
        if (nloc == 0u) { xcd_barrier_complete(bar, b.x, nloc, nx); b.st[0] = nloc; b.st[1] = nx; }
        const unsigned old = xb_add(&bar[XB_XSUB(b.x)], 1u);
        const unsigned gen = old / nloc;
        if (old + 1u == (gen + 1u) * nloc) {
            __builtin_amdgcn_fence(__ATOMIC_RELEASE, "agent");
            asm volatile("s_waitcnt vmcnt(0)" ::: "memory");
            const unsigned og = xb_add(&bar[XB_TOP], 1u);
            const unsigned tg = og / nx;
            if (og + 1u == (tg + 1u) * nx) xb_add(&bar[XB_TOPGEN], 1u);
            else XB_SPIN(xb_ld(&bar[XB_TOPGEN]) == tg, bar);
            __builtin_amdgcn_fence(__ATOMIC_ACQUIRE, "agent");
            xb_add(&bar[XB_XGEN(b.x)], 1u);
            asm volatile("s_waitcnt vmcnt(0)" ::: "memory");
        } else {
            XB_SPIN(xb_ld(&bar[XB_XGEN(b.x)]) == gen, bar);
            __builtin_amdgcn_fence(__ATOMIC_ACQUIRE, "agent");
            asm volatile("s_waitcnt vmcnt(0)" ::: "memory");
        }
    }
    __syncthreads();
}


struct EpiBf16 {
    static constexpr bool PERM = true, AFTER_DRAIN = false;
    bf16_t* O; int ldc;
    __device__ __forceinline__ void operator()(const f32x4 (&acc)[2][2][4][2], const pg8::Unit& u, int wr, int wc, int fr, int fq) const {
        const int row0 = u.pm * 256 + wr * 64 + fr, col0 = u.pn * 256 + wc * 32 + 8 * fq;
#pragma unroll
        for (int ai = 0; ai < 2; ++ai)
#pragma unroll
            for (int m = 0; m < 4; ++m) { bf16_t* rowp = O + (size_t)(row0 + ai * 128 + m * 16) * ldc + col0;
#pragma unroll
                for (int bj = 0; bj < 2; ++bj) { const f32x4 v0 = acc[ai][bj][m][0], v1 = acc[ai][bj][m][1];
                    u32x4 w; w.x = pk2(v0[0], v0[1]); w.y = pk2(v0[2], v0[3]); w.z = pk2(v1[0], v1[1]); w.w = pk2(v1[2], v1[3]);
                    *(u32x4*)(rowp + bj * 128) = w; } }
    }
};
struct EpiGateMul {
    static constexpr bool PERM = true, AFTER_DRAIN = false;
    bf16_t* O; int ldc;
    __device__ __forceinline__ void operator()(const f32x4 (&acc)[2][2][4][2], const pg8::Unit& u, int wr, int wc, int fr, int fq) const {
        const int row0 = u.pm * 256 + wr * 64 + fr, col0 = u.pn * 256 + wc * 32 + 8 * fq;
#pragma unroll
        for (int ai = 0; ai < 2; ++ai)
#pragma unroll
            for (int m = 0; m < 4; ++m) { bf16_t* rowp = O + (size_t)(row0 + ai * 128 + m * 16) * ldc + col0;
#pragma unroll
                for (int bj = 0; bj < 2; ++bj) { const f32x4 v0 = acc[ai][bj][m][0], v1 = acc[ai][bj][m][1];
                    const u32x4 b = *(const u32x4*)(rowp + bj * 128);
                    u32x4 w; w.x = pk2(sigmoidf_(v0[0]) * bflo(b.x), sigmoidf_(v0[1]) * bfhi(b.x)); w.y = pk2(sigmoidf_(v0[2]) * bflo(b.y), sigmoidf_(v0[3]) * bfhi(b.y));
                    w.z = pk2(sigmoidf_(v1[0]) * bflo(b.z), sigmoidf_(v1[1]) * bfhi(b.z)); w.w = pk2(sigmoidf_(v1[2]) * bflo(b.w), sigmoidf_(v1[3]) * bfhi(b.w));
                    *(u32x4*)(rowp + bj * 128) = w; } }
    }
};
struct EpiSwiGLU {
    static constexpr bool PERM = true, AFTER_DRAIN = false;
    bf16_t* H; int ldh;
    __device__ __forceinline__ void operator()(const f32x4 (&acc)[2][2][4][2], const pg8::Unit& u, int wr, int wc, int fr, int fq) const {
        const int row0 = u.pm * 256 + wr * 64 + fr, col0 = (u.pn * 256 + wc * 32 + 8 * fq) >> 1;
#pragma unroll
        for (int ai = 0; ai < 2; ++ai)
#pragma unroll
            for (int m = 0; m < 4; ++m) { bf16_t* rowp = H + (size_t)(row0 + ai * 128 + m * 16) * ldh + col0;
#pragma unroll
                for (int bj = 0; bj < 2; ++bj) { const f32x4 g = acc[ai][bj][m][0], up = acc[ai][bj][m][1];
                    u32x2 w; w.x = pk2(siluf_(g[0]) * up[0], siluf_(g[1]) * up[1]); w.y = pk2(siluf_(g[2]) * up[2], siluf_(g[3]) * up[3]);
                    *(u32x2*)(rowp + bj * 64) = w; } }
    }
};
struct EpiF32 {
    static constexpr bool PERM = false, AFTER_DRAIN = false;
    float* Y; int ldc;
    __device__ __forceinline__ void operator()(const f32x4 (&acc)[2][2][4][2], const pg8::Unit& u, int wr, int wc, int fr, int fq) const {
        const int row0 = u.pm * 256 + wr * 64 + fr, col0 = u.pn * 256 + wc * 32 + 4 * fq;
#pragma unroll
        for (int ai = 0; ai < 2; ++ai)
#pragma unroll
            for (int m = 0; m < 4; ++m) { float* rowp = Y + (size_t)(row0 + ai * 128 + m * 16) * ldc + col0;
#pragma unroll
                for (int bj = 0; bj < 2; ++bj)
#pragma unroll
                    for (int n = 0; n < 2; ++n) *(f32x4*)(rowp + bj * 128 + n * 16) = acc[ai][bj][m][n]; }
    }
};

template <class Map>
__device__ __forceinline__ void transpose_item(const float* W, int K, int N, LAS float* scr, int item, int lane, const Map& map) {
    const int nblk = (N + 31) / 32, kb = item / nblk, nb = item % nblk, k0 = 64 * kb, n0 = 32 * nb;
    const int nn = n0 + (lane & 31); const bool ok = nn < N;
#pragma unroll 8
    for (int i = 0; i < 32; ++i) { const int kk = 2 * i + (lane >> 5); scr[kk * 33 + (lane & 31)] = ok ? W[(size_t)(k0 + kk) * N + nn] : 0.f; }
    LDS_WAIT(); asm volatile("" ::: "memory");
    const int c = lane & 7;
#pragma unroll
    for (int j = 0; j < 4; ++j) { const int n = (lane >> 3) + 8 * j; const LAS float* s = scr + (8 * c) * 33 + n;
        u32x4 o; o.x = pk2(s[0 * 33], s[1 * 33]); o.y = pk2(s[2 * 33], s[3 * 33]); o.z = pk2(s[4 * 33], s[5 * 33]); o.w = pk2(s[6 * 33], s[7 * 33]);
        if (n0 + n < N) map(n0 + n, k0 + 8 * c, o); }
    LDS_WAIT(); asm volatile("" ::: "memory");
}

__device__ __forceinline__ void convert_weights(const Args& a, LAS unsigned char* lds, int l, int gw, int NGW, int lane, int wave) {
    LAS float* scr = (LAS float*)(lds + wave * 16384);
    unsigned char* wb = a.ws + WS_W;
    constexpr int I_FI = 16 * 176, I_FO = 44 * 32, I_IN = 16 * 250, I_BR = 8 * 32, I_OU = 16 * 32;
    constexpr int NITEMS = 2 * I_FI + 2 * I_FO + I_IN + 3 * I_BR + I_OU;
    for (int it = gw; it < NITEMS; it += NGW) {
        int r = it;
        if (r < 2 * I_FI) { const int f = r / I_FI; r -= f * I_FI; bf16_t* dst = (bf16_t*)(wb + W_FFIN) + (size_t)f * NFF2 * D;
            transpose_item(inp(a, I_WFIN) + (size_t)(l * 2 + f) * D * NFF2, D, NFF2, scr, r, lane,
                [=](int n, int k, u32x4 o) { const int h = n < DFF ? n : n - DFF; const int row = 8 * (h >> 2) + (n < DFF ? 0 : 4) + (h & 3); *(u32x4*)(dst + (size_t)row * D + k) = o; });
            continue; }
        r -= 2 * I_FI;
        if (r < 2 * I_FO) { const int f = r / I_FO; r -= f * I_FO; bf16_t* dst = (bf16_t*)(wb + W_FFOUT) + (size_t)f * D * DFF;
            transpose_item(inp(a, I_WFOUT) + (size_t)(l * 2 + f) * DFF * D, DFF, D, scr, r, lane,
                [=](int n, int k, u32x4 o) { *(u32x4*)(dst + (size_t)n * DFF + k) = o; });
            continue; }
        r -= 2 * I_FO;
        if (r < I_IN) { bf16_t* dp = (bf16_t*)(wb + W_P); bf16_t* dm = (bf16_t*)(wb + W_MG);
            transpose_item(inp(a, I_WIN) + (size_t)l * D * INC, D, INC, scr, r, lane,
                [=](int n, int k, u32x4 o) { if (n < PREAL) *(u32x4*)(dp + (size_t)n * D + k) = o; else *(u32x4*)(dm + (size_t)(n - PREAL) * D + k) = o; });
            continue; }
        r -= I_IN;
        if (r < 3 * I_BR) { const int nb = r / I_BR; r -= nb * I_BR; bf16_t* dst = (bf16_t*)(wb + W_B) + (size_t)nb * 1024 * 512;
            transpose_item(inp(a, I_WBR) + (size_t)(l * 3 + nb) * 512 * D, 512, D, scr, r, lane,
                [=](int n, int k, u32x4 o) { *(u32x4*)(dst + (size_t)n * 512 + k) = o; });
            continue; }
        r -= 3 * I_BR;
        { bf16_t* dst = (bf16_t*)(wb + W_O3);
            transpose_item(inp(a, I_WOUT) + (size_t)l * D * D, D, D, scr, r, lane,
                [=](int n, int k, u32x4 o) { bf16_t* p = dst + (size_t)n * 3072 + k; *(u32x4*)p = o; *(u32x4*)(p + 1024) = o; *(u32x4*)(p + 2048) = o; }); }
    }
    { u32x4* z = (u32x4*)((bf16_t*)(wb + W_P) + (size_t)PREAL * D); const int nz = (PN - PREAL) * D * 2 / 16;
      for (int i = gw * 64 + lane; i < nz; i += NGW * 64) z[i] = (u32x4){0u, 0u, 0u, 0u}; }
}

__device__ __forceinline__ void ada_partial(const Args& a, int gw, int NGW, int lane) {
    float* modp = (float*)(a.ws + WS_MODP);
    for (int it = gw; it < 2 * 144 * 8; it += NGW) {
        const int ks = it & 7, cgp = (it >> 3) % 144, l = it / (8 * 144);
        const int col = cgp * 64 + lane;
        const float* w = inp(a, I_WADA) + ((size_t)l * D + ks * 128) * 9216 + col;
        float acc[5] = {0.f, 0.f, 0.f, 0.f, 0.f};
#pragma unroll 4
        for (int k = 0; k < 128; ++k) { const float wv = w[(size_t)k * 9216]; const int kk = ks * 128 + k;
            acc[0] += siluf_(inp(a, I_CCTX)[kk]) * wv;
#pragma unroll
            for (int i = 0; i < 4; ++i) acc[1 + i] += siluf_(inp(a, I_C)[i * D + kk]) * wv; }
#pragma unroll
        for (int i = 0; i < 5; ++i) modp[((size_t)(ks * 2 + l) * 5 + i) * 9216 + col] = acc[i];
    }
}

struct RowOp { int src_input, has_y; float coef; const float* npost; const float* mdg_base; int has_xn; const float* npre; const float* md_base; int si; int add_pos; };
__device__ __forceinline__ void rowwise(const Args& a, const RowOp& op, int r, int lane) {
    const bool lat = r < MLAT; const int cv = lat ? 1 + (r >> 12) : 0;
    const float* xs = op.src_input ? (lat ? inp(a, I_XS) + (size_t)r * D : inp(a, I_XP) + (size_t)(r - MLAT) * D)
                                   : (lat ? a.out + OFF_YS + (size_t)r * D : a.out + OFF_YP + (size_t)(r - MLAT) * D);
    float* xd = lat ? a.out + OFF_YS + (size_t)r * D : a.out + OFF_YP + (size_t)(r - MLAT) * D;
    f32x4 v[4];
#pragma unroll
    for (int j = 0; j < 4; ++j) v[j] = *(const f32x4*)(xs + 4 * lane + 256 * j);
    if (op.has_y) {
        const float* yr = (const float*)(a.ws + WS_A) + (size_t)r * D; f32x4 y[4]; float ss = 0.f;
#pragma unroll
        for (int j = 0; j < 4; ++j) { y[j] = *(const f32x4*)(yr + 4 * lane + 256 * j); ss += (y[j].x * y[j].x + y[j].y * y[j].y) + (y[j].z * y[j].z + y[j].w * y[j].w); }
        const float rr = rsqrtf(wave_sum(ss) * (1.f / D) + EPSN) * op.coef;
        const float* gp = op.mdg_base + (size_t)cv * 9216;
#pragma unroll
        for (int j = 0; j < 4; ++j) { const f32x4 w = *(const f32x4*)(op.npost + 4 * lane + 256 * j), gg = *(const f32x4*)(gp + 4 * lane + 256 * j);
            v[j] = v[j] + gg * (y[j] * rr) * w; *(f32x4*)(xd + 4 * lane + 256 * j) = v[j]; }
    }
    if (op.has_xn) {
        float ss = 0.f;
#pragma unroll
        for (int j = 0; j < 4; ++j) ss += (v[j].x * v[j].x + v[j].y * v[j].y) + (v[j].z * v[j].z + v[j].w * v[j].w);
        const float rr = rsqrtf(wave_sum(ss) * (1.f / D) + EPSN);
        const float* sh = op.md_base + (size_t)cv * 9216 + (size_t)op.si * D; const float* sc = sh + D;
        const float* pos = (const float*)(a.ws + WS_POS); const int t = r & 4095;
        bf16_t* xo = (bf16_t*)(a.ws + WS_XN) + (size_t)r * D;
#pragma unroll
        for (int j = 0; j < 4; ++j) { const int c = 4 * lane + 256 * j; const f32x4 w = *(const f32x4*)(op.npre + c), s1 = *(const f32x4*)(sc + c), s0 = *(const f32x4*)(sh + c);
            f32x4 o = (v[j] * rr) * w * (s1 + 1.0f) + s0;
            if (op.add_pos && lat) { const float* pp = (c < 512) ? pos + (size_t)(t >> 6) * 512 + c : pos + (size_t)(t & 63) * 512 + (c - 512); o = o + *(const f32x4*)pp; }
            u32x2 pk; pk.x = pk2(o.x, o.y); pk.y = pk2(o.z, o.w); *(u32x2*)(xo + c) = pk; }
    }
}

constexpr int C_MQ = 0, C_MK = 256, C_MV = 512, C_MO = 1024, C_MIF = 1536, C_GQ = 1552, C_GK = 1808, C_GV = 2064, C_GR = 2576, C_GLR = 3088, C_HQ = 3120, C_HF = 3376, C_HV = 3888, C_HG = 4400;

struct ItemInfo { int br, dir, head, seq, c, T, NC; };
__device__ __forceinline__ ItemInfo item_info(int g, int it) { ItemInfo I; const int hdb = it % 24, cgl = it / 24; I.br = hdb >> 3; I.dir = (hdb >> 2) & 1; I.head = hdb & 3;
    I.T = g < 2 ? 4096 : 256; I.NC = I.T >> 6; I.seq = cgl / I.NC; I.c = cgl % I.NC; return I; }
__device__ __forceinline__ int item_row(const ItemInfo& I, int s) { const int tau = I.c * 64 + s; return I.seq * I.T + (I.dir ? I.T - 1 - tau : tau); }
__device__ __forceinline__ float lb_of(const Args& a, int l, int ch) { if (l == 0) return 0.f; const float g0 = inp(a, I_HGAM)[ch], g1 = inp(a, I_HGAM)[256 + ch]; return 1.0f / (1.0f + expf(g0 - g1)); }

template <bool NEEDQ>
__device__ __forceinline__ void load_gated(const Args& a, const bf16_t* P, const ItemInfo& I, int l, int d, int sg, float (&qv)[8], float (&kv)[8], float (&la)[8]) {
    const int ch = I.head * 64 + d;
    if (I.br == 1) {
        float wup[16];
        const float* wp = inp(a, I_GWUP) + ((size_t)(l * 2 + I.dir) * 16) * 256 + ch;
#pragma unroll
        for (int r = 0; r < 16; ++r) wup[r] = wp[r * 256];
        const float gb = inp(a, I_GLB)[(l * 2 + I.dir) * 256 + ch];
#pragma unroll
        for (int i = 0; i < 8; ++i) { const bf16_t* pr = P + (size_t)item_row(I, 8 * sg + i) * PN;
            const u32x4 g0 = *(const u32x4*)(pr + C_GLR + I.dir * 16), g1 = *(const u32x4*)(pr + C_GLR + I.dir * 16 + 8);
            float z = gb;
            z += bflo(g0.x) * wup[0] + bfhi(g0.x) * wup[1] + bflo(g0.y) * wup[2] + bfhi(g0.y) * wup[3] + bflo(g0.z) * wup[4] + bfhi(g0.z) * wup[5] + bflo(g0.w) * wup[6] + bfhi(g0.w) * wup[7];
            z += bflo(g1.x) * wup[8] + bfhi(g1.x) * wup[9] + bflo(g1.y) * wup[10] + bfhi(g1.y) * wup[11] + bflo(g1.z) * wup[12] + bfhi(g1.z) * wup[13] + bflo(g1.w) * wup[14] + bfhi(g1.w) * wup[15];
            la[i] = logsigf_(z) * (1.0f / 16.0f);
            if (NEEDQ) qv[i] = bf2f(pr[C_GQ + ch]) * 0.125f; kv[i] = bf2f(pr[C_GK + ch]); }
    } else {
        const float lb = lb_of(a, l, ch);
#pragma unroll
        for (int i = 0; i < 8; ++i) { const bf16_t* pr = P + (size_t)item_row(I, 8 * sg + i) * PN;
            const float z = bf2f(pr[C_HF + I.dir * 256 + ch]); const float sg_ = sigmoidf_(z);
            la[i] = (lb == 0.f) ? logsigf_(z) : __logf(lb + (1.0f - lb) * sg_);
            if (NEEDQ) qv[i] = bf2f(pr[C_HQ + ch]) * 1.0f;
            kv[i] = (1.0f - lb) * (1.0f - sg_); }
    }
}
template <bool NEEDQ>
__device__ __forceinline__ void load_mlstm(const Args& a, const bf16_t* P, const ItemInfo& I, int l, int d, int sg, float (&qv)[8], float (&kv)[8], float (&lf)[8], float (&li)[8]) {
    const float bi = inp(a, I_GB)[((l * 2 + I.dir) * 2 + 0) * 4 + I.head], bf_ = inp(a, I_GB)[((l * 2 + I.dir) * 2 + 1) * 4 + I.head];
#pragma unroll
    for (int i = 0; i < 8; ++i) { const bf16_t* pr = P + (size_t)item_row(I, 8 * sg + i) * PN;
        li[i] = bf2f(pr[C_MIF + I.dir * 8 + I.head]) + bi; lf[i] = logsigf_(bf2f(pr[C_MIF + I.dir * 8 + 4 + I.head]) + bf_);
        if (NEEDQ) qv[i] = bf2f(pr[C_MQ + I.head * 64 + d]) * 0.125f; kv[i] = bf2f(pr[C_MK + I.head * 64 + d]); }
}
__device__ __forceinline__ void stage_vT(const bf16_t* P, const ItemInfo& I, LAS bf16_t* Y, int pitch, int tid) {
    const int s = tid >> 3, eg = tid & 7; const int vb = I.br == 0 ? C_MV : (I.br == 1 ? C_GV : C_HV);
    const bf16_t* pv = P + (size_t)item_row(I, s) * PN + vb + I.head * 128 + 16 * eg;
    const u32x4 v0 = *(const u32x4*)pv, v1 = *(const u32x4*)(pv + 8);
    const unsigned wds[8] = {v0.x, v0.y, v0.z, v0.w, v1.x, v1.y, v1.z, v1.w};
#pragma unroll
    for (int i = 0; i < 8; ++i) { float x0 = bflo(wds[i]), x1 = bfhi(wds[i]); if (I.br == 2) { x0 = siluf_(x0); x1 = siluf_(x1); }
        Y[(16 * eg + 2 * i) * pitch + s] = (bf16_t)f2bf(x0); Y[(16 * eg + 2 * i + 1) * pitch + s] = (bf16_t)f2bf(x1); }
}
__device__ __forceinline__ bf16x8 ldfrag(const LAS bf16_t* T, int pitch, int row0, int k0, int lane) { return *(const LAS bf16x8*)(T + (row0 + (lane & 15)) * pitch + k0 + 8 * (lane >> 4)); }

__device__ __forceinline__ void scan_s1(const Args& a, LAS unsigned char* lds, int l, int g, int it) {
    int tid_ = threadIdx.x; asm volatile("" : "+v"(tid_)); const int tid = tid_, d = tid & 63, lane = d, sg = __builtin_amdgcn_readfirstlane(tid >> 6);
    const ItemInfo I = item_info(g, it);
    const bf16_t* P = (const bf16_t*)(a.ws + WS_BIG);
    bf16_t* US = (bf16_t*)(a.ws + WS_BIG + BIG_US) + (size_t)it * 8192;
    float* DEC = (float*)(a.ws + WS_DEC) + (size_t)it * 64; float* SC = (float*)(a.ws + WS_SC) + (size_t)it * 4;
    LAS bf16_t* XT = (LAS bf16_t*)lds;
    LAS bf16_t* YV = (LAS bf16_t*)(lds + 9216);
    LAS float* TOT = (LAS float*)(lds + 9216 + 20736);
    LAS float* TMX = TOT + 512;
    float qv[8], kv[8], x0[8], x1[8];
    if (I.br == 0) {
        load_mlstm<false>(a, P, I, l, d, sg, qv, kv, x0, x1);
        float run = 0.f;
#pragma unroll
        for (int i = 0; i < 8; ++i) { run += x0[i]; x0[i] = run; }
        TOT[sg * 64 + d] = run; LDS_WAIT(); __syncthreads();
        float pre = 0.f, tot = 0.f;
#pragma unroll
        for (int w = 0; w < 8; ++w) { const float t = TOT[w * 64 + d]; if (w < sg) pre += t; tot += t; }
        float mx = -3.0e38f;
#pragma unroll
        for (int i = 0; i < 8; ++i) { x0[i] = tot - (pre + x0[i]) + x1[i]; mx = fmaxf(mx, x0[i]); }
        TMX[sg * 64 + d] = mx; LDS_WAIT(); __syncthreads();
        float mlw = -3.0e38f;
#pragma unroll
        for (int w = 0; w < 8; ++w) mlw = fmaxf(mlw, TMX[w * 64 + d]);
#pragma unroll
        for (int i = 0; i < 8; ++i) kv[i] *= __expf(x0[i] - mlw);
        if (tid == 0) { SC[0] = mlw; SC[1] = tot; }
        for (int idx = tid; idx < 16 * 64; idx += 512) YV[(128 + (idx >> 6)) * 72 + (idx & 63)] = (bf16_t)((idx >> 6) == 0 ? 0x3F80 : 0);
    } else {
        load_gated<false>(a, P, I, l, d, sg, qv, kv, x0);
        float run = 0.f;
#pragma unroll
        for (int i = 0; i < 8; ++i) { run += x0[i]; x0[i] = run; }
        TOT[sg * 64 + d] = run; LDS_WAIT(); __syncthreads();
        float pre = 0.f, tot = 0.f;
#pragma unroll
        for (int w = 0; w < 8; ++w) { const float t = TOT[w * 64 + d]; if (w < sg) pre += t; tot += t; }
#pragma unroll
        for (int i = 0; i < 8; ++i) kv[i] *= __expf(tot - (pre + x0[i]));
        if (sg == 0) DEC[d] = __expf(tot);
    }
    { u32x4 w; w.x = pk2(kv[0], kv[1]); w.y = pk2(kv[2], kv[3]); w.z = pk2(kv[4], kv[5]); w.w = pk2(kv[6], kv[7]); *(LAS u32x4*)(XT + d * 72 + 8 * sg) = w; }
    stage_vT(P, I, YV, 72, tid);
    LDS_WAIT(); __syncthreads();
    f32x4 acc[4];
#pragma unroll
    for (int mt = 0; mt < 4; ++mt) acc[mt] = (f32x4){0.f, 0.f, 0.f, 0.f};
#pragma unroll
    for (int ks = 0; ks < 2; ++ks) { const bf16x8 b = ldfrag(YV, 72, 16 * sg, 32 * ks, lane);
#pragma unroll
        for (int mt = 0; mt < 4; ++mt) acc[mt] = __builtin_amdgcn_mfma_f32_16x16x32_bf16(ldfrag(XT, 72, 16 * mt, 32 * ks, lane), b, acc[mt], 0, 0, 0); }
    { const int e = 16 * sg + (lane & 15);
#pragma unroll
      for (int mt = 0; mt < 4; ++mt) { u32x2 o; o.x = pk2(acc[mt][0], acc[mt][1]); o.y = pk2(acc[mt][2], acc[mt][3]); *(u32x2*)(US + e * 64 + 16 * mt + 4 * (lane >> 4)) = o; } }
    if (I.br == 0 && sg < 4) {
        f32x4 an = (f32x4){0.f, 0.f, 0.f, 0.f};
#pragma unroll
        for (int ks = 0; ks < 2; ++ks) an = __builtin_amdgcn_mfma_f32_16x16x32_bf16(ldfrag(XT, 72, 16 * sg, 32 * ks, lane), ldfrag(YV, 72, 128, 32 * ks, lane), an, 0, 0, 0);
        if ((lane & 15) == 0) { const int d0 = 16 * sg + 4 * (lane >> 4); DEC[d0] = an[0]; DEC[d0 + 1] = an[1]; DEC[d0 + 2] = an[2]; DEC[d0 + 3] = an[3]; }
    }
    __syncthreads();
}

__device__ __forceinline__ void scan_s2(const Args& a, int l, int g) {
    const int T = g < 2 ? 4096 : 256, NC = T >> 6, nseq = g < 2 ? 2 : 32, nslot = nseq * 24 * 1024;
    bf16_t* USb = (bf16_t*)(a.ws + WS_BIG + BIG_US); float* DECb = (float*)(a.ws + WS_DEC); float* SCb = (float*)(a.ws + WS_SC);
    int tid_ = threadIdx.x; asm volatile("" : "+v"(tid_));
    for (int slot = blockIdx.x * 512 + tid_; slot < nslot; slot += gridDim.x * 512) {
        const int sub = slot & 1023, stream = slot >> 10, hdb = stream % 24, seq = stream / 24, br = hdb >> 3, dir = (hdb >> 2) & 1, head = hdb & 3;
        const int e = sub >> 3, d0 = (sub & 7) * 8;
        float S[8], nst[8], mst = 0.f;
#pragma unroll
        for (int i = 0; i < 8; ++i) { S[i] = 0.f; nst[i] = 0.f; }
        if (g < 2) { const int b = g * 2 + seq; const size_t sidx = (size_t)((b * 2 + l) * 2 + dir) * 4 + head;
            const float* sp = (br == 0 ? inp(a, I_SC) : (br == 1 ? inp(a, I_SG) : inp(a, I_SH))) + sidx * 8192;
#pragma unroll
            for (int i = 0; i < 8; ++i) S[i] = sp[(d0 + i) * 128 + e];
            if (br == 0) { mst = inp(a, I_SM)[sidx];
#pragma unroll
                for (int i = 0; i < 8; ++i) nst[i] = inp(a, I_SN)[sidx * 64 + d0 + i]; } }
        const bool nrow = (br == 0) && (e == 0);
        for (int c0 = 0; c0 < NC; c0 += 4) {
            u32x4 ub[4]; f32x4 q0[4], q1[4]; float m0[4], m1[4];
#pragma unroll
            for (int j = 0; j < 4; ++j) { const size_t it = (size_t)(seq * NC + c0 + j) * 24 + hdb;
                ub[j] = *(const u32x4*)(USb + it * 8192 + e * 64 + d0);
                if (br == 0) { m0[j] = SCb[it * 4]; m1[j] = SCb[it * 4 + 1]; }
                if (br != 0 || nrow) { q0[j] = *(const f32x4*)(DECb + it * 64 + d0); q1[j] = *(const f32x4*)(DECb + it * 64 + d0 + 4); } }
#pragma unroll
            for (int j = 0; j < 4; ++j) { const size_t it = (size_t)(seq * NC + c0 + j) * 24 + hdb;
                bf16_t* p = USb + it * 8192 + e * 64 + d0; float* dec = DECb + it * 64 + d0; float* sc = SCb + it * 4;
                const u32x4 u = ub[j];
                const float uu[8] = {bflo(u.x), bfhi(u.x), bflo(u.y), bfhi(u.y), bflo(u.z), bfhi(u.z), bflo(u.w), bfhi(u.w)};
                { u32x4 w; w.x = pk2(S[0], S[1]); w.y = pk2(S[2], S[3]); w.z = pk2(S[4], S[5]); w.w = pk2(S[6], S[7]); *(u32x4*)p = w; }
                if (br == 0) {
                    const float mlw = m0[j], bl = m1[j]; const float mn = fmaxf(bl + mst, mlw); const float fa = __expf(bl + mst - mn), fb = __expf(mlw - mn);
                    if (nrow) { const f32x4 n0 = q0[j], n1 = q1[j];
                        *(f32x4*)dec = (f32x4){nst[0], nst[1], nst[2], nst[3]}; *(f32x4*)(dec + 4) = (f32x4){nst[4], nst[5], nst[6], nst[7]};
                        const float nn[8] = {n0.x, n0.y, n0.z, n0.w, n1.x, n1.y, n1.z, n1.w};
#pragma unroll
                        for (int i = 0; i < 8; ++i) nst[i] = fa * nst[i] + fb * nn[i];
                        if (d0 == 0) sc[2] = mst; }
#pragma unroll
                    for (int i = 0; i < 8; ++i) S[i] = fa * S[i] + fb * uu[i];
                    mst = mn;
                } else {
                    const f32x4 a0 = q0[j], a1 = q1[j]; const float dd[8] = {a0.x, a0.y, a0.z, a0.w, a1.x, a1.y, a1.z, a1.w};
#pragma unroll
                    for (int i = 0; i < 8; ++i) S[i] = dd[i] * S[i] + uu[i];
                }
            }
        }
        if (g == 2) { const size_t sidx = (size_t)((seq * 2 + l) * 2 + dir) * 4 + head;
            float* op = a.out + (br == 0 ? OFF_C : (br == 1 ? OFF_G : OFF_H)) + sidx * 8192;
#pragma unroll
            for (int i = 0; i < 8; ++i) op[(d0 + i) * 128 + e] = S[i];
            if (nrow) {
#pragma unroll
                for (int i = 0; i < 8; ++i) a.out[OFF_N + sidx * 64 + d0 + i] = nst[i];
                if (d0 == 0) a.out[OFF_M + sidx] = mst; } }
    }
}

constexpr int S3_QO = 0, S3_KO = 23040, S3_G = 41472, S3_XA = 57856, S3_YV = 75264, S3_TOT = 114432, S3_VEC = 116480;
__device__ __forceinline__ void scan_s3(const Args& a, LAS unsigned char* lds, int l, int g, int it) {
    int tid_ = threadIdx.x; asm volatile("" : "+v"(tid_)); const int tid = tid_, d = tid & 63, lane = d, sg = __builtin_amdgcn_readfirstlane(tid >> 6);
    const ItemInfo I = item_info(g, it);
    const bf16_t* P = (const bf16_t*)(a.ws + WS_BIG);
    const bf16_t* US = (const bf16_t*)(a.ws + WS_BIG + BIG_US) + (size_t)it * 8192;
    const float* DEC = (const float*)(a.ws + WS_DEC) + (size_t)it * 64; const float* SC = (const float*)(a.ws + WS_SC) + (size_t)it * 4;
    bf16_t* Od = I.dir == 0 ? (bf16_t*)(a.ws + WS_A) + (size_t)g * GROWS * 1536 : (bf16_t*)(a.ws + WS_BIG + BIG_OB);
    LAS bf16_t* QO = (LAS bf16_t*)(lds + S3_QO); LAS bf16_t* KO = (LAS bf16_t*)(lds + S3_KO); LAS float* G = (LAS float*)(lds + S3_G);
    LAS bf16_t* XA = (LAS bf16_t*)(lds + S3_XA); LAS bf16_t* YV = (LAS bf16_t*)(lds + S3_YV); LAS float* TOT = (LAS float*)(lds + S3_TOT);
    LAS float* Bv = (LAS float*)(lds + S3_VEC); LAS float* LIv = Bv + 64; LAS float* MT = Bv + 128; LAS float* EI = Bv + 192;
    float qv[8], kv[8], x0[8], x1[8];
    stage_vT(P, I, YV, 136, tid);
    { const int e = tid >> 2, part = tid & 3; const u32x4 s0 = *(const u32x4*)(US + e * 64 + 16 * part), s1 = *(const u32x4*)(US + e * 64 + 16 * part + 8);
      *(LAS u32x4*)(YV + e * 136 + 64 + 16 * part) = s0; *(LAS u32x4*)(YV + e * 136 + 64 + 16 * part + 8) = s1; }
    const int bi = sg >> 1;
    f32x4 acc[4];
#pragma unroll
    for (int nt = 0; nt < 4; ++nt) acc[nt] = (f32x4){0.f, 0.f, 0.f, 0.f};
    if (I.br != 0) {
        load_gated<true>(a, P, I, l, d, sg, qv, kv, x0);
        float run = 0.f;
#pragma unroll
        for (int i = 0; i < 8; ++i) { run += x0[i]; x0[i] = run; }
        TOT[sg * 64 + d] = run; LDS_WAIT(); __syncthreads();
        float pre = 0.f;
#pragma unroll
        for (int w = 0; w < 8; ++w) { const float t = TOT[w * 64 + d]; if (w < sg) pre += t; }
#pragma unroll
        for (int i = 0; i < 8; ++i) { x0[i] += pre; const int s = 8 * sg + i; G[s * 64 + d] = x0[i]; XA[s * 136 + 64 + d] = (bf16_t)f2bf(qv[i] * __expf(x0[i])); }
        LDS_WAIT(); __syncthreads();
        const float gs = bi ? G[(16 * bi - 1) * 64 + d] : 0.f, geo = G[(16 * bi + 15) * 64 + d];
        float gej[3];
#pragma unroll
        for (int j = 0; j < 3; ++j) gej[j] = G[(16 * j + 15) * 64 + d];
#pragma unroll
        for (int i = 0; i < 8; ++i) { const int tt = 8 * (sg & 1) + i;
            QO[(6 + bi) * 1152 + tt * 72 + d] = (bf16_t)f2bf(qv[i] * __expf(x0[i] - gs));
            KO[(4 + bi) * 1152 + tt * 72 + d] = (bf16_t)f2bf(kv[i] * __expf(fminf(gs - x0[i], 80.f)));
            KO[bi * 1152 + tt * 72 + d] = (bf16_t)f2bf(kv[i] * __expf(geo - x0[i]));
#pragma unroll
            for (int j = 0; j < 3; ++j) if (j < bi) QO[(bi * (bi - 1) / 2 + j) * 1152 + tt * 72 + d] = (bf16_t)f2bf(qv[i] * __expf(fminf(x0[i] - gej[j], 0.f))); }
        LDS_WAIT(); __syncthreads();
#pragma unroll
        for (int jj = 0; jj < 2; ++jj) { const int j = 2 * (sg & 1) + jj; f32x4 t = (f32x4){0.f, 0.f, 0.f, 0.f};
            if (j <= bi) { const int qt = (j == bi) ? 6 + bi : bi * (bi - 1) / 2 + j, kt = (j == bi) ? 4 + bi : j;
#pragma unroll
                for (int ks = 0; ks < 2; ++ks) t = __builtin_amdgcn_mfma_f32_16x16x32_bf16(ldfrag(QO + qt * 1152, 72, 0, 32 * ks, lane), ldfrag(KO + kt * 1152, 72, 0, 32 * ks, lane), t, 0, 0, 0); }
#pragma unroll
            for (int r = 0; r < 4; ++r) { const int tl = 4 * (lane >> 4) + r, sl = lane & 15; float v = t[r]; if (j == bi && sl > tl) v = 0.f;
                XA[(16 * bi + tl) * 136 + 16 * j + sl] = (bf16_t)f2bf(v); } }
        LDS_WAIT(); __syncthreads();
    } else {
        load_mlstm<true>(a, P, I, l, d, sg, qv, kv, x0, x1);
        float run = 0.f;
#pragma unroll
        for (int i = 0; i < 8; ++i) { run += x0[i]; x0[i] = run; }
        TOT[sg * 64 + d] = run;
        for (int idx = tid; idx < 16 * 128; idx += 512) { const int r = idx >> 7, k = idx & 127; YV[(128 + r) * 136 + k] = (bf16_t)(r == 0 ? (k < 64 ? 0x3F80u : f2bf(DEC[k - 64])) : 0u); }
        LDS_WAIT(); __syncthreads();
        float pre = 0.f;
#pragma unroll
        for (int w = 0; w < 8; ++w) { const float t = TOT[w * 64 + d]; if (w < sg) pre += t; }
#pragma unroll
        for (int i = 0; i < 8; ++i) { x0[i] += pre; const int s = 8 * sg + i; if (d == 0) { Bv[s] = x0[i]; LIv[s] = x1[i]; }
            QO[s * 72 + d] = (bf16_t)f2bf(qv[i]); KO[s * 72 + d] = (bf16_t)f2bf(kv[i]); }
        LDS_WAIT(); __syncthreads();
        if (tid < 64) { float rn = -3.0e38f; for (int s = 0; s <= tid; ++s) rn = fmaxf(rn, LIv[s] - Bv[s]);
            const float bt = Bv[tid], inter = bt + SC[2], mt = fmaxf(inter, bt + rn); MT[tid] = mt; EI[tid] = __expf(inter - mt); }
        f32x4 t2[2];
#pragma unroll
        for (int jj = 0; jj < 2; ++jj) { const int j = 2 * (sg & 1) + jj; t2[jj] = (f32x4){0.f, 0.f, 0.f, 0.f};
            if (j <= bi) {
#pragma unroll
                for (int ks = 0; ks < 2; ++ks) t2[jj] = __builtin_amdgcn_mfma_f32_16x16x32_bf16(ldfrag(QO, 72, 16 * bi, 32 * ks, lane), ldfrag(KO, 72, 16 * j, 32 * ks, lane), t2[jj], 0, 0, 0); } }
        LDS_WAIT(); __syncthreads();
#pragma unroll
        for (int jj = 0; jj < 2; ++jj) { const int j = 2 * (sg & 1) + jj;
#pragma unroll
            for (int r = 0; r < 4; ++r) { const int t = 16 * bi + 4 * (lane >> 4) + r, s = 16 * j + (lane & 15); float v = 0.f;
                if (s <= t) v = t2[jj][r] * __expf(Bv[t] - Bv[s] + LIv[s] - MT[t]);
                XA[t * 136 + s] = (bf16_t)f2bf(v); } }
#pragma unroll
        for (int i = 0; i < 8; ++i) { const int s = 8 * sg + i; XA[s * 136 + 64 + d] = (bf16_t)f2bf(qv[i] * EI[s]); }
        LDS_WAIT(); __syncthreads();
    }
    f32x4 accd[4];
#pragma unroll
    for (int nt = 0; nt < 4; ++nt) accd[nt] = (f32x4){0.f, 0.f, 0.f, 0.f};
#pragma unroll
    for (int ks = 0; ks < 4; ++ks) { const bf16x8 av = ldfrag(YV, 136, 16 * sg, 32 * ks, lane);
        bf16x8 ad = av; if (I.br == 0) ad = ldfrag(YV, 136, 128, 32 * ks, lane);
#pragma unroll
        for (int nt = 0; nt < 4; ++nt) { const bf16x8 bx = ldfrag(XA, 136, 16 * nt, 32 * ks, lane);
            acc[nt] = __builtin_amdgcn_mfma_f32_16x16x32_bf16(av, bx, acc[nt], 0, 0, 0);
            if (I.br == 0) accd[nt] = __builtin_amdgcn_mfma_f32_16x16x32_bf16(ad, bx, accd[nt], 0, 0, 0); } }
    const int ecol = I.br * 512 + I.head * 128 + 16 * sg + 4 * (lane >> 4);
#pragma unroll
    for (int nt = 0; nt < 4; ++nt) { const int t = 16 * nt + (lane & 15); f32x4 o = acc[nt];
        if (I.br == 0) { const float den = __shfl(accd[nt][0], lane & 15); const float dn = fmaxf(fabsf(den), __expf(-MT[t])); o = o * (1.0f / dn); }
        u32x2 w; w.x = pk2(o[0], o[1]); w.y = pk2(o[2], o[3]);
        *(u32x2*)(Od + (size_t)item_row(I, t) * 1536 + ecol) = w; }
    __syncthreads();
}

__device__ __forceinline__ void headnorm_row(const Args& a, int l, int g, int lr, int lane) {
    const bf16_t* P = (const bf16_t*)(a.ws + WS_BIG) + (size_t)lr * PN;
    bf16_t* of = (bf16_t*)(a.ws + WS_A) + ((size_t)g * GROWS + lr) * 1536; const bf16_t* ob = (const bf16_t*)(a.ws + WS_BIG + BIG_OB) + (size_t)lr * 1536;
#pragma unroll
    for (int br = 0; br < 3; ++br) { const int c = br * 512 + 8 * lane;
        const u32x4 f = *(const u32x4*)(of + c), b = *(const u32x4*)(ob + c);
        float o[8] = {bflo(f.x) + bflo(b.x), bfhi(f.x) + bfhi(b.x), bflo(f.y) + bflo(b.y), bfhi(f.y) + bfhi(b.y), bflo(f.z) + bflo(b.z), bfhi(f.z) + bfhi(b.z), bflo(f.w) + bflo(b.w), bfhi(f.w) + bfhi(b.w)};
        float ss = 0.f;
#pragma unroll
        for (int i = 0; i < 8; ++i) ss += o[i] * o[i];
        ss += __shfl_xor(ss, 1); ss += __shfl_xor(ss, 2); ss += __shfl_xor(ss, 4); ss += __shfl_xor(ss, 8);
        const float rr = rsqrtf(ss * (1.0f / 128.0f) + EPSN);
        const u32x4 gt = *(const u32x4*)(P + (br == 0 ? C_MO : (br == 1 ? C_GR : C_HG)) + 8 * lane);
        const float gv[8] = {bflo(gt.x), bfhi(gt.x), bflo(gt.y), bfhi(gt.y), bflo(gt.z), bfhi(gt.z), bflo(gt.w), bfhi(gt.w)};
        const float* hn = inp(a, I_HN) + (size_t)(l * 3 + br) * 512 + 8 * lane;
        const f32x4 h0 = *(const f32x4*)hn, h1 = *(const f32x4*)(hn + 4); const float hw[8] = {h0.x, h0.y, h0.z, h0.w, h1.x, h1.y, h1.z, h1.w};
        float y[8];
#pragma unroll
        for (int i = 0; i < 8; ++i) { const float gg = br == 0 ? sigmoidf_(gv[i]) : siluf_(gv[i]); y[i] = gg * (o[i] * rr) * hw[i]; }
        u32x4 w; w.x = pk2(y[0], y[1]); w.y = pk2(y[2], y[3]); w.z = pk2(y[4], y[5]); w.w = pk2(y[6], y[7]); *(u32x4*)(of + c) = w; }
}

#ifndef REP_S1
#define REP_S1 1
#endif
#ifndef REP_S3
#define REP_S3 1
#endif
#ifndef REP_G
#define REP_G 1
#endif
template <int M_, int N_, int K_, int LDA_, int LDB_, int ADIV, int AMUL, class Epi>
__device__ __forceinline__ void run_gemm(LAS unsigned char* lds, const bf16_t* A, const bf16_t* Bt, const Epi& E) {
    typedef pg8::GemmT<M_, N_, K_, LDA_, LDB_> GT; GT g{A, Bt}; pg8::StaticOrderT<M_, N_, ADIV, AMUL> S; S.init((int)gridDim.x, (int)blockIdx.x);
    pg8::gemm_phase<GT, Epi, pg8::StaticOrderT<M_, N_, ADIV, AMUL>, true, true>((PG8_LAS unsigned char*)lds, g, S, E);
}

__global__ void __launch_bounds__(512, 2) mk_fwd(Args a) {
    extern __shared__ __attribute__((aligned(16))) unsigned char lds_raw[];
    LAS unsigned char* lds = (LAS unsigned char*)lds_raw;
    cg::grid_group grid = cg::this_grid();
    for (int u = threadIdx.x; u < (LDS_BYTES - 131072) / 4; u += 512) ((LAS unsigned*)(lds + 131072))[u] = 0u;
    __syncthreads();
    (void)xcd_barrier_post((unsigned*)a.ws, (volatile LAS unsigned*)(lds + 131072 + 352));
    const int tid = threadIdx.x, lane = tid & 63, wave = __builtin_amdgcn_readfirstlane(tid >> 6);
    const int G = gridDim.x, gw = blockIdx.x * 8 + wave, NGW = G * 8;
    unsigned char* ws = a.ws;
    float* mod = (float*)(ws + WS_MOD);

#ifndef SKIP_PRO
    convert_weights(a, lds, 0, gw, NGW, lane, wave);
    ada_partial(a, gw, NGW, lane);
    { float* pos = (float*)(ws + WS_POS);
      for (int i = blockIdx.x * 512 + tid; i < 64 * 512; i += G * 512) { const int v = i >> 9, j = i & 511, fi = j & 255;
          const float fr = expf((-9.210340371976184f * (float)fi) / 256.0f); const float ang = (float)v * fr; pos[i] = j < 256 ? sinf(ang) : cosf(ang); } }
    grid.sync();
    { const float* modp = (const float*)(ws + WS_MODP);
      for (int i = blockIdx.x * 512 + tid; i < 2 * 5 * 9216; i += G * 512) { const int col = i % 9216, l = i / (5 * 9216); float s = inp(a, I_BADA)[l * 9216 + col];
#pragma unroll
          for (int ks = 0; ks < 8; ++ks) s += modp[(size_t)ks * (2 * 5 * 9216) + i]; mod[i] = s; } }
    xcd_barrier_ni((unsigned*)a.ws, 131072 + 352);
    { RowOp op{}; op.src_input = 1; op.has_y = 0; op.has_xn = 1; op.npre = inp(a, I_NPRE); op.md_base = mod; op.si = 0; op.add_pos = 0;
      for (int r = gw; r < MTOT; r += NGW) rowwise(a, op, r, lane); }
    xcd_barrier_ni((unsigned*)a.ws, 131072 + 352);
#endif

    for (int l = 0; l < 2; ++l) {
        for (int st = 0; st < 25; ++st) {
            int tid = threadIdx.x; asm volatile("" : "+v"(tid));
            const int lane = tid & 63, wave = __builtin_amdgcn_readfirstlane(tid >> 6), gw = blockIdx.x * 8 + wave;
            unsigned char* ws = a.ws; asm volatile("" : "+s"(ws));
            float* mod = (float*)(ws + WS_MOD); const float* modl = mod + (size_t)l * 5 * 9216;
            bf16_t* XN = (bf16_t*)(ws + WS_XN); bf16_t* BIG = (bf16_t*)(ws + WS_BIG); float* Y = (float*)(ws + WS_A); bf16_t* YS = (bf16_t*)(ws + WS_A);
            unsigned char* wb = ws + WS_W; const int G = gridDim.x, NGW = G * 8;
            const int kind = (st == 0 || st == 22) ? 0 : (st == 1 || st == 20 || st == 23) ? 1 : (st == 2 || st == 21 || st == 24) ? 2 : (st == 18) ? 3 : (st == 19) ? 4 : 5 + ((st - 3) % 5);
            const int g = (st >= 3 && st < 18) ? (st - 3) / 5 : 0;
            switch (kind) {
            case 0: {
#ifndef SKIP_G0
                const int f = st == 0 ? 0 : 1; EpiSwiGLU E{BIG, DFF};
                for (int rep = 0; rep < REP_G; ++rep) run_gemm<MTOT, NFF2, D, D, D, 0, 0>(lds, XN, (const bf16_t*)(wb + W_FFIN) + (size_t)f * NFF2 * D, E);
#endif
                break; }
            case 1: {
#ifndef SKIP_G1
                EpiF32 E{Y, D};
                for (int rep = 0; rep < REP_G; ++rep)
                if (st == 20) run_gemm<MTOT, D, 3072, 3072, 3072, 0, 0>(lds, BIG, (const bf16_t*)(wb + W_O3), E);
                else run_gemm<MTOT, D, DFF, DFF, DFF, 0, 0>(lds, BIG, (const bf16_t*)(wb + W_FFOUT) + (size_t)(st == 1 ? 0 : 1) * D * DFF, E);
#endif
                break; }
            case 2: {
#ifndef SKIP_ROW
                RowOp op{}; op.has_y = 1; op.mdg_base = modl + (st == 2 ? 2 : st == 21 ? 5 : 8) * D; op.coef = st == 21 ? 1.0f : 0.5f;
                op.npost = inp(a, I_NPOST) + (size_t)(l * 3 + (st == 2 ? 0 : st == 21 ? 1 : 2)) * D; op.src_input = (l == 0 && st == 2) ? 1 : 0;
                if (st == 2) { op.has_xn = 1; op.npre = inp(a, I_NPRE) + (size_t)(l * 3 + 1) * D; op.md_base = modl; op.si = 3; op.add_pos = 1; }
                else if (st == 21) { op.has_xn = 1; op.npre = inp(a, I_NPRE) + (size_t)(l * 3 + 2) * D; op.md_base = modl; op.si = 6; op.add_pos = 0; }
                else { op.has_xn = (l == 0) ? 1 : 0; op.npre = inp(a, I_NPRE) + (size_t)3 * D; op.md_base = mod + (size_t)5 * 9216; op.si = 0; op.add_pos = 0; }
                for (int r = gw; r < MTOT; r += NGW) rowwise(a, op, r, lane);
                if (st == 24 && l == 0) { __syncthreads(); convert_weights(a, lds, 1, gw, NGW, lane, wave); }
#endif
                break; }
            case 3: {
#ifndef SKIP_G3
                EpiBf16 E{BIG, 3072};
                for (int rep = 0; rep < REP_G; ++rep) run_gemm<MTOT, 3072, 512, 1536, 512, 4, 512>(lds, YS, (const bf16_t*)(wb + W_B), E);
#endif
                break; }
            case 4: {
#ifndef SKIP_G4
                EpiGateMul E{BIG, 3072};
                run_gemm<MTOT, MGN, D, D, D, 0, 0>(lds, XN, (const bf16_t*)(wb + W_MG), E);
#endif
                break; }
            case 5: {
#ifndef SKIP_G3
                EpiBf16 E{BIG, PN};
                for (int rep = 0; rep < REP_G; ++rep) run_gemm<GROWS, PN, D, D, D, 0, 0>(lds, XN + (size_t)g * GROWS * D, (const bf16_t*)(wb + W_P), E);
#endif
                break; }
            case 6: {
#ifndef SKIP_S1
                for (int rep = 0; rep < REP_S1; ++rep) for (int it = blockIdx.x; it < 3072; it += G) scan_s1(a, lds, l, g, it);
#endif
                break; }
            case 7: {
#ifndef SKIP_S2
                scan_s2(a, l, g);
#endif
                break; }
            case 8: {
#ifndef SKIP_S3
                for (int rep = 0; rep < REP_S3; ++rep) for (int it = blockIdx.x; it < 3072; it += G) scan_s3(a, lds, l, g, it);
#endif
                break; }
            default: {
#ifndef SKIP_HN
                for (int lr = gw; lr < GROWS; lr += NGW) headnorm_row(a, l, g, lr, lane);
#endif
                break; }
            }
            xcd_barrier_ni((unsigned*)a.ws, 131072 + 352);
#ifdef EXTRA_SYNC
            xcd_barrier_ni((unsigned*)a.ws, 131072 + 352);
#endif
        }
    }
}

extern "C" void kernel_launch(void* const* d_in, const int* in_sizes, int n_in, void* d_out, int out_size, void* d_ws, size_t ws_size, hipStream_t stream) {
    static int grid = 0;
    if (grid == 0) {
        if (n_in != 23 || ws_size < WS_END) { fprintf(stderr, "kernel_launch: unexpected n_in %d / ws_size %zu (need %zu)\n", n_in, ws_size, (size_t)WS_END); grid = -1; return; }
        int dev = 0, cus = 0, per_cu = 0;
        hipGetDevice(&dev); hipDeviceGetAttribute(&cus, hipDeviceAttributeMultiprocessorCount, dev);
        hipFuncSetAttribute((const void*)mk_fwd, hipFuncAttributeMaxDynamicSharedMemorySize, LDS_BYTES);
        hipOccupancyMaxActiveBlocksPerMultiprocessor(&per_cu, (const void*)mk_fwd, 512, LDS_BYTES);
        (void)hipGetLastError();
        if (per_cu < 1) per_cu = 1;
        grid = cus;
    }
    if (grid < 0) return;
    if (hipMemsetAsync(d_ws, 0, 16384, stream) != hipSuccess) { fprintf(stderr, "memset failed\n"); return; }
    Args a{};
    for (int i = 0; i < 23; ++i) a.in[i] = (const float*)d_in[i];
    a.out = (float*)d_out; a.ws = (unsigned char*)d_ws;
    void* args[] = {&a};
    hipError_t e = hipLaunchCooperativeKernel((const void*)mk_fwd, dim3(grid), dim3(512), args, LDS_BYTES, stream);
    if (e != hipSuccess) fprintf(stderr, "cooperative launch failed: %s (grid %d)\n", hipGetErrorString(e), grid);
}
```

```cpp
#include <hip/hip_runtime.h>
#include <hip/hip_cooperative_groups.h>
#include <cstdio>
#include <cstdint>
namespace cg = cooperative_groups;

namespace pg8 {
#define PG8_LAS __attribute__((address_space(3)))
typedef unsigned short bf16_t;
typedef short bf16x8 __attribute__((ext_vector_type(8)));
typedef float f32x4 __attribute__((ext_vector_type(4)));
typedef unsigned u32x4 __attribute__((ext_vector_type(4)));
typedef unsigned u32x2 __attribute__((ext_vector_type(2)));
constexpr int BM = 256, BK = 64, HALF = 128, HTB = HALF * BK * 2, STAGE_BYTES = 8 * HTB, NXCD = 8, WGM = 8;

__host__ __device__ __forceinline__ int lds_byte(int r, int c) { const int st = (r >> 4) * 2 + (c >> 5), rr = r & 15, cc = c & 31, ob = rr * 64 + cc * 2; return st * 1024 + (ob ^ (((ob >> 9) & 1) << 5)); }
__host__ __device__ __forceinline__ void stage_rc(int b, int& R, int& C) { const int st = b / 1024, sb = b % 1024, swz = sb ^ (((sb >> 9) & 1) << 5); R = (st >> 1) * 16 + swz / 64; C = (st & 1) * 32 + (swz % 64) / 2; }
__host__ __device__ __forceinline__ int perm32(int rho) { const int n = rho >> 4, i = rho & 15; return 8 * (i >> 2) + 4 * n + (i & 3); }

struct Unit { int pm, pn; };
template <int M_, int N_, int K_, int LDA_, int LDB_> struct GemmT { const bf16_t* A; const bf16_t* Bt; static constexpr int M = M_, N = N_, K = K_, lda = LDA_, ldb = LDB_; };

template <int M_, int N_, int ADIV, int AMUL> struct StaticOrderT {
    static constexpr int nM = M_ / BM, nN = N_ / BM, nwg = nM * nN;
    int G, c;
    __device__ void init(int G_, int c_) { G = G_; c = c_; }
    __device__ __forceinline__ bool next(int i, Unit& u) const {
        const int L = i * G + c; if (L >= nwg) return false;
        int wgid = L; { constexpr int q = nwg / NXCD, r = nwg % NXCD; const int xcd = wgid % NXCD, off = wgid / NXCD; wgid = (xcd < r ? xcd * (q + 1) : r * (q + 1) + (xcd - r) * q) + off; }
        constexpr int nig = WGM * nN; const int gid = wgid / nig, fm = gid * WGM, gsz = (nM - fm) < WGM ? (nM - fm) : WGM;
        u.pm = fm + ((wgid % nig) % gsz); u.pn = (wgid % nig) / gsz; return true;
    }
    __device__ __forceinline__ int a_off(const Unit& u) const { return ADIV > 0 ? (u.pn / (ADIV > 0 ? ADIV : 1)) * AMUL : 0; }
    __device__ __forceinline__ void a_ready(const Unit&) const {}
    __device__ __forceinline__ void done(const Unit&) const {}
};

template <class GT, class Epi, class Sched, bool ALIGN_EPI = false, bool SP2 = false>
__device__ __forceinline__ void gemm_phase(PG8_LAS unsigned char* lds, const GT g, const Sched& S, const Epi& E) {
    int tid_ = threadIdx.x; asm volatile("" : "+v"(tid_));
    const int tid = tid_, wid = __builtin_amdgcn_readfirstlane(tid >> 6), lane = tid & 63, wr = wid >> 2, wc = wid & 3, fr = lane & 15, fq = lane >> 4;
    constexpr int K = GT::K, nt = K / BK;
    unsigned voffA[2], voffB[2];
#pragma unroll
    for (int i = 0; i < 2; ++i) { int R, C; stage_rc(tid * 16 + i * 8192, R, C); const int Rb = Epi::PERM ? ((R & ~31) + perm32(R & 31)) : R;
        voffA[i] = (unsigned)(R * GT::lda + C) * 2u; voffB[i] = (unsigned)(Rb * GT::ldb + C) * 2u; }
    constexpr size_t kstep = (size_t)(BK * 2);
    constexpr size_t hstepA = (size_t)HALF * GT::lda * 2, hstepB = (size_t)HALF * GT::ldb * 2;
    constexpr size_t tstepA = 2 * hstepA, tstepB = 2 * hstepB;
    const unsigned ldsw = (unsigned)wid * 1024u;
    const int aoff = lds_byte(wr * 64 + fr, fq * 8), boff = lds_byte(wc * 32 + fr, fq * 8);
#define PG8_SA(b, h) (((b) * 2 + (h)) * HTB)
#define PG8_SB(b, h) ((4 + (b) * 2 + (h)) * HTB)
#define PG8_STAGE(bufoff, gbase, voff) do { _Pragma("unroll") for (int _i = 0; _i < 2; ++_i) \
        __builtin_amdgcn_global_load_lds((const unsigned*)((const char*)(gbase) + (voff)[_i]), (PG8_LAS unsigned*)(lds + (bufoff) + ldsw + _i * 8192), 16, 0, 0); } while (0)
#define PG8_LDA(dst, b, h) do { _Pragma("unroll") for (int m = 0; m < 4; ++m) _Pragma("unroll") for (int k = 0; k < 2; ++k) dst[m][k] = *(const PG8_LAS bf16x8*)(lds + PG8_SA(b, h) + aoff + m * 2048 + k * 1024); } while (0)
#define PG8_LDB(dst, b, h) do { _Pragma("unroll") for (int n = 0; n < 2; ++n) _Pragma("unroll") for (int k = 0; k < 2; ++k) dst[n][k] = *(const PG8_LAS bf16x8*)(lds + PG8_SB(b, h) + boff + n * 2048 + k * 1024); } while (0)
#define PG8_MMA(ai, bj, At, Bt) do { __builtin_amdgcn_s_setprio(1); _Pragma("unroll") for (int m = 0; m < 4; ++m) _Pragma("unroll") for (int n = 0; n < 2; ++n) _Pragma("unroll") for (int k = 0; k < 2; ++k) \
        acc[ai][bj][m][n] = __builtin_amdgcn_mfma_f32_16x16x32_bf16(Bt[n][k], At[m][k], acc[ai][bj][m][n], 0, 0, 0); __builtin_amdgcn_s_setprio(0); } while (0)
#define PG8_WAIT_V(n) asm volatile("s_waitcnt vmcnt(" #n ")" ::: "memory")
#define PG8_WAIT_L(n) asm volatile("s_waitcnt lgkmcnt(" #n ")" ::: "memory")
#define PG8_BAR __builtin_amdgcn_s_barrier()
#define PG8_SCHED __builtin_amdgcn_sched_barrier(0)
    Unit cur, nxt; int ui = 0;
    if (!S.next(0, cur)) return;
    f32x4 acc[2][2][4][2];
#pragma unroll
    for (int a = 0; a < 2; ++a)
#pragma unroll
        for (int b = 0; b < 2; ++b)
#pragma unroll
            for (int m = 0; m < 4; ++m)
#pragma unroll
                for (int n = 0; n < 2; ++n) acc[a][b][m][n] = (f32x4){0.f, 0.f, 0.f, 0.f};
    bf16x8 At[4][2], B0[2][2], B1[2][2];
    const char* cA = (const char*)g.A + (size_t)cur.pm * tstepA + (size_t)S.a_off(cur) * 2; const char* cB = (const char*)g.Bt + (size_t)cur.pn * tstepB;
    S.a_ready(cur);
    if constexpr (SP2) {
        PG8_STAGE(PG8_SB(0, 0), cB, voffB); PG8_STAGE(PG8_SB(0, 1), cB + hstepB, voffB); PG8_STAGE(PG8_SA(0, 0), cA, voffA); PG8_STAGE(PG8_SA(0, 1), cA + hstepA, voffA);
        if (wr == 1) PG8_BAR;
        PG8_WAIT_V(2); PG8_BAR;
        PG8_STAGE(PG8_SB(1, 0), cB + kstep, voffB); PG8_STAGE(PG8_SA(1, 0), cA + kstep, voffA); PG8_STAGE(PG8_SB(1, 1), cB + hstepB + kstep, voffB);
        PG8_WAIT_V(6); PG8_BAR;
    } else {
        PG8_STAGE(PG8_SB(0, 0), cB, voffB); PG8_STAGE(PG8_SA(0, 0), cA, voffA); PG8_STAGE(PG8_SB(0, 1), cB + hstepB, voffB); PG8_STAGE(PG8_SA(0, 1), cA + hstepA, voffA);
        if (wr == 1) PG8_BAR;
        PG8_WAIT_V(4); PG8_BAR;
        PG8_STAGE(PG8_SB(1, 0), cB + kstep, voffB); PG8_STAGE(PG8_SA(1, 0), cA + kstep, voffA); PG8_STAGE(PG8_SB(1, 1), cB + hstepB + kstep, voffB);
        PG8_WAIT_V(6); PG8_BAR;
    }
    for (;;) {
        const bool has_next = S.next(ui + 1, nxt);
        const char* nA = has_next ? (const char*)g.A + (size_t)nxt.pm * tstepA + (size_t)S.a_off(nxt) * 2 : cA; const char* nB = has_next ? (const char*)g.Bt + (size_t)nxt.pn * tstepB : cB;
        for (int t = 0; t < nt; t += 2) {
            const bool last = (t == nt - 2);
            const char* a1 = cA + (size_t)(t + 1) * kstep;
            const char* a2 = last ? nA : cA + (size_t)(t + 2) * kstep; const char* b2 = last ? nB : cB + (size_t)(t + 2) * kstep;
            const char* a3 = a2 + kstep; const char* b3 = b2 + kstep;
            if (last && has_next) S.a_ready(nxt);
            if constexpr (SP2) {
            PG8_LDB(B0, 0, 0); PG8_LDB(B1, 0, 1); PG8_SCHED; PG8_LDA(At, 0, 0); PG8_STAGE(PG8_SA(1, 1), a1 + hstepA, voffA);
            PG8_WAIT_V(8); PG8_WAIT_L(0); PG8_BAR; PG8_MMA(0, 0, At, B0); PG8_MMA(0, 1, At, B1); PG8_BAR; PG8_SCHED;
            PG8_LDA(At, 0, 1); PG8_STAGE(PG8_SB(0, 0), b2, voffB); PG8_STAGE(PG8_SB(0, 1), b2 + hstepB, voffB); PG8_STAGE(PG8_SA(0, 0), a2, voffA);
            PG8_WAIT_V(8); PG8_WAIT_L(0); PG8_BAR; PG8_MMA(1, 0, At, B0); PG8_MMA(1, 1, At, B1); PG8_BAR; PG8_SCHED;
            PG8_LDB(B0, 1, 0); PG8_LDB(B1, 1, 1); PG8_SCHED; PG8_LDA(At, 1, 0); PG8_STAGE(PG8_SA(0, 1), a2 + hstepA, voffA);
            PG8_WAIT_V(8); PG8_WAIT_L(0); PG8_BAR; PG8_MMA(0, 0, At, B0); PG8_MMA(0, 1, At, B1); PG8_BAR; PG8_SCHED;
            PG8_LDA(At, 1, 1); PG8_STAGE(PG8_SB(1, 0), b3, voffB); PG8_STAGE(PG8_SB(1, 1), b3 + hstepB, voffB); PG8_STAGE(PG8_SA(1, 0), a3, voffA);
            PG8_WAIT_V(8); PG8_WAIT_L(0); PG8_BAR; PG8_MMA(1, 0, At, B0); PG8_MMA(1, 1, At, B1); PG8_BAR; PG8_SCHED;
            } else {
            PG8_LDB(B0, 0, 0); PG8_SCHED; PG8_LDA(At, 0, 0); PG8_STAGE(PG8_SA(1, 1), a1 + hstepA, voffA);
            PG8_WAIT_L(8); PG8_BAR; PG8_WAIT_L(0); PG8_MMA(0, 0, At, B0); PG8_BAR; PG8_SCHED;
            PG8_LDB(B1, 0, 1); PG8_STAGE(PG8_SB(0, 0), b2, voffB);
            PG8_BAR; PG8_WAIT_L(0); PG8_MMA(0, 1, At, B1); PG8_BAR;
            PG8_LDA(At, 0, 1); PG8_STAGE(PG8_SA(0, 0), a2, voffA);
            PG8_BAR; PG8_WAIT_L(0); PG8_MMA(1, 0, At, B0); PG8_BAR; PG8_SCHED;
            PG8_STAGE(PG8_SB(0, 1), b2 + hstepB, voffB);
            PG8_WAIT_V(6); PG8_BAR; PG8_MMA(1, 1, At, B1); PG8_BAR;
            PG8_LDB(B0, 1, 0); PG8_SCHED; PG8_LDA(At, 1, 0); PG8_STAGE(PG8_SA(0, 1), a2 + hstepA, voffA);
            PG8_WAIT_L(8); PG8_BAR; PG8_WAIT_L(0); PG8_MMA(0, 0, At, B0); PG8_BAR; PG8_SCHED;
            PG8_LDB(B1, 1, 1); PG8_STAGE(PG8_SB(1, 0), b3, voffB);
            PG8_BAR; PG8_WAIT_L(0); PG8_MMA(0, 1, At, B1); PG8_BAR;
            PG8_LDA(At, 1, 1); PG8_STAGE(PG8_SA(1, 0), a3, voffA);
            PG8_BAR; PG8_WAIT_L(0); PG8_MMA(1, 0, At, B0); PG8_BAR; PG8_SCHED;
            PG8_STAGE(PG8_SB(1, 1), b3 + hstepB, voffB);
            PG8_WAIT_V(6); PG8_BAR; PG8_MMA(1, 1, At, B1); PG8_BAR;
            }
        }
        if constexpr (ALIGN_EPI) { if (wr == 0) PG8_BAR; }
        if constexpr (!Epi::AFTER_DRAIN) { E(acc, cur, wr, wc, fr, fq); S.done(cur); }
        if (!has_next) break;
#pragma unroll
        for (int a = 0; a < 2; ++a)
#pragma unroll
            for (int b = 0; b < 2; ++b)
#pragma unroll
                for (int m = 0; m < 4; ++m)
#pragma unroll
                    for (int n = 0; n < 2; ++n) acc[a][b][m][n] = (f32x4){0.f, 0.f, 0.f, 0.f};
        cur = nxt; cA = nA; cB = nB; ++ui;
        if constexpr (ALIGN_EPI) { if (wr == 1) PG8_BAR; }
    }
    PG8_WAIT_V(0);
    if constexpr (!ALIGN_EPI) { if (wr == 0) PG8_BAR; }
    PG8_BAR;
    if constexpr (Epi::AFTER_DRAIN) { E.fused(acc, cur, wr, wc, fr, fq, lds, wid, lane); S.done(cur); }
#undef PG8_SA
#undef PG8_SB
#undef PG8_STAGE
#undef PG8_LDA
#undef PG8_LDB
#undef PG8_MMA
#undef PG8_WAIT_V
#undef PG8_WAIT_L
#undef PG8_BAR
#undef PG8_SCHED
}
}

#define LAS __attribute__((address_space(3)))
typedef unsigned short bf16_t;
typedef short bf16x8 __attribute__((ext_vector_type(8)));
typedef float f32x4 __attribute__((ext_vector_type(4)));
typedef unsigned u32x4 __attribute__((ext_vector_type(4)));
typedef unsigned u32x2 __attribute__((ext_vector_type(2)));

constexpr int D = 1024, DFF = 2816, NFF2 = 5632, INC = 7984, PN = 5120, PREAL = 4912, MGN = 3072;
constexpr int MTOT = 24576, MLAT = 16384, GROWS = 8192;
constexpr float EPSN = 1e-6f;
constexpr size_t MiB = 1u << 20;
constexpr size_t WS_MOD = 1 * MiB, WS_MODP = 2 * MiB, WS_POS = 5 * MiB, WS_DEC = 6 * MiB, WS_SC = 7 * MiB;
constexpr size_t WS_W = 8 * MiB;
constexpr size_t W_FFIN = 0, W_FFOUT = W_FFIN + 2ull * NFF2 * D * 2, W_P = W_FFOUT + 2ull * D * DFF * 2, W_MG = W_P + (size_t)PN * D * 2,
                 W_B = W_MG + (size_t)MGN * D * 2, W_O3 = W_B + 3072ull * 512 * 2, W_END = W_O3 + 1024ull * 3072 * 2;
static_assert(W_END <= 58 * MiB, "weights region");
constexpr size_t WS_XN = 66 * MiB, WS_A = 114 * MiB, WS_BIG = 210 * MiB, WS_END = 370 * MiB;
constexpr size_t BIG_US = 80 * MiB, BIG_OB = 128 * MiB;
constexpr size_t OFF_YP = 0, OFF_YS = 8388608, OFF_C = 25165824, OFF_N = 29360128, OFF_M = 29392896, OFF_G = 29393408, OFF_H = 33587712;
constexpr int LDS_BYTES = 147456;

struct Args { const float* in[23]; float* out; unsigned char* ws; };
enum { I_XP = 0, I_XS, I_C, I_SC, I_SN, I_SM, I_SG, I_SH, I_CCTX, I_WADA, I_BADA, I_NPRE, I_NPOST, I_WFIN, I_WFOUT, I_WIN, I_GB, I_GWUP, I_GLB, I_HGAM, I_HN, I_WBR, I_WOUT };
__device__ __forceinline__ const float* inp(const Args& a, int i) { asm volatile("" : "+s"(i)); return a.in[i]; }

__device__ __forceinline__ unsigned f2bf(float f) { unsigned u = __float_as_uint(f); return (u + 0x7fffu + ((u >> 16) & 1u)) >> 16; }
__device__ __forceinline__ unsigned pk2(float lo, float hi) { return f2bf(lo) | (f2bf(hi) << 16); }
__device__ __forceinline__ float bf2f(bf16_t h) { return __uint_as_float(((unsigned)h) << 16); }
__device__ __forceinline__ float bflo(unsigned w) { return __uint_as_float(w << 16); }
__device__ __forceinline__ float bfhi(unsigned w) { return __uint_as_float(w & 0xffff0000u); }
__device__ __forceinline__ float sigmoidf_(float x) { return 1.0f / (1.0f + __expf(-x)); }
__device__ __forceinline__ float siluf_(float x) { return x / (1.0f + __expf(-x)); }
__device__ __forceinline__ float logsigf_(float x) { return fminf(x, 0.f) - __logf(1.0f + __expf(-fabsf(x))); }
__device__ __forceinline__ float wave_sum(float v) {
#pragma unroll
    for (int o = 1; o < 64; o <<= 1) v += __shfl_xor(v, o);
    return v;
}
#define LDS_WAIT() asm volatile("s_waitcnt lgkmcnt(0)" ::: "memory")

#define XB_TMO      128
#define XB_XCNT(j)  (256  + 64 * (j))
#define XB_XSUB(j)  (1280 + 64 * (j))
#define XB_XGEN(j)  (2304 + 64 * (j))
#define XB_TOP      3328
#define XB_TOPGEN   3392
#define XCD_BAR_WORDS 3456
#define XB_SPIN_CAP (1u << 18)

__device__ __forceinline__ unsigned xb_ld(unsigned* p)              { return __hip_atomic_load(p, __ATOMIC_RELAXED, __HIP_MEMORY_SCOPE_AGENT); }
__device__ __forceinline__ unsigned xb_add(unsigned* p, unsigned v) { return __hip_atomic_fetch_add(p, v, __ATOMIC_RELAXED, __HIP_MEMORY_SCOPE_AGENT); }
__device__ __forceinline__ unsigned xb_xcc_id() { return (unsigned)__builtin_amdgcn_s_getreg((3 << 11) | 20) & 0xFu; }
#define XB_SPIN(cond, bar) do { unsigned _sp = 0; while (cond) { __builtin_amdgcn_s_sleep(1); \
    if ((++_sp & 255u) == 0u) { if (xb_ld(&(bar)[XB_TMO])) break; if (_sp > XB_SPIN_CAP) { atomicAdd(&(bar)[XB_TMO], 1u); break; } } } } while (0)

struct XcdBarrier {
    unsigned* bar; unsigned x;
    volatile LAS unsigned* st;
};

__device__ __forceinline__ XcdBarrier xcd_barrier_post(unsigned* bar, volatile LAS unsigned* st) {
    XcdBarrier b; b.bar = bar; b.x = xb_xcc_id(); b.st = st;
    if (threadIdx.x == 0) (void)xb_add(&bar[XB_XCNT(b.x)], 1u);
    return b;
}
__device__ __forceinline__ void xcd_barrier_complete(unsigned* bar, unsigned x, unsigned& nloc, unsigned& nx) {
    const unsigned G = gridDim.x * gridDim.y * gridDim.z;
    unsigned sum, cnt, mine, sp = 0u;
    for (;;) {
        sum = 0u; cnt = 0u; mine = 0u;
#pragma unroll
        for (unsigned j = 0; j < 16; ++j) { const unsigned c = xb_ld(&bar[XB_XCNT(j)]); sum += c; cnt += (c > 0u) ? 1u : 0u; mine = (j == x) ? c : mine; }
        if (sum == G) break;
        __builtin_amdgcn_s_sleep(1);
        if ((++sp & 255u) == 0u) { if (xb_ld(&bar[XB_TMO])) break; if (sp > XB_SPIN_CAP) { atomicAdd(&bar[XB_TMO], 1u); break; } }
    }
    nloc = mine > 0u ? mine : 1u; nx = cnt > 0u ? cnt : 1u;
}

__device__ __attribute__((noinline)) void xcd_barrier_ni(unsigned* bar_, unsigned st_off) {
    XcdBarrier b; b.bar = bar_; b.x = xb_xcc_id(); b.st = (volatile LAS unsigned*)(size_t)st_off;
    asm volatile("s_waitcnt vmcnt(0)" ::: "memory");
    __syncthreads();
    if (threadIdx.x == 0) {
        unsigned* bar = b.bar;
        __builtin_amdgcn_s_waitcnt(0);
        unsigned nloc = b.st[0], nx = b.st[1];
        if (nloc == 0u) { xcd_barrier_complete(bar, b.x, nloc, nx); b.st[0] = nloc; b.st[1] = nx; }
        const unsigned old = xb_add(&bar[XB_XSUB(b.x)], 1u);
        const unsigned gen = old / nloc;
        if (old + 1u == (gen + 1u) * nloc) {
            __builtin_amdgcn_fence(__ATOMIC_RELEASE, "agent");
            asm volatile("s_waitcnt vmcnt(0)" ::: "memory");
            const unsigned og = xb_add(&bar[XB_TOP], 1u);
            const unsigned tg = og / nx;
            if (og + 1u == (tg + 1u) * nx) xb_add(&bar[XB_TOPGEN], 1u);
            else XB_SPIN(xb_ld(&bar[XB_TOPGEN]) == tg, bar);
            __builtin_amdgcn_fence(__ATOMIC_ACQUIRE, "agent");
            xb_add(&bar[XB_XGEN(b.x)], 1u);
            asm volatile("s_waitcnt vmcnt(0)" ::: "memory");
        } else {
            XB_SPIN(xb_ld(&bar[XB_XGEN(b.x)]) == gen, bar);
            __builtin_amdgcn_fence(__ATOMIC_ACQUIRE, "agent");
            asm volatile("s_waitcnt vmcnt(0)" ::: "memory");
        }
    }
    __syncthreads();
}


struct EpiBf16 {
    static constexpr bool PERM = true, AFTER_DRAIN = false;
    bf16_t* O; int ldc;
    __device__ __forceinline__ void operator()(const f32x4 (&acc)[2][2][4][2], const pg8::Unit& u, int wr, int wc, int fr, int fq) const {
        const int row0 = u.pm * 256 + wr * 64 + fr, col0 = u.pn * 256 + wc * 32 + 8 * fq;
#pragma unroll
        for (int ai = 0; ai < 2; ++ai)
#pragma unroll
            for (int m = 0; m < 4; ++m) { bf16_t* rowp = O + (size_t)(row0 + ai * 128 + m * 16) * ldc + col0;
#pragma unroll
                for (int bj = 0; bj < 2; ++bj) { const f32x4 v0 = acc[ai][bj][m][0], v1 = acc[ai][bj][m][1];
                    u32x4 w; w.x = pk2(v0[0], v0[1]); w.y = pk2(v0[2], v0[3]); w.z = pk2(v1[0], v1[1]); w.w = pk2(v1[2], v1[3]);
                    *(u32x4*)(rowp + bj * 128) = w; } }
    }
};
struct EpiGateMul {
    static constexpr bool PERM = true, AFTER_DRAIN = false;
    bf16_t* O; int ldc;
    __device__ __forceinline__ void operator()(const f32x4 (&acc)[2][2][4][2], const pg8::Unit& u, int wr, int wc, int fr, int fq) const {
        const int row0 = u.pm * 256 + wr * 64 + fr, col0 = u.pn * 256 + wc * 32 + 8 * fq;
#pragma unroll
        for (int ai = 0; ai < 2; ++ai)
#pragma unroll
            for (int m = 0; m < 4; ++m) { bf16_t* rowp = O + (size_t)(row0 + ai * 128 + m * 16) * ldc + col0;
#pragma unroll
                for (int bj = 0; bj < 2; ++bj) { const f32x4 v0 = acc[ai][bj][m][0], v1 = acc[ai][bj][m][1];
                    const u32x4 b = *(const u32x4*)(rowp + bj * 128);
                    u32x4 w; w.x = pk2(sigmoidf_(v0[0]) * bflo(b.x), sigmoidf_(v0[1]) * bfhi(b.x)); w.y = pk2(sigmoidf_(v0[2]) * bflo(b.y), sigmoidf_(v0[3]) * bfhi(b.y));
                    w.z = pk2(sigmoidf_(v1[0]) * bflo(b.z), sigmoidf_(v1[1]) * bfhi(b.z)); w.w = pk2(sigmoidf_(v1[2]) * bflo(b.w), sigmoidf_(v1[3]) * bfhi(b.w));
                    *(u32x4*)(rowp + bj * 128) = w; } }
    }
};
struct EpiSwiGLU {
    static constexpr bool PERM = true, AFTER_DRAIN = false;
    bf16_t* H; int ldh;
    __device__ __forceinline__ void operator()(const f32x4 (&acc)[2][2][4][2], const pg8::Unit& u, int wr, int wc, int fr, int fq) const {
        const int row0 = u.pm * 256 + wr * 64 + fr, col0 = (u.pn * 256 + wc * 32 + 8 * fq) >> 1;
#pragma unroll
        for (int ai = 0; ai < 2; ++ai)
#pragma unroll
            for (int m = 0; m < 4; ++m) { bf16_t* rowp = H + (size_t)(row0 + ai * 128 + m * 16) * ldh + col0;
#pragma unroll
                for (int bj = 0; bj < 2; ++bj) { const f32x4 g = acc[ai][bj][m][0], up = acc[ai][bj][m][1];
                    u32x2 w; w.x = pk2(siluf_(g[0]) * up[0], siluf_(g[1]) * up[1]); w.y = pk2(siluf_(g[2]) * up[2], siluf_(g[3]) * up[3]);
                    *(u32x2*)(rowp + bj * 64) = w; } }
    }
};
struct EpiF32 {
    static constexpr bool PERM = false, AFTER_DRAIN = false;
    float* Y; int ldc;
    __device__ __forceinline__ void operator()(const f32x4 (&acc)[2][2][4][2], const pg8::Unit& u, int wr, int wc, int fr, int fq) const {
        const int row0 = u.pm * 256 + wr * 64 + fr, col0 = u.pn * 256 + wc * 32 + 4 * fq;
#pragma unroll
        for (int ai = 0; ai < 2; ++ai)
#pragma unroll
            for (int m = 0; m < 4; ++m) { float* rowp = Y + (size_t)(row0 + ai * 128 + m * 16) * ldc + col0;
#pragma unroll
                for (int bj = 0; bj < 2; ++bj)
#pragma unroll
                    for (int n = 0; n < 2; ++n) *(f32x4*)(rowp + bj * 128 + n * 16) = acc[ai][bj][m][n]; }
    }
};

template <class Map>
__device__ __forceinline__ void transpose_item(const float* W, int K, int N, LAS float* scr, int item, int lane, const Map& map) {
    const int nblk = (N + 31) / 32, kb = item / nblk, nb = item % nblk, k0 = 64 * kb, n0 = 32 * nb;
    const int nn = n0 + (lane & 31); const bool ok = nn < N;
#pragma unroll 8
    for (int i = 0; i < 32; ++i) { const int kk = 2 * i + (lane >> 5); scr[kk * 33 + (lane & 31)] = ok ? W[(size_t)(k0 + kk) * N + nn] : 0.f; }
    LDS_WAIT(); asm volatile("" ::: "memory");
    const int c = lane & 7;
#pragma unroll
    for (int j = 0; j < 4; ++j) { const int n = (lane >> 3) + 8 * j; const LAS float* s = scr + (8 * c) * 33 + n;
        u32x4 o; o.x = pk2(s[0 * 33], s[1 * 33]); o.y = pk2(s[2 * 33], s[3 * 33]); o.z = pk2(s[4 * 33], s[5 * 33]); o.w = pk2(s[6 * 33], s[7 * 33]);
        if (n0 + n < N) map(n0 + n, k0 + 8 * c, o); }
    LDS_WAIT(); asm volatile("" ::: "memory");
}

__device__ __forceinline__ void convert_weights(const Args& a, LAS unsigned char* lds, int l, int gw, int NGW, int lane, int wave) {
    LAS float* scr = (LAS float*)(lds + wave * 16384);
    unsigned char* wb = a.ws + WS_W;
    constexpr int I_FI = 16 * 176, I_FO = 44 * 32, I_IN = 16 * 250, I_BR = 8 * 32, I_OU = 16 * 32;
    constexpr int NITEMS = 2 * I_FI + 2 * I_FO + I_IN + 3 * I_BR + I_OU;
    for (int it = gw; it < NITEMS; it += NGW) {
        int r = it;
        if (r < 2 * I_FI) { const int f = r / I_FI; r -= f * I_FI; bf16_t* dst = (bf16_t*)(wb + W_FFIN) + (size_t)f * NFF2 * D;
            transpose_item(inp(a, I_WFIN) + (size_t)(l * 2 + f) * D * NFF2, D, NFF2, scr, r, lane,
                [=](int n, int k, u32x4 o) { const int h = n < DFF ? n : n - DFF; const int row = 8 * (h >> 2) + (n < DFF ? 0 : 4) + (h & 3); *(u32x4*)(dst + (size_t)row * D + k) = o; });
            continue; }
        r -= 2 * I_FI;
        if (r < 2 * I_FO) { const int f = r / I_FO; r -= f * I_FO; bf16_t* dst = (bf16_t*)(wb + W_FFOUT) + (size_t)f * D * DFF;
            transpose_item(inp(a, I_WFOUT) + (size_t)(l * 2 + f) * DFF * D, DFF, D, scr, r, lane,
                [=](int n, int k, u32x4 o) { *(u32x4*)(dst + (size_t)n * DFF + k) = o; });
            continue; }
        r -= 2 * I_FO;
        if (r < I_IN) { bf16_t* dp = (bf16_t*)(wb + W_P); bf16_t* dm = (bf16_t*)(wb + W_MG);
            transpose_item(inp(a, I_WIN) + (size_t)l * D * INC, D, INC, scr, r, lane,
                [=](int n, int k, u32x4 o) { if (n < PREAL) *(u32x4*)(dp + (size_t)n * D + k) = o; else *(u32x4*)(dm + (size_t)(n - PREAL) * D + k) = o; });
            continue; }
        r -= I_IN;
        if (r < 3 * I_BR) { const int nb = r / I_BR; r -= nb * I_BR; bf16_t* dst = (bf16_t*)(wb + W_B) + (size_t)nb * 1024 * 512;
            transpose_item(inp(a, I_WBR) + (size_t)(l * 3 + nb) * 512 * D, 512, D, scr, r, lane,
                [=](int n, int k, u32x4 o) { *(u32x4*)(dst + (size_t)n * 512 + k) = o; });
            continue; }
        r -= 3 * I_BR;
        { bf16_t* dst = (bf16_t*)(wb + W_O3);
            transpose_item(inp(a, I_WOUT) + (size_t)l * D * D, D, D, scr, r, lane,
                [=](int n, int k, u32x4 o) { bf16_t* p = dst + (size_t)n * 3072 + k; *(u32x4*)p = o; *(u32x4*)(p + 1024) = o; *(u32x4*)(p + 2048) = o; }); }
    }
    { u32x4* z = (u32x4*)((bf16_t*)(wb + W_P) + (size_t)PREAL * D); const int nz = (PN - PREAL) * D * 2 / 16;
      for (int i = gw * 64 + lane; i < nz; i += NGW * 64) z[i] = (u32x4){0u, 0u, 0u, 0u}; }
}

__device__ __forceinline__ void ada_partial(const Args& a, int gw, int NGW, int lane) {
    float* modp = (float*)(a.ws + WS_MODP);
    for (int it = gw; it < 2 * 144 * 8; it += NGW) {
        const int ks = it & 7, cgp = (it >> 3) % 144, l = it / (8 * 144);
        const int col = cgp * 64 + lane;
        const float* w = inp(a, I_WADA) + ((size_t)l * D + ks * 128) * 9216 + col;
        float acc[5] = {0.f, 0.f, 0.f, 0.f, 0.f};
#pragma unroll 4
        for (int k = 0; k < 128; ++k) { const float wv = w[(size_t)k * 9216]; const int kk = ks * 128 + k;
            acc[0] += siluf_(inp(a, I_CCTX)[kk]) * wv;
#pragma unroll
            for (int i = 0; i < 4; ++i) acc[1 + i] += siluf_(inp(a, I_C)[i * D + kk]) * wv; }
#pragma unroll
        for (int i = 0; i < 5; ++i) modp[((size_t)(ks * 2 + l) * 5 + i) * 9216 + col] = acc[i];
    }
}

struct RowOp { int src_input, has_y; float coef; const float* npost; const float* mdg_base; int has_xn; const float* npre; const float* md_base; int si; int add_pos; };
template <int NR>
__device__ __forceinline__ void rowwise(const Args& a, const RowOp& op, const int (&rs)[NR], int lane) {
    f32x4 v[NR][4]; u32x2 yb[NR][4]; float* xd[NR]; bool lat[NR]; int cv[NR];
#pragma unroll
    for (int q = 0; q < NR; ++q) { const int r = rs[q]; lat[q] = r < MLAT; cv[q] = lat[q] ? 1 + (r >> 12) : 0;
        const float* xs = op.src_input ? (lat[q] ? inp(a, I_XS) + (size_t)r * D : inp(a, I_XP) + (size_t)(r - MLAT) * D)
                                       : (lat[q] ? a.out + OFF_YS + (size_t)r * D : a.out + OFF_YP + (size_t)(r - MLAT) * D);
        xd[q] = lat[q] ? a.out + OFF_YS + (size_t)r * D : a.out + OFF_YP + (size_t)(r - MLAT) * D;
#pragma unroll
        for (int j = 0; j < 4; ++j) v[q][j] = *(const f32x4*)(xs + 4 * lane + 256 * j);
        if (op.has_y) { const bf16_t* yr = (const bf16_t*)(a.ws + WS_A) + (size_t)r * D;
#pragma unroll
            for (int j = 0; j < 4; ++j) yb[q][j] = *(const u32x2*)(yr + 4 * lane + 256 * j); } }
#pragma unroll
    for (int q = 0; q < NR; ++q) { const int r = rs[q];
        if (op.has_y) {
            f32x4 y[4]; float ss = 0.f;
#pragma unroll
            for (int j = 0; j < 4; ++j) { y[j] = (f32x4){bflo(yb[q][j].x), bfhi(yb[q][j].x), bflo(yb[q][j].y), bfhi(yb[q][j].y)}; ss += (y[j].x * y[j].x + y[j].y * y[j].y) + (y[j].z * y[j].z + y[j].w * y[j].w); }
            const float rr = rsqrtf(wave_sum(ss) * (1.f / D) + EPSN) * op.coef;
            const float* gp = op.mdg_base + (size_t)cv[q] * 9216;
#pragma unroll
            for (int j = 0; j < 4; ++j) { const f32x4 w = *(const f32x4*)(op.npost + 4 * lane + 256 * j), gg = *(const f32x4*)(gp + 4 * lane + 256 * j);
                v[q][j] = v[q][j] + gg * (y[j] * rr) * w; *(f32x4*)(xd[q] + 4 * lane + 256 * j) = v[q][j]; }
        }
        if (op.has_xn) {
            float ss = 0.f;
#pragma unroll
            for (int j = 0; j < 4; ++j) ss += (v[q][j].x * v[q][j].x + v[q][j].y * v[q][j].y) + (v[q][j].z * v[q][j].z + v[q][j].w * v[q][j].w);
            const float rr = rsqrtf(wave_sum(ss) * (1.f / D) + EPSN);
            const float* sh = op.md_base + (size_t)cv[q] * 9216 + (size_t)op.si * D; const float* sc = sh + D;
            const float* pos = (const float*)(a.ws + WS_POS); const int t = r & 4095;
            bf16_t* xo = (bf16_t*)(a.ws + WS_XN) + (size_t)r * D;
#pragma unroll
            for (int j = 0; j < 4; ++j) { const int c = 4 * lane + 256 * j; const f32x4 w = *(const f32x4*)(op.npre + c), s1 = *(const f32x4*)(sc + c), s0 = *(const f32x4*)(sh + c);
                f32x4 o = (v[q][j] * rr) * w * (s1 + 1.0f) + s0;
                if (op.add_pos && lat[q]) { const float* pp = (c < 512) ? pos + (size_t)(t >> 6) * 512 + c : pos + (size_t)(t & 63) * 512 + (c - 512); o = o + *(const f32x4*)pp; }
                u32x2 pk; pk.x = pk2(o.x, o.y); pk.y = pk2(o.z, o.w); *(u32x2*)(xo + c) = pk; }
        }
    }
}
__device__ __forceinline__ void rowwise_all(const Args& a, const RowOp& op, int gw, int NGW, int lane) {
    int r = gw;
    for (; r + NGW < MTOT; r += 2 * NGW) { const int rs[2] = {r, r + NGW}; rowwise<2>(a, op, rs, lane); }
    if (r < MTOT) { const int rs[1] = {r}; rowwise<1>(a, op, rs, lane); }
}

constexpr int C_MQ = 0, C_MK = 256, C_MV = 512, C_MO = 1024, C_MIF = 1536, C_GQ = 1552, C_GK = 1808, C_GV = 2064, C_GR = 2576, C_GLR = 3088, C_HQ = 3120, C_HF = 3376, C_HV = 3888, C_HG = 4400;

struct ItemInfo { int br, dir, head, seq, c, T, NC; };
__device__ __forceinline__ ItemInfo item_info(int g, int it) { ItemInfo I; const int hdb = it % 24, cgl = it / 24; I.br = hdb >> 3; I.dir = (hdb >> 2) & 1; I.head = hdb & 3;
    I.T = g < 2 ? 4096 : 256; I.NC = I.T >> 6; I.seq = cgl / I.NC; I.c = cgl % I.NC; return I; }
__device__ __forceinline__ int item_row(const ItemInfo& I, int s) { const int tau = I.c * 64 + s; return I.seq * I.T + (I.dir ? I.T - 1 - tau : tau); }
__device__ __forceinline__ float lb_of(const Args& a, int l, int ch) { if (l == 0) return 0.f; const float g0 = inp(a, I_HGAM)[ch], g1 = inp(a, I_HGAM)[256 + ch]; return 1.0f / (1.0f + expf(g0 - g1)); }

template <bool NEEDQ>
__device__ __forceinline__ void load_gated(const Args& a, const bf16_t* P, const ItemInfo& I, int l, int d, int sg, float (&qv)[8], float (&kv)[8], float (&la)[8]) {
    const int ch = I.head * 64 + d;
    if (I.br == 1) {
        float wup[16];
        const float* wp = inp(a, I_GWUP) + ((size_t)(l * 2 + I.dir) * 16) * 256 + ch;
#pragma unroll
        for (int r = 0; r < 16; ++r) wup[r] = wp[r * 256];
        const float gb = inp(a, I_GLB)[(l * 2 + I.dir) * 256 + ch];
#pragma unroll
        for (int i = 0; i < 8; ++i) { const bf16_t* pr = P + (size_t)item_row(I, 8 * sg + i) * PN;
            const u32x4 g0 = *(const u32x4*)(pr + C_GLR + I.dir * 16), g1 = *(const u32x4*)(pr + C_GLR + I.dir * 16 + 8);
            float z = gb;
            z += bflo(g0.x) * wup[0] + bfhi(g0.x) * wup[1] + bflo(g0.y) * wup[2] + bfhi(g0.y) * wup[3] + bflo(g0.z) * wup[4] + bfhi(g0.z) * wup[5] + bflo(g0.w) * wup[6] + bfhi(g0.w) * wup[7];
            z += bflo(g1.x) * wup[8] + bfhi(g1.x) * wup[9] + bflo(g1.y) * wup[10] + bfhi(g1.y) * wup[11] + bflo(g1.z) * wup[12] + bfhi(g1.z) * wup[13] + bflo(g1.w) * wup[14] + bfhi(g1.w) * wup[15];
            la[i] = logsigf_(z) * (1.0f / 16.0f);
            if (NEEDQ) qv[i] = bf2f(pr[C_GQ + ch]) * 0.125f; kv[i] = bf2f(pr[C_GK + ch]); }
    } else {
        const float lb = lb_of(a, l, ch);
#pragma unroll
        for (int i = 0; i < 8; ++i) { const bf16_t* pr = P + (size_t)item_row(I, 8 * sg + i) * PN;
            const float z = bf2f(pr[C_HF + I.dir * 256 + ch]); const float sg_ = sigmoidf_(z);
            la[i] = (lb == 0.f) ? logsigf_(z) : __logf(lb + (1.0f - lb) * sg_);
            if (NEEDQ) qv[i] = bf2f(pr[C_HQ + ch]) * 1.0f;
            kv[i] = (1.0f - lb) * (1.0f - sg_); }
    }
}
template <bool NEEDQ>
__device__ __forceinline__ void load_mlstm(const Args& a, const bf16_t* P, const ItemInfo& I, int l, int d, int sg, float (&qv)[8], float (&kv)[8], float (&lf)[8], float (&li)[8]) {
    const float bi = inp(a, I_GB)[((l * 2 + I.dir) * 2 + 0) * 4 + I.head], bf_ = inp(a, I_GB)[((l * 2 + I.dir) * 2 + 1) * 4 + I.head];
#pragma unroll
    for (int i = 0; i < 8; ++i) { const bf16_t* pr = P + (size_t)item_row(I, 8 * sg + i) * PN;
        li[i] = bf2f(pr[C_MIF + I.dir * 8 + I.head]) + bi; lf[i] = logsigf_(bf2f(pr[C_MIF + I.dir * 8 + 4 + I.head]) + bf_);
        if (NEEDQ) qv[i] = bf2f(pr[C_MQ + I.head * 64 + d]) * 0.125f; kv[i] = bf2f(pr[C_MK + I.head * 64 + d]); }
}
__device__ __forceinline__ void stage_vT(const bf16_t* P, const ItemInfo& I, LAS bf16_t* Y, int pitch, int tid) {
    const int s = tid >> 3, eg = tid & 7; const int vb = I.br == 0 ? C_MV : (I.br == 1 ? C_GV : C_HV);
    const bf16_t* pv = P + (size_t)item_row(I, s) * PN + vb + I.head * 128 + 16 * eg;
    const u32x4 v0 = *(const u32x4*)pv, v1 = *(const u32x4*)(pv + 8);
    const unsigned wds[8] = {v0.x, v0.y, v0.z, v0.w, v1.x, v1.y, v1.z, v1.w};
#pragma unroll
    for (int i = 0; i < 8; ++i) { float x0 = bflo(wds[i]), x1 = bfhi(wds[i]); if (I.br == 2) { x0 = siluf_(x0); x1 = siluf_(x1); }
        Y[(16 * eg + 2 * i) * pitch + s] = (bf16_t)f2bf(x0); Y[(16 * eg + 2 * i + 1) * pitch + s] = (bf16_t)f2bf(x1); }
}
__device__ __forceinline__ bf16x8 ldfrag(const LAS bf16_t* T, int pitch, int row0, int k0, int lane) { return *(const LAS bf16x8*)(T + (row0 + (lane & 15)) * pitch + k0 + 8 * (lane >> 4)); }

__device__ __forceinline__ void scan_s1(const Args& a, LAS unsigned char* lds, int l, int g, int it) {
    int tid_ = threadIdx.x; asm volatile("" : "+v"(tid_)); const int tid = tid_, d = tid & 63, lane = d, sg = __builtin_amdgcn_readfirstlane(tid >> 6);
    const ItemInfo I = item_info(g, it);
    const bf16_t* P = (const bf16_t*)(a.ws + WS_BIG);
    bf16_t* US = (bf16_t*)(a.ws + WS_BIG + BIG_US) + (size_t)it * 8192;
    float* DEC = (float*)(a.ws + WS_DEC) + (size_t)it * 64; float* SC = (float*)(a.ws + WS_SC) + (size_t)it * 4;
    LAS bf16_t* XT = (LAS bf16_t*)lds;
    LAS bf16_t* YV = (LAS bf16_t*)(lds + 9216);
    LAS float* TOT = (LAS float*)(lds + 9216 + 20736);
    LAS float* TMX = TOT + 512;
    float qv[8], kv[8], x0[8], x1[8];
    if (I.br == 0) {
        load_mlstm<false>(a, P, I, l, d, sg, qv, kv, x0, x1);
        float run = 0.f;
#pragma unroll
        for (int i = 0; i < 8; ++i) { run += x0[i]; x0[i] = run; }
        TOT[sg * 64 + d] = run; LDS_WAIT(); __syncthreads();
        float pre = 0.f, tot = 0.f;
#pragma unroll
        for (int w = 0; w < 8; ++w) { const float t = TOT[w * 64 + d]; if (w < sg) pre += t; tot += t; }
        float mx = -3.0e38f;
#pragma unroll
        for (int i = 0; i < 8; ++i) { x0[i] = tot - (pre + x0[i]) + x1[i]; mx = fmaxf(mx, x0[i]); }
        TMX[sg * 64 + d] = mx; LDS_WAIT(); __syncthreads();
        float mlw = -3.0e38f;
#pragma unroll
        for (int w = 0; w < 8; ++w) mlw = fmaxf(mlw, TMX[w * 64 + d]);
#pragma unroll
        for (int i = 0; i < 8; ++i) kv[i] *= __expf(x0[i] - mlw);
        if (tid == 0) { SC[0] = mlw; SC[1] = tot; }
        for (int idx = tid; idx < 16 * 64; idx += 512) YV[(128 + (idx >> 6)) * 72 + (idx & 63)] = (bf16_t)((idx >> 6) == 0 ? 0x3F80 : 0);
    } else {
        load_gated<false>(a, P, I, l, d, sg, qv, kv, x0);
        float run = 0.f;
#pragma unroll
        for (int i = 0; i < 8; ++i) { run += x0[i]; x0[i] = run; }
        TOT[sg * 64 + d] = run; LDS_WAIT(); __syncthreads();
        float pre = 0.f, tot = 0.f;
#pragma unroll
        for (int w = 0; w < 8; ++w) { const float t = TOT[w * 64 + d]; if (w < sg) pre += t; tot += t; }
#pragma unroll
        for (int i = 0; i < 8; ++i) kv[i] *= __expf(tot - (pre + x0[i]));
        if (sg == 0) DEC[d] = __expf(tot);
    }
    { u32x4 w; w.x = pk2(kv[0], kv[1]); w.y = pk2(kv[2], kv[3]); w.z = pk2(kv[4], kv[5]); w.w = pk2(kv[6], kv[7]); *(LAS u32x4*)(XT + d * 72 + 8 * sg) = w; }
    stage_vT(P, I, YV, 72, tid);
    LDS_WAIT(); __syncthreads();
    f32x4 acc[4];
#pragma unroll
    for (int mt = 0; mt < 4; ++mt) acc[mt] = (f32x4){0.f, 0.f, 0.f, 0.f};
#pragma unroll
    for (int ks = 0; ks < 2; ++ks) { const bf16x8 b = ldfrag(YV, 72, 16 * sg, 32 * ks, lane);
#pragma unroll
        for (int mt = 0; mt < 4; ++mt) acc[mt] = __builtin_amdgcn_mfma_f32_16x16x32_bf16(ldfrag(XT, 72, 16 * mt, 32 * ks, lane), b, acc[mt], 0, 0, 0); }
    { const int e = 16 * sg + (lane & 15);
#pragma unroll
      for (int mt = 0; mt < 4; ++mt) { u32x2 o; o.x = pk2(acc[mt][0], acc[mt][1]); o.y = pk2(acc[mt][2], acc[mt][3]); *(u32x2*)(US + e * 64 + 16 * mt + 4 * (lane >> 4)) = o; } }
    if (I.br == 0 && sg < 4) {
        f32x4 an = (f32x4){0.f, 0.f, 0.f, 0.f};
#pragma unroll
        for (int ks = 0; ks < 2; ++ks) an = __builtin_amdgcn_mfma_f32_16x16x32_bf16(ldfrag(XT, 72, 16 * sg, 32 * ks, lane), ldfrag(YV, 72, 128, 32 * ks, lane), an, 0, 0, 0);
        if ((lane & 15) == 0) { const int d0 = 16 * sg + 4 * (lane >> 4); DEC[d0] = an[0]; DEC[d0 + 1] = an[1]; DEC[d0 + 2] = an[2]; DEC[d0 + 3] = an[3]; }
    }
    __syncthreads();
}

__device__ __forceinline__ void scan_s2(const Args& a, int l, int g) {
    const int T = g < 2 ? 4096 : 256, NC = T >> 6, nseq = g < 2 ? 2 : 32, nslot = nseq * 24 * 1024;
    bf16_t* USb = (bf16_t*)(a.ws + WS_BIG + BIG_US); float* DECb = (float*)(a.ws + WS_DEC); float* SCb = (float*)(a.ws + WS_SC);
    int tid_ = threadIdx.x; asm volatile("" : "+v"(tid_));
    for (int slot = blockIdx.x * 512 + tid_; slot < nslot; slot += gridDim.x * 512) {
        const int sub = slot & 1023, stream = slot >> 10, hdb = stream % 24, seq = stream / 24, br = hdb >> 3, dir = (hdb >> 2) & 1, head = hdb & 3;
        const int e = sub >> 3, d0 = (sub & 7) * 8;
        float S[8], nst[8], mst = 0.f;
#pragma unroll
        for (int i = 0; i < 8; ++i) { S[i] = 0.f; nst[i] = 0.f; }
        if (g < 2) { const int b = g * 2 + seq; const size_t sidx = (size_t)((b * 2 + l) * 2 + dir) * 4 + head;
            const float* sp = (br == 0 ? inp(a, I_SC) : (br == 1 ? inp(a, I_SG) : inp(a, I_SH))) + sidx * 8192;
#pragma unroll
            for (int i = 0; i < 8; ++i) S[i] = sp[(d0 + i) * 128 + e];
            if (br == 0) { mst = inp(a, I_SM)[sidx];
#pragma unroll
                for (int i = 0; i < 8; ++i) nst[i] = inp(a, I_SN)[sidx * 64 + d0 + i]; } }
        const bool nrow = (br == 0) && (e == 0);
        for (int c0 = 0; c0 < NC; c0 += 4) {
            u32x4 ub[4]; f32x4 q0[4], q1[4]; float m0[4], m1[4];
#pragma unroll
            for (int j = 0; j < 4; ++j) { const size_t it = (size_t)(seq * NC + c0 + j) * 24 + hdb;
                ub[j] = *(const u32x4*)(USb + it * 8192 + e * 64 + d0);
                if (br == 0) { m0[j] = SCb[it * 4]; m1[j] = SCb[it * 4 + 1]; }
                if (br != 0 || nrow) { q0[j] = *(const f32x4*)(DECb + it * 64 + d0); q1[j] = *(const f32x4*)(DECb + it * 64 + d0 + 4); } }
#pragma unroll
            for (int j = 0; j < 4; ++j) { const size_t it = (size_t)(seq * NC + c0 + j) * 24 + hdb;
                bf16_t* p = USb + it * 8192 + e * 64 + d0; float* dec = DECb + it * 64 + d0; float* sc = SCb + it * 4;
                const u32x4 u = ub[j];
                const float uu[8] = {bflo(u.x), bfhi(u.x), bflo(u.y), bfhi(u.y), bflo(u.z), bfhi(u.z), bflo(u.w), bfhi(u.w)};
                { u32x4 w; w.x = pk2(S[0], S[1]); w.y = pk2(S[2], S[3]); w.z = pk2(S[4], S[5]); w.w = pk2(S[6], S[7]); *(u32x4*)p = w; }
                if (br == 0) {
                    const float mlw = m0[j], bl = m1[j]; const float mn = fmaxf(bl + mst, mlw); const float fa = __expf(bl + mst - mn), fb = __expf(mlw - mn);
                    if (nrow) { const f32x4 n0 = q0[j], n1 = q1[j];
                        *(f32x4*)dec = (f32x4){nst[0], nst[1], nst[2], nst[3]}; *(f32x4*)(dec + 4) = (f32x4){nst[4], nst[5], nst[6], nst[7]};
                        const float nn[8] = {n0.x, n0.y, n0.z, n0.w, n1.x, n1.y, n1.z, n1.w};
#pragma unroll
                        for (int i = 0; i < 8; ++i) nst[i] = fa * nst[i] + fb * nn[i];
                        if (d0 == 0) sc[2] = mst; }
#pragma unroll
                    for (int i = 0; i < 8; ++i) S[i] = fa * S[i] + fb * uu[i];
                    mst = mn;
                } else {
                    const f32x4 a0 = q0[j], a1 = q1[j]; const float dd[8] = {a0.x, a0.y, a0.z, a0.w, a1.x, a1.y, a1.z, a1.w};
#pragma unroll
                    for (int i = 0; i < 8; ++i) S[i] = dd[i] * S[i] + uu[i];
                }
            }
        }
        if (g == 2) { const size_t sidx = (size_t)((seq * 2 + l) * 2 + dir) * 4 + head;
            float* op = a.out + (br == 0 ? OFF_C : (br == 1 ? OFF_G : OFF_H)) + sidx * 8192;
#pragma unroll
            for (int i = 0; i < 8; ++i) op[(d0 + i) * 128 + e] = S[i];
            if (nrow) {
#pragma unroll
                for (int i = 0; i < 8; ++i) a.out[OFF_N + sidx * 64 + d0 + i] = nst[i];
                if (d0 == 0) a.out[OFF_M + sidx] = mst; } }
    }
}

constexpr int S3_QO = 0, S3_KO = 23040, S3_G = 41472, S3_XA = 57856, S3_YV = 75264, S3_TOT = 114432, S3_VEC = 116480;
__device__ __forceinline__ void scan_s3(const Args& a, LAS unsigned char* lds, int l, int g, int it) {
    int tid_ = threadIdx.x; asm volatile("" : "+v"(tid_)); const int tid = tid_, d = tid & 63, lane = d, sg = __builtin_amdgcn_readfirstlane(tid >> 6);
    const ItemInfo I = item_info(g, it);
    const bf16_t* P = (const bf16_t*)(a.ws + WS_BIG);
    const bf16_t* US = (const bf16_t*)(a.ws + WS_BIG + BIG_US) + (size_t)it * 8192;
    const float* DEC = (const float*)(a.ws + WS_DEC) + (size_t)it * 64; const float* SC = (const float*)(a.ws + WS_SC) + (size_t)it * 4;
    bf16_t* Od = I.dir == 0 ? (bf16_t*)(a.ws + WS_A) + (size_t)g * GROWS * 1536 : (bf16_t*)(a.ws + WS_BIG + BIG_OB);
    LAS bf16_t* QO = (LAS bf16_t*)(lds + S3_QO); LAS bf16_t* KO = (LAS bf16_t*)(lds + S3_KO); LAS float* G = (LAS float*)(lds + S3_G);
    LAS bf16_t* XA = (LAS bf16_t*)(lds + S3_XA); LAS bf16_t* YV = (LAS bf16_t*)(lds + S3_YV); LAS float* TOT = (LAS float*)(lds + S3_TOT);
    LAS float* Bv = (LAS float*)(lds + S3_VEC); LAS float* LIv = Bv + 64; LAS float* MT = Bv + 128; LAS float* EI = Bv + 192;
    float qv[8], kv[8], x0[8], x1[8];
    stage_vT(P, I, YV, 136, tid);
    { const int e = tid >> 2, part = tid & 3; const u32x4 s0 = *(const u32x4*)(US + e * 64 + 16 * part), s1 = *(const u32x4*)(US + e * 64 + 16 * part + 8);
      *(LAS u32x4*)(YV + e * 136 + 64 + 16 * part) = s0; *(LAS u32x4*)(YV + e * 136 + 64 + 16 * part + 8) = s1; }
    const int bi = sg >> 1;
    f32x4 acc[4];
#pragma unroll
    for (int nt = 0; nt < 4; ++nt) acc[nt] = (f32x4){0.f, 0.f, 0.f, 0.f};
    if (I.br != 0) {
        load_gated<true>(a, P, I, l, d, sg, qv, kv, x0);
        float run = 0.f;
#pragma unroll
        for (int i = 0; i < 8; ++i) { run += x0[i]; x0[i] = run; }
        TOT[sg * 64 + d] = run; LDS_WAIT(); __syncthreads();
        float pre = 0.f;
#pragma unroll
        for (int w = 0; w < 8; ++w) { const float t = TOT[w * 64 + d]; if (w < sg) pre += t; }
#pragma unroll
        for (int i = 0; i < 8; ++i) { x0[i] += pre; const int s = 8 * sg + i; G[s * 64 + d] = x0[i]; XA[s * 136 + 64 + d] = (bf16_t)f2bf(qv[i] * __expf(x0[i])); }
        LDS_WAIT(); __syncthreads();
        const float gs = bi ? G[(16 * bi - 1) * 64 + d] : 0.f, geo = G[(16 * bi + 15) * 64 + d];
        float gej[3];
#pragma unroll
        for (int j = 0; j < 3; ++j) gej[j] = G[(16 * j + 15) * 64 + d];
#pragma unroll
        for (int i = 0; i < 8; ++i) { const int tt = 8 * (sg & 1) + i;
            QO[(6 + bi) * 1152 + tt * 72 + d] = (bf16_t)f2bf(qv[i] * __expf(x0[i] - gs));
            KO[(4 + bi) * 1152 + tt * 72 + d] = (bf16_t)f2bf(kv[i] * __expf(fminf(gs - x0[i], 80.f)));
            KO[bi * 1152 + tt * 72 + d] = (bf16_t)f2bf(kv[i] * __expf(geo - x0[i]));
#pragma unroll
            for (int j = 0; j < 3; ++j) if (j < bi) QO[(bi * (bi - 1) / 2 + j) * 1152 + tt * 72 + d] = (bf16_t)f2bf(qv[i] * __expf(fminf(x0[i] - gej[j], 0.f))); }
        LDS_WAIT(); __syncthreads();
#pragma unroll
        for (int jj = 0; jj < 2; ++jj) { const int j = 2 * (sg & 1) + jj; f32x4 t = (f32x4){0.f, 0.f, 0.f, 0.f};
            if (j <= bi) { const int qt = (j == bi) ? 6 + bi : bi * (bi - 1) / 2 + j, kt = (j == bi) ? 4 + bi : j;
#pragma unroll
                for (int ks = 0; ks < 2; ++ks) t = __builtin_amdgcn_mfma_f32_16x16x32_bf16(ldfrag(QO + qt * 1152, 72, 0, 32 * ks, lane), ldfrag(KO + kt * 1152, 72, 0, 32 * ks, lane), t, 0, 0, 0); }
#pragma unroll
            for (int r = 0; r < 4; ++r) { const int tl = 4 * (lane >> 4) + r, sl = lane & 15; float v = t[r]; if (j == bi && sl > tl) v = 0.f;
                XA[(16 * bi + tl) * 136 + 16 * j + sl] = (bf16_t)f2bf(v); } }
        LDS_WAIT(); __syncthreads();
    } else {
        load_mlstm<true>(a, P, I, l, d, sg, qv, kv, x0, x1);
        float run = 0.f;
#pragma unroll
        for (int i = 0; i < 8; ++i) { run += x0[i]; x0[i] = run; }
        TOT[sg * 64 + d] = run;
        for (int idx = tid; idx < 16 * 128; idx += 512) { const int r = idx >> 7, k = idx & 127; YV[(128 + r) * 136 + k] = (bf16_t)(r == 0 ? (k < 64 ? 0x3F80u : f2bf(DEC[k - 64])) : 0u); }
        LDS_WAIT(); __syncthreads();
        float pre = 0.f;
#pragma unroll
        for (int w = 0; w < 8; ++w) { const float t = TOT[w * 64 + d]; if (w < sg) pre += t; }
#pragma unroll
        for (int i = 0; i < 8; ++i) { x0[i] += pre; const int s = 8 * sg + i; if (d == 0) { Bv[s] = x0[i]; LIv[s] = x1[i]; }
            QO[s * 72 + d] = (bf16_t)f2bf(qv[i]); KO[s * 72 + d] = (bf16_t)f2bf(kv[i]); }
        LDS_WAIT(); __syncthreads();
        if (tid < 64) { float rn = -3.0e38f; for (int s = 0; s <= tid; ++s) rn = fmaxf(rn, LIv[s] - Bv[s]);
            const float bt = Bv[tid], inter = bt + SC[2], mt = fmaxf(inter, bt + rn); MT[tid] = mt; EI[tid] = __expf(inter - mt); }
        f32x4 t2[2];
#pragma unroll
        for (int jj = 0; jj < 2; ++jj) { const int j = 2 * (sg & 1) + jj; t2[jj] = (f32x4){0.f, 0.f, 0.f, 0.f};
            if (j <= bi) {
#pragma unroll
                for (int ks = 0; ks < 2; ++ks) t2[jj] = __builtin_amdgcn_mfma_f32_16x16x32_bf16(ldfrag(QO, 72, 16 * bi, 32 * ks, lane), ldfrag(KO, 72, 16 * j, 32 * ks, lane), t2[jj], 0, 0, 0); } }
        LDS_WAIT(); __syncthreads();
#pragma unroll
        for (int jj = 0; jj < 2; ++jj) { const int j = 2 * (sg & 1) + jj;
#pragma unroll
            for (int r = 0; r < 4; ++r) { const int t = 16 * bi + 4 * (lane >> 4) + r, s = 16 * j + (lane & 15); float v = 0.f;
                if (s <= t) v = t2[jj][r] * __expf(Bv[t] - Bv[s] + LIv[s] - MT[t]);
                XA[t * 136 + s] = (bf16_t)f2bf(v); } }
#pragma unroll
        for (int i = 0; i < 8; ++i) { const int s = 8 * sg + i; XA[s * 136 + 64 + d] = (bf16_t)f2bf(qv[i] * EI[s]); }
        LDS_WAIT(); __syncthreads();
    }
    f32x4 accd[4];
#pragma unroll
    for (int nt = 0; nt < 4; ++nt) accd[nt] = (f32x4){0.f, 0.f, 0.f, 0.f};
#pragma unroll
    for (int ks = 0; ks < 4; ++ks) { const bf16x8 av = ldfrag(YV, 136, 16 * sg, 32 * ks, lane);
        bf16x8 ad = av; if (I.br == 0) ad = ldfrag(YV, 136, 128, 32 * ks, lane);
#pragma unroll
        for (int nt = 0; nt < 4; ++nt) { const bf16x8 bx = ldfrag(XA, 136, 16 * nt, 32 * ks, lane);
            acc[nt] = __builtin_amdgcn_mfma_f32_16x16x32_bf16(av, bx, acc[nt], 0, 0, 0);
            if (I.br == 0) accd[nt] = __builtin_amdgcn_mfma_f32_16x16x32_bf16(ad, bx, accd[nt], 0, 0, 0); } }
    const int ecol = I.br * 512 + I.head * 128 + 16 * sg + 4 * (lane >> 4);
#pragma unroll
    for (int nt = 0; nt < 4; ++nt) { const int t = 16 * nt + (lane & 15); f32x4 o = acc[nt];
        if (I.br == 0) { const float den = __shfl(accd[nt][0], lane & 15); const float dn = fmaxf(fabsf(den), __expf(-MT[t])); o = o * (1.0f / dn); }
        u32x2 w; w.x = pk2(o[0], o[1]); w.y = pk2(o[2], o[3]);
        *(u32x2*)(Od + (size_t)item_row(I, t) * 1536 + ecol) = w; }
    __syncthreads();
}

__device__ __forceinline__ void headnorm_row(const Args& a, int l, int g, int lr, int lane) {
    const bf16_t* P = (const bf16_t*)(a.ws + WS_BIG) + (size_t)lr * PN;
    bf16_t* of = (bf16_t*)(a.ws + WS_A) + ((size_t)g * GROWS + lr) * 1536; const bf16_t* ob = (const bf16_t*)(a.ws + WS_BIG + BIG_OB) + (size_t)lr * 1536;
#pragma unroll
    for (int br = 0; br < 3; ++br) { const int c = br * 512 + 8 * lane;
        const u32x4 f = *(const u32x4*)(of + c), b = *(const u32x4*)(ob + c);
        float o[8] = {bflo(f.x) + bflo(b.x), bfhi(f.x) + bfhi(b.x), bflo(f.y) + bflo(b.y), bfhi(f.y) + bfhi(b.y), bflo(f.z) + bflo(b.z), bfhi(f.z) + bfhi(b.z), bflo(f.w) + bflo(b.w), bfhi(f.w) + bfhi(b.w)};
        float ss = 0.f;
#pragma unroll
        for (int i = 0; i < 8; ++i) ss += o[i] * o[i];
        ss += __shfl_xor(ss, 1); ss += __shfl_xor(ss, 2); ss += __shfl_xor(ss, 4); ss += __shfl_xor(ss, 8);
        const float rr = rsqrtf(ss * (1.0f / 128.0f) + EPSN);
        const u32x4 gt = *(const u32x4*)(P + (br == 0 ? C_MO : (br == 1 ? C_GR : C_HG)) + 8 * lane);
        const float gv[8] = {bflo(gt.x), bfhi(gt.x), bflo(gt.y), bfhi(gt.y), bflo(gt.z), bfhi(gt.z), bflo(gt.w), bfhi(gt.w)};
        const float* hn = inp(a, I_HN) + (size_t)(l * 3 + br) * 512 + 8 * lane;
        const f32x4 h0 = *(const f32x4*)hn, h1 = *(const f32x4*)(hn + 4); const float hw[8] = {h0.x, h0.y, h0.z, h0.w, h1.x, h1.y, h1.z, h1.w};
        float y[8];
#pragma unroll
        for (int i = 0; i < 8; ++i) { const float gg = br == 0 ? sigmoidf_(gv[i]) : siluf_(gv[i]); y[i] = gg * (o[i] * rr) * hw[i]; }
        u32x4 w; w.x = pk2(y[0], y[1]); w.y = pk2(y[2], y[3]); w.z = pk2(y[4], y[5]); w.w = pk2(y[6], y[7]); *(u32x4*)(of + c) = w; }
}

#ifndef REP_S1
#define REP_S1 1
#endif
#ifndef REP_S3
#define REP_S3 1
#endif
#ifndef REP_G
#define REP_G 1
#endif
template <int M_, int N_, int K_, int LDA_, int LDB_, int ADIV, int AMUL, class Epi>
__device__ __forceinline__ void run_gemm(LAS unsigned char* lds, const bf16_t* A, const bf16_t* Bt, const Epi& E) {
    typedef pg8::GemmT<M_, N_, K_, LDA_, LDB_> GT; GT g{A, Bt}; pg8::StaticOrderT<M_, N_, ADIV, AMUL> S; S.init((int)gridDim.x, (int)blockIdx.x);
    pg8::gemm_phase<GT, Epi, pg8::StaticOrderT<M_, N_, ADIV, AMUL>, true, true>((PG8_LAS unsigned char*)lds, g, S, E);
}

__global__ void __launch_bounds__(512, 2) mk_fwd(Args a) {
    extern __shared__ __attribute__((aligned(16))) unsigned char lds_raw[];
    LAS unsigned char* lds = (LAS unsigned char*)lds_raw;
    cg::grid_group grid = cg::this_grid();
    for (int u = threadIdx.x; u < (LDS_BYTES - 131072) / 4; u += 512) ((LAS unsigned*)(lds + 131072))[u] = 0u;
    __syncthreads();
    (void)xcd_barrier_post((unsigned*)a.ws, (volatile LAS unsigned*)(lds + 131072 + 352));
    const int tid = threadIdx.x, lane = tid & 63, wave = __builtin_amdgcn_readfirstlane(tid >> 6);
    const int G = gridDim.x, gw = blockIdx.x * 8 + wave, NGW = G * 8;
    unsigned char* ws = a.ws;
    float* mod = (float*)(ws + WS_MOD);

#ifndef SKIP_PRO
    convert_weights(a, lds, 0, gw, NGW, lane, wave);
    ada_partial(a, gw, NGW, lane);
    { float* pos = (float*)(ws + WS_POS);
      for (int i = blockIdx.x * 512 + tid; i < 64 * 512; i += G * 512) { const int v = i >> 9, j = i & 511, fi = j & 255;
          const float fr = expf((-9.210340371976184f * (float)fi) / 256.0f); const float ang = (float)v * fr; pos[i] = j < 256 ? sinf(ang) : cosf(ang); } }
    grid.sync();
    { const float* modp = (const float*)(ws + WS_MODP);
      for (int i = blockIdx.x * 512 + tid; i < 2 * 5 * 9216; i += G * 512) { const int col = i % 9216, l = i / (5 * 9216); float s = inp(a, I_BADA)[l * 9216 + col];
#pragma unroll
          for (int ks = 0; ks < 8; ++ks) s += modp[(size_t)ks * (2 * 5 * 9216) + i]; mod[i] = s; } }
    xcd_barrier_ni((unsigned*)a.ws, 131072 + 352);
    { RowOp op{}; op.src_input = 1; op.has_y = 0; op.has_xn = 1; op.npre = inp(a, I_NPRE); op.md_base = mod; op.si = 0; op.add_pos = 0;
      rowwise_all(a, op, gw, NGW, lane); }
    xcd_barrier_ni((unsigned*)a.ws, 131072 + 352);
#endif

    for (int l = 0; l < 2; ++l) {
        for (int st = 0; st < 25; ++st) {
            int tid = threadIdx.x; asm volatile("" : "+v"(tid));
            const int lane = tid & 63, wave = __builtin_amdgcn_readfirstlane(tid >> 6), gw = blockIdx.x * 8 + wave;
            unsigned char* ws = a.ws; asm volatile("" : "+s"(ws));
            float* mod = (float*)(ws + WS_MOD); const float* modl = mod + (size_t)l * 5 * 9216;
            bf16_t* XN = (bf16_t*)(ws + WS_XN); bf16_t* BIG = (bf16_t*)(ws + WS_BIG); float* Y = (float*)(ws + WS_A); bf16_t* YS = (bf16_t*)(ws + WS_A);
            unsigned char* wb = ws + WS_W; const int G = gridDim.x, NGW = G * 8;
            const int kind = (st == 0 || st == 22) ? 0 : (st == 1 || st == 20 || st == 23) ? 1 : (st == 2 || st == 21 || st == 24) ? 2 : (st == 18) ? 3 : (st == 19) ? 4 : 5 + ((st - 3) % 5);
            const int g = (st >= 3 && st < 18) ? (st - 3) / 5 : 0;
            switch (kind) {
            case 0: {
#ifndef SKIP_G0
                const int f = st == 0 ? 0 : 1; EpiSwiGLU E{BIG, DFF};
                for (int rep = 0; rep < REP_G; ++rep) run_gemm<MTOT, NFF2, D, D, D, 0, 0>(lds, XN, (const bf16_t*)(wb + W_FFIN) + (size_t)f * NFF2 * D, E);
#endif
                break; }
            case 1: {
#ifndef SKIP_G1
                EpiBf16 E{(bf16_t*)Y, D};
                for (int rep = 0; rep < REP_G; ++rep)
                if (st == 20) run_gemm<MTOT, D, 3072, 3072, 3072, 0, 0>(lds, BIG, (const bf16_t*)(wb + W_O3), E);
                else run_gemm<MTOT, D, DFF, DFF, DFF, 0, 0>(lds, BIG, (const bf16_t*)(wb + W_FFOUT) + (size_t)(st == 1 ? 0 : 1) * D * DFF, E);
#endif
                break; }
            case 2: {
#ifndef SKIP_ROW
                RowOp op{}; op.has_y = 1; op.mdg_base = modl + (st == 2 ? 2 : st == 21 ? 5 : 8) * D; op.coef = st == 21 ? 1.0f : 0.5f;
                op.npost = inp(a, I_NPOST) + (size_t)(l * 3 + (st == 2 ? 0 : st == 21 ? 1 : 2)) * D; op.src_input = (l == 0 && st == 2) ? 1 : 0;
                if (st == 2) { op.has_xn = 1; op.npre = inp(a, I_NPRE) + (size_t)(l * 3 + 1) * D; op.md_base = modl; op.si = 3; op.add_pos = 1; }
                else if (st == 21) { op.has_xn = 1; op.npre = inp(a, I_NPRE) + (size_t)(l * 3 + 2) * D; op.md_base = modl; op.si = 6; op.add_pos = 0; }
                else { op.has_xn = (l == 0) ? 1 : 0; op.npre = inp(a, I_NPRE) + (size_t)3 * D; op.md_base = mod + (size_t)5 * 9216; op.si = 0; op.add_pos = 0; }
                rowwise_all(a, op, gw, NGW, lane);
                if (st == 24 && l == 0) { __syncthreads(); convert_weights(a, lds, 1, gw, NGW, lane, wave); }
#endif
                break; }
            case 3: {
#ifndef SKIP_G3
                EpiBf16 E{BIG, 3072};
                for (int rep = 0; rep < REP_G; ++rep) run_gemm<MTOT, 3072, 512, 1536, 512, 4, 512>(lds, YS, (const bf16_t*)(wb + W_B), E);
#endif
                break; }
            case 4: {
#ifndef SKIP_G4
                EpiGateMul E{BIG, 3072};
                run_gemm<MTOT, MGN, D, D, D, 0, 0>(lds, XN, (const bf16_t*)(wb + W_MG), E);
#endif
                break; }
            case 5: {
#ifndef SKIP_G3
                EpiBf16 E{BIG, PN};
                for (int rep = 0; rep < REP_G; ++rep) run_gemm<GROWS, PN, D, D, D, 0, 0>(lds, XN + (size_t)g * GROWS * D, (const bf16_t*)(wb + W_P), E);
#endif
                break; }
            case 6: {
#ifndef SKIP_S1
                for (int rep = 0; rep < REP_S1; ++rep) for (int it = blockIdx.x; it < 3072; it += G) scan_s1(a, lds, l, g, it);
#endif
                break; }
            case 7: {
#ifndef SKIP_S2
                scan_s2(a, l, g);
#endif
                break; }
            case 8: {
#ifndef SKIP_S3
                for (int rep = 0; rep < REP_S3; ++rep) for (int it = blockIdx.x; it < 3072; it += G) scan_s3(a, lds, l, g, it);
#endif
                break; }
            default: {
#ifndef SKIP_HN
                for (int lr = gw; lr < GROWS; lr += NGW) headnorm_row(a, l, g, lr, lane);
#endif
                break; }
            }
            xcd_barrier_ni((unsigned*)a.ws, 131072 + 352);
#ifdef EXTRA_SYNC
            xcd_barrier_ni((unsigned*)a.ws, 131072 + 352);
#endif
        }
    }
}

extern "C" void kernel_launch(void* const* d_in, const int* in_sizes, int n_in, void* d_out, int out_size, void* d_ws, size_t ws_size, hipStream_t stream) {
    static int grid = 0;
    if (grid == 0) {
        if (n_in != 23 || ws_size < WS_END) { fprintf(stderr, "kernel_launch: unexpected n_in %d / ws_size %zu (need %zu)\n", n_in, ws_size, (size_t)WS_END); grid = -1; return; }
        int dev = 0, cus = 0, per_cu = 0;
        hipGetDevice(&dev); hipDeviceGetAttribute(&cus, hipDeviceAttributeMultiprocessorCount, dev);
        hipFuncSetAttribute((const void*)mk_fwd, hipFuncAttributeMaxDynamicSharedMemorySize, LDS_BYTES);
        hipOccupancyMaxActiveBlocksPerMultiprocessor(&per_cu, (const void*)mk_fwd, 512, LDS_BYTES);
        (void)hipGetLastError();
        if (per_cu < 1) per_cu = 1;
        grid = cus;
    }
    if (grid < 0) return;
    if (hipMemsetAsync(d_ws, 0, 16384, stream) != hipSuccess) { fprintf(stderr, "memset failed\n"); return; }
    Args a{};
    for (int i = 0; i < 23; ++i) a.in[i] = (const float*)d_in[i];
    a.out = (float*)d_out; a.ws = (unsigned char*)d_ws;
    void* args[] = {&a};
    hipError_t e = hipLaunchCooperativeKernel((const void*)mk_fwd, dim3(grid), dim3(512), args, LDS_BYTES, stream);
    if (e != hipSuccess) fprintf(stderr, "cooperative launch failed: %s (grid %d)\n", hipGetErrorString(e), grid);
}
```

```cpp
#include <hip/hip_runtime.h>
#include <hip/hip_cooperative_groups.h>
#include <cstdio>
#include <cstdint>
namespace cg = cooperative_groups;

namespace pg8 {
#define PG8_LAS __attribute__((address_space(3)))
typedef unsigned short bf16_t;
typedef short bf16x8 __attribute__((ext_vector_type(8)));
typedef float f32x4 __attribute__((ext_vector_type(4)));
typedef unsigned u32x4 __attribute__((ext_vector_type(4)));
typedef unsigned u32x2 __attribute__((ext_vector_type(2)));
constexpr int BM = 256, BK = 64, HALF = 128, HTB = HALF * BK * 2, STAGE_BYTES = 8 * HTB, NXCD = 8, WGM = 8;

__host__ __device__ __forceinline__ int lds_byte(int r, int c) { const int st = (r >> 4) * 2 + (c >> 5), rr = r & 15, cc = c & 31, ob = rr * 64 + cc * 2; return st * 1024 + (ob ^ (((ob >> 9) & 1) << 5)); }
__host__ __device__ __forceinline__ void stage_rc(int b, int& R, int& C) { const int st = b / 1024, sb = b % 1024, swz = sb ^ (((sb >> 9) & 1) << 5); R = (st >> 1) * 16 + swz / 64; C = (st & 1) * 32 + (swz % 64) / 2; }
__host__ __device__ __forceinline__ int perm32(int rho) { const int n = rho >> 4, i = rho & 15; return 8 * (i >> 2) + 4 * n + (i & 3); }

struct Unit { int pm, pn; };
template <int M_, int N_, int K_, int LDA_, int LDB_> struct GemmT { const bf16_t* A; const bf16_t* Bt; static constexpr int M = M_, N = N_, K = K_, lda = LDA_, ldb = LDB_; };

template <int M_, int N_, int ADIV, int AMUL, int KS = 1> struct StaticOrderT {
    static constexpr int nM = M_ / BM, nN = N_ / BM, nwg = nM * nN;
    int G, c;
    __device__ void init(int G_, int c_) { G = G_; c = c_; }
    __device__ __forceinline__ bool next(int i, Unit& u) const {
        const int L = i * G + c; if (L >= nwg) return false;
        int wgid = L; { constexpr int q = nwg / NXCD, r = nwg % NXCD; const int xcd = wgid % NXCD, off = wgid / NXCD; wgid = (xcd < r ? xcd * (q + 1) : r * (q + 1) + (xcd - r) * q) + off; }
        constexpr int nig = WGM * nN; const int gid = wgid / nig, fm = gid * WGM, gsz = (nM - fm) < WGM ? (nM - fm) : WGM;
        u.pm = fm + ((wgid % nig) % gsz); u.pn = (wgid % nig) / gsz; return true;
    }
    __device__ __forceinline__ int a_off(const Unit& u) const { return ADIV > 0 ? (u.pn / (ADIV > 0 ? ADIV : 1)) * AMUL : 0; }
    __device__ __forceinline__ int b_tile(const Unit& u) const { return KS > 1 ? u.pn % (nN / KS) : u.pn; }
    __device__ __forceinline__ int b_koff(const Unit& u) const { return KS > 1 ? (u.pn / (nN / KS)) * AMUL : 0; }
    __device__ __forceinline__ void a_ready(const Unit&) const {}
    __device__ __forceinline__ void done(const Unit&) const {}
};

template <class GT, class Epi, class Sched, bool ALIGN_EPI = false, bool SP2 = false>
__device__ __forceinline__ void gemm_phase(PG8_LAS unsigned char* lds, const GT g, const Sched& S, const Epi& E) {
    int tid_ = threadIdx.x; asm volatile("" : "+v"(tid_));
    const int tid = tid_, wid = __builtin_amdgcn_readfirstlane(tid >> 6), lane = tid & 63, wr = wid >> 2, wc = wid & 3, fr = lane & 15, fq = lane >> 4;
    constexpr int K = GT::K, nt = K / BK;
    unsigned voffA[2], voffB[2];
#pragma unroll
    for (int i = 0; i < 2; ++i) { int R, C; stage_rc(tid * 16 + i * 8192, R, C); const int Rb = Epi::PERM ? ((R & ~31) + perm32(R & 31)) : R;
        voffA[i] = (unsigned)(R * GT::lda + C) * 2u; voffB[i] = (unsigned)(Rb * GT::ldb + C) * 2u; }
    constexpr size_t kstep = (size_t)(BK * 2);
    constexpr size_t hstepA = (size_t)HALF * GT::lda * 2, hstepB = (size_t)HALF * GT::ldb * 2;
    constexpr size_t tstepA = 2 * hstepA, tstepB = 2 * hstepB;
    const unsigned ldsw = (unsigned)wid * 1024u;
    const int aoff = lds_byte(wr * 64 + fr, fq * 8), boff = lds_byte(wc * 32 + fr, fq * 8);
#define PG8_SA(b, h) (((b) * 2 + (h)) * HTB)
#define PG8_SB(b, h) ((4 + (b) * 2 + (h)) * HTB)
#define PG8_STAGE(bufoff, gbase, voff) do { _Pragma("unroll") for (int _i = 0; _i < 2; ++_i) \
        __builtin_amdgcn_global_load_lds((const unsigned*)((const char*)(gbase) + (voff)[_i]), (PG8_LAS unsigned*)(lds + (bufoff) + ldsw + _i * 8192), 16, 0, 0); } while (0)
#define PG8_LDA(dst, b, h) do { _Pragma("unroll") for (int m = 0; m < 4; ++m) _Pragma("unroll") for (int k = 0; k < 2; ++k) dst[m][k] = *(const PG8_LAS bf16x8*)(lds + PG8_SA(b, h) + aoff + m * 2048 + k * 1024); } while (0)
#define PG8_LDB(dst, b, h) do { _Pragma("unroll") for (int n = 0; n < 2; ++n) _Pragma("unroll") for (int k = 0; k < 2; ++k) dst[n][k] = *(const PG8_LAS bf16x8*)(lds + PG8_SB(b, h) + boff + n * 2048 + k * 1024); } while (0)
#define PG8_MMA(ai, bj, At, Bt) do { __builtin_amdgcn_s_setprio(1); _Pragma("unroll") for (int m = 0; m < 4; ++m) _Pragma("unroll") for (int n = 0; n < 2; ++n) _Pragma("unroll") for (int k = 0; k < 2; ++k) \
        acc[ai][bj][m][n] = __builtin_amdgcn_mfma_f32_16x16x32_bf16(Bt[n][k], At[m][k], acc[ai][bj][m][n], 0, 0, 0); __builtin_amdgcn_s_setprio(0); } while (0)
#define PG8_WAIT_V(n) asm volatile("s_waitcnt vmcnt(" #n ")" ::: "memory")
#define PG8_WAIT_L(n) asm volatile("s_waitcnt lgkmcnt(" #n ")" ::: "memory")
#define PG8_BAR __builtin_amdgcn_s_barrier()
#define PG8_SCHED __builtin_amdgcn_sched_barrier(0)
    Unit cur, nxt; int ui = 0;
    if (!S.next(0, cur)) return;
    f32x4 acc[2][2][4][2];
#pragma unroll
    for (int a = 0; a < 2; ++a)
#pragma unroll
        for (int b = 0; b < 2; ++b)
#pragma unroll
            for (int m = 0; m < 4; ++m)
#pragma unroll
                for (int n = 0; n < 2; ++n) acc[a][b][m][n] = (f32x4){0.f, 0.f, 0.f, 0.f};
    bf16x8 At[4][2], B0[2][2], B1[2][2];
    const char* cA = (const char*)g.A + (size_t)cur.pm * tstepA + (size_t)S.a_off(cur) * 2; const char* cB = (const char*)g.Bt + (size_t)S.b_tile(cur) * tstepB + (size_t)S.b_koff(cur) * 2;
    S.a_ready(cur);
    if constexpr (SP2) {
        PG8_STAGE(PG8_SB(0, 0), cB, voffB); PG8_STAGE(PG8_SB(0, 1), cB + hstepB, voffB); PG8_STAGE(PG8_SA(0, 0), cA, voffA); PG8_STAGE(PG8_SA(0, 1), cA + hstepA, voffA);
        if (wr == 1) PG8_BAR;
        PG8_WAIT_V(2); PG8_BAR;
        PG8_STAGE(PG8_SB(1, 0), cB + kstep, voffB); PG8_STAGE(PG8_SA(1, 0), cA + kstep, voffA); PG8_STAGE(PG8_SB(1, 1), cB + hstepB + kstep, voffB);
        PG8_WAIT_V(6); PG8_BAR;
    } else {
        PG8_STAGE(PG8_SB(0, 0), cB, voffB); PG8_STAGE(PG8_SA(0, 0), cA, voffA); PG8_STAGE(PG8_SB(0, 1), cB + hstepB, voffB); PG8_STAGE(PG8_SA(0, 1), cA + hstepA, voffA);
        if (wr == 1) PG8_BAR;
        PG8_WAIT_V(4); PG8_BAR;
        PG8_STAGE(PG8_SB(1, 0), cB + kstep, voffB); PG8_STAGE(PG8_SA(1, 0), cA + kstep, voffA); PG8_STAGE(PG8_SB(1, 1), cB + hstepB + kstep, voffB);
        PG8_WAIT_V(6); PG8_BAR;
    }
    for (;;) {
        const bool has_next = S.next(ui + 1, nxt);
        const char* nA = has_next ? (const char*)g.A + (size_t)nxt.pm * tstepA + (size_t)S.a_off(nxt) * 2 : cA; const char* nB = has_next ? (const char*)g.Bt + (size_t)S.b_tile(nxt) * tstepB + (size_t)S.b_koff(nxt) * 2 : cB;
        for (int t = 0; t < nt; t += 2) {
            const bool last = (t == nt - 2);
            const char* a1 = cA + (size_t)(t + 1) * kstep;
            const char* a2 = last ? nA : cA + (size_t)(t + 2) * kstep; const char* b2 = last ? nB : cB + (size_t)(t + 2) * kstep;
            const char* a3 = a2 + kstep; const char* b3 = b2 + kstep;
            if (last && has_next) S.a_ready(nxt);
            if constexpr (SP2) {
            PG8_LDB(B0, 0, 0); PG8_LDB(B1, 0, 1); PG8_SCHED; PG8_LDA(At, 0, 0); PG8_STAGE(PG8_SA(1, 1), a1 + hstepA, voffA);
            PG8_WAIT_V(8); PG8_WAIT_L(0); PG8_BAR; PG8_MMA(0, 0, At, B0); PG8_MMA(0, 1, At, B1); PG8_BAR; PG8_SCHED;
            PG8_LDA(At, 0, 1); PG8_STAGE(PG8_SB(0, 0), b2, voffB); PG8_STAGE(PG8_SB(0, 1), b2 + hstepB, voffB); PG8_STAGE(PG8_SA(0, 0), a2, voffA);
            PG8_WAIT_V(8); PG8_WAIT_L(0); PG8_BAR; PG8_MMA(1, 0, At, B0); PG8_MMA(1, 1, At, B1); PG8_BAR; PG8_SCHED;
            PG8_LDB(B0, 1, 0); PG8_LDB(B1, 1, 1); PG8_SCHED; PG8_LDA(At, 1, 0); PG8_STAGE(PG8_SA(0, 1), a2 + hstepA, voffA);
            PG8_WAIT_V(8); PG8_WAIT_L(0); PG8_BAR; PG8_MMA(0, 0, At, B0); PG8_MMA(0, 1, At, B1); PG8_BAR; PG8_SCHED;
            PG8_LDA(At, 1, 1); PG8_STAGE(PG8_SB(1, 0), b3, voffB); PG8_STAGE(PG8_SB(1, 1), b3 + hstepB, voffB); PG8_STAGE(PG8_SA(1, 0), a3, voffA);
            PG8_WAIT_V(8); PG8_WAIT_L(0); PG8_BAR; PG8_MMA(1, 0, At, B0); PG8_MMA(1, 1, At, B1); PG8_BAR; PG8_SCHED;
            } else {
            PG8_LDB(B0, 0, 0); PG8_SCHED; PG8_LDA(At, 0, 0); PG8_STAGE(PG8_SA(1, 1), a1 + hstepA, voffA);
            PG8_WAIT_L(8); PG8_BAR; PG8_WAIT_L(0); PG8_MMA(0, 0, At, B0); PG8_BAR; PG8_SCHED;
            PG8_LDB(B1, 0, 1); PG8_STAGE(PG8_SB(0, 0), b2, voffB);
            PG8_BAR; PG8_WAIT_L(0); PG8_MMA(0, 1, At, B1); PG8_BAR;
            PG8_LDA(At, 0, 1); PG8_STAGE(PG8_SA(0, 0), a2, voffA);
            PG8_BAR; PG8_WAIT_L(0); PG8_MMA(1, 0, At, B0); PG8_BAR; PG8_SCHED;
            PG8_STAGE(PG8_SB(0, 1), b2 + hstepB, voffB);
            PG8_WAIT_V(6); PG8_BAR; PG8_MMA(1, 1, At, B1); PG8_BAR;
            PG8_LDB(B0, 1, 0); PG8_SCHED; PG8_LDA(At, 1, 0); PG8_STAGE(PG8_SA(0, 1), a2 + hstepA, voffA);
            PG8_WAIT_L(8); PG8_BAR; PG8_WAIT_L(0); PG8_MMA(0, 0, At, B0); PG8_BAR; PG8_SCHED;
            PG8_LDB(B1, 1, 1); PG8_STAGE(PG8_SB(1, 0), b3, voffB);
            PG8_BAR; PG8_WAIT_L(0); PG8_MMA(0, 1, At, B1); PG8_BAR;
            PG8_LDA(At, 1, 1); PG8_STAGE(PG8_SA(1, 0), a3, voffA);
            PG8_BAR; PG8_WAIT_L(0); PG8_MMA(1, 0, At, B0); PG8_BAR; PG8_SCHED;
            PG8_STAGE(PG8_SB(1, 1), b3 + hstepB, voffB);
            PG8_WAIT_V(6); PG8_BAR; PG8_MMA(1, 1, At, B1); PG8_BAR;
            }
        }
        if constexpr (ALIGN_EPI) { if (wr == 0) PG8_BAR; }
        if constexpr (!Epi::AFTER_DRAIN) { E(acc, cur, wr, wc, fr, fq); S.done(cur); }
        if (!has_next) break;
#pragma unroll
        for (int a = 0; a < 2; ++a)
#pragma unroll
            for (int b = 0; b < 2; ++b)
#pragma unroll
                for (int m = 0; m < 4; ++m)
#pragma unroll
                    for (int n = 0; n < 2; ++n) acc[a][b][m][n] = (f32x4){0.f, 0.f, 0.f, 0.f};
        cur = nxt; cA = nA; cB = nB; ++ui;
        if constexpr (ALIGN_EPI) { if (wr == 1) PG8_BAR; }
    }
    PG8_WAIT_V(0);
    if constexpr (!ALIGN_EPI) { if (wr == 0) PG8_BAR; }
    PG8_BAR;
    if constexpr (Epi::AFTER_DRAIN) { E.fused(acc, cur, wr, wc, fr, fq, lds, wid, lane); S.done(cur); }
#undef PG8_SA
#undef PG8_SB
#undef PG8_STAGE
#undef PG8_LDA
#undef PG8_LDB
#undef PG8_MMA
#undef PG8_WAIT_V
#undef PG8_WAIT_L
#undef PG8_BAR
#undef PG8_SCHED
}
}

#define LAS __attribute__((address_space(3)))
typedef unsigned short bf16_t;
typedef short bf16x8 __attribute__((ext_vector_type(8)));
typedef float f32x4 __attribute__((ext_vector_type(4)));
typedef unsigned u32x4 __attribute__((ext_vector_type(4)));
typedef unsigned u32x2 __attribute__((ext_vector_type(2)));

constexpr int D = 1024, DFF = 2816, NFF2 = 5632, INC = 7984, PN = 5120, PREAL = 4912, MGN = 3072;
constexpr int MTOT = 24576, MLAT = 16384, GROWS = 8192;
constexpr float EPSN = 1e-6f;
constexpr size_t MiB = 1u << 20;
constexpr size_t WS_MOD = 1 * MiB, WS_MODP = 2 * MiB, WS_POS = 5 * MiB, WS_DEC = 6 * MiB, WS_SC = 7 * MiB;
constexpr size_t WS_W = 8 * MiB;
constexpr size_t W_FFIN = 0, W_FFOUT = W_FFIN + 2ull * NFF2 * D * 2, W_P = W_FFOUT + 2ull * D * DFF * 2, W_MG = W_P + (size_t)PN * D * 2,
                 W_B = W_MG + (size_t)MGN * D * 2, W_O3 = W_B + 3072ull * 512 * 2, W_END = W_O3 + 1024ull * 3072 * 2;
static_assert(W_END <= 58 * MiB, "weights region");
constexpr size_t WS_XN = 66 * MiB, WS_A = 114 * MiB, WS_BIG = 210 * MiB, WS_END = 370 * MiB;
constexpr size_t BIG_US = 80 * MiB, BIG_OB = 128 * MiB;
constexpr size_t OFF_YP = 0, OFF_YS = 8388608, OFF_C = 25165824, OFF_N = 29360128, OFF_M = 29392896, OFF_G = 29393408, OFF_H = 33587712;
constexpr int LDS_BYTES = 147456;

struct Args { const float* in[23]; float* out; unsigned char* ws; };
enum { I_XP = 0, I_XS, I_C, I_SC, I_SN, I_SM, I_SG, I_SH, I_CCTX, I_WADA, I_BADA, I_NPRE, I_NPOST, I_WFIN, I_WFOUT, I_WIN, I_GB, I_GWUP, I_GLB, I_HGAM, I_HN, I_WBR, I_WOUT };
__device__ __forceinline__ const float* inp(const Args& a, int i) { asm volatile("" : "+s"(i)); return a.in[i]; }

__device__ __forceinline__ unsigned f2bf(float f) { unsigned u = __float_as_uint(f); return (u + 0x7fffu + ((u >> 16) & 1u)) >> 16; }
__device__ __forceinline__ unsigned pk2(float lo, float hi) { return f2bf(lo) | (f2bf(hi) << 16); }
__device__ __forceinline__ float bf2f(bf16_t h) { return __uint_as_float(((unsigned)h) << 16); }
__device__ __forceinline__ float bflo(unsigned w) { return __uint_as_float(w << 16); }
__device__ __forceinline__ float bfhi(unsigned w) { return __uint_as_float(w & 0xffff0000u); }
__device__ __forceinline__ float sigmoidf_(float x) { return 1.0f / (1.0f + __expf(-x)); }
__device__ __forceinline__ float siluf_(float x) { return x / (1.0f + __expf(-x)); }
__device__ __forceinline__ float logsigf_(float x) { return fminf(x, 0.f) - __logf(1.0f + __expf(-fabsf(x))); }
__device__ __forceinline__ float wave_sum(float v) {
#pragma unroll
    for (int o = 1; o < 64; o <<= 1) v += __shfl_xor(v, o);
    return v;
}
#define LDS_WAIT() asm volatile("s_waitcnt lgkmcnt(0)" ::: "memory")

#define XB_TMO      128
#define XB_XCNT(j)  (256  + 64 * (j))
#define XB_XSUB(j)  (1280 + 64 * (j))
#define XB_XGEN(j)  (2304 + 64 * (j))
#define XB_TOP      3328
#define XB_TOPGEN   3392
#define XCD_BAR_WORDS 3456
#define XB_SPIN_CAP (1u << 18)

__device__ __forceinline__ unsigned xb_ld(unsigned* p)              { return __hip_atomic_load(p, __ATOMIC_RELAXED, __HIP_MEMORY_SCOPE_AGENT); }
__device__ __forceinline__ unsigned xb_add(unsigned* p, unsigned v) { return __hip_atomic_fetch_add(p, v, __ATOMIC_RELAXED, __HIP_MEMORY_SCOPE_AGENT); }
__device__ __forceinline__ unsigned xb_xcc_id() { return (unsigned)__builtin_amdgcn_s_getreg((3 << 11) | 20) & 0xFu; }
#define XB_SPIN(cond, bar) do { unsigned _sp = 0; while (cond) { __builtin_amdgcn_s_sleep(1); \
    if ((++_sp & 255u) == 0u) { if (xb_ld(&(bar)[XB_TMO])) break; if (_sp > XB_SPIN_CAP) { atomicAdd(&(bar)[XB_TMO], 1u); break; } } } } while (0)

struct XcdBarrier {
    unsigned* bar; unsigned x;
    volatile LAS unsigned* st;
};

__device__ __forceinline__ XcdBarrier xcd_barrier_post(unsigned* bar, volatile LAS unsigned* st) {
    XcdBarrier b; b.bar = bar; b.x = xb_xcc_id(); b.st = st;
    if (threadIdx.x == 0) (void)xb_add(&bar[XB_XCNT(b.x)], 1u);
    return b;
}
__device__ __forceinline__ void xcd_barrier_complete(unsigned* bar, unsigned x, unsigned& nloc, unsigned& nx) {
    const unsigned G = gridDim.x * gridDim.y * gridDim.z;
    unsigned sum, cnt, mine, sp = 0u;
    for (;;) {
        sum = 0u; cnt = 0u; mine = 0u;
#pragma unroll
        for (unsigned j = 0; j < 16; ++j) { const unsigned c = xb_ld(&bar[XB_XCNT(j)]); sum += c; cnt += (c > 0u) ? 1u : 0u; mine = (j == x) ? c : mine; }
        if (sum == G) break;
        __builtin_amdgcn_s_sleep(1);
        if ((++sp & 255u) == 0u) { if (xb_ld(&bar[XB_TMO])) break; if (sp > XB_SPIN_CAP) { atomicAdd(&bar[XB_TMO], 1u); break; } }
    }
    nloc = mine > 0u ? mine : 1u; nx = cnt > 0u ? cnt : 1u;
}

__device__ __attribute__((noinline)) void xcd_barrier_ni(unsigned* bar_, unsigned st_off) {
    XcdBarrier b; b.bar = bar_; b.x = xb_xcc_id(); b.st = (volatile LAS unsigned*)(size_t)st_off;
    asm volatile("s_waitcnt vmcnt(0)" ::: "memory");
    __syncthreads();
    if (threadIdx.x == 0) {
        unsigned* bar = b.bar;
        __builtin_amdgcn_s_waitcnt(0);
        unsigned nloc = b.st[0], nx = b.st[1];
        if (nloc == 0u) { xcd_barrier_complete(bar, b.x, nloc, nx); b.st[0] = nloc; b.st[1] = nx; }
        const unsigned old = xb_add(&bar[XB_XSUB(b.x)], 1u);
        const unsigned gen = old / nloc;
        if (old + 1u == (gen + 1u) * nloc) {
            __builtin_amdgcn_fence(__ATOMIC_RELEASE, "agent");
            asm volatile("s_waitcnt vmcnt(0)" ::: "memory");
            const unsigned og = xb_add(&bar[XB_TOP], 1u);
            const unsigned tg = og / nx;
            if (og + 1u == (tg + 1u) * nx) xb_add(&bar[XB_TOPGEN], 1u);
            else XB_SPIN(xb_ld(&bar[XB_TOPGEN]) == tg, bar);
            __builtin_amdgcn_fence(__ATOMIC_ACQUIRE, "agent");
            xb_add(&bar[XB_XGEN(b.x)], 1u);
            asm volatile("s_waitcnt vmcnt(0)" ::: "memory");
        } else {
            XB_SPIN(xb_ld(&bar[XB_XGEN(b.x)]) == gen, bar);
            __builtin_amdgcn_fence(__ATOMIC_ACQUIRE, "agent");
            asm volatile("s_waitcnt vmcnt(0)" ::: "memory");
        }
    }
    __syncthreads();
}


struct EpiBf16 {
    static constexpr bool PERM = true, AFTER_DRAIN = false;
    bf16_t* O; int ldc; int nsplit; size_t sstride;
    __device__ __forceinline__ void operator()(const f32x4 (&acc)[2][2][4][2], const pg8::Unit& u, int wr, int wc, int fr, int fq) const {
        int pn = u.pn; bf16_t* Ob = O; if (nsplit) { Ob += (size_t)(pn / nsplit) * sstride; pn = pn % nsplit; }
        const int row0 = u.pm * 256 + wr * 64 + fr, col0 = pn * 256 + wc * 32 + 8 * fq;
#pragma unroll
        for (int ai = 0; ai < 2; ++ai)
#pragma unroll
            for (int m = 0; m < 4; ++m) { bf16_t* rowp = Ob + (size_t)(row0 + ai * 128 + m * 16) * ldc + col0;
#pragma unroll
                for (int bj = 0; bj < 2; ++bj) { const f32x4 v0 = acc[ai][bj][m][0], v1 = acc[ai][bj][m][1];
                    u32x4 w; w.x = pk2(v0[0], v0[1]); w.y = pk2(v0[2], v0[3]); w.z = pk2(v1[0], v1[1]); w.w = pk2(v1[2], v1[3]);
                    *(u32x4*)(rowp + bj * 128) = w; } }
    }
};
struct EpiGateMul {
    static constexpr bool PERM = true, AFTER_DRAIN = false;
    bf16_t* O; int ldc;
    __device__ __forceinline__ void operator()(const f32x4 (&acc)[2][2][4][2], const pg8::Unit& u, int wr, int wc, int fr, int fq) const {
        const int row0 = u.pm * 256 + wr * 64 + fr, col0 = u.pn * 256 + wc * 32 + 8 * fq;
#pragma unroll
        for (int ai = 0; ai < 2; ++ai)
#pragma unroll
            for (int m = 0; m < 4; ++m) { bf16_t* rowp = O + (size_t)(row0 + ai * 128 + m * 16) * ldc + col0;
#pragma unroll
                for (int bj = 0; bj < 2; ++bj) { const f32x4 v0 = acc[ai][bj][m][0], v1 = acc[ai][bj][m][1];
                    const u32x4 b = *(const u32x4*)(rowp + bj * 128);
                    u32x4 w; w.x = pk2(sigmoidf_(v0[0]) * bflo(b.x), sigmoidf_(v0[1]) * bfhi(b.x)); w.y = pk2(sigmoidf_(v0[2]) * bflo(b.y), sigmoidf_(v0[3]) * bfhi(b.y));
                    w.z = pk2(sigmoidf_(v1[0]) * bflo(b.z), sigmoidf_(v1[1]) * bfhi(b.z)); w.w = pk2(sigmoidf_(v1[2]) * bflo(b.w), sigmoidf_(v1[3]) * bfhi(b.w));
                    *(u32x4*)(rowp + bj * 128) = w; } }
    }
};
struct EpiSwiGLU {
    static constexpr bool PERM = true, AFTER_DRAIN = false;
    bf16_t* H; int ldh;
    __device__ __forceinline__ void operator()(const f32x4 (&acc)[2][2][4][2], const pg8::Unit& u, int wr, int wc, int fr, int fq) const {
        const int row0 = u.pm * 256 + wr * 64 + fr, col0 = (u.pn * 256 + wc * 32 + 8 * fq) >> 1;
#pragma unroll
        for (int ai = 0; ai < 2; ++ai)
#pragma unroll
            for (int m = 0; m < 4; ++m) { bf16_t* rowp = H + (size_t)(row0 + ai * 128 + m * 16) * ldh + col0;
#pragma unroll
                for (int bj = 0; bj < 2; ++bj) { const f32x4 g = acc[ai][bj][m][0], up = acc[ai][bj][m][1];
                    u32x2 w; w.x = pk2(siluf_(g[0]) * up[0], siluf_(g[1]) * up[1]); w.y = pk2(siluf_(g[2]) * up[2], siluf_(g[3]) * up[3]);
                    *(u32x2*)(rowp + bj * 64) = w; } }
    }
};
struct EpiF32 {
    static constexpr bool PERM = false, AFTER_DRAIN = false;
    float* Y; int ldc;
    __device__ __forceinline__ void operator()(const f32x4 (&acc)[2][2][4][2], const pg8::Unit& u, int wr, int wc, int fr, int fq) const {
        const int row0 = u.pm * 256 + wr * 64 + fr, col0 = u.pn * 256 + wc * 32 + 4 * fq;
#pragma unroll
        for (int ai = 0; ai < 2; ++ai)
#pragma unroll
            for (int m = 0; m < 4; ++m) { float* rowp = Y + (size_t)(row0 + ai * 128 + m * 16) * ldc + col0;
#pragma unroll
                for (int bj = 0; bj < 2; ++bj)
#pragma unroll
                    for (int n = 0; n < 2; ++n) *(f32x4*)(rowp + bj * 128 + n * 16) = acc[ai][bj][m][n]; }
    }
};

template <class Map>
__device__ __forceinline__ void transpose_item(const float* W, int K, int N, LAS float* scr, int item, int lane, const Map& map) {
    const int nblk = (N + 31) / 32, kb = item / nblk, nb = item % nblk, k0 = 64 * kb, n0 = 32 * nb;
    const int nn = n0 + (lane & 31); const bool ok = nn < N;
#pragma unroll 8
    for (int i = 0; i < 32; ++i) { const int kk = 2 * i + (lane >> 5); scr[kk * 33 + (lane & 31)] = ok ? W[(size_t)(k0 + kk) * N + nn] : 0.f; }
    LDS_WAIT(); asm volatile("" ::: "memory");
    const int c = lane & 7;
#pragma unroll
    for (int j = 0; j < 4; ++j) { const int n = (lane >> 3) + 8 * j; const LAS float* s = scr + (8 * c) * 33 + n;
        u32x4 o; o.x = pk2(s[0 * 33], s[1 * 33]); o.y = pk2(s[2 * 33], s[3 * 33]); o.z = pk2(s[4 * 33], s[5 * 33]); o.w = pk2(s[6 * 33], s[7 * 33]);
        if (n0 + n < N) map(n0 + n, k0 + 8 * c, o); }
    LDS_WAIT(); asm volatile("" ::: "memory");
}

__device__ __forceinline__ void convert_weights(const Args& a, LAS unsigned char* lds, int l, int gw, int NGW, int lane, int wave) {
    LAS float* scr = (LAS float*)(lds + wave * 16384);
    unsigned char* wb = a.ws + WS_W;
    constexpr int I_FI = 16 * 176, I_FO = 44 * 32, I_IN = 16 * 250, I_BR = 8 * 32, I_OU = 16 * 32;
    constexpr int NITEMS = 2 * I_FI + 2 * I_FO + I_IN + 3 * I_BR + I_OU;
    for (int it = gw; it < NITEMS; it += NGW) {
        int r = it;
        if (r < 2 * I_FI) { const int f = r / I_FI; r -= f * I_FI; bf16_t* dst = (bf16_t*)(wb + W_FFIN) + (size_t)f * NFF2 * D;
            transpose_item(inp(a, I_WFIN) + (size_t)(l * 2 + f) * D * NFF2, D, NFF2, scr, r, lane,
                [=](int n, int k, u32x4 o) { const int h = n < DFF ? n : n - DFF; const int row = 8 * (h >> 2) + (n < DFF ? 0 : 4) + (h & 3); *(u32x4*)(dst + (size_t)row * D + k) = o; });
            continue; }
        r -= 2 * I_FI;
        if (r < 2 * I_FO) { const int f = r / I_FO; r -= f * I_FO; bf16_t* dst = (bf16_t*)(wb + W_FFOUT) + (size_t)f * D * DFF;
            transpose_item(inp(a, I_WFOUT) + (size_t)(l * 2 + f) * DFF * D, DFF, D, scr, r, lane,
                [=](int n, int k, u32x4 o) { *(u32x4*)(dst + (size_t)n * DFF + k) = o; });
            continue; }
        r -= 2 * I_FO;
        if (r < I_IN) { bf16_t* dp = (bf16_t*)(wb + W_P); bf16_t* dm = (bf16_t*)(wb + W_MG);
            transpose_item(inp(a, I_WIN) + (size_t)l * D * INC, D, INC, scr, r, lane,
                [=](int n, int k, u32x4 o) { if (n < PREAL) *(u32x4*)(dp + (size_t)n * D + k) = o; else *(u32x4*)(dm + (size_t)(n - PREAL) * D + k) = o; });
            continue; }
        r -= I_IN;
        if (r < 3 * I_BR) { const int nb = r / I_BR; r -= nb * I_BR; bf16_t* dst = (bf16_t*)(wb + W_B) + (size_t)nb * 1024 * 512;
            transpose_item(inp(a, I_WBR) + (size_t)(l * 3 + nb) * 512 * D, 512, D, scr, r, lane,
                [=](int n, int k, u32x4 o) { *(u32x4*)(dst + (size_t)n * 512 + k) = o; });
            continue; }
        r -= 3 * I_BR;
        { bf16_t* dst = (bf16_t*)(wb + W_O3);
            transpose_item(inp(a, I_WOUT) + (size_t)l * D * D, D, D, scr, r, lane,
                [=](int n, int k, u32x4 o) { bf16_t* p = dst + (size_t)n * 3072 + k; *(u32x4*)p = o; *(u32x4*)(p + 1024) = o; *(u32x4*)(p + 2048) = o; }); }
    }
    { u32x4* z = (u32x4*)((bf16_t*)(wb + W_P) + (size_t)PREAL * D); const int nz = (PN - PREAL) * D * 2 / 16;
      for (int i = gw * 64 + lane; i < nz; i += NGW * 64) z[i] = (u32x4){0u, 0u, 0u, 0u}; }
}

__device__ __forceinline__ void ada_partial(const Args& a, int gw, int NGW, int lane) {
    float* modp = (float*)(a.ws + WS_MODP);
    for (int it = gw; it < 2 * 144 * 8; it += NGW) {
        const int ks = it & 7, cgp = (it >> 3) % 144, l = it / (8 * 144);
        const int col = cgp * 64 + lane;
        const float* w = inp(a, I_WADA) + ((size_t)l * D + ks * 128) * 9216 + col;
        float acc[5] = {0.f, 0.f, 0.f, 0.f, 0.f};
#pragma unroll 4
        for (int k = 0; k < 128; ++k) { const float wv = w[(size_t)k * 9216]; const int kk = ks * 128 + k;
            acc[0] += siluf_(inp(a, I_CCTX)[kk]) * wv;
#pragma unroll
            for (int i = 0; i < 4; ++i) acc[1 + i] += siluf_(inp(a, I_C)[i * D + kk]) * wv; }
#pragma unroll
        for (int i = 0; i < 5; ++i) modp[((size_t)(ks * 2 + l) * 5 + i) * 9216 + col] = acc[i];
    }
}

struct RowOp { int src_input, has_y; float coef; const float* npost; const float* mdg_base; int has_xn; const float* npre; const float* md_base; int si; int add_pos; };
template <int NR>
__device__ __forceinline__ void rowwise(const Args& a, const RowOp& op, const int (&rs)[NR], int lane) {
    f32x4 v[NR][4]; u32x2 yb[NR][4], yb2[NR][4]; float* xd[NR]; bool lat[NR]; int cv[NR];
#pragma unroll
    for (int q = 0; q < NR; ++q) { const int r = rs[q]; lat[q] = r < MLAT; cv[q] = lat[q] ? 1 + (r >> 12) : 0;
        const float* xs = op.src_input ? (lat[q] ? inp(a, I_XS) + (size_t)r * D : inp(a, I_XP) + (size_t)(r - MLAT) * D)
                                       : (lat[q] ? a.out + OFF_YS + (size_t)r * D : a.out + OFF_YP + (size_t)(r - MLAT) * D);
        xd[q] = lat[q] ? a.out + OFF_YS + (size_t)r * D : a.out + OFF_YP + (size_t)(r - MLAT) * D;
#pragma unroll
        for (int j = 0; j < 4; ++j) v[q][j] = *(const f32x4*)(xs + 4 * lane + 256 * j);
        if (op.has_y) { const bf16_t* yr = (const bf16_t*)(a.ws + WS_A) + (size_t)r * D;
#pragma unroll
            for (int j = 0; j < 4; ++j) { yb[q][j] = *(const u32x2*)(yr + 4 * lane + 256 * j); yb2[q][j] = *(const u32x2*)(yr + (size_t)MTOT * D + 4 * lane + 256 * j); } } }
#pragma unroll
    for (int q = 0; q < NR; ++q) { const int r = rs[q];
        if (op.has_y) {
            f32x4 y[4]; float ss = 0.f;
#pragma unroll
            for (int j = 0; j < 4; ++j) { y[j] = (f32x4){bflo(yb[q][j].x) + bflo(yb2[q][j].x), bfhi(yb[q][j].x) + bfhi(yb2[q][j].x), bflo(yb[q][j].y) + bflo(yb2[q][j].y), bfhi(yb[q][j].y) + bfhi(yb2[q][j].y)}; ss += (y[j].x * y[j].x + y[j].y * y[j].y) + (y[j].z * y[j].z + y[j].w * y[j].w); }
            const float rr = rsqrtf(wave_sum(ss) * (1.f / D) + EPSN) * op.coef;
            const float* gp = op.mdg_base + (size_t)cv[q] * 9216;
#pragma unroll
            for (int j = 0; j < 4; ++j) { const f32x4 w = *(const f32x4*)(op.npost + 4 * lane + 256 * j), gg = *(const f32x4*)(gp + 4 * lane + 256 * j);
                v[q][j] = v[q][j] + gg * (y[j] * rr) * w; *(f32x4*)(xd[q] + 4 * lane + 256 * j) = v[q][j]; }
        }
        if (op.has_xn) {
            float ss = 0.f;
#pragma unroll
            for (int j = 0; j < 4; ++j) ss += (v[q][j].x * v[q][j].x + v[q][j].y * v[q][j].y) + (v[q][j].z * v[q][j].z + v[q][j].w * v[q][j].w);
            const float rr = rsqrtf(wave_sum(ss) * (1.f / D) + EPSN);
            const float* sh = op.md_base + (size_t)cv[q] * 9216 + (size_t)op.si * D; const float* sc = sh + D;
            const float* pos = (const float*)(a.ws + WS_POS); const int t = r & 4095;
            bf16_t* xo = (bf16_t*)(a.ws + WS_XN) + (size_t)r * D;
#pragma unroll
            for (int j = 0; j < 4; ++j) { const int c = 4 * lane + 256 * j; const f32x4 w = *(const f32x4*)(op.npre + c), s1 = *(const f32x4*)(sc + c), s0 = *(const f32x4*)(sh + c);
                f32x4 o = (v[q][j] * rr) * w * (s1 + 1.0f) + s0;
                if (op.add_pos && lat[q]) { const float* pp = (c < 512) ? pos + (size_t)(t >> 6) * 512 + c : pos + (size_t)(t & 63) * 512 + (c - 512); o = o + *(const f32x4*)pp; }
                u32x2 pk; pk.x = pk2(o.x, o.y); pk.y = pk2(o.z, o.w); *(u32x2*)(xo + c) = pk; }
        }
    }
}
__device__ __forceinline__ void rowwise_all(const Args& a, const RowOp& op, int gw, int NGW, int lane) {
    int r = gw;
    for (; r + NGW < MTOT; r += 2 * NGW) { const int rs[2] = {r, r + NGW}; rowwise<2>(a, op, rs, lane); }
    if (r < MTOT) { const int rs[1] = {r}; rowwise<1>(a, op, rs, lane); }
}

constexpr int C_MQ = 0, C_MK = 256, C_MV = 512, C_MO = 1024, C_MIF = 1536, C_GQ = 1552, C_GK = 1808, C_GV = 2064, C_GR = 2576, C_GLR = 3088, C_HQ = 3120, C_HF = 3376, C_HV = 3888, C_HG = 4400;

struct ItemInfo { int br, dir, head, seq, c, T, NC; };
__device__ __forceinline__ ItemInfo item_info(int g, int it) { ItemInfo I; const int hdb = it % 24, cgl = it / 24; I.br = hdb >> 3; I.dir = (hdb >> 2) & 1; I.head = hdb & 3;
    I.T = g < 2 ? 4096 : 256; I.NC = I.T >> 6; I.seq = cgl / I.NC; I.c = cgl % I.NC; return I; }
__device__ __forceinline__ int item_row(const ItemInfo& I, int s) { const int tau = I.c * 64 + s; return I.seq * I.T + (I.dir ? I.T - 1 - tau : tau); }
__device__ __forceinline__ float lb_of(const Args& a, int l, int ch) { if (l == 0) return 0.f; const float g0 = inp(a, I_HGAM)[ch], g1 = inp(a, I_HGAM)[256 + ch]; return 1.0f / (1.0f + expf(g0 - g1)); }

template <bool NEEDQ>
__device__ __forceinline__ void load_gated(const Args& a, const bf16_t* P, const ItemInfo& I, int l, int d, int sg, float (&qv)[8], float (&kv)[8], float (&la)[8]) {
    const int ch = I.head * 64 + d;
    if (I.br == 1) {
        float wup[16];
        const float* wp = inp(a, I_GWUP) + ((size_t)(l * 2 + I.dir) * 16) * 256 + ch;
#pragma unroll
        for (int r = 0; r < 16; ++r) wup[r] = wp[r * 256];
        const float gb = inp(a, I_GLB)[(l * 2 + I.dir) * 256 + ch];
#pragma unroll
        for (int i = 0; i < 8; ++i) { const bf16_t* pr = P + (size_t)item_row(I, 8 * sg + i) * PN;
            const u32x4 g0 = *(const u32x4*)(pr + C_GLR + I.dir * 16), g1 = *(const u32x4*)(pr + C_GLR + I.dir * 16 + 8);
            float z = gb;
            z += bflo(g0.x) * wup[0] + bfhi(g0.x) * wup[1] + bflo(g0.y) * wup[2] + bfhi(g0.y) * wup[3] + bflo(g0.z) * wup[4] + bfhi(g0.z) * wup[5] + bflo(g0.w) * wup[6] + bfhi(g0.w) * wup[7];
            z += bflo(g1.x) * wup[8] + bfhi(g1.x) * wup[9] + bflo(g1.y) * wup[10] + bfhi(g1.y) * wup[11] + bflo(g1.z) * wup[12] + bfhi(g1.z) * wup[13] + bflo(g1.w) * wup[14] + bfhi(g1.w) * wup[15];
            la[i] = logsigf_(z) * (1.0f / 16.0f);
            if (NEEDQ) qv[i] = bf2f(pr[C_GQ + ch]) * 0.125f; kv[i] = bf2f(pr[C_GK + ch]); }
    } else {
        const float lb = lb_of(a, l, ch);
#pragma unroll
        for (int i = 0; i < 8; ++i) { const bf16_t* pr = P + (size_t)item_row(I, 8 * sg + i) * PN;
            const float z = bf2f(pr[C_HF + I.dir * 256 + ch]); const float sg_ = sigmoidf_(z);
            la[i] = (lb == 0.f) ? logsigf_(z) : __logf(lb + (1.0f - lb) * sg_);
            if (NEEDQ) qv[i] = bf2f(pr[C_HQ + ch]) * 1.0f;
            kv[i] = (1.0f - lb) * (1.0f - sg_); }
    }
}
template <bool NEEDQ>
__device__ __forceinline__ void load_mlstm(const Args& a, const bf16_t* P, const ItemInfo& I, int l, int d, int sg, float (&qv)[8], float (&kv)[8], float (&lf)[8], float (&li)[8]) {
    const float bi = inp(a, I_GB)[((l * 2 + I.dir) * 2 + 0) * 4 + I.head], bf_ = inp(a, I_GB)[((l * 2 + I.dir) * 2 + 1) * 4 + I.head];
#pragma unroll
    for (int i = 0; i < 8; ++i) { const bf16_t* pr = P + (size_t)item_row(I, 8 * sg + i) * PN;
        li[i] = bf2f(pr[C_MIF + I.dir * 8 + I.head]) + bi; lf[i] = logsigf_(bf2f(pr[C_MIF + I.dir * 8 + 4 + I.head]) + bf_);
        if (NEEDQ) qv[i] = bf2f(pr[C_MQ + I.head * 64 + d]) * 0.125f; kv[i] = bf2f(pr[C_MK + I.head * 64 + d]); }
}
__device__ __forceinline__ void stage_vT(const bf16_t* P, const ItemInfo& I, LAS bf16_t* Y, int pitch, int tid) {
    const int s = tid >> 3, eg = tid & 7; const int vb = I.br == 0 ? C_MV : (I.br == 1 ? C_GV : C_HV);
    const bf16_t* pv = P + (size_t)item_row(I, s) * PN + vb + I.head * 128 + 16 * eg;
    const u32x4 v0 = *(const u32x4*)pv, v1 = *(const u32x4*)(pv + 8);
    const unsigned wds[8] = {v0.x, v0.y, v0.z, v0.w, v1.x, v1.y, v1.z, v1.w};
#pragma unroll
    for (int i = 0; i < 8; ++i) { float x0 = bflo(wds[i]), x1 = bfhi(wds[i]); if (I.br == 2) { x0 = siluf_(x0); x1 = siluf_(x1); }
        Y[(16 * eg + 2 * i) * pitch + s] = (bf16_t)f2bf(x0); Y[(16 * eg + 2 * i + 1) * pitch + s] = (bf16_t)f2bf(x1); }
}
__device__ __forceinline__ bf16x8 ldfrag(const LAS bf16_t* T, int pitch, int row0, int k0, int lane) { return *(const LAS bf16x8*)(T + (row0 + (lane & 15)) * pitch + k0 + 8 * (lane >> 4)); }

__device__ __forceinline__ void scan_s1(const Args& a, LAS unsigned char* lds, int l, int g, int it) {
    int tid_ = threadIdx.x; asm volatile("" : "+v"(tid_)); const int tid = tid_, d = tid & 63, lane = d, sg = __builtin_amdgcn_readfirstlane(tid >> 6);
    const ItemInfo I = item_info(g, it);
    const bf16_t* P = (const bf16_t*)(a.ws + WS_BIG);
    bf16_t* US = (bf16_t*)(a.ws + WS_BIG + BIG_US) + (size_t)it * 8192;
    float* DEC = (float*)(a.ws + WS_DEC) + (size_t)it * 64; float* SC = (float*)(a.ws + WS_SC) + (size_t)it * 4;
    LAS bf16_t* XT = (LAS bf16_t*)lds;
    LAS bf16_t* YV = (LAS bf16_t*)(lds + 9216);
    LAS float* TOT = (LAS float*)(lds + 9216 + 20736);
    LAS float* TMX = TOT + 512;
    float qv[8], kv[8], x0[8], x1[8];
    if (I.br == 0) {
        load_mlstm<false>(a, P, I, l, d, sg, qv, kv, x0, x1);
        float run = 0.f;
#pragma unroll
        for (int i = 0; i < 8; ++i) { run += x0[i]; x0[i] = run; }
        TOT[sg * 64 + d] = run; LDS_WAIT(); __syncthreads();
        float pre = 0.f, tot = 0.f;
#pragma unroll
        for (int w = 0; w < 8; ++w) { const float t = TOT[w * 64 + d]; if (w < sg) pre += t; tot += t; }
        float mx = -3.0e38f;
#pragma unroll
        for (int i = 0; i < 8; ++i) { x0[i] = tot - (pre + x0[i]) + x1[i]; mx = fmaxf(mx, x0[i]); }
        TMX[sg * 64 + d] = mx; LDS_WAIT(); __syncthreads();
        float mlw = -3.0e38f;
#pragma unroll
        for (int w = 0; w < 8; ++w) mlw = fmaxf(mlw, TMX[w * 64 + d]);
#pragma unroll
        for (int i = 0; i < 8; ++i) kv[i] *= __expf(x0[i] - mlw);
        if (tid == 0) { SC[0] = mlw; SC[1] = tot; }
        for (int idx = tid; idx < 16 * 64; idx += 512) YV[(128 + (idx >> 6)) * 72 + (idx & 63)] = (bf16_t)((idx >> 6) == 0 ? 0x3F80 : 0);
    } else {
        load_gated<false>(a, P, I, l, d, sg, qv, kv, x0);
        float run = 0.f;
#pragma unroll
        for (int i = 0; i < 8; ++i) { run += x0[i]; x0[i] = run; }
        TOT[sg * 64 + d] = run; LDS_WAIT(); __syncthreads();
        float pre = 0.f, tot = 0.f;
#pragma unroll
        for (int w = 0; w < 8; ++w) { const float t = TOT[w * 64 + d]; if (w < sg) pre += t; tot += t; }
#pragma unroll
        for (int i = 0; i < 8; ++i) kv[i] *= __expf(tot - (pre + x0[i]));
        if (sg == 0) DEC[d] = __expf(tot);
    }
    { u32x4 w; w.x = pk2(kv[0], kv[1]); w.y = pk2(kv[2], kv[3]); w.z = pk2(kv[4], kv[5]); w.w = pk2(kv[6], kv[7]); *(LAS u32x4*)(XT + d * 72 + 8 * sg) = w; }
    stage_vT(P, I, YV, 72, tid);
    LDS_WAIT(); __syncthreads();
    f32x4 acc[4];
#pragma unroll
    for (int mt = 0; mt < 4; ++mt) acc[mt] = (f32x4){0.f, 0.f, 0.f, 0.f};
#pragma unroll
    for (int ks = 0; ks < 2; ++ks) { const bf16x8 b = ldfrag(YV, 72, 16 * sg, 32 * ks, lane);
#pragma unroll
        for (int mt = 0; mt < 4; ++mt) acc[mt] = __builtin_amdgcn_mfma_f32_16x16x32_bf16(ldfrag(XT, 72, 16 * mt, 32 * ks, lane), b, acc[mt], 0, 0, 0); }
    { const int e = 16 * sg + (lane & 15);
#pragma unroll
      for (int mt = 0; mt < 4; ++mt) { u32x2 o; o.x = pk2(acc[mt][0], acc[mt][1]); o.y = pk2(acc[mt][2], acc[mt][3]); *(u32x2*)(US + e * 64 + 16 * mt + 4 * (lane >> 4)) = o; } }
    if (I.br == 0 && sg < 4) {
        f32x4 an = (f32x4){0.f, 0.f, 0.f, 0.f};
#pragma unroll
        for (int ks = 0; ks < 2; ++ks) an = __builtin_amdgcn_mfma_f32_16x16x32_bf16(ldfrag(XT, 72, 16 * sg, 32 * ks, lane), ldfrag(YV, 72, 128, 32 * ks, lane), an, 0, 0, 0);
        if ((lane & 15) == 0) { const int d0 = 16 * sg + 4 * (lane >> 4); DEC[d0] = an[0]; DEC[d0 + 1] = an[1]; DEC[d0 + 2] = an[2]; DEC[d0 + 3] = an[3]; }
    }
    __syncthreads();
}

__device__ __forceinline__ void scan_s2(const Args& a, int l, int g) {
    const int T = g < 2 ? 4096 : 256, NC = T >> 6, nseq = g < 2 ? 2 : 32, nslot = nseq * 24 * 1024;
    bf16_t* USb = (bf16_t*)(a.ws + WS_BIG + BIG_US); float* DECb = (float*)(a.ws + WS_DEC); float* SCb = (float*)(a.ws + WS_SC);
    int tid_ = threadIdx.x; asm volatile("" : "+v"(tid_));
    for (int slot = blockIdx.x * 512 + tid_; slot < nslot; slot += gridDim.x * 512) {
        const int sub = slot & 1023, stream = slot >> 10, hdb = stream % 24, seq = stream / 24, br = hdb >> 3, dir = (hdb >> 2) & 1, head = hdb & 3;
        const int e = sub >> 3, d0 = (sub & 7) * 8;
        float S[8], nst[8], mst = 0.f;
#pragma unroll
        for (int i = 0; i < 8; ++i) { S[i] = 0.f; nst[i] = 0.f; }
        if (g < 2) { const int b = g * 2 + seq; const size_t sidx = (size_t)((b * 2 + l) * 2 + dir) * 4 + head;
            const float* sp = (br == 0 ? inp(a, I_SC) : (br == 1 ? inp(a, I_SG) : inp(a, I_SH))) + sidx * 8192;
#pragma unroll
            for (int i = 0; i < 8; ++i) S[i] = sp[(d0 + i) * 128 + e];
            if (br == 0) { mst = inp(a, I_SM)[sidx];
#pragma unroll
                for (int i = 0; i < 8; ++i) nst[i] = inp(a, I_SN)[sidx * 64 + d0 + i]; } }
        const bool nrow = (br == 0) && (e == 0);
        for (int c0 = 0; c0 < NC; c0 += 4) {
            u32x4 ub[4]; f32x4 q0[4], q1[4]; float m0[4], m1[4];
#pragma unroll
            for (int j = 0; j < 4; ++j) { const size_t it = (size_t)(seq * NC + c0 + j) * 24 + hdb;
                ub[j] = *(const u32x4*)(USb + it * 8192 + e * 64 + d0);
                if (br == 0) { m0[j] = SCb[it * 4]; m1[j] = SCb[it * 4 + 1]; }
                if (br != 0 || nrow) { q0[j] = *(const f32x4*)(DECb + it * 64 + d0); q1[j] = *(const f32x4*)(DECb + it * 64 + d0 + 4); } }
#pragma unroll
            for (int j = 0; j < 4; ++j) { const size_t it = (size_t)(seq * NC + c0 + j) * 24 + hdb;
                bf16_t* p = USb + it * 8192 + e * 64 + d0; float* dec = DECb + it * 64 + d0; float* sc = SCb + it * 4;
                const u32x4 u = ub[j];
                const float uu[8] = {bflo(u.x), bfhi(u.x), bflo(u.y), bfhi(u.y), bflo(u.z), bfhi(u.z), bflo(u.w), bfhi(u.w)};
                { u32x4 w; w.x = pk2(S[0], S[1]); w.y = pk2(S[2], S[3]); w.z = pk2(S[4], S[5]); w.w = pk2(S[6], S[7]); *(u32x4*)p = w; }
                if (br == 0) {
                    const float mlw = m0[j], bl = m1[j]; const float mn = fmaxf(bl + mst, mlw); const float fa = __expf(bl + mst - mn), fb = __expf(mlw - mn);
                    if (nrow) { const f32x4 n0 = q0[j], n1 = q1[j];
                        *(f32x4*)dec = (f32x4){nst[0], nst[1], nst[2], nst[3]}; *(f32x4*)(dec + 4) = (f32x4){nst[4], nst[5], nst[6], nst[7]};
                        const float nn[8] = {n0.x, n0.y, n0.z, n0.w, n1.x, n1.y, n1.z, n1.w};
#pragma unroll
                        for (int i = 0; i < 8; ++i) nst[i] = fa * nst[i] + fb * nn[i];
                        if (d0 == 0) sc[2] = mst; }
#pragma unroll
                    for (int i = 0; i < 8; ++i) S[i] = fa * S[i] + fb * uu[i];
                    mst = mn;
                } else {
                    const f32x4 a0 = q0[j], a1 = q1[j]; const float dd[8] = {a0.x, a0.y, a0.z, a0.w, a1.x, a1.y, a1.z, a1.w};
#pragma unroll
                    for (int i = 0; i < 8; ++i) S[i] = dd[i] * S[i] + uu[i];
                }
            }
        }
        if (g == 2) { const size_t sidx = (size_t)((seq * 2 + l) * 2 + dir) * 4 + head;
            float* op = a.out + (br == 0 ? OFF_C : (br == 1 ? OFF_G : OFF_H)) + sidx * 8192;
#pragma unroll
            for (int i = 0; i < 8; ++i) op[(d0 + i) * 128 + e] = S[i];
            if (nrow) {
#pragma unroll
                for (int i = 0; i < 8; ++i) a.out[OFF_N + sidx * 64 + d0 + i] = nst[i];
                if (d0 == 0) a.out[OFF_M + sidx] = mst; } }
    }
}

constexpr int S3_QO = 0, S3_KO = 23040, S3_G = 41472, S3_XA = 57856, S3_YV = 75264, S3_TOT = 114432, S3_VEC = 116480;
__device__ __forceinline__ void scan_s3(const Args& a, LAS unsigned char* lds, int l, int g, int it) {
    int tid_ = threadIdx.x; asm volatile("" : "+v"(tid_)); const int tid = tid_, d = tid & 63, lane = d, sg = __builtin_amdgcn_readfirstlane(tid >> 6);
    const ItemInfo I = item_info(g, it);
    const bf16_t* P = (const bf16_t*)(a.ws + WS_BIG);
    const bf16_t* US = (const bf16_t*)(a.ws + WS_BIG + BIG_US) + (size_t)it * 8192;
    const float* DEC = (const float*)(a.ws + WS_DEC) + (size_t)it * 64; const float* SC = (const float*)(a.ws + WS_SC) + (size_t)it * 4;
    bf16_t* Od = I.dir == 0 ? (bf16_t*)(a.ws + WS_A) + (size_t)g * GROWS * 1536 : (bf16_t*)(a.ws + WS_BIG + BIG_OB);
    LAS bf16_t* QO = (LAS bf16_t*)(lds + S3_QO); LAS bf16_t* KO = (LAS bf16_t*)(lds + S3_KO); LAS float* G = (LAS float*)(lds + S3_G);
    LAS bf16_t* XA = (LAS bf16_t*)(lds + S3_XA); LAS bf16_t* YV = (LAS bf16_t*)(lds + S3_YV); LAS float* TOT = (LAS float*)(lds + S3_TOT);
    LAS float* Bv = (LAS float*)(lds + S3_VEC); LAS float* LIv = Bv + 64; LAS float* MT = Bv + 128; LAS float* EI = Bv + 192;
    float qv[8], kv[8], x0[8], x1[8];
    stage_vT(P, I, YV, 136, tid);
    { const int e = tid >> 2, part = tid & 3; const u32x4 s0 = *(const u32x4*)(US + e * 64 + 16 * part), s1 = *(const u32x4*)(US + e * 64 + 16 * part + 8);
      *(LAS u32x4*)(YV + e * 136 + 64 + 16 * part) = s0; *(LAS u32x4*)(YV + e * 136 + 64 + 16 * part + 8) = s1; }
    const int bi = sg >> 1;
    f32x4 acc[4];
#pragma unroll
    for (int nt = 0; nt < 4; ++nt) acc[nt] = (f32x4){0.f, 0.f, 0.f, 0.f};
    if (I.br != 0) {
        load_gated<true>(a, P, I, l, d, sg, qv, kv, x0);
        float run = 0.f;
#pragma unroll
        for (int i = 0; i < 8; ++i) { run += x0[i]; x0[i] = run; }
        TOT[sg * 64 + d] = run; LDS_WAIT(); __syncthreads();
        float pre = 0.f;
#pragma unroll
        for (int w = 0; w < 8; ++w) { const float t = TOT[w * 64 + d]; if (w < sg) pre += t; }
#pragma unroll
        for (int i = 0; i < 8; ++i) { x0[i] += pre; const int s = 8 * sg + i; G[s * 64 + d] = x0[i]; XA[s * 136 + 64 + d] = (bf16_t)f2bf(qv[i] * __expf(x0[i])); }
        LDS_WAIT(); __syncthreads();
        const float gs = bi ? G[(16 * bi - 1) * 64 + d] : 0.f, geo = G[(16 * bi + 15) * 64 + d];
        float gej[3];
#pragma unroll
        for (int j = 0; j < 3; ++j) gej[j] = G[(16 * j + 15) * 64 + d];
#pragma unroll
        for (int i = 0; i < 8; ++i) { const int tt = 8 * (sg & 1) + i;
            QO[(6 + bi) * 1152 + tt * 72 + d] = (bf16_t)f2bf(qv[i] * __expf(x0[i] - gs));
            KO[(4 + bi) * 1152 + tt * 72 + d] = (bf16_t)f2bf(kv[i] * __expf(fminf(gs - x0[i], 80.f)));
            KO[bi * 1152 + tt * 72 + d] = (bf16_t)f2bf(kv[i] * __expf(geo - x0[i]));
#pragma unroll
            for (int j = 0; j < 3; ++j) if (j < bi) QO[(bi * (bi - 1) / 2 + j) * 1152 + tt * 72 + d] = (bf16_t)f2bf(qv[i] * __expf(fminf(x0[i] - gej[j], 0.f))); }
        LDS_WAIT(); __syncthreads();
#pragma unroll
        for (int jj = 0; jj < 2; ++jj) { const int j = 2 * (sg & 1) + jj; f32x4 t = (f32x4){0.f, 0.f, 0.f, 0.f};
            if (j <= bi) { const int qt = (j == bi) ? 6 + bi : bi * (bi - 1) / 2 + j, kt = (j == bi) ? 4 + bi : j;
#pragma unroll
                for (int ks = 0; ks < 2; ++ks) t = __builtin_amdgcn_mfma_f32_16x16x32_bf16(ldfrag(QO + qt * 1152, 72, 0, 32 * ks, lane), ldfrag(KO + kt * 1152, 72, 0, 32 * ks, lane), t, 0, 0, 0); }
#pragma unroll
            for (int r = 0; r < 4; ++r) { const int tl = 4 * (lane >> 4) + r, sl = lane & 15; float v = t[r]; if (j == bi && sl > tl) v = 0.f;
                XA[(16 * bi + tl) * 136 + 16 * j + sl] = (bf16_t)f2bf(v); } }
        LDS_WAIT(); __syncthreads();
    } else {
        load_mlstm<true>(a, P, I, l, d, sg, qv, kv, x0, x1);
        float run = 0.f;
#pragma unroll
        for (int i = 0; i < 8; ++i) { run += x0[i]; x0[i] = run; }
        TOT[sg * 64 + d] = run;
        for (int idx = tid; idx < 16 * 128; idx += 512) { const int r = idx >> 7, k = idx & 127; YV[(128 + r) * 136 + k] = (bf16_t)(r == 0 ? (k < 64 ? 0x3F80u : f2bf(DEC[k - 64])) : 0u); }
        LDS_WAIT(); __syncthreads();
        float pre = 0.f;
#pragma unroll
        for (int w = 0; w < 8; ++w) { const float t = TOT[w * 64 + d]; if (w < sg) pre += t; }
#pragma unroll
        for (int i = 0; i < 8; ++i) { x0[i] += pre; const int s = 8 * sg + i; if (d == 0) { Bv[s] = x0[i]; LIv[s] = x1[i]; }
            QO[s * 72 + d] = (bf16_t)f2bf(qv[i]); KO[s * 72 + d] = (bf16_t)f2bf(kv[i]); }
        LDS_WAIT(); __syncthreads();
        if (tid < 64) { float rn = -3.0e38f; for (int s = 0; s <= tid; ++s) rn = fmaxf(rn, LIv[s] - Bv[s]);
            const float bt = Bv[tid], inter = bt + SC[2], mt = fmaxf(inter, bt + rn); MT[tid] = mt; EI[tid] = __expf(inter - mt); }
        f32x4 t2[2];
#pragma unroll
        for (int jj = 0; jj < 2; ++jj) { const int j = 2 * (sg & 1) + jj; t2[jj] = (f32x4){0.f, 0.f, 0.f, 0.f};
            if (j <= bi) {
#pragma unroll
                for (int ks = 0; ks < 2; ++ks) t2[jj] = __builtin_amdgcn_mfma_f32_16x16x32_bf16(ldfrag(QO, 72, 16 * bi, 32 * ks, lane), ldfrag(KO, 72, 16 * j, 32 * ks, lane), t2[jj], 0, 0, 0); } }
        LDS_WAIT(); __syncthreads();
#pragma unroll
        for (int jj = 0; jj < 2; ++jj) { const int j = 2 * (sg & 1) + jj;
#pragma unroll
            for (int r = 0; r < 4; ++r) { const int t = 16 * bi + 4 * (lane >> 4) + r, s = 16 * j + (lane & 15); float v = 0.f;
                if (s <= t) v = t2[jj][r] * __expf(Bv[t] - Bv[s] + LIv[s] - MT[t]);
                XA[t * 136 + s] = (bf16_t)f2bf(v); } }
#pragma unroll
        for (int i = 0; i < 8; ++i) { const int s = 8 * sg + i; XA[s * 136 + 64 + d] = (bf16_t)f2bf(qv[i] * EI[s]); }
        LDS_WAIT(); __syncthreads();
    }
    f32x4 accd[4];
#pragma unroll
    for (int nt = 0; nt < 4; ++nt) accd[nt] = (f32x4){0.f, 0.f, 0.f, 0.f};
#pragma unroll
    for (int ks = 0; ks < 4; ++ks) { const bf16x8 av = ldfrag(YV, 136, 16 * sg, 32 * ks, lane);
        bf16x8 ad = av; if (I.br == 0) ad = ldfrag(YV, 136, 128, 32 * ks, lane);
#pragma unroll
        for (int nt = 0; nt < 4; ++nt) { const bf16x8 bx = ldfrag(XA, 136, 16 * nt, 32 * ks, lane);
            acc[nt] = __builtin_amdgcn_mfma_f32_16x16x32_bf16(av, bx, acc[nt], 0, 0, 0);
            if (I.br == 0) accd[nt] = __builtin_amdgcn_mfma_f32_16x16x32_bf16(ad, bx, accd[nt], 0, 0, 0); } }
    const int ecol = I.br * 512 + I.head * 128 + 16 * sg + 4 * (lane >> 4);
#pragma unroll
    for (int nt = 0; nt < 4; ++nt) { const int t = 16 * nt + (lane & 15); f32x4 o = acc[nt];
        if (I.br == 0) { const float den = __shfl(accd[nt][0], lane & 15); const float dn = fmaxf(fabsf(den), __expf(-MT[t])); o = o * (1.0f / dn); }
        u32x2 w; w.x = pk2(o[0], o[1]); w.y = pk2(o[2], o[3]);
        *(u32x2*)(Od + (size_t)item_row(I, t) * 1536 + ecol) = w; }
    __syncthreads();
}

__device__ __forceinline__ void headnorm_row(const Args& a, int l, int g, int lr, int lane) {
    const bf16_t* P = (const bf16_t*)(a.ws + WS_BIG) + (size_t)lr * PN;
    bf16_t* of = (bf16_t*)(a.ws + WS_A) + ((size_t)g * GROWS + lr) * 1536; const bf16_t* ob = (const bf16_t*)(a.ws + WS_BIG + BIG_OB) + (size_t)lr * 1536;
#pragma unroll
    for (int br = 0; br < 3; ++br) { const int c = br * 512 + 8 * lane;
        const u32x4 f = *(const u32x4*)(of + c), b = *(const u32x4*)(ob + c);
        float o[8] = {bflo(f.x) + bflo(b.x), bfhi(f.x) + bfhi(b.x), bflo(f.y) + bflo(b.y), bfhi(f.y) + bfhi(b.y), bflo(f.z) + bflo(b.z), bfhi(f.z) + bfhi(b.z), bflo(f.w) + bflo(b.w), bfhi(f.w) + bfhi(b.w)};
        float ss = 0.f;
#pragma unroll
        for (int i = 0; i < 8; ++i) ss += o[i] * o[i];
        ss += __shfl_xor(ss, 1); ss += __shfl_xor(ss, 2); ss += __shfl_xor(ss, 4); ss += __shfl_xor(ss, 8);
        const float rr = rsqrtf(ss * (1.0f / 128.0f) + EPSN);
        const u32x4 gt = *(const u32x4*)(P + (br == 0 ? C_MO : (br == 1 ? C_GR : C_HG)) + 8 * lane);
        const float gv[8] = {bflo(gt.x), bfhi(gt.x), bflo(gt.y), bfhi(gt.y), bflo(gt.z), bfhi(gt.z), bflo(gt.w), bfhi(gt.w)};
        const float* hn = inp(a, I_HN) + (size_t)(l * 3 + br) * 512 + 8 * lane;
        const f32x4 h0 = *(const f32x4*)hn, h1 = *(const f32x4*)(hn + 4); const float hw[8] = {h0.x, h0.y, h0.z, h0.w, h1.x, h1.y, h1.z, h1.w};
        float y[8];
#pragma unroll
        for (int i = 0; i < 8; ++i) { const float gg = br == 0 ? sigmoidf_(gv[i]) : siluf_(gv[i]); y[i] = gg * (o[i] * rr) * hw[i]; }
        u32x4 w; w.x = pk2(y[0], y[1]); w.y = pk2(y[2], y[3]); w.z = pk2(y[4], y[5]); w.w = pk2(y[6], y[7]); *(u32x4*)(of + c) = w; }
}

#ifndef REP_S1
#define REP_S1 1
#endif
#ifndef REP_S3
#define REP_S3 1
#endif
#ifndef REP_G
#define REP_G 1
#endif
template <int M_, int N_, int K_, int LDA_, int LDB_, int ADIV, int AMUL, int KS, class Epi>
__device__ __forceinline__ void run_gemm(LAS unsigned char* lds, const bf16_t* A, const bf16_t* Bt, const Epi& E) {
    typedef pg8::GemmT<M_, N_, K_, LDA_, LDB_> GT; GT g{A, Bt}; typedef pg8::StaticOrderT<M_, N_, ADIV, AMUL, KS> SO; SO S; S.init((int)gridDim.x, (int)blockIdx.x);
    pg8::gemm_phase<GT, Epi, SO, true, true>((PG8_LAS unsigned char*)lds, g, S, E);
}

__global__ void __launch_bounds__(512, 2) mk_fwd(Args a) {
    extern __shared__ __attribute__((aligned(16))) unsigned char lds_raw[];
    LAS unsigned char* lds = (LAS unsigned char*)lds_raw;
    cg::grid_group grid = cg::this_grid();
    for (int u = threadIdx.x; u < (LDS_BYTES - 131072) / 4; u += 512) ((LAS unsigned*)(lds + 131072))[u] = 0u;
    __syncthreads();
    (void)xcd_barrier_post((unsigned*)a.ws, (volatile LAS unsigned*)(lds + 131072 + 352));
    const int tid = threadIdx.x, lane = tid & 63, wave = __builtin_amdgcn_readfirstlane(tid >> 6);
    const int G = gridDim.x, gw = blockIdx.x * 8 + wave, NGW = G * 8;
    unsigned char* ws = a.ws;
    float* mod = (float*)(ws + WS_MOD);

#ifndef SKIP_PRO
    convert_weights(a, lds, 0, gw, NGW, lane, wave);
    ada_partial(a, gw, NGW, lane);
    { float* pos = (float*)(ws + WS_POS);
      for (int i = blockIdx.x * 512 + tid; i < 64 * 512; i += G * 512) { const int v = i >> 9, j = i & 511, fi = j & 255;
          const float fr = expf((-9.210340371976184f * (float)fi) / 256.0f); const float ang = (float)v * fr; pos[i] = j < 256 ? sinf(ang) : cosf(ang); } }
    grid.sync();
    { const float* modp = (const float*)(ws + WS_MODP);
      for (int i = blockIdx.x * 512 + tid; i < 2 * 5 * 9216; i += G * 512) { const int col = i % 9216, l = i / (5 * 9216); float s = inp(a, I_BADA)[l * 9216 + col];
#pragma unroll
          for (int ks = 0; ks < 8; ++ks) s += modp[(size_t)ks * (2 * 5 * 9216) + i]; mod[i] = s; } }
    xcd_barrier_ni((unsigned*)a.ws, 131072 + 352);
    { RowOp op{}; op.src_input = 1; op.has_y = 0; op.has_xn = 1; op.npre = inp(a, I_NPRE); op.md_base = mod; op.si = 0; op.add_pos = 0;
      rowwise_all(a, op, gw, NGW, lane); }
    xcd_barrier_ni((unsigned*)a.ws, 131072 + 352);
#endif

    for (int l = 0; l < 2; ++l) {
        for (int st = 0; st < 25; ++st) {
            int tid = threadIdx.x; asm volatile("" : "+v"(tid));
            const int lane = tid & 63, wave = __builtin_amdgcn_readfirstlane(tid >> 6), gw = blockIdx.x * 8 + wave;
            unsigned char* ws = a.ws; asm volatile("" : "+s"(ws));
            float* mod = (float*)(ws + WS_MOD); const float* modl = mod + (size_t)l * 5 * 9216;
            bf16_t* XN = (bf16_t*)(ws + WS_XN); bf16_t* BIG = (bf16_t*)(ws + WS_BIG); float* Y = (float*)(ws + WS_A); bf16_t* YS = (bf16_t*)(ws + WS_A);
            unsigned char* wb = ws + WS_W; const int G = gridDim.x, NGW = G * 8;
            const int kind = (st == 0 || st == 22) ? 0 : (st == 1 || st == 20 || st == 23) ? 1 : (st == 2 || st == 21 || st == 24) ? 2 : (st == 18) ? 3 : (st == 19) ? 4 : 5 + ((st - 3) % 5);
            const int g = (st >= 3 && st < 18) ? (st - 3) / 5 : 0;
            switch (kind) {
            case 0: {
#ifndef SKIP_G0
                const int f = st == 0 ? 0 : 1; EpiSwiGLU E{BIG, DFF};
                for (int rep = 0; rep < REP_G; ++rep) run_gemm<MTOT, NFF2, D, D, D, 0, 0, 1>(lds, XN, (const bf16_t*)(wb + W_FFIN) + (size_t)f * NFF2 * D, E);
#endif
                break; }
            case 1: {
#ifndef SKIP_G1
                EpiBf16 E{(bf16_t*)Y, D, 4, (size_t)MTOT * D};
                for (int rep = 0; rep < REP_G; ++rep)
                if (st == 20) run_gemm<MTOT, 2 * D, 1536, 3072, 3072, 4, 1536, 2>(lds, BIG, (const bf16_t*)(wb + W_O3), E);
                else run_gemm<MTOT, 2 * D, DFF / 2, DFF, DFF, 4, DFF / 2, 2>(lds, BIG, (const bf16_t*)(wb + W_FFOUT) + (size_t)(st == 1 ? 0 : 1) * D * DFF, E);
#endif
                break; }
            case 2: {
#ifndef SKIP_ROW
                RowOp op{}; op.has_y = 1; op.mdg_base = modl + (st == 2 ? 2 : st == 21 ? 5 : 8) * D; op.coef = st == 21 ? 1.0f : 0.5f;
                op.npost = inp(a, I_NPOST) + (size_t)(l * 3 + (st == 2 ? 0 : st == 21 ? 1 : 2)) * D; op.src_input = (l == 0 && st == 2) ? 1 : 0;
                if (st == 2) { op.has_xn = 1; op.npre = inp(a, I_NPRE) + (size_t)(l * 3 + 1) * D; op.md_base = modl; op.si = 3; op.add_pos = 1; }
                else if (st == 21) { op.has_xn = 1; op.npre = inp(a, I_NPRE) + (size_t)(l * 3 + 2) * D; op.md_base = modl; op.si = 6; op.add_pos = 0; }
                else { op.has_xn = (l == 0) ? 1 : 0; op.npre = inp(a, I_NPRE) + (size_t)3 * D; op.md_base = mod + (size_t)5 * 9216; op.si = 0; op.add_pos = 0; }
                rowwise_all(a, op, gw, NGW, lane);
                if (st == 24 && l == 0) { __syncthreads(); convert_weights(a, lds, 1, gw, NGW, lane, wave); }
#endif
                break; }
            case 3: {
#ifndef SKIP_G3
                EpiBf16 E{BIG, 3072, 0, 0};
                for (int rep = 0; rep < REP_G; ++rep) run_gemm<MTOT, 3072, 512, 1536, 512, 4, 512, 1>(lds, YS, (const bf16_t*)(wb + W_B), E);
#endif
                break; }
            case 4: {
#ifndef SKIP_G4
                EpiGateMul E{BIG, 3072};
                run_gemm<MTOT, MGN, D, D, D, 0, 0, 1>(lds, XN, (const bf16_t*)(wb + W_MG), E);
#endif
                break; }
            case 5: {
#ifndef SKIP_G3
                EpiBf16 E{BIG, PN, 0, 0};
                for (int rep = 0; rep < REP_G; ++rep) run_gemm<GROWS, PN, D, D, D, 0, 0, 1>(lds, XN + (size_t)g * GROWS * D, (const bf16_t*)(wb + W_P), E);
#endif
                break; }
            case 6: {
#ifndef SKIP_S1
                for (int rep = 0; rep < REP_S1; ++rep) for (int it = blockIdx.x; it < 3072; it += G) scan_s1(a, lds, l, g, it);
#endif
                break; }
            case 7: {
#ifndef SKIP_S2
                scan_s2(a, l, g);
#endif
                break; }
            case 8: {
#ifndef SKIP_S3
                for (int rep = 0; rep < REP_S3; ++rep) for (int it = blockIdx.x; it < 3072; it += G) scan_s3(a, lds, l, g, it);
#endif
                break; }
            default: {
#ifndef SKIP_HN
                for (int lr = gw; lr < GROWS; lr += NGW) headnorm_row(a, l, g, lr, lane);
#endif
                break; }
            }
            xcd_barrier_ni((unsigned*)a.ws, 131072 + 352);
#ifdef EXTRA_SYNC
            xcd_barrier_ni((unsigned*)a.ws, 131072 + 352);
#endif
        }
    }
}

extern "C" void kernel_launch(void* const* d_in, const int* in_sizes, int n_in, void* d_out, int out_size, void* d_ws, size_t ws_size, hipStream_t stream) {
    static int grid = 0;
    if (grid == 0) {
        if (n_in != 23 || ws_size < WS_END) { fprintf(stderr, "kernel_launch: unexpected n_in %d / ws_size %zu (need %zu)\n", n_in, ws_size, (size_t)WS_END); grid = -1; return; }
        int dev = 0, cus = 0, per_cu = 0;
        hipGetDevice(&dev); hipDeviceGetAttribute(&cus, hipDeviceAttributeMultiprocessorCount, dev);
        hipFuncSetAttribute((const void*)mk_fwd, hipFuncAttributeMaxDynamicSharedMemorySize, LDS_BYTES);
        hipOccupancyMaxActiveBlocksPerMultiprocessor(&per_cu, (const void*)mk_fwd, 512, LDS_BYTES);
        (void)hipGetLastError();
        if (per_cu < 1) per_cu = 1;
        grid = cus;
    }
    if (grid < 0) return;
    if (hipMemsetAsync(d_ws, 0, 16384, stream) != hipSuccess) { fprintf(stderr, "memset failed\n"); return; }
    Args a{};
    for (int i = 0; i < 23; ++i) a.in[i] = (const float*)d_in[i];
    a.out = (float*)d_out; a.ws = (unsigned char*)d_ws;
    void* args[] = {&a};
    hipError_t e = hipLaunchCooperativeKernel((const void*)mk_fwd, dim3(grid), dim3(512), args, LDS_BYTES, stream);
    if (e != hipSuccess) fprintf(stderr, "cooperative launch failed: %s (grid %d)\n", hipGetErrorString(e), grid);
}
```

```cpp
#include <hip/hip_runtime.h>
#include <hip/hip_cooperative_groups.h>
#include <cstdio>
#include <cstdint>
namespace cg = cooperative_groups;

namespace pg8 {
#define PG8_LAS __attribute__((address_space(3)))
typedef unsigned short bf16_t;
typedef short bf16x8 __attribute__((ext_vector_type(8)));
typedef float f32x4 __attribute__((ext_vector_type(4)));
typedef unsigned u32x4 __attribute__((ext_vector_type(4)));
typedef unsigned u32x2 __attribute__((ext_vector_type(2)));
constexpr int BM = 256, BK = 64, HALF = 128, HTB = HALF * BK * 2, STAGE_BYTES = 8 * HTB, NXCD = 8, WGM = 8;

__host__ __device__ __forceinline__ int lds_byte(int r, int c) { const int st = (r >> 4) * 2 + (c >> 5), rr = r & 15, cc = c & 31, ob = rr * 64 + cc * 2; return st * 1024 + (ob ^ (((ob >> 9) & 1) << 5)); }
__host__ __device__ __forceinline__ void stage_rc(int b, int& R, int& C) { const int st = b / 1024, sb = b % 1024, swz = sb ^ (((sb >> 9) & 1) << 5); R = (st >> 1) * 16 + swz / 64; C = (st & 1) * 32 + (swz % 64) / 2; }
__host__ __device__ __forceinline__ int perm32(int rho) { const int n = rho >> 4, i = rho & 15; return 8 * (i >> 2) + 4 * n + (i & 3); }

struct Unit { int pm, pn; };
template <int M_, int N_, int K_, int LDA_, int LDB_> struct GemmT { const bf16_t* A; const bf16_t* Bt; static constexpr int M = M_, N = N_, K = K_, lda = LDA_, ldb = LDB_; };

template <int M_, int N_, int ADIV, int AMUL, int KS = 1> struct StaticOrderT {
    static constexpr int nM = M_ / BM, nN = N_ / BM, nwg = nM * nN;
    int G, c;
    __device__ void init(int G_, int c_) { G = G_; c = c_; }
    __device__ __forceinline__ bool next(int i, Unit& u) const {
        const int L = i * G + c; if (L >= nwg) return false;
        int wgid = L; { constexpr int q = nwg / NXCD, r = nwg % NXCD; const int xcd = wgid % NXCD, off = wgid / NXCD; wgid = (xcd < r ? xcd * (q + 1) : r * (q + 1) + (xcd - r) * q) + off; }
        constexpr int nig = WGM * nN; const int gid = wgid / nig, fm = gid * WGM, gsz = (nM - fm) < WGM ? (nM - fm) : WGM;
        u.pm = fm + ((wgid % nig) % gsz); u.pn = (wgid % nig) / gsz; return true;
    }
    __device__ __forceinline__ int a_off(const Unit& u) const { return ADIV > 0 ? (u.pn / (ADIV > 0 ? ADIV : 1)) * AMUL : 0; }
    __device__ __forceinline__ int b_tile(const Unit& u) const { return KS > 1 ? u.pn % (nN / KS) : u.pn; }
    __device__ __forceinline__ int b_koff(const Unit& u) const { return KS > 1 ? (u.pn / (nN / KS)) * AMUL : 0; }
    __device__ __forceinline__ void a_ready(const Unit&) const {}
    __device__ __forceinline__ void done(const Unit&) const {}
};

template <class GT, class Epi, class Sched, bool ALIGN_EPI = false, bool SP2 = false>
__device__ __forceinline__ void gemm_phase(PG8_LAS unsigned char* lds, const GT g, const Sched& S, const Epi& E) {
    int tid_ = threadIdx.x; asm volatile("" : "+v"(tid_));
    const int tid = tid_, wid = __builtin_amdgcn_readfirstlane(tid >> 6), lane = tid & 63, wr = wid >> 2, wc = wid & 3, fr = lane & 15, fq = lane >> 4;
    constexpr int K = GT::K, nt = K / BK;
    unsigned voffA[2], voffB[2];
#pragma unroll
    for (int i = 0; i < 2; ++i) { int R, C; stage_rc(tid * 16 + i * 8192, R, C); const int Rb = Epi::PERM ? ((R & ~31) + perm32(R & 31)) : R;
        voffA[i] = (unsigned)(R * GT::lda + C) * 2u; voffB[i] = (unsigned)(Rb * GT::ldb + C) * 2u; }
    constexpr size_t kstep = (size_t)(BK * 2);
    constexpr size_t hstepA = (size_t)HALF * GT::lda * 2, hstepB = (size_t)HALF * GT::ldb * 2;
    constexpr size_t tstepA = 2 * hstepA, tstepB = 2 * hstepB;
    const unsigned ldsw = (unsigned)wid * 1024u;
    const int aoff = lds_byte(wr * 64 + fr, fq * 8), boff = lds_byte(wc * 32 + fr, fq * 8);
#define PG8_SA(b, h) (((b) * 2 + (h)) * HTB)
#define PG8_SB(b, h) ((4 + (b) * 2 + (h)) * HTB)
#define PG8_STAGE(bufoff, gbase, voff) do { _Pragma("unroll") for (int _i = 0; _i < 2; ++_i) \
        __builtin_amdgcn_global_load_lds((const unsigned*)((const char*)(gbase) + (voff)[_i]), (PG8_LAS unsigned*)(lds + (bufoff) + ldsw + _i * 8192), 16, 0, 0); } while (0)
#define PG8_LDA(dst, b, h) do { _Pragma("unroll") for (int m = 0; m < 4; ++m) _Pragma("unroll") for (int k = 0; k < 2; ++k) dst[m][k] = *(const PG8_LAS bf16x8*)(lds + PG8_SA(b, h) + aoff + m * 2048 + k * 1024); } while (0)
#define PG8_LDB(dst, b, h) do { _Pragma("unroll") for (int n = 0; n < 2; ++n) _Pragma("unroll") for (int k = 0; k < 2; ++k) dst[n][k] = *(const PG8_LAS bf16x8*)(lds + PG8_SB(b, h) + boff + n * 2048 + k * 1024); } while (0)
#define PG8_MMA(ai, bj, At, Bt) do { __builtin_amdgcn_s_setprio(1); _Pragma("unroll") for (int m = 0; m < 4; ++m) _Pragma("unroll") for (int n = 0; n < 2; ++n) _Pragma("unroll") for (int k = 0; k < 2; ++k) \
        acc[ai][bj][m][n] = __builtin_amdgcn_mfma_f32_16x16x32_bf16(Bt[n][k], At[m][k], acc[ai][bj][m][n], 0, 0, 0); __builtin_amdgcn_s_setprio(0); } while (0)
#define PG8_WAIT_V(n) asm volatile("s_waitcnt vmcnt(" #n ")" ::: "memory")
#define PG8_WAIT_L(n) asm volatile("s_waitcnt lgkmcnt(" #n ")" ::: "memory")
#define PG8_BAR __builtin_amdgcn_s_barrier()
#define PG8_SCHED __builtin_amdgcn_sched_barrier(0)
    Unit cur, nxt; int ui = 0;
    if (!S.next(0, cur)) return;
    f32x4 acc[2][2][4][2];
#pragma unroll
    for (int a = 0; a < 2; ++a)
#pragma unroll
        for (int b = 0; b < 2; ++b)
#pragma unroll
            for (int m = 0; m < 4; ++m)
#pragma unroll
                for (int n = 0; n < 2; ++n) acc[a][b][m][n] = (f32x4){0.f, 0.f, 0.f, 0.f};
    bf16x8 At[4][2], B0[2][2], B1[2][2];
    const char* cA = (const char*)g.A + (size_t)cur.pm * tstepA + (size_t)S.a_off(cur) * 2; const char* cB = (const char*)g.Bt + (size_t)S.b_tile(cur) * tstepB + (size_t)S.b_koff(cur) * 2;
    S.a_ready(cur);
    if constexpr (SP2) {
        PG8_STAGE(PG8_SB(0, 0), cB, voffB); PG8_STAGE(PG8_SB(0, 1), cB + hstepB, voffB); PG8_STAGE(PG8_SA(0, 0), cA, voffA); PG8_STAGE(PG8_SA(0, 1), cA + hstepA, voffA);
        if (wr == 1) PG8_BAR;
        PG8_WAIT_V(2); PG8_BAR;
        PG8_STAGE(PG8_SB(1, 0), cB + kstep, voffB); PG8_STAGE(PG8_SA(1, 0), cA + kstep, voffA); PG8_STAGE(PG8_SB(1, 1), cB + hstepB + kstep, voffB);
        PG8_WAIT_V(6); PG8_BAR;
    } else {
        PG8_STAGE(PG8_SB(0, 0), cB, voffB); PG8_STAGE(PG8_SA(0, 0), cA, voffA); PG8_STAGE(PG8_SB(0, 1), cB + hstepB, voffB); PG8_STAGE(PG8_SA(0, 1), cA + hstepA, voffA);
        if (wr == 1) PG8_BAR;
        PG8_WAIT_V(4); PG8_BAR;
        PG8_STAGE(PG8_SB(1, 0), cB + kstep, voffB); PG8_STAGE(PG8_SA(1, 0), cA + kstep, voffA); PG8_STAGE(PG8_SB(1, 1), cB + hstepB + kstep, voffB);
        PG8_WAIT_V(6); PG8_BAR;
    }
    for (;;) {
        const bool has_next = S.next(ui + 1, nxt);
        const char* nA = has_next ? (const char*)g.A + (size_t)nxt.pm * tstepA + (size_t)S.a_off(nxt) * 2 : cA; const char* nB = has_next ? (const char*)g.Bt + (size_t)S.b_tile(nxt) * tstepB + (size_t)S.b_koff(nxt) * 2 : cB;
        for (int t = 0; t < nt; t += 2) {
            const bool last = (t == nt - 2);
            const char* a1 = cA + (size_t)(t + 1) * kstep;
            const char* a2 = last ? nA : cA + (size_t)(t + 2) * kstep; const char* b2 = last ? nB : cB + (size_t)(t + 2) * kstep;
            const char* a3 = a2 + kstep; const char* b3 = b2 + kstep;
            if (last && has_next) S.a_ready(nxt);
            if constexpr (SP2) {
            PG8_LDB(B0, 0, 0); PG8_LDB(B1, 0, 1); PG8_SCHED; PG8_LDA(At, 0, 0); PG8_STAGE(PG8_SA(1, 1), a1 + hstepA, voffA);
            PG8_WAIT_V(8); PG8_WAIT_L(0); PG8_BAR; PG8_MMA(0, 0, At, B0); PG8_MMA(0, 1, At, B1); PG8_BAR; PG8_SCHED;
            PG8_LDA(At, 0, 1); PG8_STAGE(PG8_SB(0, 0), b2, voffB); PG8_STAGE(PG8_SB(0, 1), b2 + hstepB, voffB); PG8_STAGE(PG8_SA(0, 0), a2, voffA);
            PG8_WAIT_V(8); PG8_WAIT_L(0); PG8_BAR; PG8_MMA(1, 0, At, B0); PG8_MMA(1, 1, At, B1); PG8_BAR; PG8_SCHED;
            PG8_LDB(B0, 1, 0); PG8_LDB(B1, 1, 1); PG8_SCHED; PG8_LDA(At, 1, 0); PG8_STAGE(PG8_SA(0, 1), a2 + hstepA, voffA);
            PG8_WAIT_V(8); PG8_WAIT_L(0); PG8_BAR; PG8_MMA(0, 0, At, B0); PG8_MMA(0, 1, At, B1); PG8_BAR; PG8_SCHED;
            PG8_LDA(At, 1, 1); PG8_STAGE(PG8_SB(1, 0), b3, voffB); PG8_STAGE(PG8_SB(1, 1), b3 + hstepB, voffB); PG8_STAGE(PG8_SA(1, 0), a3, voffA);
            PG8_WAIT_V(8); PG8_WAIT_L(0); PG8_BAR; PG8_MMA(1, 0, At, B0); PG8_MMA(1, 1, At, B1); PG8_BAR; PG8_SCHED;
            } else {
            PG8_LDB(B0, 0, 0); PG8_SCHED; PG8_LDA(At, 0, 0); PG8_STAGE(PG8_SA(1, 1), a1 + hstepA, voffA);
            PG8_WAIT_L(8); PG8_BAR; PG8_WAIT_L(0); PG8_MMA(0, 0, At, B0); PG8_BAR; PG8_SCHED;
            PG8_LDB(B1, 0, 1); PG8_STAGE(PG8_SB(0, 0), b2, voffB);
            PG8_BAR; PG8_WAIT_L(0); PG8_MMA(0, 1, At, B1); PG8_BAR;
            PG8_LDA(At, 0, 1); PG8_STAGE(PG8_SA(0, 0), a2, voffA);
            PG8_BAR; PG8_WAIT_L(0); PG8_MMA(1, 0, At, B0); PG8_BAR; PG8_SCHED;
            PG8_STAGE(PG8_SB(0, 1), b2 + hstepB, voffB);
            PG8_WAIT_V(6); PG8_BAR; PG8_MMA(1, 1, At, B1); PG8_BAR;
            PG8_LDB(B0, 1, 0); PG8_SCHED; PG8_LDA(At, 1, 0); PG8_STAGE(PG8_SA(0, 1), a2 + hstepA, voffA);
            PG8_WAIT_L(8); PG8_BAR; PG8_WAIT_L(0); PG8_MMA(0, 0, At, B0); PG8_BAR; PG8_SCHED;
            PG8_LDB(B1, 1, 1); PG8_STAGE(PG8_SB(1, 0), b3, voffB);
            PG8_BAR; PG8_WAIT_L(0); PG8_MMA(0, 1, At, B1); PG8_BAR;
            PG8_LDA(At, 1, 1); PG8_STAGE(PG8_SA(1, 0), a3, voffA);
            PG8_BAR; PG8_WAIT_L(0); PG8_MMA(1, 0, At, B0); PG8_BAR; PG8_SCHED;
            PG8_STAGE(PG8_SB(1, 1), b3 + hstepB, voffB);
            PG8_WAIT_V(6); PG8_BAR; PG8_MMA(1, 1, At, B1); PG8_BAR;
            }
        }
        if constexpr (ALIGN_EPI) { if (wr == 0) PG8_BAR; }
        if constexpr (!Epi::AFTER_DRAIN) { E(acc, cur, wr, wc, fr, fq); S.done(cur); }
        if (!has_next) break;
#pragma unroll
        for (int a = 0; a < 2; ++a)
#pragma unroll
            for (int b = 0; b < 2; ++b)
#pragma unroll
                for (int m = 0; m < 4; ++m)
#pragma unroll
                    for (int n = 0; n < 2; ++n) acc[a][b][m][n] = (f32x4){0.f, 0.f, 0.f, 0.f};
        cur = nxt; cA = nA; cB = nB; ++ui;
        if constexpr (ALIGN_EPI) { if (wr == 1) PG8_BAR; }
    }
    PG8_WAIT_V(0);
    if constexpr (!ALIGN_EPI) { if (wr == 0) PG8_BAR; }
    PG8_BAR;
    if constexpr (Epi::AFTER_DRAIN) { E.fused(acc, cur, wr, wc, fr, fq, lds, wid, lane); S.done(cur); }
#undef PG8_SA
#undef PG8_SB
#undef PG8_STAGE
#undef PG8_LDA
#undef PG8_LDB
#undef PG8_MMA
#undef PG8_WAIT_V
#undef PG8_WAIT_L
#undef PG8_BAR
#undef PG8_SCHED
}
}

#define LAS __attribute__((address_space(3)))
typedef unsigned short bf16_t;
typedef short bf16x8 __attribute__((ext_vector_type(8)));
typedef float f32x4 __attribute__((ext_vector_type(4)));
typedef unsigned u32x4 __attribute__((ext_vector_type(4)));
typedef unsigned u32x2 __attribute__((ext_vector_type(2)));

constexpr int D = 1024, DFF = 2816, NFF2 = 5632, INC = 7984, PN = 5120, PREAL = 4912, MGN = 3072;
constexpr int MTOT = 24576, MLAT = 16384, GROWS = 8192;
constexpr float EPSN = 1e-6f;
constexpr size_t MiB = 1u << 20;
constexpr size_t WS_MOD = 1 * MiB, WS_MODP = 2 * MiB, WS_POS = 5 * MiB, WS_DEC = 6 * MiB, WS_SC = 7 * MiB;
constexpr size_t WS_W = 8 * MiB;
constexpr size_t W_FFIN = 0, W_FFOUT = W_FFIN + 2ull * NFF2 * D * 2, W_P = W_FFOUT + 2ull * D * DFF * 2, W_MG = W_P + (size_t)PN * D * 2,
                 W_B = W_MG + (size_t)MGN * D * 2, W_O3 = W_B + 3072ull * 512 * 2, W_END = W_O3 + 1024ull * 3072 * 2;
static_assert(W_END <= 58 * MiB, "weights region");
constexpr size_t WS_XN = 66 * MiB, WS_A = 114 * MiB, WS_BIG = 210 * MiB, WS_END = 370 * MiB;
constexpr size_t BIG_US = 80 * MiB, BIG_OB = 128 * MiB;
constexpr size_t OFF_YP = 0, OFF_YS = 8388608, OFF_C = 25165824, OFF_N = 29360128, OFF_M = 29392896, OFF_G = 29393408, OFF_H = 33587712;
constexpr int LDS_BYTES = 147456;

struct Args { const float* in[23]; float* out; unsigned char* ws; };
enum { I_XP = 0, I_XS, I_C, I_SC, I_SN, I_SM, I_SG, I_SH, I_CCTX, I_WADA, I_BADA, I_NPRE, I_NPOST, I_WFIN, I_WFOUT, I_WIN, I_GB, I_GWUP, I_GLB, I_HGAM, I_HN, I_WBR, I_WOUT };
__device__ __forceinline__ const float* inp(const Args& a, int i) { asm volatile("" : "+s"(i)); return a.in[i]; }

__device__ __forceinline__ unsigned f2bf(float f) { unsigned u = __float_as_uint(f); return (u + 0x7fffu + ((u >> 16) & 1u)) >> 16; }
__device__ __forceinline__ unsigned pk2(float lo, float hi) { return f2bf(lo) | (f2bf(hi) << 16); }
__device__ __forceinline__ float bf2f(bf16_t h) { return __uint_as_float(((unsigned)h) << 16); }
__device__ __forceinline__ float bflo(unsigned w) { return __uint_as_float(w << 16); }
__device__ __forceinline__ float bfhi(unsigned w) { return __uint_as_float(w & 0xffff0000u); }
__device__ __forceinline__ float sigmoidf_(float x) { return 1.0f / (1.0f + __expf(-x)); }
__device__ __forceinline__ float siluf_(float x) { return x / (1.0f + __expf(-x)); }
__device__ __forceinline__ float logsigf_(float x) { return fminf(x, 0.f) - __logf(1.0f + __expf(-fabsf(x))); }
__device__ __forceinline__ float wave_sum(float v) {
#pragma unroll
    for (int o = 1; o < 64; o <<= 1) v += __shfl_xor(v, o);
    return v;
}
#define LDS_WAIT() asm volatile("s_waitcnt lgkmcnt(0)" ::: "memory")

#define XB_TMO      128
#define XB_XCNT(j)  (256  + 64 * (j))
#define XB_XSUB(j)  (1280 + 64 * (j))
#define XB_XGEN(j)  (2304 + 64 * (j))
#define XB_TOP      3328
#define XB_TOPGEN   3392
#define XCD_BAR_WORDS 3456
#define XB_SPIN_CAP (1u << 18)

__device__ __forceinline__ unsigned xb_ld(unsigned* p)              { return __hip_atomic_load(p, __ATOMIC_RELAXED, __HIP_MEMORY_SCOPE_AGENT); }
__device__ __forceinline__ unsigned xb_add(unsigned* p, unsigned v) { return __hip_atomic_fetch_add(p, v, __ATOMIC_RELAXED, __HIP_MEMORY_SCOPE_AGENT); }
__device__ __forceinline__ unsigned xb_xcc_id() { return (unsigned)__builtin_amdgcn_s_getreg((3 << 11) | 20) & 0xFu; }
#define XB_SPIN(cond, bar) do { unsigned _sp = 0; while (cond) { __builtin_amdgcn_s_sleep(1); \
    if ((++_sp & 255u) == 0u) { if (xb_ld(&(bar)[XB_TMO])) break; if (_sp > XB_SPIN_CAP) { atomicAdd(&(bar)[XB_TMO], 1u); break; } } } } while (0)

struct XcdBarrier {
    unsigned* bar; unsigned x;
    volatile LAS unsigned* st;
};

__device__ __forceinline__ XcdBarrier xcd_barrier_post(unsigned* bar, volatile LAS unsigned* st) {
    XcdBarrier b; b.bar = bar; b.x = xb_xcc_id(); b.st = st;
    if (threadIdx.x == 0) (void)xb_add(&bar[XB_XCNT(b.x)], 1u);
    return b;
}
__device__ __forceinline__ void xcd_barrier_complete(unsigned* bar, unsigned x, unsigned& nloc, unsigned& nx) {
    const unsigned G = gridDim.x * gridDim.y * gridDim.z;
    unsigned sum, cnt, mine, sp = 0u;
    for (;;) {
        sum = 0u; cnt = 0u; mine = 0u;
#pragma unroll
        for (unsigned j = 0; j < 16; ++j) { const unsigned c = xb_ld(&bar[XB_XCNT(j)]); sum += c; cnt += (c > 0u) ? 1u : 0u; mine = (j == x) ? c : mine; }
        if (sum == G) break;
        __builtin_amdgcn_s_sleep(1);
        if ((++sp & 255u) == 0u) { if (xb_ld(&bar[XB_TMO])) break; if (sp > XB_SPIN_CAP) { atomicAdd(&bar[XB_TMO], 1u); break; } }
    }
    nloc = mine > 0u ? mine : 1u; nx = cnt > 0u ? cnt : 1u;
}

__device__ __attribute__((noinline)) void xcd_barrier_ni(unsigned* bar_, unsigned st_off) {
    XcdBarrier b; b.bar = bar_; b.x = xb_xcc_id(); b.st = (volatile LAS unsigned*)(size_t)st_off;
    asm volatile("s_waitcnt vmcnt(0)" ::: "memory");
    __syncthreads();
    if (threadIdx.x == 0) {
        unsigned* bar = b.bar;
        __builtin_amdgcn_s_waitcnt(0);
        unsigned nloc = b.st[0], nx = b.st[1];
        if (nloc == 0u) { xcd_barrier_complete(bar, b.x, nloc, nx); b.st[0] = nloc; b.st[1] = nx; }
        const unsigned old = xb_add(&bar[XB_XSUB(b.x)], 1u);
        const unsigned gen = old / nloc;
        if (old + 1u == (gen + 1u) * nloc) {
            __builtin_amdgcn_fence(__ATOMIC_RELEASE, "agent");
            asm volatile("s_waitcnt vmcnt(0)" ::: "memory");
            const unsigned og = xb_add(&bar[XB_TOP], 1u);
            const unsigned tg = og / nx;
            if (og + 1u == (tg + 1u) * nx) xb_add(&bar[XB_TOPGEN], 1u);
            else XB_SPIN(xb_ld(&bar[XB_TOPGEN]) == tg, bar);
            __builtin_amdgcn_fence(__ATOMIC_ACQUIRE, "agent");
            xb_add(&bar[XB_XGEN(b.x)], 1u);
            asm volatile("s_waitcnt vmcnt(0)" ::: "memory");
        } else {
            XB_SPIN(xb_ld(&bar[XB_XGEN(b.x)]) == gen, bar);
            __builtin_amdgcn_fence(__ATOMIC_ACQUIRE, "agent");
            asm volatile("s_waitcnt vmcnt(0)" ::: "memory");
        }
    }
    __syncthreads();
}


struct EpiBf16 {
    static constexpr bool PERM = true, AFTER_DRAIN = false;
    bf16_t* O; int ldc; int nsplit; size_t sstride;
    __device__ __forceinline__ void operator()(const f32x4 (&acc)[2][2][4][2], const pg8::Unit& u, int wr, int wc, int fr, int fq) const {
        int pn = u.pn; bf16_t* Ob = O; if (nsplit) { Ob += (size_t)(pn / nsplit) * sstride; pn = pn % nsplit; }
        const int row0 = u.pm * 256 + wr * 64 + fr, col0 = pn * 256 + wc * 32 + 8 * fq;
#pragma unroll
        for (int ai = 0; ai < 2; ++ai)
#pragma unroll
            for (int m = 0; m < 4; ++m) { bf16_t* rowp = Ob + (size_t)(row0 + ai * 128 + m * 16) * ldc + col0;
#pragma unroll
                for (int bj = 0; bj < 2; ++bj) { const f32x4 v0 = acc[ai][bj][m][0], v1 = acc[ai][bj][m][1];
                    u32x4 w; w.x = pk2(v0[0], v0[1]); w.y = pk2(v0[2], v0[3]); w.z = pk2(v1[0], v1[1]); w.w = pk2(v1[2], v1[3]);
                    *(u32x4*)(rowp + bj * 128) = w; } }
    }
};
struct EpiGateMul {
    static constexpr bool PERM = true, AFTER_DRAIN = false;
    bf16_t* O; int ldc;
    __device__ __forceinline__ void operator()(const f32x4 (&acc)[2][2][4][2], const pg8::Unit& u, int wr, int wc, int fr, int fq) const {
        const int row0 = u.pm * 256 + wr * 64 + fr, col0 = u.pn * 256 + wc * 32 + 8 * fq;
#pragma unroll
        for (int ai = 0; ai < 2; ++ai)
#pragma unroll
            for (int m = 0; m < 4; ++m) { bf16_t* rowp = O + (size_t)(row0 + ai * 128 + m * 16) * ldc + col0;
#pragma unroll
                for (int bj = 0; bj < 2; ++bj) { const f32x4 v0 = acc[ai][bj][m][0], v1 = acc[ai][bj][m][1];
                    const u32x4 b = *(const u32x4*)(rowp + bj * 128);
                    u32x4 w; w.x = pk2(sigmoidf_(v0[0]) * bflo(b.x), sigmoidf_(v0[1]) * bfhi(b.x)); w.y = pk2(sigmoidf_(v0[2]) * bflo(b.y), sigmoidf_(v0[3]) * bfhi(b.y));
                    w.z = pk2(sigmoidf_(v1[0]) * bflo(b.z), sigmoidf_(v1[1]) * bfhi(b.z)); w.w = pk2(sigmoidf_(v1[2]) * bflo(b.w), sigmoidf_(v1[3]) * bfhi(b.w));
                    *(u32x4*)(rowp + bj * 128) = w; } }
    }
};
struct EpiSwiGLU {
    static constexpr bool PERM = true, AFTER_DRAIN = false;
    bf16_t* H; int ldh;
    __device__ __forceinline__ void operator()(const f32x4 (&acc)[2][2][4][2], const pg8::Unit& u, int wr, int wc, int fr, int fq) const {
        const int row0 = u.pm * 256 + wr * 64 + fr, col0 = (u.pn * 256 + wc * 32 + 8 * fq) >> 1;
#pragma unroll
        for (int ai = 0; ai < 2; ++ai)
#pragma unroll
            for (int m = 0; m < 4; ++m) { bf16_t* rowp = H + (size_t)(row0 + ai * 128 + m * 16) * ldh + col0;
#pragma unroll
                for (int bj = 0; bj < 2; ++bj) { const f32x4 g = acc[ai][bj][m][0], up = acc[ai][bj][m][1];
                    u32x2 w; w.x = pk2(siluf_(g[0]) * up[0], siluf_(g[1]) * up[1]); w.y = pk2(siluf_(g[2]) * up[2], siluf_(g[3]) * up[3]);
                    *(u32x2*)(rowp + bj * 64) = w; } }
    }
};
struct EpiF32 {
    static constexpr bool PERM = false, AFTER_DRAIN = false;
    float* Y; int ldc;
    __device__ __forceinline__ void operator()(const f32x4 (&acc)[2][2][4][2], const pg8::Unit& u, int wr, int wc, int fr, int fq) const {
        const int row0 = u.pm * 256 + wr * 64 + fr, col0 = u.pn * 256 + wc * 32 + 4 * fq;
#pragma unroll
        for (int ai = 0; ai < 2; ++ai)
#pragma unroll
            for (int m = 0; m < 4; ++m) { float* rowp = Y + (size_t)(row0 + ai * 128 + m * 16) * ldc + col0;
#pragma unroll
                for (int bj = 0; bj < 2; ++bj)
#pragma unroll
                    for (int n = 0; n < 2; ++n) *(f32x4*)(rowp + bj * 128 + n * 16) = acc[ai][bj][m][n]; }
    }
};

template <class Map>
__device__ __forceinline__ void transpose_item(const float* W, int K, int N, LAS float* scr, int item, int lane, const Map& map) {
    const int nblk = (N + 31) / 32, kb = item / nblk, nb = item % nblk, k0 = 64 * kb, n0 = 32 * nb;
    const int nn = n0 + (lane & 31); const bool ok = nn < N;
#pragma unroll 8
    for (int i = 0; i < 32; ++i) { const int kk = 2 * i + (lane >> 5); scr[kk * 33 + (lane & 31)] = ok ? W[(size_t)(k0 + kk) * N + nn] : 0.f; }
    LDS_WAIT(); asm volatile("" ::: "memory");
    const int c = lane & 7;
#pragma unroll
    for (int j = 0; j < 4; ++j) { const int n = (lane >> 3) + 8 * j; const LAS float* s = scr + (8 * c) * 33 + n;
        u32x4 o; o.x = pk2(s[0 * 33], s[1 * 33]); o.y = pk2(s[2 * 33], s[3 * 33]); o.z = pk2(s[4 * 33], s[5 * 33]); o.w = pk2(s[6 * 33], s[7 * 33]);
        if (n0 + n < N) map(n0 + n, k0 + 8 * c, o); }
    LDS_WAIT(); asm volatile("" ::: "memory");
}

__device__ __forceinline__ void convert_weights(const Args& a, LAS unsigned char* lds, int l, int gw, int NGW, int lane, int wave) {
    LAS float* scr = (LAS float*)(lds + wave * 16384);
    unsigned char* wb = a.ws + WS_W;
    constexpr int I_FI = 16 * 176, I_FO = 44 * 32, I_IN = 16 * 250, I_BR = 8 * 32, I_OU = 16 * 32;
    constexpr int NITEMS = 2 * I_FI + 2 * I_FO + I_IN + 3 * I_BR + I_OU;
    for (int it = gw; it < NITEMS; it += NGW) {
        int r = it;
        if (r < 2 * I_FI) { const int f = r / I_FI; r -= f * I_FI; bf16_t* dst = (bf16_t*)(wb + W_FFIN) + (size_t)f * NFF2 * D;
            transpose_item(inp(a, I_WFIN) + (size_t)(l * 2 + f) * D * NFF2, D, NFF2, scr, r, lane,
                [=](int n, int k, u32x4 o) { const int h = n < DFF ? n : n - DFF; const int row = 8 * (h >> 2) + (n < DFF ? 0 : 4) + (h & 3); *(u32x4*)(dst + (size_t)row * D + k) = o; });
            continue; }
        r -= 2 * I_FI;
        if (r < 2 * I_FO) { const int f = r / I_FO; r -= f * I_FO; bf16_t* dst = (bf16_t*)(wb + W_FFOUT) + (size_t)f * D * DFF;
            transpose_item(inp(a, I_WFOUT) + (size_t)(l * 2 + f) * DFF * D, DFF, D, scr, r, lane,
                [=](int n, int k, u32x4 o) { *(u32x4*)(dst + (size_t)n * DFF + k) = o; });
            continue; }
        r -= 2 * I_FO;
        if (r < I_IN) { bf16_t* dp = (bf16_t*)(wb + W_P); bf16_t* dm = (bf16_t*)(wb + W_MG);
            transpose_item(inp(a, I_WIN) + (size_t)l * D * INC, D, INC, scr, r, lane,
                [=](int n, int k, u32x4 o) { if (n < PREAL) *(u32x4*)(dp + (size_t)n * D + k) = o; else *(u32x4*)(dm + (size_t)(n - PREAL) * D + k) = o; });
            continue; }
        r -= I_IN;
        if (r < 3 * I_BR) { const int nb = r / I_BR; r -= nb * I_BR; bf16_t* dst = (bf16_t*)(wb + W_B) + (size_t)nb * 1024 * 512;
            transpose_item(inp(a, I_WBR) + (size_t)(l * 3 + nb) * 512 * D, 512, D, scr, r, lane,
                [=](int n, int k, u32x4 o) { *(u32x4*)(dst + (size_t)n * 512 + k) = o; });
            continue; }
        r -= 3 * I_BR;
        { bf16_t* dst = (bf16_t*)(wb + W_O3);
            transpose_item(inp(a, I_WOUT) + (size_t)l * D * D, D, D, scr, r, lane,
                [=](int n, int k, u32x4 o) { bf16_t* p = dst + (size_t)n * 3072 + k; *(u32x4*)p = o; *(u32x4*)(p + 1024) = o; *(u32x4*)(p + 2048) = o; }); }
    }
    { u32x4* z = (u32x4*)((bf16_t*)(wb + W_P) + (size_t)PREAL * D); const int nz = (PN - PREAL) * D * 2 / 16;
      for (int i = gw * 64 + lane; i < nz; i += NGW * 64) z[i] = (u32x4){0u, 0u, 0u, 0u}; }
}

__device__ __forceinline__ void ada_partial(const Args& a, int gw, int NGW, int lane) {
    float* modp = (float*)(a.ws + WS_MODP);
    for (int it = gw; it < 2 * 144 * 8; it += NGW) {
        const int ks = it & 7, cgp = (it >> 3) % 144, l = it / (8 * 144);
        const int col = cgp * 64 + lane;
        const float* w = inp(a, I_WADA) + ((size_t)l * D + ks * 128) * 9216 + col;
        float acc[5] = {0.f, 0.f, 0.f, 0.f, 0.f};
#pragma unroll 4
        for (int k = 0; k < 128; ++k) { const float wv = w[(size_t)k * 9216]; const int kk = ks * 128 + k;
            acc[0] += siluf_(inp(a, I_CCTX)[kk]) * wv;
#pragma unroll
            for (int i = 0; i < 4; ++i) acc[1 + i] += siluf_(inp(a, I_C)[i * D + kk]) * wv; }
#pragma unroll
        for (int i = 0; i < 5; ++i) modp[((size_t)(ks * 2 + l) * 5 + i) * 9216 + col] = acc[i];
    }
}

struct RowOp { int src_input, has_y; float coef; const float* npost; const float* mdg_base; int has_xn; const float* npre; const float* md_base; int si; int add_pos; };
template <int NR>
__device__ __forceinline__ void rowwise(const Args& a, const RowOp& op, const int (&rs)[NR], int lane) {
    f32x4 v[NR][4]; u32x2 yb[NR][4], yb2[NR][4]; float* xd[NR]; bool lat[NR]; int cv[NR];
#pragma unroll
    for (int q = 0; q < NR; ++q) { const int r = rs[q]; lat[q] = r < MLAT; cv[q] = lat[q] ? 1 + (r >> 12) : 0;
        const float* xs = op.src_input ? (lat[q] ? inp(a, I_XS) + (size_t)r * D : inp(a, I_XP) + (size_t)(r - MLAT) * D)
                                       : (lat[q] ? a.out + OFF_YS + (size_t)r * D : a.out + OFF_YP + (size_t)(r - MLAT) * D);
        xd[q] = lat[q] ? a.out + OFF_YS + (size_t)r * D : a.out + OFF_YP + (size_t)(r - MLAT) * D;
#pragma unroll
        for (int j = 0; j < 4; ++j) v[q][j] = *(const f32x4*)(xs + 4 * lane + 256 * j);
        if (op.has_y) { const bf16_t* yr = (const bf16_t*)(a.ws + WS_A) + (size_t)r * D;
#pragma unroll
            for (int j = 0; j < 4; ++j) { yb[q][j] = *(const u32x2*)(yr + 4 * lane + 256 * j); yb2[q][j] = *(const u32x2*)(yr + (size_t)MTOT * D + 4 * lane + 256 * j); } } }
#pragma unroll
    for (int q = 0; q < NR; ++q) { const int r = rs[q];
        if (op.has_y) {
            f32x4 y[4]; float ss = 0.f;
#pragma unroll
            for (int j = 0; j < 4; ++j) { y[j] = (f32x4){bflo(yb[q][j].x) + bflo(yb2[q][j].x), bfhi(yb[q][j].x) + bfhi(yb2[q][j].x), bflo(yb[q][j].y) + bflo(yb2[q][j].y), bfhi(yb[q][j].y) + bfhi(yb2[q][j].y)}; ss += (y[j].x * y[j].x + y[j].y * y[j].y) + (y[j].z * y[j].z + y[j].w * y[j].w); }
            const float rr = rsqrtf(wave_sum(ss) * (1.f / D) + EPSN) * op.coef;
            const float* gp = op.mdg_base + (size_t)cv[q] * 9216;
#pragma unroll
            for (int j = 0; j < 4; ++j) { const f32x4 w = *(const f32x4*)(op.npost + 4 * lane + 256 * j), gg = *(const f32x4*)(gp + 4 * lane + 256 * j);
                v[q][j] = v[q][j] + gg * (y[j] * rr) * w; *(f32x4*)(xd[q] + 4 * lane + 256 * j) = v[q][j]; }
        }
        if (op.has_xn) {
            float ss = 0.f;
#pragma unroll
            for (int j = 0; j < 4; ++j) ss += (v[q][j].x * v[q][j].x + v[q][j].y * v[q][j].y) + (v[q][j].z * v[q][j].z + v[q][j].w * v[q][j].w);
            const float rr = rsqrtf(wave_sum(ss) * (1.f / D) + EPSN);
            const float* sh = op.md_base + (size_t)cv[q] * 9216 + (size_t)op.si * D; const float* sc = sh + D;
            const float* pos = (const float*)(a.ws + WS_POS); const int t = r & 4095;
            bf16_t* xo = (bf16_t*)(a.ws + WS_XN) + (size_t)r * D;
#pragma unroll
            for (int j = 0; j < 4; ++j) { const int c = 4 * lane + 256 * j; const f32x4 w = *(const f32x4*)(op.npre + c), s1 = *(const f32x4*)(sc + c), s0 = *(const f32x4*)(sh + c);
                f32x4 o = (v[q][j] * rr) * w * (s1 + 1.0f) + s0;
                if (op.add_pos && lat[q]) { const float* pp = (c < 512) ? pos + (size_t)(t >> 6) * 512 + c : pos + (size_t)(t & 63) * 512 + (c - 512); o = o + *(const f32x4*)pp; }
                u32x2 pk; pk.x = pk2(o.x, o.y); pk.y = pk2(o.z, o.w); *(u32x2*)(xo + c) = pk; }
        }
    }
}
__device__ __forceinline__ void rowwise_all(const Args& a, const RowOp& op, int gw, int NGW, int lane) {
    int r = gw;
    for (; r + NGW < MTOT; r += 2 * NGW) { const int rs[2] = {r, r + NGW}; rowwise<2>(a, op, rs, lane); }
    if (r < MTOT) { const int rs[1] = {r}; rowwise<1>(a, op, rs, lane); }
}

constexpr int C_MQ = 0, C_MK = 256, C_MV = 512, C_MO = 1024, C_MIF = 1536, C_GQ = 1552, C_GK = 1808, C_GV = 2064, C_GR = 2576, C_GLR = 3088, C_HQ = 3120, C_HF = 3376, C_HV = 3888, C_HG = 4400;

struct ItemInfo { int br, dir, head, seq, c, T, NC; };
__device__ __forceinline__ ItemInfo item_info(int g, int it) { ItemInfo I; const int hdb = it % 24, cgl = it / 24; I.br = hdb >> 3; I.dir = (hdb >> 2) & 1; I.head = hdb & 3;
    I.T = g < 2 ? 4096 : 256; I.NC = I.T >> 6; I.seq = cgl / I.NC; I.c = cgl % I.NC; return I; }
__device__ __forceinline__ int item_row(const ItemInfo& I, int s) { const int tau = I.c * 64 + s; return I.seq * I.T + (I.dir ? I.T - 1 - tau : tau); }
__device__ __forceinline__ float lb_of(const Args& a, int l, int ch) { if (l == 0) return 0.f; const float g0 = inp(a, I_HGAM)[ch], g1 = inp(a, I_HGAM)[256 + ch]; return 1.0f / (1.0f + expf(g0 - g1)); }

template <bool NEEDQ>
__device__ __forceinline__ void load_gated(const Args& a, const bf16_t* P, const ItemInfo& I, int l, int d, int sg, float (&qv)[8], float (&kv)[8], float (&la)[8]) {
    const int ch = I.head * 64 + d;
    if (I.br == 1) {
        float wup[16];
        const float* wp = inp(a, I_GWUP) + ((size_t)(l * 2 + I.dir) * 16) * 256 + ch;
#pragma unroll
        for (int r = 0; r < 16; ++r) wup[r] = wp[r * 256];
        const float gb = inp(a, I_GLB)[(l * 2 + I.dir) * 256 + ch];
#pragma unroll
        for (int i = 0; i < 8; ++i) { const bf16_t* pr = P + (size_t)item_row(I, 8 * sg + i) * PN;
            const u32x4 g0 = *(const u32x4*)(pr + C_GLR + I.dir * 16), g1 = *(const u32x4*)(pr + C_GLR + I.dir * 16 + 8);
            float z = gb;
            z += bflo(g0.x) * wup[0] + bfhi(g0.x) * wup[1] + bflo(g0.y) * wup[2] + bfhi(g0.y) * wup[3] + bflo(g0.z) * wup[4] + bfhi(g0.z) * wup[5] + bflo(g0.w) * wup[6] + bfhi(g0.w) * wup[7];
            z += bflo(g1.x) * wup[8] + bfhi(g1.x) * wup[9] + bflo(g1.y) * wup[10] + bfhi(g1.y) * wup[11] + bflo(g1.z) * wup[12] + bfhi(g1.z) * wup[13] + bflo(g1.w) * wup[14] + bfhi(g1.w) * wup[15];
            la[i] = logsigf_(z) * (1.0f / 16.0f);
            if (NEEDQ) qv[i] = bf2f(pr[C_GQ + ch]) * 0.125f; kv[i] = bf2f(pr[C_GK + ch]); }
    } else {
        const float lb = lb_of(a, l, ch);
#pragma unroll
        for (int i = 0; i < 8; ++i) { const bf16_t* pr = P + (size_t)item_row(I, 8 * sg + i) * PN;
            const float z = bf2f(pr[C_HF + I.dir * 256 + ch]); const float sg_ = sigmoidf_(z);
            la[i] = (lb == 0.f) ? logsigf_(z) : __logf(lb + (1.0f - lb) * sg_);
            if (NEEDQ) qv[i] = bf2f(pr[C_HQ + ch]) * 1.0f;
            kv[i] = (1.0f - lb) * (1.0f - sg_); }
    }
}
template <bool NEEDQ>
__device__ __forceinline__ void load_mlstm(const Args& a, const bf16_t* P, const ItemInfo& I, int l, int d, int sg, float (&qv)[8], float (&kv)[8], float (&lf)[8], float (&li)[8]) {
    const float bi = inp(a, I_GB)[((l * 2 + I.dir) * 2 + 0) * 4 + I.head], bf_ = inp(a, I_GB)[((l * 2 + I.dir) * 2 + 1) * 4 + I.head];
#pragma unroll
    for (int i = 0; i < 8; ++i) { const bf16_t* pr = P + (size_t)item_row(I, 8 * sg + i) * PN;
        li[i] = bf2f(pr[C_MIF + I.dir * 8 + I.head]) + bi; lf[i] = logsigf_(bf2f(pr[C_MIF + I.dir * 8 + 4 + I.head]) + bf_);
        if (NEEDQ) qv[i] = bf2f(pr[C_MQ + I.head * 64 + d]) * 0.125f; kv[i] = bf2f(pr[C_MK + I.head * 64 + d]); }
}
__device__ __forceinline__ void stage_vT(const bf16_t* P, const ItemInfo& I, LAS bf16_t* Y, int pitch, int tid) {
    const int s = tid >> 3, eg = tid & 7; const int vb = I.br == 0 ? C_MV : (I.br == 1 ? C_GV : C_HV);
    const bf16_t* pv = P + (size_t)item_row(I, s) * PN + vb + I.head * 128 + 16 * eg;
    const u32x4 v0 = *(const u32x4*)pv, v1 = *(const u32x4*)(pv + 8);
    const unsigned wds[8] = {v0.x, v0.y, v0.z, v0.w, v1.x, v1.y, v1.z, v1.w};
#pragma unroll
    for (int i = 0; i < 8; ++i) { float x0 = bflo(wds[i]), x1 = bfhi(wds[i]); if (I.br == 2) { x0 = siluf_(x0); x1 = siluf_(x1); }
        Y[(16 * eg + 2 * i) * pitch + s] = (bf16_t)f2bf(x0); Y[(16 * eg + 2 * i + 1) * pitch + s] = (bf16_t)f2bf(x1); }
}
__device__ __forceinline__ bf16x8 ldfrag(const LAS bf16_t* T, int pitch, int row0, int k0, int lane) { return *(const LAS bf16x8*)(T + (row0 + (lane & 15)) * pitch + k0 + 8 * (lane >> 4)); }

__device__ __forceinline__ void scan_s1(const Args& a, LAS unsigned char* lds, int l, int g, int it) {
    int tid_ = threadIdx.x; asm volatile("" : "+v"(tid_)); const int tid = tid_, d = tid & 63, lane = d, sg = __builtin_amdgcn_readfirstlane(tid >> 6);
    const ItemInfo I = item_info(g, it);
    const bf16_t* P = (const bf16_t*)(a.ws + WS_BIG);
    bf16_t* US = (bf16_t*)(a.ws + WS_BIG + BIG_US) + (size_t)it * 8192;
    float* DEC = (float*)(a.ws + WS_DEC) + (size_t)it * 64; float* SC = (float*)(a.ws + WS_SC) + (size_t)it * 4;
    LAS bf16_t* XT = (LAS bf16_t*)lds;
    LAS bf16_t* YV = (LAS bf16_t*)(lds + 9216);
    LAS float* TOT = (LAS float*)(lds + 9216 + 20736);
    LAS float* TMX = TOT + 512;
    float qv[8], kv[8], x0[8], x1[8];
    if (I.br == 0) {
        load_mlstm<false>(a, P, I, l, d, sg, qv, kv, x0, x1);
        float run = 0.f;
#pragma unroll
        for (int i = 0; i < 8; ++i) { run += x0[i]; x0[i] = run; }
        TOT[sg * 64 + d] = run; LDS_WAIT(); __syncthreads();
        float pre = 0.f, tot = 0.f;
#pragma unroll
        for (int w = 0; w < 8; ++w) { const float t = TOT[w * 64 + d]; if (w < sg) pre += t; tot += t; }
        float mx = -3.0e38f;
#pragma unroll
        for (int i = 0; i < 8; ++i) { x0[i] = tot - (pre + x0[i]) + x1[i]; mx = fmaxf(mx, x0[i]); }
        TMX[sg * 64 + d] = mx; LDS_WAIT(); __syncthreads();
        float mlw = -3.0e38f;
#pragma unroll
        for (int w = 0; w < 8; ++w) mlw = fmaxf(mlw, TMX[w * 64 + d]);
#pragma unroll
        for (int i = 0; i < 8; ++i) kv[i] *= __expf(x0[i] - mlw);
        if (tid == 0) { SC[0] = mlw; SC[1] = tot; }
        for (int idx = tid; idx < 16 * 64; idx += 512) YV[(128 + (idx >> 6)) * 72 + (idx & 63)] = (bf16_t)((idx >> 6) == 0 ? 0x3F80 : 0);
    } else {
        load_gated<false>(a, P, I, l, d, sg, qv, kv, x0);
        float run = 0.f;
#pragma unroll
        for (int i = 0; i < 8; ++i) { run += x0[i]; x0[i] = run; }
        TOT[sg * 64 + d] = run; LDS_WAIT(); __syncthreads();
        float pre = 0.f, tot = 0.f;
#pragma unroll
        for (int w = 0; w < 8; ++w) { const float t = TOT[w * 64 + d]; if (w < sg) pre += t; tot += t; }
#pragma unroll
        for (int i = 0; i < 8; ++i) kv[i] *= __expf(tot - (pre + x0[i]));
        if (sg == 0) DEC[d] = __expf(tot);
    }
    { u32x4 w; w.x = pk2(kv[0], kv[1]); w.y = pk2(kv[2], kv[3]); w.z = pk2(kv[4], kv[5]); w.w = pk2(kv[6], kv[7]); *(LAS u32x4*)(XT + d * 72 + 8 * sg) = w; }
    stage_vT(P, I, YV, 72, tid);
    LDS_WAIT(); __syncthreads();
    f32x4 acc[4];
#pragma unroll
    for (int mt = 0; mt < 4; ++mt) acc[mt] = (f32x4){0.f, 0.f, 0.f, 0.f};
#pragma unroll
    for (int ks = 0; ks < 2; ++ks) { const bf16x8 b = ldfrag(YV, 72, 16 * sg, 32 * ks, lane);
#pragma unroll
        for (int mt = 0; mt < 4; ++mt) acc[mt] = __builtin_amdgcn_mfma_f32_16x16x32_bf16(ldfrag(XT, 72, 16 * mt, 32 * ks, lane), b, acc[mt], 0, 0, 0); }
    { const int e = 16 * sg + (lane & 15);
#pragma unroll
      for (int mt = 0; mt < 4; ++mt) { u32x2 o; o.x = pk2(acc[mt][0], acc[mt][1]); o.y = pk2(acc[mt][2], acc[mt][3]); *(u32x2*)(US + e * 64 + 16 * mt + 4 * (lane >> 4)) = o; } }
    if (I.br == 0 && sg < 4) {
        f32x4 an = (f32x4){0.f, 0.f, 0.f, 0.f};
#pragma unroll
        for (int ks = 0; ks < 2; ++ks) an = __builtin_amdgcn_mfma_f32_16x16x32_bf16(ldfrag(XT, 72, 16 * sg, 32 * ks, lane), ldfrag(YV, 72, 128, 32 * ks, lane), an, 0, 0, 0);
        if ((lane & 15) == 0) { const int d0 = 16 * sg + 4 * (lane >> 4); DEC[d0] = an[0]; DEC[d0 + 1] = an[1]; DEC[d0 + 2] = an[2]; DEC[d0 + 3] = an[3]; }
    }
    __syncthreads();
}

__device__ __forceinline__ void scan_s2(const Args& a, int l, int g) {
    const int T = g < 2 ? 4096 : 256, NC = T >> 6, nseq = g < 2 ? 2 : 32, nslot = nseq * 24 * 1024;
    bf16_t* USb = (bf16_t*)(a.ws + WS_BIG + BIG_US); float* DECb = (float*)(a.ws + WS_DEC); float* SCb = (float*)(a.ws + WS_SC);
    int tid_ = threadIdx.x; asm volatile("" : "+v"(tid_));
    for (int slot = blockIdx.x * 512 + tid_; slot < nslot; slot += gridDim.x * 512) {
        const int sub = slot & 1023, stream = slot >> 10, hdb = stream % 24, seq = stream / 24, br = hdb >> 3, dir = (hdb >> 2) & 1, head = hdb & 3;
        const int e = sub >> 3, d0 = (sub & 7) * 8;
        float S[8], nst[8], mst = 0.f;
#pragma unroll
        for (int i = 0; i < 8; ++i) { S[i] = 0.f; nst[i] = 0.f; }
        if (g < 2) { const int b = g * 2 + seq; const size_t sidx = (size_t)((b * 2 + l) * 2 + dir) * 4 + head;
            const float* sp = (br == 0 ? inp(a, I_SC) : (br == 1 ? inp(a, I_SG) : inp(a, I_SH))) + sidx * 8192;
#pragma unroll
            for (int i = 0; i < 8; ++i) S[i] = sp[(d0 + i) * 128 + e];
            if (br == 0) { mst = inp(a, I_SM)[sidx];
#pragma unroll
                for (int i = 0; i < 8; ++i) nst[i] = inp(a, I_SN)[sidx * 64 + d0 + i]; } }
        const bool nrow = (br == 0) && (e == 0);
        for (int c0 = 0; c0 < NC; c0 += 4) {
            u32x4 ub[4]; f32x4 q0[4], q1[4]; float m0[4], m1[4];
#pragma unroll
            for (int j = 0; j < 4; ++j) { const size_t it = (size_t)(seq * NC + c0 + j) * 24 + hdb;
                ub[j] = *(const u32x4*)(USb + it * 8192 + e * 64 + d0);
                if (br == 0) { m0[j] = SCb[it * 4]; m1[j] = SCb[it * 4 + 1]; }
                if (br != 0 || nrow) { q0[j] = *(const f32x4*)(DECb + it * 64 + d0); q1[j] = *(const f32x4*)(DECb + it * 64 + d0 + 4); } }
#pragma unroll
            for (int j = 0; j < 4; ++j) { const size_t it = (size_t)(seq * NC + c0 + j) * 24 + hdb;
                bf16_t* p = USb + it * 8192 + e * 64 + d0; float* dec = DECb + it * 64 + d0; float* sc = SCb + it * 4;
                const u32x4 u = ub[j];
                const float uu[8] = {bflo(u.x), bfhi(u.x), bflo(u.y), bfhi(u.y), bflo(u.z), bfhi(u.z), bflo(u.w), bfhi(u.w)};
                { u32x4 w; w.x = pk2(S[0], S[1]); w.y = pk2(S[2], S[3]); w.z = pk2(S[4], S[5]); w.w = pk2(S[6], S[7]); *(u32x4*)p = w; }
                if (br == 0) {
                    const float mlw = m0[j], bl = m1[j]; const float mn = fmaxf(bl + mst, mlw); const float fa = __expf(bl + mst - mn), fb = __expf(mlw - mn);
                    if (nrow) { const f32x4 n0 = q0[j], n1 = q1[j];
                        *(f32x4*)dec = (f32x4){nst[0], nst[1], nst[2], nst[3]}; *(f32x4*)(dec + 4) = (f32x4){nst[4], nst[5], nst[6], nst[7]};
                        const float nn[8] = {n0.x, n0.y, n0.z, n0.w, n1.x, n1.y, n1.z, n1.w};
#pragma unroll
                        for (int i = 0; i < 8; ++i) nst[i] = fa * nst[i] + fb * nn[i];
                        if (d0 == 0) sc[2] = mst; }
#pragma unroll
                    for (int i = 0; i < 8; ++i) S[i] = fa * S[i] + fb * uu[i];
                    mst = mn;
                } else {
                    const f32x4 a0 = q0[j], a1 = q1[j]; const float dd[8] = {a0.x, a0.y, a0.z, a0.w, a1.x, a1.y, a1.z, a1.w};
#pragma unroll
                    for (int i = 0; i < 8; ++i) S[i] = dd[i] * S[i] + uu[i];
                }
            }
        }
        if (g == 2) { const size_t sidx = (size_t)((seq * 2 + l) * 2 + dir) * 4 + head;
            float* op = a.out + (br == 0 ? OFF_C : (br == 1 ? OFF_G : OFF_H)) + sidx * 8192;
#pragma unroll
            for (int i = 0; i < 8; ++i) op[(d0 + i) * 128 + e] = S[i];
            if (nrow) {
#pragma unroll
                for (int i = 0; i < 8; ++i) a.out[OFF_N + sidx * 64 + d0 + i] = nst[i];
                if (d0 == 0) a.out[OFF_M + sidx] = mst; } }
    }
}

constexpr int S3_QO = 0, S3_KO = 23040, S3_G = 41472, S3_XA = 57856, S3_YV = 75264, S3_TOT = 114432, S3_VEC = 116480;
__device__ __forceinline__ void scan_s3(const Args& a, LAS unsigned char* lds, int l, int g, int it2) {
    int tid_ = threadIdx.x; asm volatile("" : "+v"(tid_)); const int tid = tid_, d = tid & 63, lane = d, sg = __builtin_amdgcn_readfirstlane(tid >> 6);
    const int hb = it2 % 12, cgl = it2 / 12; ItemInfo I; I.br = hb >> 2; I.head = hb & 3; I.T = g < 2 ? 4096 : 256; I.NC = I.T >> 6; I.seq = cgl / I.NC; const int cn = cgl % I.NC; I.dir = 0; I.c = cn;
    const bf16_t* P = (const bf16_t*)(a.ws + WS_BIG);
    LAS bf16_t* QO = (LAS bf16_t*)(lds + S3_QO); LAS bf16_t* KO = (LAS bf16_t*)(lds + S3_KO); LAS float* G = (LAS float*)(lds + S3_G);
    LAS bf16_t* XA = (LAS bf16_t*)(lds + S3_XA); LAS bf16_t* YV = (LAS bf16_t*)(lds + S3_YV); LAS float* TOT = (LAS float*)(lds + S3_TOT);
    LAS float* Bv = (LAS float*)(lds + S3_VEC); LAS float* LIv = Bv + 64; LAS float* MT = Bv + 128; LAS float* EI = Bv + 192;
    stage_vT(P, I, YV, 136, tid);
    f32x4 osum[4];
#pragma unroll
    for (int nt = 0; nt < 4; ++nt) osum[nt] = (f32x4){0.f, 0.f, 0.f, 0.f};
  for (int dir = 0; dir < 2; ++dir) {
    I.dir = dir; I.c = dir ? I.NC - 1 - cn : cn;
    const int it = (I.seq * I.NC + I.c) * 24 + I.br * 8 + dir * 4 + I.head;
#define RV(x) (dir ? 63 - (x) : (x))
    const bf16_t* US = (const bf16_t*)(a.ws + WS_BIG + BIG_US) + (size_t)it * 8192;
    const float* DEC = (const float*)(a.ws + WS_DEC) + (size_t)it * 64; const float* SC = (const float*)(a.ws + WS_SC) + (size_t)it * 4;
    float qv[8], kv[8], x0[8], x1[8];
    { const int e = tid >> 2, part = tid & 3; const u32x4 s0 = *(const u32x4*)(US + e * 64 + 16 * part), s1 = *(const u32x4*)(US + e * 64 + 16 * part + 8);
      *(LAS u32x4*)(YV + e * 136 + 64 + 16 * part) = s0; *(LAS u32x4*)(YV + e * 136 + 64 + 16 * part + 8) = s1; }
    const int bi = sg >> 1;
    f32x4 acc[4];
#pragma unroll
    for (int nt = 0; nt < 4; ++nt) acc[nt] = (f32x4){0.f, 0.f, 0.f, 0.f};
    if (I.br != 0) {
        load_gated<true>(a, P, I, l, d, sg, qv, kv, x0);
        float run = 0.f;
#pragma unroll
        for (int i = 0; i < 8; ++i) { run += x0[i]; x0[i] = run; }
        TOT[sg * 64 + d] = run; LDS_WAIT(); __syncthreads();
        float pre = 0.f;
#pragma unroll
        for (int w = 0; w < 8; ++w) { const float t = TOT[w * 64 + d]; if (w < sg) pre += t; }
#pragma unroll
        for (int i = 0; i < 8; ++i) { x0[i] += pre; const int s = 8 * sg + i; G[s * 64 + d] = x0[i]; XA[RV(s) * 136 + 64 + d] = (bf16_t)f2bf(qv[i] * __expf(x0[i])); }
        LDS_WAIT(); __syncthreads();
        const float gs = bi ? G[(16 * bi - 1) * 64 + d] : 0.f, geo = G[(16 * bi + 15) * 64 + d];
        float gej[3];
#pragma unroll
        for (int j = 0; j < 3; ++j) gej[j] = G[(16 * j + 15) * 64 + d];
#pragma unroll
        for (int i = 0; i < 8; ++i) { const int tt = 8 * (sg & 1) + i;
            QO[(6 + bi) * 1152 + tt * 72 + d] = (bf16_t)f2bf(qv[i] * __expf(x0[i] - gs));
            KO[(4 + bi) * 1152 + tt * 72 + d] = (bf16_t)f2bf(kv[i] * __expf(fminf(gs - x0[i], 80.f)));
            KO[bi * 1152 + tt * 72 + d] = (bf16_t)f2bf(kv[i] * __expf(geo - x0[i]));
#pragma unroll
            for (int j = 0; j < 3; ++j) if (j < bi) QO[(bi * (bi - 1) / 2 + j) * 1152 + tt * 72 + d] = (bf16_t)f2bf(qv[i] * __expf(fminf(x0[i] - gej[j], 0.f))); }
        LDS_WAIT(); __syncthreads();
#pragma unroll
        for (int jj = 0; jj < 2; ++jj) { const int j = 2 * (sg & 1) + jj; f32x4 t = (f32x4){0.f, 0.f, 0.f, 0.f};
            if (j <= bi) { const int qt = (j == bi) ? 6 + bi : bi * (bi - 1) / 2 + j, kt = (j == bi) ? 4 + bi : j;
#pragma unroll
                for (int ks = 0; ks < 2; ++ks) t = __builtin_amdgcn_mfma_f32_16x16x32_bf16(ldfrag(QO + qt * 1152, 72, 0, 32 * ks, lane), ldfrag(KO + kt * 1152, 72, 0, 32 * ks, lane), t, 0, 0, 0); }
#pragma unroll
            for (int r = 0; r < 4; ++r) { const int tl = 4 * (lane >> 4) + r, sl = lane & 15; float v = t[r]; if (j == bi && sl > tl) v = 0.f;
                XA[RV(16 * bi + tl) * 136 + RV(16 * j + sl)] = (bf16_t)f2bf(v); } }
        LDS_WAIT(); __syncthreads();
    } else {
        load_mlstm<true>(a, P, I, l, d, sg, qv, kv, x0, x1);
        float run = 0.f;
#pragma unroll
        for (int i = 0; i < 8; ++i) { run += x0[i]; x0[i] = run; }
        TOT[sg * 64 + d] = run;
        for (int idx = tid; idx < 16 * 128; idx += 512) { const int r = idx >> 7, k = idx & 127; YV[(128 + r) * 136 + k] = (bf16_t)(r == 0 ? (k < 64 ? 0x3F80u : f2bf(DEC[k - 64])) : 0u); }
        LDS_WAIT(); __syncthreads();
        float pre = 0.f;
#pragma unroll
        for (int w = 0; w < 8; ++w) { const float t = TOT[w * 64 + d]; if (w < sg) pre += t; }
#pragma unroll
        for (int i = 0; i < 8; ++i) { x0[i] += pre; const int s = 8 * sg + i; if (d == 0) { Bv[s] = x0[i]; LIv[s] = x1[i]; }
            QO[s * 72 + d] = (bf16_t)f2bf(qv[i]); KO[s * 72 + d] = (bf16_t)f2bf(kv[i]); }
        LDS_WAIT(); __syncthreads();
        if (tid < 64) { float rn = -3.0e38f; for (int s = 0; s <= tid; ++s) rn = fmaxf(rn, LIv[s] - Bv[s]);
            const float bt = Bv[tid], inter = bt + SC[2], mt = fmaxf(inter, bt + rn); MT[RV(tid)] = mt; EI[RV(tid)] = __expf(inter - mt); }
        f32x4 t2[2];
#pragma unroll
        for (int jj = 0; jj < 2; ++jj) { const int j = 2 * (sg & 1) + jj; t2[jj] = (f32x4){0.f, 0.f, 0.f, 0.f};
            if (j <= bi) {
#pragma unroll
                for (int ks = 0; ks < 2; ++ks) t2[jj] = __builtin_amdgcn_mfma_f32_16x16x32_bf16(ldfrag(QO, 72, 16 * bi, 32 * ks, lane), ldfrag(KO, 72, 16 * j, 32 * ks, lane), t2[jj], 0, 0, 0); } }
        LDS_WAIT(); __syncthreads();
#pragma unroll
        for (int jj = 0; jj < 2; ++jj) { const int j = 2 * (sg & 1) + jj;
#pragma unroll
            for (int r = 0; r < 4; ++r) { const int t = 16 * bi + 4 * (lane >> 4) + r, s = 16 * j + (lane & 15); float v = 0.f;
                if (s <= t) v = t2[jj][r] * __expf(Bv[t] - Bv[s] + LIv[s] - MT[RV(t)]);
                XA[RV(t) * 136 + RV(s)] = (bf16_t)f2bf(v); } }
#pragma unroll
        for (int i = 0; i < 8; ++i) { const int s = 8 * sg + i; XA[RV(s) * 136 + 64 + d] = (bf16_t)f2bf(qv[i] * EI[RV(s)]); }
        LDS_WAIT(); __syncthreads();
    }
    f32x4 accd[4];
#pragma unroll
    for (int nt = 0; nt < 4; ++nt) accd[nt] = (f32x4){0.f, 0.f, 0.f, 0.f};
#pragma unroll
    for (int ks = 0; ks < 4; ++ks) { const bf16x8 av = ldfrag(YV, 136, 16 * sg, 32 * ks, lane);
        bf16x8 ad = av; if (I.br == 0) ad = ldfrag(YV, 136, 128, 32 * ks, lane);
#pragma unroll
        for (int nt = 0; nt < 4; ++nt) { const bf16x8 bx = ldfrag(XA, 136, 16 * nt, 32 * ks, lane);
            acc[nt] = __builtin_amdgcn_mfma_f32_16x16x32_bf16(av, bx, acc[nt], 0, 0, 0);
            if (I.br == 0) accd[nt] = __builtin_amdgcn_mfma_f32_16x16x32_bf16(ad, bx, accd[nt], 0, 0, 0); } }
#pragma unroll
    for (int nt = 0; nt < 4; ++nt) { const int t = 16 * nt + (lane & 15); f32x4 o = acc[nt];
        if (I.br == 0) { const float den = __shfl(accd[nt][0], lane & 15); const float dn = fmaxf(fabsf(den), __expf(-MT[t])); o = o * (1.0f / dn); }
        osum[nt] = osum[nt] + o; }
    __syncthreads();
#undef RV
  }
    LAS float* RED = TOT;
#pragma unroll
    for (int nt = 0; nt < 4; ++nt) { float ss = (osum[nt][0] * osum[nt][0] + osum[nt][1] * osum[nt][1]) + (osum[nt][2] * osum[nt][2] + osum[nt][3] * osum[nt][3]);
        ss += __shfl_xor(ss, 16); ss += __shfl_xor(ss, 32);
        if (lane < 16) RED[sg * 64 + 16 * nt + lane] = ss; }
    LDS_WAIT(); __syncthreads();
    const int e0 = 16 * sg + 4 * (lane >> 4); const int gcol = (I.br == 0 ? C_MO : (I.br == 1 ? C_GR : C_HG)) + I.head * 128 + e0;
    const f32x4 hw = *(const f32x4*)(inp(a, I_HN) + (size_t)(l * 3 + I.br) * 512 + I.head * 128 + e0);
    bf16_t* YSo = (bf16_t*)(a.ws + WS_A) + (size_t)g * GROWS * 1536;
#pragma unroll
    for (int nt = 0; nt < 4; ++nt) { const int t = 16 * nt + (lane & 15); float tot = 0.f;
#pragma unroll
        for (int w = 0; w < 8; ++w) tot += RED[w * 64 + t];
        const float rr = rsqrtf(tot * (1.0f / 128.0f) + EPSN);
        const int lr = I.seq * I.T + 64 * cn + t;
        const u32x2 gt = *(const u32x2*)(P + (size_t)lr * PN + gcol);
        const float gv[4] = {bflo(gt.x), bfhi(gt.x), bflo(gt.y), bfhi(gt.y)}; float y[4];
#pragma unroll
        for (int r = 0; r < 4; ++r) { const float gg = I.br == 0 ? sigmoidf_(gv[r]) : siluf_(gv[r]); y[r] = gg * (osum[nt][r] * rr) * hw[r]; }
        u32x2 w; w.x = pk2(y[0], y[1]); w.y = pk2(y[2], y[3]);
        *(u32x2*)(YSo + (size_t)lr * 1536 + I.br * 512 + I.head * 128 + e0) = w; }
    __syncthreads();
}


enum { ST_F1IN = 0, ST_F1OUT = 1, ST_ROWA = 2, ST_G0 = 3, ST_BR = 15, ST_MG = 16, ST_OUT = 17, ST_ROWB = 18, ST_F2IN = 19, ST_F2OUT = 20, ST_ROWC = 21, NST = 22 };
#ifndef REP_S1
#define REP_S1 1
#endif
#ifndef REP_S3
#define REP_S3 1
#endif
#ifndef REP_G
#define REP_G 1
#endif
template <int M_, int N_, int K_, int LDA_, int LDB_, int ADIV, int AMUL, int KS, class Epi>
__device__ __forceinline__ void run_gemm(LAS unsigned char* lds, const bf16_t* A, const bf16_t* Bt, const Epi& E) {
    typedef pg8::GemmT<M_, N_, K_, LDA_, LDB_> GT; GT g{A, Bt}; typedef pg8::StaticOrderT<M_, N_, ADIV, AMUL, KS> SO; SO S; S.init((int)gridDim.x, (int)blockIdx.x);
    pg8::gemm_phase<GT, Epi, SO, true, true>((PG8_LAS unsigned char*)lds, g, S, E);
}

__global__ void __launch_bounds__(512, 2) mk_fwd(Args a) {
    extern __shared__ __attribute__((aligned(16))) unsigned char lds_raw[];
    LAS unsigned char* lds = (LAS unsigned char*)lds_raw;
    cg::grid_group grid = cg::this_grid();
    for (int u = threadIdx.x; u < (LDS_BYTES - 131072) / 4; u += 512) ((LAS unsigned*)(lds + 131072))[u] = 0u;
    __syncthreads();
    (void)xcd_barrier_post((unsigned*)a.ws, (volatile LAS unsigned*)(lds + 131072 + 352));
    const int tid = threadIdx.x, lane = tid & 63, wave = __builtin_amdgcn_readfirstlane(tid >> 6);
    const int G = gridDim.x, gw = blockIdx.x * 8 + wave, NGW = G * 8;
    unsigned char* ws = a.ws;
    float* mod = (float*)(ws + WS_MOD);

#ifndef SKIP_PRO
    convert_weights(a, lds, 0, gw, NGW, lane, wave);
    ada_partial(a, gw, NGW, lane);
    { float* pos = (float*)(ws + WS_POS);
      for (int i = blockIdx.x * 512 + tid; i < 64 * 512; i += G * 512) { const int v = i >> 9, j = i & 511, fi = j & 255;
          const float fr = expf((-9.210340371976184f * (float)fi) / 256.0f); const float ang = (float)v * fr; pos[i] = j < 256 ? sinf(ang) : cosf(ang); } }
    grid.sync();
    { const float* modp = (const float*)(ws + WS_MODP);
      for (int i = blockIdx.x * 512 + tid; i < 2 * 5 * 9216; i += G * 512) { const int col = i % 9216, l = i / (5 * 9216); float s = inp(a, I_BADA)[l * 9216 + col];
#pragma unroll
          for (int ks = 0; ks < 8; ++ks) s += modp[(size_t)ks * (2 * 5 * 9216) + i]; mod[i] = s; } }
    xcd_barrier_ni((unsigned*)a.ws, 131072 + 352);
    { RowOp op{}; op.src_input = 1; op.has_y = 0; op.has_xn = 1; op.npre = inp(a, I_NPRE); op.md_base = mod; op.si = 0; op.add_pos = 0;
      rowwise_all(a, op, gw, NGW, lane); }
    xcd_barrier_ni((unsigned*)a.ws, 131072 + 352);
#endif

    for (int l = 0; l < 2; ++l) {
        for (int st = 0; st < NST; ++st) {
            int tid = threadIdx.x; asm volatile("" : "+v"(tid));
            const int lane = tid & 63, wave = __builtin_amdgcn_readfirstlane(tid >> 6), gw = blockIdx.x * 8 + wave;
            unsigned char* ws = a.ws; asm volatile("" : "+s"(ws));
            float* mod = (float*)(ws + WS_MOD); const float* modl = mod + (size_t)l * 5 * 9216;
            bf16_t* XN = (bf16_t*)(ws + WS_XN); bf16_t* BIG = (bf16_t*)(ws + WS_BIG); float* Y = (float*)(ws + WS_A); bf16_t* YS = (bf16_t*)(ws + WS_A);
            unsigned char* wb = ws + WS_W; const int G = gridDim.x, NGW = G * 8;
            const int kind = (st == ST_F1IN || st == ST_F2IN) ? 0 : (st == ST_F1OUT || st == ST_OUT || st == ST_F2OUT) ? 1 : (st == ST_ROWA || st == ST_ROWB || st == ST_ROWC) ? 2 : (st == ST_BR) ? 3 : (st == ST_MG) ? 4 : 5 + ((st - ST_G0) % 4);
            const int g = (st >= ST_G0 && st < ST_BR) ? (st - ST_G0) / 4 : 0;
            switch (kind) {
            case 0: {
#ifndef SKIP_G0
                const int f = st == ST_F1IN ? 0 : 1; EpiSwiGLU E{BIG, DFF};
                for (int rep = 0; rep < REP_G; ++rep) run_gemm<MTOT, NFF2, D, D, D, 0, 0, 1>(lds, XN, (const bf16_t*)(wb + W_FFIN) + (size_t)f * NFF2 * D, E);
#endif
                break; }
            case 1: {
#ifndef SKIP_G1
                EpiBf16 E{(bf16_t*)Y, D, 4, (size_t)MTOT * D};
                for (int rep = 0; rep < REP_G; ++rep)
                if (st == ST_OUT) run_gemm<MTOT, 2 * D, 1536, 3072, 3072, 4, 1536, 2>(lds, BIG, (const bf16_t*)(wb + W_O3), E);
                else run_gemm<MTOT, 2 * D, DFF / 2, DFF, DFF, 4, DFF / 2, 2>(lds, BIG, (const bf16_t*)(wb + W_FFOUT) + (size_t)(st == ST_F1OUT ? 0 : 1) * D * DFF, E);
#endif
                break; }
            case 2: {
#ifndef SKIP_ROW
                RowOp op{}; op.has_y = 1; op.mdg_base = modl + (st == ST_ROWA ? 2 : st == ST_ROWB ? 5 : 8) * D; op.coef = st == ST_ROWB ? 1.0f : 0.5f;
                op.npost = inp(a, I_NPOST) + (size_t)(l * 3 + (st == ST_ROWA ? 0 : st == ST_ROWB ? 1 : 2)) * D; op.src_input = (l == 0 && st == ST_ROWA) ? 1 : 0;
                if (st == ST_ROWA) { op.has_xn = 1; op.npre = inp(a, I_NPRE) + (size_t)(l * 3 + 1) * D; op.md_base = modl; op.si = 3; op.add_pos = 1; }
                else if (st == ST_ROWB) { op.has_xn = 1; op.npre = inp(a, I_NPRE) + (size_t)(l * 3 + 2) * D; op.md_base = modl; op.si = 6; op.add_pos = 0; }
                else { op.has_xn = (l == 0) ? 1 : 0; op.npre = inp(a, I_NPRE) + (size_t)3 * D; op.md_base = mod + (size_t)5 * 9216; op.si = 0; op.add_pos = 0; }
                rowwise_all(a, op, gw, NGW, lane);
                if (st == ST_ROWC && l == 0) { __syncthreads(); convert_weights(a, lds, 1, gw, NGW, lane, wave); }
#endif
                break; }
            case 3: {
#ifndef SKIP_G3
                EpiBf16 E{BIG, 3072, 0, 0};
                for (int rep = 0; rep < REP_G; ++rep) run_gemm<MTOT, 3072, 512, 1536, 512, 4, 512, 1>(lds, YS, (const bf16_t*)(wb + W_B), E);
#endif
                break; }
            case 4: {
#ifndef SKIP_G4
                EpiGateMul E{BIG, 3072};
                run_gemm<MTOT, MGN, D, D, D, 0, 0, 1>(lds, XN, (const bf16_t*)(wb + W_MG), E);
#endif
                break; }
            case 5: {
#ifndef SKIP_G3
                EpiBf16 E{BIG, PN, 0, 0};
                for (int rep = 0; rep < REP_G; ++rep) run_gemm<GROWS, PN, D, D, D, 0, 0, 1>(lds, XN + (size_t)g * GROWS * D, (const bf16_t*)(wb + W_P), E);
#endif
                break; }
            case 6: {
#ifndef SKIP_S1
                for (int rep = 0; rep < REP_S1; ++rep) for (int it = blockIdx.x; it < 3072; it += G) scan_s1(a, lds, l, g, it);
#endif
                break; }
            case 7: {
#ifndef SKIP_S2
                scan_s2(a, l, g);
#endif
                break; }
            case 8: {
#ifndef SKIP_S3
                for (int rep = 0; rep < REP_S3; ++rep) for (int it = blockIdx.x; it < 1536; it += G) scan_s3(a, lds, l, g, it);
#endif
                break; }
            default: break;
            }
            if (st != ST_BR) xcd_barrier_ni((unsigned*)a.ws, 131072 + 352); else { asm volatile("s_waitcnt vmcnt(0)" ::: "memory"); __syncthreads(); }
#ifdef EXTRA_SYNC
            xcd_barrier_ni((unsigned*)a.ws, 131072 + 352);
#endif
        }
    }
}

extern "C" void kernel_launch(void* const* d_in, const int* in_sizes, int n_in, void* d_out, int out_size, void* d_ws, size_t ws_size, hipStream_t stream) {
    static int grid = 0;
    if (grid == 0) {
        if (n_in != 23 || ws_size < WS_END) { fprintf(stderr, "kernel_launch: unexpected n_in %d / ws_size %zu (need %zu)\n", n_in, ws_size, (size_t)WS_END); grid = -1; return; }
        int dev = 0, cus = 0, per_cu = 0;
        hipGetDevice(&dev); hipDeviceGetAttribute(&cus, hipDeviceAttributeMultiprocessorCount, dev);
        hipFuncSetAttribute((const void*)mk_fwd, hipFuncAttributeMaxDynamicSharedMemorySize, LDS_BYTES);
        hipOccupancyMaxActiveBlocksPerMultiprocessor(&per_cu, (const void*)mk_fwd, 512, LDS_BYTES);
        (void)hipGetLastError();
        if (per_cu < 1) per_cu = 1;
        grid = cus;
    }
    if (grid < 0) return;
    if (hipMemsetAsync(d_ws, 0, 16384, stream) != hipSuccess) { fprintf(stderr, "memset failed\n"); return; }
    Args a{};
    for (int i = 0; i < 23; ++i) a.in[i] = (const float*)d_in[i];
    a.out = (float*)d_out; a.ws = (unsigned char*)d_ws;
    void* args[] = {&a};
    hipError_t e = hipLaunchCooperativeKernel((const void*)mk_fwd, dim3(grid), dim3(512), args, LDS_BYTES, stream);
    if (e != hipSuccess) fprintf(stderr, "cooperative launch failed: %s (grid %d)\n", hipGetErrorString(e), grid);
}
```

```cpp
#include <hip/hip_runtime.h>
#include <hip/hip_cooperative_groups.h>
#include <cstdio>
#include <cstdint>
namespace cg = cooperative_groups;

namespace pg8 {
#define PG8_LAS __attribute__((address_space(3)))
typedef unsigned short bf16_t;
typedef short bf16x8 __attribute__((ext_vector_type(8)));
typedef float f32x4 __attribute__((ext_vector_type(4)));
typedef unsigned u32x4 __attribute__((ext_vector_type(4)));
typedef unsigned u32x2 __attribute__((ext_vector_type(2)));
constexpr int BM = 256, BK = 64, HALF = 128, HTB = HALF * BK * 2, STAGE_BYTES = 8 * HTB, NXCD = 8, WGM = 8;

__host__ __device__ __forceinline__ int lds_byte(int r, int c) { const int st = (r >> 4) * 2 + (c >> 5), rr = r & 15, cc = c & 31, ob = rr * 64 + cc * 2; return st * 1024 + (ob ^ (((ob >> 9) & 1) << 5)); }
__host__ __device__ __forceinline__ void stage_rc(int b, int& R, int& C) { const int st = b / 1024, sb = b % 1024, swz = sb ^ (((sb >> 9) & 1) << 5); R = (st >> 1) * 16 + swz / 64; C = (st & 1) * 32 + (swz % 64) / 2; }
__host__ __device__ __forceinline__ int perm32(int rho) { const int n = rho >> 4, i = rho & 15; return 8 * (i >> 2) + 4 * n + (i & 3); }

struct Unit { int pm, pn; };
template <int M_, int N_, int K_, int LDA_, int LDB_> struct GemmT { const bf16_t* A; const bf16_t* Bt; static constexpr int M = M_, N = N_, K = K_, lda = LDA_, ldb = LDB_; };

template <int M_, int N_, int ADIV, int AMUL, int KS = 1> struct StaticOrderT {
    static constexpr int nM = M_ / BM, nN = N_ / BM, nwg = nM * nN;
    int G, c;
    __device__ void init(int G_, int c_) { G = G_; c = c_; }
    __device__ __forceinline__ bool next(int i, Unit& u) const {
        const int L = i * G + c; if (L >= nwg) return false;
        int wgid = L; { constexpr int q = nwg / NXCD, r = nwg % NXCD; const int xcd = wgid % NXCD, off = wgid / NXCD; wgid = (xcd < r ? xcd * (q + 1) : r * (q + 1) + (xcd - r) * q) + off; }
        constexpr int nig = WGM * nN; const int gid = wgid / nig, fm = gid * WGM, gsz = (nM - fm) < WGM ? (nM - fm) : WGM;
        u.pm = fm + ((wgid % nig) % gsz); u.pn = (wgid % nig) / gsz; return true;
    }
    __device__ __forceinline__ int a_off(const Unit& u) const { return ADIV > 0 ? (u.pn / (ADIV > 0 ? ADIV : 1)) * AMUL : 0; }
    __device__ __forceinline__ int b_tile(const Unit& u) const { return KS > 1 ? u.pn % (nN / KS) : u.pn; }
    __device__ __forceinline__ int b_koff(const Unit& u) const { return KS > 1 ? (u.pn / (nN / KS)) * AMUL : 0; }
    __device__ __forceinline__ void a_ready(const Unit&) const {}
    __device__ __forceinline__ void done(const Unit&) const {}
};

template <class GT, class Epi, class Sched, bool ALIGN_EPI = false, bool SP2 = false>
__device__ __forceinline__ void gemm_phase(PG8_LAS unsigned char* lds, const GT g, const Sched& S, const Epi& E) {
    int tid_ = threadIdx.x; asm volatile("" : "+v"(tid_));
    const int tid = tid_, wid = __builtin_amdgcn_readfirstlane(tid >> 6), lane = tid & 63, wr = wid >> 2, wc = wid & 3, fr = lane & 15, fq = lane >> 4;
    constexpr int K = GT::K, nt = K / BK;
    unsigned voffA[2], voffB[2];
#pragma unroll
    for (int i = 0; i < 2; ++i) { int R, C; stage_rc(tid * 16 + i * 8192, R, C); const int Rb = Epi::PERM ? ((R & ~31) + perm32(R & 31)) : R;
        voffA[i] = (unsigned)(R * GT::lda + C) * 2u; voffB[i] = (unsigned)(Rb * GT::ldb + C) * 2u; }
    constexpr size_t kstep = (size_t)(BK * 2);
    constexpr size_t hstepA = (size_t)HALF * GT::lda * 2, hstepB = (size_t)HALF * GT::ldb * 2;
    constexpr size_t tstepA = 2 * hstepA, tstepB = 2 * hstepB;
    const unsigned ldsw = (unsigned)wid * 1024u;
    const int aoff = lds_byte(wr * 64 + fr, fq * 8), boff = lds_byte(wc * 32 + fr, fq * 8);
#define PG8_SA(b, h) (((b) * 2 + (h)) * HTB)
#define PG8_SB(b, h) ((4 + (b) * 2 + (h)) * HTB)
#define PG8_STAGE(bufoff, gbase, voff) do { _Pragma("unroll") for (int _i = 0; _i < 2; ++_i) \
        __builtin_amdgcn_global_load_lds((const unsigned*)((const char*)(gbase) + (voff)[_i]), (PG8_LAS unsigned*)(lds + (bufoff) + ldsw + _i * 8192), 16, 0, 0); } while (0)
#define PG8_LDA(dst, b, h) do { _Pragma("unroll") for (int m = 0; m < 4; ++m) _Pragma("unroll") for (int k = 0; k < 2; ++k) dst[m][k] = *(const PG8_LAS bf16x8*)(lds + PG8_SA(b, h) + aoff + m * 2048 + k * 1024); } while (0)
#define PG8_LDB(dst, b, h) do { _Pragma("unroll") for (int n = 0; n < 2; ++n) _Pragma("unroll") for (int k = 0; k < 2; ++k) dst[n][k] = *(const PG8_LAS bf16x8*)(lds + PG8_SB(b, h) + boff + n * 2048 + k * 1024); } while (0)
#define PG8_MMA(ai, bj, At, Bt) do { __builtin_amdgcn_s_setprio(1); _Pragma("unroll") for (int m = 0; m < 4; ++m) _Pragma("unroll") for (int n = 0; n < 2; ++n) _Pragma("unroll") for (int k = 0; k < 2; ++k) \
        acc[ai][bj][m][n] = __builtin_amdgcn_mfma_f32_16x16x32_bf16(Bt[n][k], At[m][k], acc[ai][bj][m][n], 0, 0, 0); __builtin_amdgcn_s_setprio(0); } while (0)
#define PG8_WAIT_V(n) asm volatile("s_waitcnt vmcnt(" #n ")" ::: "memory")
#define PG8_WAIT_L(n) asm volatile("s_waitcnt lgkmcnt(" #n ")" ::: "memory")
#define PG8_BAR __builtin_amdgcn_s_barrier()
#define PG8_SCHED __builtin_amdgcn_sched_barrier(0)
    Unit cur, nxt; int ui = 0;
    if (!S.next(0, cur)) return;
    f32x4 acc[2][2][4][2];
#pragma unroll
    for (int a = 0; a < 2; ++a)
#pragma unroll
        for (int b = 0; b < 2; ++b)
#pragma unroll
            for (int m = 0; m < 4; ++m)
#pragma unroll
                for (int n = 0; n < 2; ++n) acc[a][b][m][n] = (f32x4){0.f, 0.f, 0.f, 0.f};
    bf16x8 At[4][2], B0[2][2], B1[2][2];
    const char* cA = (const char*)g.A + (size_t)cur.pm * tstepA + (size_t)S.a_off(cur) * 2; const char* cB = (const char*)g.Bt + (size_t)S.b_tile(cur) * tstepB + (size_t)S.b_koff(cur) * 2;
    S.a_ready(cur);
    if constexpr (SP2) {
        PG8_STAGE(PG8_SB(0, 0), cB, voffB); PG8_STAGE(PG8_SB(0, 1), cB + hstepB, voffB); PG8_STAGE(PG8_SA(0, 0), cA, voffA); PG8_STAGE(PG8_SA(0, 1), cA + hstepA, voffA);
        if (wr == 1) PG8_BAR;
        PG8_WAIT_V(2); PG8_BAR;
        PG8_STAGE(PG8_SB(1, 0), cB + kstep, voffB); PG8_STAGE(PG8_SA(1, 0), cA + kstep, voffA); PG8_STAGE(PG8_SB(1, 1), cB + hstepB + kstep, voffB);
        PG8_WAIT_V(6); PG8_BAR;
    } else {
        PG8_STAGE(PG8_SB(0, 0), cB, voffB); PG8_STAGE(PG8_SA(0, 0), cA, voffA); PG8_STAGE(PG8_SB(0, 1), cB + hstepB, voffB); PG8_STAGE(PG8_SA(0, 1), cA + hstepA, voffA);
        if (wr == 1) PG8_BAR;
        PG8_WAIT_V(4); PG8_BAR;
        PG8_STAGE(PG8_SB(1, 0), cB + kstep, voffB); PG8_STAGE(PG8_SA(1, 0), cA + kstep, voffA); PG8_STAGE(PG8_SB(1, 1), cB + hstepB + kstep, voffB);
        PG8_WAIT_V(6); PG8_BAR;
    }
    for (;;) {
        const bool has_next = S.next(ui + 1, nxt);
        const char* nA = has_next ? (const char*)g.A + (size_t)nxt.pm * tstepA + (size_t)S.a_off(nxt) * 2 : cA; const char* nB = has_next ? (const char*)g.Bt + (size_t)S.b_tile(nxt) * tstepB + (size_t)S.b_koff(nxt) * 2 : cB;
        for (int t = 0; t < nt; t += 2) {
            const bool last = (t == nt - 2);
            const char* a1 = cA + (size_t)(t + 1) * kstep;
            const char* a2 = last ? nA : cA + (size_t)(t + 2) * kstep; const char* b2 = last ? nB : cB + (size_t)(t + 2) * kstep;
            const char* a3 = a2 + kstep; const char* b3 = b2 + kstep;
            if (last && has_next) S.a_ready(nxt);
            if constexpr (SP2) {
            PG8_LDB(B0, 0, 0); PG8_LDB(B1, 0, 1); PG8_SCHED; PG8_LDA(At, 0, 0); PG8_STAGE(PG8_SA(1, 1), a1 + hstepA, voffA);
            PG8_WAIT_V(8); PG8_WAIT_L(0); PG8_BAR; PG8_MMA(0, 0, At, B0); PG8_MMA(0, 1, At, B1); PG8_BAR; PG8_SCHED;
            PG8_LDA(At, 0, 1); PG8_STAGE(PG8_SB(0, 0), b2, voffB); PG8_STAGE(PG8_SB(0, 1), b2 + hstepB, voffB); PG8_STAGE(PG8_SA(0, 0), a2, voffA);
            PG8_WAIT_V(8); PG8_WAIT_L(0); PG8_BAR; PG8_MMA(1, 0, At, B0); PG8_MMA(1, 1, At, B1); PG8_BAR; PG8_SCHED;
            PG8_LDB(B0, 1, 0); PG8_LDB(B1, 1, 1); PG8_SCHED; PG8_LDA(At, 1, 0); PG8_STAGE(PG8_SA(0, 1), a2 + hstepA, voffA);
            PG8_WAIT_V(8); PG8_WAIT_L(0); PG8_BAR; PG8_MMA(0, 0, At, B0); PG8_MMA(0, 1, At, B1); PG8_BAR; PG8_SCHED;
            PG8_LDA(At, 1, 1); PG8_STAGE(PG8_SB(1, 0), b3, voffB); PG8_STAGE(PG8_SB(1, 1), b3 + hstepB, voffB); PG8_STAGE(PG8_SA(1, 0), a3, voffA);
            PG8_WAIT_V(8); PG8_WAIT_L(0); PG8_BAR; PG8_MMA(1, 0, At, B0); PG8_MMA(1, 1, At, B1); PG8_BAR; PG8_SCHED;
            } else {
            PG8_LDB(B0, 0, 0); PG8_SCHED; PG8_LDA(At, 0, 0); PG8_STAGE(PG8_SA(1, 1), a1 + hstepA, voffA);
            PG8_WAIT_L(8); PG8_BAR; PG8_WAIT_L(0); PG8_MMA(0, 0, At, B0); PG8_BAR; PG8_SCHED;
            PG8_LDB(B1, 0, 1); PG8_STAGE(PG8_SB(0, 0), b2, voffB);
            PG8_BAR; PG8_WAIT_L(0); PG8_MMA(0, 1, At, B1); PG8_BAR;
            PG8_LDA(At, 0, 1); PG8_STAGE(PG8_SA(0, 0), a2, voffA);
            PG8_BAR; PG8_WAIT_L(0); PG8_MMA(1, 0, At, B0); PG8_BAR; PG8_SCHED;
            PG8_STAGE(PG8_SB(0, 1), b2 + hstepB, voffB);
            PG8_WAIT_V(6); PG8_BAR; PG8_MMA(1, 1, At, B1); PG8_BAR;
            PG8_LDB(B0, 1, 0); PG8_SCHED; PG8_LDA(At, 1, 0); PG8_STAGE(PG8_SA(0, 1), a2 + hstepA, voffA);
            PG8_WAIT_L(8); PG8_BAR; PG8_WAIT_L(0); PG8_MMA(0, 0, At, B0); PG8_BAR; PG8_SCHED;
            PG8_LDB(B1, 1, 1); PG8_STAGE(PG8_SB(1, 0), b3, voffB);
            PG8_BAR; PG8_WAIT_L(0); PG8_MMA(0, 1, At, B1); PG8_BAR;
            PG8_LDA(At, 1, 1); PG8_STAGE(PG8_SA(1, 0), a3, voffA);
            PG8_BAR; PG8_WAIT_L(0); PG8_MMA(1, 0, At, B0); PG8_BAR; PG8_SCHED;
            PG8_STAGE(PG8_SB(1, 1), b3 + hstepB, voffB);
            PG8_WAIT_V(6); PG8_BAR; PG8_MMA(1, 1, At, B1); PG8_BAR;
            }
        }
        if constexpr (ALIGN_EPI) { if (wr == 0) PG8_BAR; }
        if constexpr (!Epi::AFTER_DRAIN) { E(acc, cur, wr, wc, fr, fq); S.done(cur); }
        if (!has_next) break;
#pragma unroll
        for (int a = 0; a < 2; ++a)
#pragma unroll
            for (int b = 0; b < 2; ++b)
#pragma unroll
                for (int m = 0; m < 4; ++m)
#pragma unroll
                    for (int n = 0; n < 2; ++n) acc[a][b][m][n] = (f32x4){0.f, 0.f, 0.f, 0.f};
        cur = nxt; cA = nA; cB = nB; ++ui;
        if constexpr (ALIGN_EPI) { if (wr == 1) PG8_BAR; }
    }
    PG8_WAIT_V(0);
    if constexpr (!ALIGN_EPI) { if (wr == 0) PG8_BAR; }
    PG8_BAR;
    if constexpr (Epi::AFTER_DRAIN) { E.fused(acc, cur, wr, wc, fr, fq, lds, wid, lane); S.done(cur); }
#undef PG8_SA
#undef PG8_SB
#undef PG8_STAGE
#undef PG8_LDA
#undef PG8_LDB
#undef PG8_MMA
#undef PG8_WAIT_V
#undef PG8_WAIT_L
#undef PG8_BAR
#undef PG8_SCHED
}
}

#define LAS __attribute__((address_space(3)))
typedef unsigned short bf16_t;
typedef short bf16x8 __attribute__((ext_vector_type(8)));
typedef float f32x4 __attribute__((ext_vector_type(4)));
typedef unsigned u32x4 __attribute__((ext_vector_type(4)));
typedef unsigned u32x2 __attribute__((ext_vector_type(2)));

constexpr int D = 1024, DFF = 2816, NFF2 = 5632, INC = 7984, PN = 5120, PREAL = 4912, MGN = 3072;
constexpr int MTOT = 24576, MLAT = 16384, GROWS = 8192;
constexpr float EPSN = 1e-6f;
constexpr size_t MiB = 1u << 20;
constexpr size_t WS_MOD = 1 * MiB, WS_MODP = 2 * MiB, WS_POS = 5 * MiB, WS_DEC = 6 * MiB, WS_SC = 7 * MiB;
constexpr size_t WS_W = 8 * MiB;
constexpr size_t W_FFIN = 0, W_FFOUT = W_FFIN + 2ull * NFF2 * D * 2, W_P = W_FFOUT + 2ull * D * DFF * 2, W_MG = W_P + (size_t)PN * D * 2,
                 W_B = W_MG + (size_t)MGN * D * 2, W_O3 = W_B + 3072ull * 512 * 2, W_END = W_O3 + 1024ull * 3072 * 2;
static_assert(W_END <= 58 * MiB, "weights region");
constexpr size_t WS_XN = 66 * MiB, WS_A = 114 * MiB, WS_BIG = 210 * MiB, WS_END = 370 * MiB;
constexpr size_t BIG_US = 80 * MiB, BIG_OB = 128 * MiB;
constexpr size_t OFF_YP = 0, OFF_YS = 8388608, OFF_C = 25165824, OFF_N = 29360128, OFF_M = 29392896, OFF_G = 29393408, OFF_H = 33587712;
constexpr int LDS_BYTES = 147456;

struct Args { const float* in[23]; float* out; unsigned char* ws; };
enum { I_XP = 0, I_XS, I_C, I_SC, I_SN, I_SM, I_SG, I_SH, I_CCTX, I_WADA, I_BADA, I_NPRE, I_NPOST, I_WFIN, I_WFOUT, I_WIN, I_GB, I_GWUP, I_GLB, I_HGAM, I_HN, I_WBR, I_WOUT };
__device__ __forceinline__ const float* inp(const Args& a, int i) { asm volatile("" : "+s"(i)); return a.in[i]; }

__device__ __forceinline__ unsigned f2bf(float f) { unsigned u = __float_as_uint(f); return (u + 0x7fffu + ((u >> 16) & 1u)) >> 16; }
__device__ __forceinline__ unsigned pk2(float lo, float hi) { return f2bf(lo) | (f2bf(hi) << 16); }
__device__ __forceinline__ float bf2f(bf16_t h) { return __uint_as_float(((unsigned)h) << 16); }
__device__ __forceinline__ float bflo(unsigned w) { return __uint_as_float(w << 16); }
__device__ __forceinline__ float bfhi(unsigned w) { return __uint_as_float(w & 0xffff0000u); }
__device__ __forceinline__ float sigmoidf_(float x) { return 1.0f / (1.0f + __expf(-x)); }
__device__ __forceinline__ float siluf_(float x) { return x / (1.0f + __expf(-x)); }
__device__ __forceinline__ float logsigf_(float x) { return fminf(x, 0.f) - __logf(1.0f + __expf(-fabsf(x))); }
__device__ __forceinline__ float wave_sum(float v) {
#pragma unroll
    for (int o = 1; o < 64; o <<= 1) v += __shfl_xor(v, o);
    return v;
}
#define LDS_WAIT() asm volatile("s_waitcnt lgkmcnt(0)" ::: "memory")

#define XB_TMO      128
#define XB_XCNT(j)  (256  + 64 * (j))
#define XB_XSUB(j)  (1280 + 64 * (j))
#define XB_XGEN(j)  (2304 + 64 * (j))
#define XB_TOP      3328
#define XB_TOPGEN   3392
#define XCD_BAR_WORDS 3456
#define XB_SPIN_CAP (1u << 18)

__device__ __forceinline__ unsigned xb_ld(unsigned* p)              { return __hip_atomic_load(p, __ATOMIC_RELAXED, __HIP_MEMORY_SCOPE_AGENT); }
__device__ __forceinline__ unsigned xb_add(unsigned* p, unsigned v) { return __hip_atomic_fetch_add(p, v, __ATOMIC_RELAXED, __HIP_MEMORY_SCOPE_AGENT); }
__device__ __forceinline__ unsigned xb_xcc_id() { return (unsigned)__builtin_amdgcn_s_getreg((3 << 11) | 20) & 0xFu; }
#define XB_SPIN(cond, bar) do { unsigned _sp = 0; while (cond) { __builtin_amdgcn_s_sleep(1); \
    if ((++_sp & 255u) == 0u) { if (xb_ld(&(bar)[XB_TMO])) break; if (_sp > XB_SPIN_CAP) { atomicAdd(&(bar)[XB_TMO], 1u); break; } } } } while (0)

struct XcdBarrier {
    unsigned* bar; unsigned x;
    volatile LAS unsigned* st;
};

__device__ __forceinline__ XcdBarrier xcd_barrier_post(unsigned* bar, volatile LAS unsigned* st) {
    XcdBarrier b; b.bar = bar; b.x = xb_xcc_id(); b.st = st;
    if (threadIdx.x == 0) (void)xb_add(&bar[XB_XCNT(b.x)], 1u);
    return b;
}
__device__ __forceinline__ void xcd_barrier_complete(unsigned* bar, unsigned x, unsigned& nloc, unsigned& nx) {
    const unsigned G = gridDim.x * gridDim.y * gridDim.z;
    unsigned sum, cnt, mine, sp = 0u;
    for (;;) {
        sum = 0u; cnt = 0u; mine = 0u;
#pragma unroll
        for (unsigned j = 0; j < 16; ++j) { const unsigned c = xb_ld(&bar[XB_XCNT(j)]); sum += c; cnt += (c > 0u) ? 1u : 0u; mine = (j == x) ? c : mine; }
        if (sum == G) break;
        __builtin_amdgcn_s_sleep(1);
        if ((++sp & 255u) == 0u) { if (xb_ld(&bar[XB_TMO])) break; if (sp > XB_SPIN_CAP) { atomicAdd(&bar[XB_TMO], 1u); break; } }
    }
    nloc = mine > 0u ? mine : 1u; nx = cnt > 0u ? cnt : 1u;
}

__device__ __attribute__((noinline)) void xcd_barrier_ni(unsigned* bar_, unsigned st_off) {
    XcdBarrier b; b.bar = bar_; b.x = xb_xcc_id(); b.st = (volatile LAS unsigned*)(size_t)st_off;
    asm volatile("s_waitcnt vmcnt(0)" ::: "memory");
    __syncthreads();
    if (threadIdx.x == 0) {
        unsigned* bar = b.bar;
        __builtin_amdgcn_s_waitcnt(0);
        unsigned nloc = b.st[0], nx = b.st[1];
        if (nloc == 0u) { xcd_barrier_complete(bar, b.x, nloc, nx); b.st[0] = nloc; b.st[1] = nx; }
        const unsigned old = xb_add(&bar[XB_XSUB(b.x)], 1u);
        const unsigned gen = old / nloc;
        if (old + 1u == (gen + 1u) * nloc) {
            __builtin_amdgcn_fence(__ATOMIC_RELEASE, "agent");
            asm volatile("s_waitcnt vmcnt(0)" ::: "memory");
            const unsigned og = xb_add(&bar[XB_TOP], 1u);
            const unsigned tg = og / nx;
            if (og + 1u == (tg + 1u) * nx) xb_add(&bar[XB_TOPGEN], 1u);
            else XB_SPIN(xb_ld(&bar[XB_TOPGEN]) == tg, bar);
            __builtin_amdgcn_fence(__ATOMIC_ACQUIRE, "agent");
            xb_add(&bar[XB_XGEN(b.x)], 1u);
            asm volatile("s_waitcnt vmcnt(0)" ::: "memory");
        } else {
            XB_SPIN(xb_ld(&bar[XB_XGEN(b.x)]) == gen, bar);
            __builtin_amdgcn_fence(__ATOMIC_ACQUIRE, "agent");
            asm volatile("s_waitcnt vmcnt(0)" ::: "memory");
        }
    }
    __syncthreads();
}


struct EpiBf16 {
    static constexpr bool PERM = true, AFTER_DRAIN = false;
    bf16_t* O; int ldc; int nsplit; size_t sstride;
    __device__ __forceinline__ void operator()(const f32x4 (&acc)[2][2][4][2], const pg8::Unit& u, int wr, int wc, int fr, int fq) const {
        int pn = u.pn; bf16_t* Ob = O; if (nsplit) { Ob += (size_t)(pn / nsplit) * sstride; pn = pn % nsplit; }
        const int row0 = u.pm * 256 + wr * 64 + fr, col0 = pn * 256 + wc * 32 + 8 * fq;
#pragma unroll
        for (int ai = 0; ai < 2; ++ai)
#pragma unroll
            for (int m = 0; m < 4; ++m) { bf16_t* rowp = Ob + (size_t)(row0 + ai * 128 + m * 16) * ldc + col0;
#pragma unroll
                for (int bj = 0; bj < 2; ++bj) { const f32x4 v0 = acc[ai][bj][m][0], v1 = acc[ai][bj][m][1];
                    u32x4 w; w.x = pk2(v0[0], v0[1]); w.y = pk2(v0[2], v0[3]); w.z = pk2(v1[0], v1[1]); w.w = pk2(v1[2], v1[3]);
                    *(u32x4*)(rowp + bj * 128) = w; } }
    }
};
struct EpiGateMul {
    static constexpr bool PERM = true, AFTER_DRAIN = false;
    bf16_t* O; int ldc;
    __device__ __forceinline__ void operator()(const f32x4 (&acc)[2][2][4][2], const pg8::Unit& u, int wr, int wc, int fr, int fq) const {
        const int row0 = u.pm * 256 + wr * 64 + fr, col0 = u.pn * 256 + wc * 32 + 8 * fq;
#pragma unroll
        for (int ai = 0; ai < 2; ++ai)
#pragma unroll
            for (int m = 0; m < 4; ++m) { bf16_t* rowp = O + (size_t)(row0 + ai * 128 + m * 16) * ldc + col0;
#pragma unroll
                for (int bj = 0; bj < 2; ++bj) { const f32x4 v0 = acc[ai][bj][m][0], v1 = acc[ai][bj][m][1];
                    const u32x4 b = *(const u32x4*)(rowp + bj * 128);
                    u32x4 w; w.x = pk2(sigmoidf_(v0[0]) * bflo(b.x), sigmoidf_(v0[1]) * bfhi(b.x)); w.y = pk2(sigmoidf_(v0[2]) * bflo(b.y), sigmoidf_(v0[3]) * bfhi(b.y));
                    w.z = pk2(sigmoidf_(v1[0]) * bflo(b.z), sigmoidf_(v1[1]) * bfhi(b.z)); w.w = pk2(sigmoidf_(v1[2]) * bflo(b.w), sigmoidf_(v1[3]) * bfhi(b.w));
                    *(u32x4*)(rowp + bj * 128) = w; } }
    }
};
struct EpiSwiGLU {
    static constexpr bool PERM = true, AFTER_DRAIN = false;
    bf16_t* H; int ldh;
    __device__ __forceinline__ void operator()(const f32x4 (&acc)[2][2][4][2], const pg8::Unit& u, int wr, int wc, int fr, int fq) const {
        const int row0 = u.pm * 256 + wr * 64 + fr, col0 = (u.pn * 256 + wc * 32 + 8 * fq) >> 1;
#pragma unroll
        for (int ai = 0; ai < 2; ++ai)
#pragma unroll
            for (int m = 0; m < 4; ++m) { bf16_t* rowp = H + (size_t)(row0 + ai * 128 + m * 16) * ldh + col0;
#pragma unroll
                for (int bj = 0; bj < 2; ++bj) { const f32x4 g = acc[ai][bj][m][0], up = acc[ai][bj][m][1];
                    u32x2 w; w.x = pk2(siluf_(g[0]) * up[0], siluf_(g[1]) * up[1]); w.y = pk2(siluf_(g[2]) * up[2], siluf_(g[3]) * up[3]);
                    *(u32x2*)(rowp + bj * 64) = w; } }
    }
};
struct EpiF32 {
    static constexpr bool PERM = false, AFTER_DRAIN = false;
    float* Y; int ldc;
    __device__ __forceinline__ void operator()(const f32x4 (&acc)[2][2][4][2], const pg8::Unit& u, int wr, int wc, int fr, int fq) const {
        const int row0 = u.pm * 256 + wr * 64 + fr, col0 = u.pn * 256 + wc * 32 + 4 * fq;
#pragma unroll
        for (int ai = 0; ai < 2; ++ai)
#pragma unroll
            for (int m = 0; m < 4; ++m) { float* rowp = Y + (size_t)(row0 + ai * 128 + m * 16) * ldc + col0;
#pragma unroll
                for (int bj = 0; bj < 2; ++bj)
#pragma unroll
                    for (int n = 0; n < 2; ++n) *(f32x4*)(rowp + bj * 128 + n * 16) = acc[ai][bj][m][n]; }
    }
};

template <class Map>
__device__ __forceinline__ void transpose_item(const float* W, int K, int N, LAS float* scr, int item, int lane, const Map& map) {
    const int nblk = (N + 31) / 32, kb = item / nblk, nb = item % nblk, k0 = 64 * kb, n0 = 32 * nb;
    const int nn = n0 + (lane & 31); const bool ok = nn < N;
#pragma unroll 8
    for (int i = 0; i < 32; ++i) { const int kk = 2 * i + (lane >> 5); scr[kk * 33 + (lane & 31)] = ok ? W[(size_t)(k0 + kk) * N + nn] : 0.f; }
    LDS_WAIT(); asm volatile("" ::: "memory");
    const int c = lane & 7;
#pragma unroll
    for (int j = 0; j < 4; ++j) { const int n = (lane >> 3) + 8 * j; const LAS float* s = scr + (8 * c) * 33 + n;
        u32x4 o; o.x = pk2(s[0 * 33], s[1 * 33]); o.y = pk2(s[2 * 33], s[3 * 33]); o.z = pk2(s[4 * 33], s[5 * 33]); o.w = pk2(s[6 * 33], s[7 * 33]);
        if (n0 + n < N) map(n0 + n, k0 + 8 * c, o); }
    LDS_WAIT(); asm volatile("" ::: "memory");
}

__device__ __forceinline__ void convert_weights(const Args& a, LAS unsigned char* lds, int l, int gw, int NGW, int lane, int wave) {
    LAS float* scr = (LAS float*)(lds + wave * 16384);
    unsigned char* wb = a.ws + WS_W;
    constexpr int I_FI = 16 * 176, I_FO = 44 * 32, I_IN = 16 * 250, I_BR = 8 * 32, I_OU = 16 * 32;
    constexpr int NITEMS = 2 * I_FI + 2 * I_FO + I_IN + 3 * I_BR + I_OU;
    for (int it = gw; it < NITEMS; it += NGW) {
        int r = it;
        if (r < 2 * I_FI) { const int f = r / I_FI; r -= f * I_FI; bf16_t* dst = (bf16_t*)(wb + W_FFIN) + (size_t)f * NFF2 * D;
            transpose_item(inp(a, I_WFIN) + (size_t)(l * 2 + f) * D * NFF2, D, NFF2, scr, r, lane,
                [=](int n, int k, u32x4 o) { const int h = n < DFF ? n : n - DFF; const int row = 8 * (h >> 2) + (n < DFF ? 0 : 4) + (h & 3); *(u32x4*)(dst + (size_t)row * D + k) = o; });
            continue; }
        r -= 2 * I_FI;
        if (r < 2 * I_FO) { const int f = r / I_FO; r -= f * I_FO; bf16_t* dst = (bf16_t*)(wb + W_FFOUT) + (size_t)f * D * DFF;
            transpose_item(inp(a, I_WFOUT) + (size_t)(l * 2 + f) * DFF * D, DFF, D, scr, r, lane,
                [=](int n, int k, u32x4 o) { *(u32x4*)(dst + (size_t)n * DFF + k) = o; });
            continue; }
        r -= 2 * I_FO;
        if (r < I_IN) { bf16_t* dp = (bf16_t*)(wb + W_P); bf16_t* dm = (bf16_t*)(wb + W_MG);
            transpose_item(inp(a, I_WIN) + (size_t)l * D * INC, D, INC, scr, r, lane,
                [=](int n, int k, u32x4 o) { if (n < PREAL) *(u32x4*)(dp + (size_t)n * D + k) = o; else *(u32x4*)(dm + (size_t)(n - PREAL) * D + k) = o; });
            continue; }
        r -= I_IN;
        if (r < 3 * I_BR) { const int nb = r / I_BR; r -= nb * I_BR; bf16_t* dst = (bf16_t*)(wb + W_B) + (size_t)nb * 1024 * 512;
            transpose_item(inp(a, I_WBR) + (size_t)(l * 3 + nb) * 512 * D, 512, D, scr, r, lane,
                [=](int n, int k, u32x4 o) { *(u32x4*)(dst + (size_t)n * 512 + k) = o; });
            continue; }
        r -= 3 * I_BR;
        { bf16_t* dst = (bf16_t*)(wb + W_O3);
            transpose_item(inp(a, I_WOUT) + (size_t)l * D * D, D, D, scr, r, lane,
                [=](int n, int k, u32x4 o) { bf16_t* p = dst + (size_t)n * 3072 + k; *(u32x4*)p = o; *(u32x4*)(p + 1024) = o; *(u32x4*)(p + 2048) = o; }); }
    }
    { u32x4* z = (u32x4*)((bf16_t*)(wb + W_P) + (size_t)PREAL * D); const int nz = (PN - PREAL) * D * 2 / 16;
      for (int i = gw * 64 + lane; i < nz; i += NGW * 64) z[i] = (u32x4){0u, 0u, 0u, 0u}; }
}

__device__ __forceinline__ void ada_partial(const Args& a, int gw, int NGW, int lane) {
    float* modp = (float*)(a.ws + WS_MODP);
    for (int it = gw; it < 2 * 144 * 8; it += NGW) {
        const int ks = it & 7, cgp = (it >> 3) % 144, l = it / (8 * 144);
        const int col = cgp * 64 + lane;
        const float* w = inp(a, I_WADA) + ((size_t)l * D + ks * 128) * 9216 + col;
        float acc[5] = {0.f, 0.f, 0.f, 0.f, 0.f};
#pragma unroll 4
        for (int k = 0; k < 128; ++k) { const float wv = w[(size_t)k * 9216]; const int kk = ks * 128 + k;
            acc[0] += siluf_(inp(a, I_CCTX)[kk]) * wv;
#pragma unroll
            for (int i = 0; i < 4; ++i) acc[1 + i] += siluf_(inp(a, I_C)[i * D + kk]) * wv; }
#pragma unroll
        for (int i = 0; i < 5; ++i) modp[((size_t)(ks * 2 + l) * 5 + i) * 9216 + col] = acc[i];
    }
}

struct RowOp { int src_input, has_y; float coef; const float* npost; const float* mdg_base; int has_xn; const float* npre; const float* md_base; int si; int add_pos; };
template <int NR>
__device__ __forceinline__ void rowwise(const Args& a, const RowOp& op, const int (&rs)[NR], int lane) {
    f32x4 v[NR][4]; u32x2 yb[NR][4], yb2[NR][4]; float* xd[NR]; bool lat[NR]; int cv[NR];
#pragma unroll
    for (int q = 0; q < NR; ++q) { const int r = rs[q]; lat[q] = r < MLAT; cv[q] = lat[q] ? 1 + (r >> 12) : 0;
        const float* xs = op.src_input ? (lat[q] ? inp(a, I_XS) + (size_t)r * D : inp(a, I_XP) + (size_t)(r - MLAT) * D)
                                       : (lat[q] ? a.out + OFF_YS + (size_t)r * D : a.out + OFF_YP + (size_t)(r - MLAT) * D);
        xd[q] = lat[q] ? a.out + OFF_YS + (size_t)r * D : a.out + OFF_YP + (size_t)(r - MLAT) * D;
#pragma unroll
        for (int j = 0; j < 4; ++j) v[q][j] = *(const f32x4*)(xs + 4 * lane + 256 * j);
        if (op.has_y) { const bf16_t* yr = (const bf16_t*)(a.ws + WS_A) + (size_t)r * D;
#pragma unroll
            for (int j = 0; j < 4; ++j) { yb[q][j] = *(const u32x2*)(yr + 4 * lane + 256 * j); yb2[q][j] = *(const u32x2*)(yr + (size_t)MTOT * D + 4 * lane + 256 * j); } } }
#pragma unroll
    for (int q = 0; q < NR; ++q) { const int r = rs[q];
        if (op.has_y) {
            f32x4 y[4]; float ss = 0.f;
#pragma unroll
            for (int j = 0; j < 4; ++j) { y[j] = (f32x4){bflo(yb[q][j].x) + bflo(yb2[q][j].x), bfhi(yb[q][j].x) + bfhi(yb2[q][j].x), bflo(yb[q][j].y) + bflo(yb2[q][j].y), bfhi(yb[q][j].y) + bfhi(yb2[q][j].y)}; ss += (y[j].x * y[j].x + y[j].y * y[j].y) + (y[j].z * y[j].z + y[j].w * y[j].w); }
            const float rr = rsqrtf(wave_sum(ss) * (1.f / D) + EPSN) * op.coef;
            const float* gp = op.mdg_base + (size_t)cv[q] * 9216;
#pragma unroll
            for (int j = 0; j < 4; ++j) { const f32x4 w = *(const f32x4*)(op.npost + 4 * lane + 256 * j), gg = *(const f32x4*)(gp + 4 * lane + 256 * j);
                v[q][j] = v[q][j] + gg * (y[j] * rr) * w; *(f32x4*)(xd[q] + 4 * lane + 256 * j) = v[q][j]; }
        }
        if (op.has_xn) {
            float ss = 0.f;
#pragma unroll
            for (int j = 0; j < 4; ++j) ss += (v[q][j].x * v[q][j].x + v[q][j].y * v[q][j].y) + (v[q][j].z * v[q][j].z + v[q][j].w * v[q][j].w);
            const float rr = rsqrtf(wave_sum(ss) * (1.f / D) + EPSN);
            const float* sh = op.md_base + (size_t)cv[q] * 9216 + (size_t)op.si * D; const float* sc = sh + D;
            const float* pos = (const float*)(a.ws + WS_POS); const int t = r & 4095;
            bf16_t* xo = (bf16_t*)(a.ws + WS_XN) + (size_t)r * D;
#pragma unroll
            for (int j = 0; j < 4; ++j) { const int c = 4 * lane + 256 * j; const f32x4 w = *(const f32x4*)(op.npre + c), s1 = *(const f32x4*)(sc + c), s0 = *(const f32x4*)(sh + c);
                f32x4 o = (v[q][j] * rr) * w * (s1 + 1.0f) + s0;
                if (op.add_pos && lat[q]) { const float* pp = (c < 512) ? pos + (size_t)(t >> 6) * 512 + c : pos + (size_t)(t & 63) * 512 + (c - 512); o = o + *(const f32x4*)pp; }
                u32x2 pk; pk.x = pk2(o.x, o.y); pk.y = pk2(o.z, o.w); *(u32x2*)(xo + c) = pk; }
        }
    }
}
__device__ __forceinline__ void rowwise_all(const Args& a, const RowOp& op, int gw, int NGW, int lane) {
    int r = gw;
    for (; r + NGW < MTOT; r += 2 * NGW) { const int rs[2] = {r, r + NGW}; rowwise<2>(a, op, rs, lane); }
    if (r < MTOT) { const int rs[1] = {r}; rowwise<1>(a, op, rs, lane); }
}

constexpr int C_MQ = 0, C_MK = 256, C_MV = 512, C_MO = 1024, C_MIF = 1536, C_GQ = 1552, C_GK = 1808, C_GV = 2064, C_GR = 2576, C_GLR = 3088, C_HQ = 3120, C_HF = 3376, C_HV = 3888, C_HG = 4400;

struct ItemInfo { int br, dir, head, seq, c, T, NC; };
__device__ __forceinline__ ItemInfo item_info(int g, int it) { ItemInfo I; const int hdb = it % 24, cgl = it / 24; I.br = hdb >> 3; I.dir = (hdb >> 2) & 1; I.head = hdb & 3;
    I.T = g < 2 ? 4096 : 256; I.NC = I.T >> 6; I.seq = cgl / I.NC; I.c = cgl % I.NC; return I; }
__device__ __forceinline__ int item_row(const ItemInfo& I, int s) { const int tau = I.c * 64 + s; return I.seq * I.T + (I.dir ? I.T - 1 - tau : tau); }
__device__ __forceinline__ float lb_of(const Args& a, int l, int ch) { if (l == 0) return 0.f; const float g0 = inp(a, I_HGAM)[ch], g1 = inp(a, I_HGAM)[256 + ch]; return 1.0f / (1.0f + expf(g0 - g1)); }

template <bool NEEDQ>
__device__ __forceinline__ void load_gated(const Args& a, const bf16_t* P, const ItemInfo& I, int l, int d, int sg, float (&qv)[8], float (&kv)[8], float (&la)[8]) {
    const int ch = I.head * 64 + d;
    if (I.br == 1) {
        float wup[16];
        const float* wp = inp(a, I_GWUP) + ((size_t)(l * 2 + I.dir) * 16) * 256 + ch;
#pragma unroll
        for (int r = 0; r < 16; ++r) wup[r] = wp[r * 256];
        const float gb = inp(a, I_GLB)[(l * 2 + I.dir) * 256 + ch];
#pragma unroll
        for (int i = 0; i < 8; ++i) { const bf16_t* pr = P + (size_t)item_row(I, 8 * sg + i) * PN;
            const u32x4 g0 = *(const u32x4*)(pr + C_GLR + I.dir * 16), g1 = *(const u32x4*)(pr + C_GLR + I.dir * 16 + 8);
            float z = gb;
            z += bflo(g0.x) * wup[0] + bfhi(g0.x) * wup[1] + bflo(g0.y) * wup[2] + bfhi(g0.y) * wup[3] + bflo(g0.z) * wup[4] + bfhi(g0.z) * wup[5] + bflo(g0.w) * wup[6] + bfhi(g0.w) * wup[7];
            z += bflo(g1.x) * wup[8] + bfhi(g1.x) * wup[9] + bflo(g1.y) * wup[10] + bfhi(g1.y) * wup[11] + bflo(g1.z) * wup[12] + bfhi(g1.z) * wup[13] + bflo(g1.w) * wup[14] + bfhi(g1.w) * wup[15];
            la[i] = logsigf_(z) * (1.0f / 16.0f);
            if (NEEDQ) qv[i] = bf2f(pr[C_GQ + ch]) * 0.125f; kv[i] = bf2f(pr[C_GK + ch]); }
    } else {
        const float lb = lb_of(a, l, ch);
#pragma unroll
        for (int i = 0; i < 8; ++i) { const bf16_t* pr = P + (size_t)item_row(I, 8 * sg + i) * PN;
            const float z = bf2f(pr[C_HF + I.dir * 256 + ch]); const float sg_ = sigmoidf_(z);
            la[i] = (lb == 0.f) ? logsigf_(z) : __logf(lb + (1.0f - lb) * sg_);
            if (NEEDQ) qv[i] = bf2f(pr[C_HQ + ch]) * 1.0f;
            kv[i] = (1.0f - lb) * (1.0f - sg_); }
    }
}
template <bool NEEDQ>
__device__ __forceinline__ void load_mlstm(const Args& a, const bf16_t* P, const ItemInfo& I, int l, int d, int sg, float (&qv)[8], float (&kv)[8], float (&lf)[8], float (&li)[8]) {
    const float bi = inp(a, I_GB)[((l * 2 + I.dir) * 2 + 0) * 4 + I.head], bf_ = inp(a, I_GB)[((l * 2 + I.dir) * 2 + 1) * 4 + I.head];
#pragma unroll
    for (int i = 0; i < 8; ++i) { const bf16_t* pr = P + (size_t)item_row(I, 8 * sg + i) * PN;
        li[i] = bf2f(pr[C_MIF + I.dir * 8 + I.head]) + bi; lf[i] = logsigf_(bf2f(pr[C_MIF + I.dir * 8 + 4 + I.head]) + bf_);
        if (NEEDQ) qv[i] = bf2f(pr[C_MQ + I.head * 64 + d]) * 0.125f; kv[i] = bf2f(pr[C_MK + I.head * 64 + d]); }
}
__device__ __forceinline__ void stage_vT(const bf16_t* P, const ItemInfo& I, LAS bf16_t* Y, int pitch, int tid) {
    const int s = tid >> 3, eg = tid & 7; const int vb = I.br == 0 ? C_MV : (I.br == 1 ? C_GV : C_HV);
    const bf16_t* pv = P + (size_t)item_row(I, s) * PN + vb + I.head * 128 + 16 * eg;
    const u32x4 v0 = *(const u32x4*)pv, v1 = *(const u32x4*)(pv + 8);
    const unsigned wds[8] = {v0.x, v0.y, v0.z, v0.w, v1.x, v1.y, v1.z, v1.w};
#pragma unroll
    for (int i = 0; i < 8; ++i) { float x0 = bflo(wds[i]), x1 = bfhi(wds[i]); if (I.br == 2) { x0 = siluf_(x0); x1 = siluf_(x1); }
        Y[(16 * eg + 2 * i) * pitch + s] = (bf16_t)f2bf(x0); Y[(16 * eg + 2 * i + 1) * pitch + s] = (bf16_t)f2bf(x1); }
}
__device__ __forceinline__ bf16x8 ldfrag(const LAS bf16_t* T, int pitch, int row0, int k0, int lane) { return *(const LAS bf16x8*)(T + (row0 + (lane & 15)) * pitch + k0 + 8 * (lane >> 4)); }

struct Raw { bf16_t q[8], k[8], z[8]; unsigned g0, g1; float wup[16]; float p0, p1, nc, mc; u32x4 s0, s1; };
template <bool NEEDQ, bool NEEDS>
__device__ __forceinline__ void raw_load(const Args& a, const bf16_t* P, const ItemInfo& I, int l, int it, int tid, Raw& R) {
    const int d = tid & 63, lane = d, sg = __builtin_amdgcn_readfirstlane(tid >> 6), ch = I.head * 64 + d;
    const int qc = I.br == 0 ? C_MQ : (I.br == 1 ? C_GQ : C_HQ), kc = I.br == 0 ? C_MK : (I.br == 1 ? C_GK : C_HF + I.dir * 256);
#pragma unroll
    for (int i = 0; i < 8; ++i) { const bf16_t* pr = P + (size_t)item_row(I, 8 * sg + i) * PN;
        if (NEEDQ) R.q[i] = pr[qc + ch];
        R.k[i] = pr[kc + ch]; }
    if (I.br == 1) {
        R.g0 = P[(size_t)item_row(I, 8 * sg + (lane >> 4)) * PN + C_GLR + I.dir * 16 + (lane & 15)];
        R.g1 = P[(size_t)item_row(I, 8 * sg + 4 + (lane >> 4)) * PN + C_GLR + I.dir * 16 + (lane & 15)];
        const float* wp = inp(a, I_GWUP) + ((size_t)(l * 2 + I.dir) * 16) * 256 + ch;
#pragma unroll
        for (int r = 0; r < 16; ++r) R.wup[r] = wp[r * 256];
        R.p0 = inp(a, I_GLB)[(l * 2 + I.dir) * 256 + ch];
    } else if (I.br == 0) {
        R.g0 = P[(size_t)item_row(I, 8 * sg + (lane & 7)) * PN + C_MIF + I.dir * 8 + ((lane >> 3) & 1) * 4 + I.head];
        R.p0 = inp(a, I_GB)[((l * 2 + I.dir) * 2 + 0) * 4 + I.head]; R.p1 = inp(a, I_GB)[((l * 2 + I.dir) * 2 + 1) * 4 + I.head];
    } else R.p0 = lb_of(a, l, ch);
    if (NEEDS) { const bf16_t* US = (const bf16_t*)(a.ws + WS_BIG + BIG_US) + (size_t)it * 8192; const int e = tid >> 2, part = tid & 3;
        R.s0 = *(const u32x4*)(US + e * 64 + 16 * part); R.s1 = *(const u32x4*)(US + e * 64 + 16 * part + 8);
        if (I.br == 0) { R.nc = ((const float*)(a.ws + WS_DEC))[(size_t)it * 64 + d]; R.mc = ((const float*)(a.ws + WS_SC))[(size_t)it * 4 + 2]; } }
}
__device__ __forceinline__ float rl_bf(unsigned v, int ln) { return __uint_as_float(((unsigned)__builtin_amdgcn_readlane((int)v, ln)) << 16); }
template <bool NEEDQ>
__device__ __forceinline__ void gated_from_raw(const Raw& R, const ItemInfo& I, float (&qv)[8], float (&kv)[8], float (&la)[8]) {
    if (I.br == 1) {
#pragma unroll
        for (int i = 0; i < 8; ++i) { float z = R.p0; const unsigned src = i < 4 ? R.g0 : R.g1;
#pragma unroll
            for (int r = 0; r < 16; ++r) z += rl_bf(src, (i & 3) * 16 + r) * R.wup[r];
            la[i] = logsigf_(z) * (1.0f / 16.0f);
            if (NEEDQ) qv[i] = bf2f(R.q[i]) * 0.125f; kv[i] = bf2f(R.k[i]); }
    } else { const float lb = R.p0;
#pragma unroll
        for (int i = 0; i < 8; ++i) { const float z = bf2f(R.k[i]); const float sg_ = sigmoidf_(z);
            la[i] = (lb == 0.f) ? logsigf_(z) : __logf(lb + (1.0f - lb) * sg_);
            if (NEEDQ) qv[i] = bf2f(R.q[i]) * 1.0f;
            kv[i] = (1.0f - lb) * (1.0f - sg_); }
    }
}
template <bool NEEDQ>
__device__ __forceinline__ void mlstm_from_raw(const Raw& R, float (&qv)[8], float (&kv)[8], float (&lf)[8], float (&li)[8]) {
#pragma unroll
    for (int i = 0; i < 8; ++i) { li[i] = rl_bf(R.g0, i) + R.p0; lf[i] = logsigf_(rl_bf(R.g0, 8 + i) + R.p1);
        if (NEEDQ) qv[i] = bf2f(R.q[i]) * 0.125f; kv[i] = bf2f(R.k[i]); }
}
__device__ __forceinline__ void v_load(const bf16_t* P, const ItemInfo& I, int tid, u32x4& v0, u32x4& v1) {
    const int s = tid >> 3, eg = tid & 7; const int vb = I.br == 0 ? C_MV : (I.br == 1 ? C_GV : C_HV);
    const bf16_t* pv = P + (size_t)item_row(I, s) * PN + vb + I.head * 128 + 16 * eg; v0 = *(const u32x4*)pv; v1 = *(const u32x4*)(pv + 8);
}
__device__ __forceinline__ void v_store(int br, LAS bf16_t* Y, int pitch, int tid, const u32x4& v0, const u32x4& v1) {
    const int s = tid >> 3, eg = tid & 7; const unsigned wds[8] = {v0.x, v0.y, v0.z, v0.w, v1.x, v1.y, v1.z, v1.w};
#pragma unroll
    for (int i = 0; i < 8; ++i) { float x0 = bflo(wds[i]), x1 = bfhi(wds[i]); if (br == 2) { x0 = siluf_(x0); x1 = siluf_(x1); }
        Y[(16 * eg + 2 * i) * pitch + s] = (bf16_t)f2bf(x0); Y[(16 * eg + 2 * i + 1) * pitch + s] = (bf16_t)f2bf(x1); }
}

__device__ __forceinline__ void scan_s1(const Args& a, LAS unsigned char* lds, int l, int g, int it, const Raw& R, const u32x4& pv0, const u32x4& pv1) {
    int tid_ = threadIdx.x; asm volatile("" : "+v"(tid_)); const int tid = tid_, d = tid & 63, lane = d, sg = __builtin_amdgcn_readfirstlane(tid >> 6);
    const ItemInfo I = item_info(g, it);
    const bf16_t* P = (const bf16_t*)(a.ws + WS_BIG);
    bf16_t* US = (bf16_t*)(a.ws + WS_BIG + BIG_US) + (size_t)it * 8192;
    float* DEC = (float*)(a.ws + WS_DEC) + (size_t)it * 64; float* SC = (float*)(a.ws + WS_SC) + (size_t)it * 4;
    LAS bf16_t* XT = (LAS bf16_t*)lds;
    LAS bf16_t* YV = (LAS bf16_t*)(lds + 9216);
    LAS float* TOT = (LAS float*)(lds + 9216 + 20736);
    LAS float* TMX = TOT + 512;
    float qv[8], kv[8], x0[8], x1[8];
    if (I.br == 0) {
        mlstm_from_raw<false>(R, qv, kv, x0, x1);
        float run = 0.f;
#pragma unroll
        for (int i = 0; i < 8; ++i) { run += x0[i]; x0[i] = run; }
        TOT[sg * 64 + d] = run; LDS_WAIT(); __syncthreads();
        float pre = 0.f, tot = 0.f;
#pragma unroll
        for (int w = 0; w < 8; ++w) { const float t = TOT[w * 64 + d]; if (w < sg) pre += t; tot += t; }
        float mx = -3.0e38f;
#pragma unroll
        for (int i = 0; i < 8; ++i) { x0[i] = tot - (pre + x0[i]) + x1[i]; mx = fmaxf(mx, x0[i]); }
        TMX[sg * 64 + d] = mx; LDS_WAIT(); __syncthreads();
        float mlw = -3.0e38f;
#pragma unroll
        for (int w = 0; w < 8; ++w) mlw = fmaxf(mlw, TMX[w * 64 + d]);
#pragma unroll
        for (int i = 0; i < 8; ++i) kv[i] *= __expf(x0[i] - mlw);
        if (tid == 0) { SC[0] = mlw; SC[1] = tot; }
        for (int idx = tid; idx < 16 * 64; idx += 512) YV[(128 + (idx >> 6)) * 72 + (idx & 63)] = (bf16_t)((idx >> 6) == 0 ? 0x3F80 : 0);
    } else {
        gated_from_raw<false>(R, I, qv, kv, x0);
        float run = 0.f;
#pragma unroll
        for (int i = 0; i < 8; ++i) { run += x0[i]; x0[i] = run; }
        TOT[sg * 64 + d] = run; LDS_WAIT(); __syncthreads();
        float pre = 0.f, tot = 0.f;
#pragma unroll
        for (int w = 0; w < 8; ++w) { const float t = TOT[w * 64 + d]; if (w < sg) pre += t; tot += t; }
#pragma unroll
        for (int i = 0; i < 8; ++i) kv[i] *= __expf(tot - (pre + x0[i]));
        if (sg == 0) DEC[d] = __expf(tot);
    }
    { u32x4 w; w.x = pk2(kv[0], kv[1]); w.y = pk2(kv[2], kv[3]); w.z = pk2(kv[4], kv[5]); w.w = pk2(kv[6], kv[7]); *(LAS u32x4*)(XT + d * 72 + 8 * sg) = w; }
    v_store(I.br, YV, 72, tid, pv0, pv1);
    LDS_WAIT(); __syncthreads();
    f32x4 acc[4];
#pragma unroll
    for (int mt = 0; mt < 4; ++mt) acc[mt] = (f32x4){0.f, 0.f, 0.f, 0.f};
#pragma unroll
    for (int ks = 0; ks < 2; ++ks) { const bf16x8 b = ldfrag(YV, 72, 16 * sg, 32 * ks, lane);
#pragma unroll
        for (int mt = 0; mt < 4; ++mt) acc[mt] = __builtin_amdgcn_mfma_f32_16x16x32_bf16(ldfrag(XT, 72, 16 * mt, 32 * ks, lane), b, acc[mt], 0, 0, 0); }
    { const int e = 16 * sg + (lane & 15);
#pragma unroll
      for (int mt = 0; mt < 4; ++mt) { u32x2 o; o.x = pk2(acc[mt][0], acc[mt][1]); o.y = pk2(acc[mt][2], acc[mt][3]); *(u32x2*)(US + e * 64 + 16 * mt + 4 * (lane >> 4)) = o; } }
    if (I.br == 0 && sg < 4) {
        f32x4 an = (f32x4){0.f, 0.f, 0.f, 0.f};
#pragma unroll
        for (int ks = 0; ks < 2; ++ks) an = __builtin_amdgcn_mfma_f32_16x16x32_bf16(ldfrag(XT, 72, 16 * sg, 32 * ks, lane), ldfrag(YV, 72, 128, 32 * ks, lane), an, 0, 0, 0);
        if ((lane & 15) == 0) { const int d0 = 16 * sg + 4 * (lane >> 4); DEC[d0] = an[0]; DEC[d0 + 1] = an[1]; DEC[d0 + 2] = an[2]; DEC[d0 + 3] = an[3]; }
    }
    __syncthreads();
}

__device__ __forceinline__ void scan_s2(const Args& a, int l, int g) {
    const int T = g < 2 ? 4096 : 256, NC = T >> 6, nseq = g < 2 ? 2 : 32, nslot = nseq * 24 * 1024;
    bf16_t* USb = (bf16_t*)(a.ws + WS_BIG + BIG_US); float* DECb = (float*)(a.ws + WS_DEC); float* SCb = (float*)(a.ws + WS_SC);
    int tid_ = threadIdx.x; asm volatile("" : "+v"(tid_));
    for (int slot = blockIdx.x * 512 + tid_; slot < nslot; slot += gridDim.x * 512) {
        const int sub = slot & 1023, stream = slot >> 10, hdb = stream % 24, seq = stream / 24, br = hdb >> 3, dir = (hdb >> 2) & 1, head = hdb & 3;
        const int e = sub >> 3, d0 = (sub & 7) * 8;
        float S[8], nst[8], mst = 0.f;
#pragma unroll
        for (int i = 0; i < 8; ++i) { S[i] = 0.f; nst[i] = 0.f; }
        if (g < 2) { const int b = g * 2 + seq; const size_t sidx = (size_t)((b * 2 + l) * 2 + dir) * 4 + head;
            const float* sp = (br == 0 ? inp(a, I_SC) : (br == 1 ? inp(a, I_SG) : inp(a, I_SH))) + sidx * 8192;
#pragma unroll
            for (int i = 0; i < 8; ++i) S[i] = sp[(d0 + i) * 128 + e];
            if (br == 0) { mst = inp(a, I_SM)[sidx];
#pragma unroll
                for (int i = 0; i < 8; ++i) nst[i] = inp(a, I_SN)[sidx * 64 + d0 + i]; } }
        const bool nrow = (br == 0) && (e == 0);
        for (int c0 = 0; c0 < NC; c0 += 4) {
            u32x4 ub[4]; f32x4 q0[4], q1[4]; float m0[4], m1[4];
#pragma unroll
            for (int j = 0; j < 4; ++j) { const size_t it = (size_t)(seq * NC + c0 + j) * 24 + hdb;
                ub[j] = *(const u32x4*)(USb + it * 8192 + e * 64 + d0);
                if (br == 0) { m0[j] = SCb[it * 4]; m1[j] = SCb[it * 4 + 1]; }
                if (br != 0 || nrow) { q0[j] = *(const f32x4*)(DECb + it * 64 + d0); q1[j] = *(const f32x4*)(DECb + it * 64 + d0 + 4); } }
#pragma unroll
            for (int j = 0; j < 4; ++j) { const size_t it = (size_t)(seq * NC + c0 + j) * 24 + hdb;
                bf16_t* p = USb + it * 8192 + e * 64 + d0; float* dec = DECb + it * 64 + d0; float* sc = SCb + it * 4;
                const u32x4 u = ub[j];
                const float uu[8] = {bflo(u.x), bfhi(u.x), bflo(u.y), bfhi(u.y), bflo(u.z), bfhi(u.z), bflo(u.w), bfhi(u.w)};
                { u32x4 w; w.x = pk2(S[0], S[1]); w.y = pk2(S[2], S[3]); w.z = pk2(S[4], S[5]); w.w = pk2(S[6], S[7]); *(u32x4*)p = w; }
                if (br == 0) {
                    const float mlw = m0[j], bl = m1[j]; const float mn = fmaxf(bl + mst, mlw); const float fa = __expf(bl + mst - mn), fb = __expf(mlw - mn);
                    if (nrow) { const f32x4 n0 = q0[j], n1 = q1[j];
                        *(f32x4*)dec = (f32x4){nst[0], nst[1], nst[2], nst[3]}; *(f32x4*)(dec + 4) = (f32x4){nst[4], nst[5], nst[6], nst[7]};
                        const float nn[8] = {n0.x, n0.y, n0.z, n0.w, n1.x, n1.y, n1.z, n1.w};
#pragma unroll
                        for (int i = 0; i < 8; ++i) nst[i] = fa * nst[i] + fb * nn[i];
                        if (d0 == 0) sc[2] = mst; }
#pragma unroll
                    for (int i = 0; i < 8; ++i) S[i] = fa * S[i] + fb * uu[i];
                    mst = mn;
                } else {
                    const f32x4 a0 = q0[j], a1 = q1[j]; const float dd[8] = {a0.x, a0.y, a0.z, a0.w, a1.x, a1.y, a1.z, a1.w};
#pragma unroll
                    for (int i = 0; i < 8; ++i) S[i] = dd[i] * S[i] + uu[i];
                }
            }
        }
        if (g == 2) { const size_t sidx = (size_t)((seq * 2 + l) * 2 + dir) * 4 + head;
            float* op = a.out + (br == 0 ? OFF_C : (br == 1 ? OFF_G : OFF_H)) + sidx * 8192;
#pragma unroll
            for (int i = 0; i < 8; ++i) op[(d0 + i) * 128 + e] = S[i];
            if (nrow) {
#pragma unroll
                for (int i = 0; i < 8; ++i) a.out[OFF_N + sidx * 64 + d0 + i] = nst[i];
                if (d0 == 0) a.out[OFF_M + sidx] = mst; } }
    }
}

constexpr int S3_QO = 0, S3_KO = 23040, S3_G = 41472, S3_XA = 57856, S3_YV = 75264, S3_TOT = 114432, S3_VEC = 116480;
__device__ __forceinline__ void scan_s3(const Args& a, LAS unsigned char* lds, int l, int g, int it2, int it2n, Raw& Rc, u32x4& pv0, u32x4& pv1) {
    int tid_ = threadIdx.x; asm volatile("" : "+v"(tid_)); const int tid = tid_, d = tid & 63, lane = d, sg = __builtin_amdgcn_readfirstlane(tid >> 6);
    const int hb = it2 % 12, cgl = it2 / 12; ItemInfo I; I.br = hb >> 2; I.head = hb & 3; I.T = g < 2 ? 4096 : 256; I.NC = I.T >> 6; I.seq = cgl / I.NC; const int cn = cgl % I.NC; I.dir = 0; I.c = cn;
    const bf16_t* P = (const bf16_t*)(a.ws + WS_BIG);
    LAS bf16_t* QO = (LAS bf16_t*)(lds + S3_QO); LAS bf16_t* KO = (LAS bf16_t*)(lds + S3_KO); LAS float* G = (LAS float*)(lds + S3_G);
    LAS bf16_t* XA = (LAS bf16_t*)(lds + S3_XA); LAS bf16_t* YV = (LAS bf16_t*)(lds + S3_YV); LAS float* TOT = (LAS float*)(lds + S3_TOT);
    LAS float* Bv = (LAS float*)(lds + S3_VEC); LAS float* LIv = Bv + 64; LAS float* MT = Bv + 128; LAS float* EI = Bv + 192;
    v_store(I.br, YV, 136, tid, pv0, pv1);
    ItemInfo In; { const int hbn = it2n % 12, cgn = it2n / 12; In.br = hbn >> 2; In.head = hbn & 3; In.T = I.T; In.NC = I.NC; In.seq = cgn / I.NC; In.c = cgn % I.NC; In.dir = 0; }
    v_load(P, In, tid, pv0, pv1);
    f32x4 osum[4];
#pragma unroll
    for (int nt = 0; nt < 4; ++nt) osum[nt] = (f32x4){0.f, 0.f, 0.f, 0.f};
  for (int dir = 0; dir < 2; ++dir) {
    I.dir = dir; I.c = dir ? I.NC - 1 - cn : cn;
    const int it = (I.seq * I.NC + I.c) * 24 + I.br * 8 + dir * 4 + I.head;
#define RV(x) (dir ? 63 - (x) : (x))
    float qv[8], kv[8], x0[8], x1[8];
    const Raw R = Rc;
    { const int e = tid >> 2, part = tid & 3; *(LAS u32x4*)(YV + e * 136 + 64 + 16 * part) = R.s0; *(LAS u32x4*)(YV + e * 136 + 64 + 16 * part + 8) = R.s1; }
    { ItemInfo It = dir ? In : I; if (!dir) { It.dir = 1; It.c = I.NC - 1 - cn; }
      const int itt = (It.seq * It.NC + It.c) * 24 + It.br * 8 + It.dir * 4 + It.head;
      raw_load<true, true>(a, P, It, l, itt, tid, Rc); }
    const int bi = sg >> 1;
    f32x4 acc[4];
#pragma unroll
    for (int nt = 0; nt < 4; ++nt) acc[nt] = (f32x4){0.f, 0.f, 0.f, 0.f};
    if (I.br != 0) {
        gated_from_raw<true>(R, I, qv, kv, x0);
        float run = 0.f;
#pragma unroll
        for (int i = 0; i < 8; ++i) { run += x0[i]; x0[i] = run; }
        TOT[sg * 64 + d] = run; LDS_WAIT(); __syncthreads();
        float pre = 0.f;
#pragma unroll
        for (int w = 0; w < 8; ++w) { const float t = TOT[w * 64 + d]; if (w < sg) pre += t; }
#pragma unroll
        for (int i = 0; i < 8; ++i) { x0[i] += pre; const int s = 8 * sg + i; G[s * 64 + d] = x0[i]; XA[RV(s) * 136 + 64 + d] = (bf16_t)f2bf(qv[i] * __expf(x0[i])); }
        LDS_WAIT(); __syncthreads();
        const float gs = bi ? G[(16 * bi - 1) * 64 + d] : 0.f, geo = G[(16 * bi + 15) * 64 + d];
        float gej[3];
#pragma unroll
        for (int j = 0; j < 3; ++j) gej[j] = G[(16 * j + 15) * 64 + d];
#pragma unroll
        for (int i = 0; i < 8; ++i) { const int tt = 8 * (sg & 1) + i;
            QO[(6 + bi) * 1152 + tt * 72 + d] = (bf16_t)f2bf(qv[i] * __expf(x0[i] - gs));
            KO[(4 + bi) * 1152 + tt * 72 + d] = (bf16_t)f2bf(kv[i] * __expf(fminf(gs - x0[i], 80.f)));
            KO[bi * 1152 + tt * 72 + d] = (bf16_t)f2bf(kv[i] * __expf(geo - x0[i]));
#pragma unroll
            for (int j = 0; j < 3; ++j) if (j < bi) QO[(bi * (bi - 1) / 2 + j) * 1152 + tt * 72 + d] = (bf16_t)f2bf(qv[i] * __expf(fminf(x0[i] - gej[j], 0.f))); }
        LDS_WAIT(); __syncthreads();
#pragma unroll
        for (int jj = 0; jj < 2; ++jj) { const int j = 2 * (sg & 1) + jj; f32x4 t = (f32x4){0.f, 0.f, 0.f, 0.f};
            if (j <= bi) { const int qt = (j == bi) ? 6 + bi : bi * (bi - 1) / 2 + j, kt = (j == bi) ? 4 + bi : j;
#pragma unroll
                for (int ks = 0; ks < 2; ++ks) t = __builtin_amdgcn_mfma_f32_16x16x32_bf16(ldfrag(QO + qt * 1152, 72, 0, 32 * ks, lane), ldfrag(KO + kt * 1152, 72, 0, 32 * ks, lane), t, 0, 0, 0); }
#pragma unroll
            for (int r = 0; r < 4; ++r) { const int tl = 4 * (lane >> 4) + r, sl = lane & 15; float v = t[r]; if (j == bi && sl > tl) v = 0.f;
                XA[RV(16 * bi + tl) * 136 + RV(16 * j + sl)] = (bf16_t)f2bf(v); } }
        LDS_WAIT(); __syncthreads();
    } else {
        mlstm_from_raw<true>(R, qv, kv, x0, x1);
        float run = 0.f;
#pragma unroll
        for (int i = 0; i < 8; ++i) { run += x0[i]; x0[i] = run; }
        TOT[sg * 64 + d] = run;
        for (int idx = tid; idx < 16 * 128; idx += 512) { const int r = idx >> 7, k = idx & 127; YV[(128 + r) * 136 + k] = (bf16_t)(r == 0 ? (k < 64 ? 0x3F80u : 0u) : 0u); }
        LDS_WAIT(); __syncthreads();
        float pre = 0.f;
#pragma unroll
        for (int w = 0; w < 8; ++w) { const float t = TOT[w * 64 + d]; if (w < sg) pre += t; }
#pragma unroll
        for (int i = 0; i < 8; ++i) { x0[i] += pre; const int s = 8 * sg + i; if (d == 0) { Bv[s] = x0[i]; LIv[s] = x1[i]; }
            if (i == 0 && sg == 1) YV[128 * 136 + 64 + d] = (bf16_t)f2bf(R.nc);
            QO[s * 72 + d] = (bf16_t)f2bf(qv[i]); KO[s * 72 + d] = (bf16_t)f2bf(kv[i]); }
        LDS_WAIT(); __syncthreads();
        if (tid < 64) { float rn = -3.0e38f; for (int s = 0; s <= tid; ++s) rn = fmaxf(rn, LIv[s] - Bv[s]);
            const float bt = Bv[tid], inter = bt + R.mc, mt = fmaxf(inter, bt + rn); MT[RV(tid)] = mt; EI[RV(tid)] = __expf(inter - mt); }
        f32x4 t2[2];
#pragma unroll
        for (int jj = 0; jj < 2; ++jj) { const int j = 2 * (sg & 1) + jj; t2[jj] = (f32x4){0.f, 0.f, 0.f, 0.f};
            if (j <= bi) {
#pragma unroll
                for (int ks = 0; ks < 2; ++ks) t2[jj] = __builtin_amdgcn_mfma_f32_16x16x32_bf16(ldfrag(QO, 72, 16 * bi, 32 * ks, lane), ldfrag(KO, 72, 16 * j, 32 * ks, lane), t2[jj], 0, 0, 0); } }
        LDS_WAIT(); __syncthreads();
#pragma unroll
        for (int jj = 0; jj < 2; ++jj) { const int j = 2 * (sg & 1) + jj;
#pragma unroll
            for (int r = 0; r < 4; ++r) { const int t = 16 * bi + 4 * (lane >> 4) + r, s = 16 * j + (lane & 15); float v = 0.f;
                if (s <= t) v = t2[jj][r] * __expf(Bv[t] - Bv[s] + LIv[s] - MT[RV(t)]);
                XA[RV(t) * 136 + RV(s)] = (bf16_t)f2bf(v); } }
#pragma unroll
        for (int i = 0; i < 8; ++i) { const int s = 8 * sg + i; XA[RV(s) * 136 + 64 + d] = (bf16_t)f2bf(qv[i] * EI[RV(s)]); }
        LDS_WAIT(); __syncthreads();
    }
    f32x4 accd[4];
#pragma unroll
    for (int nt = 0; nt < 4; ++nt) accd[nt] = (f32x4){0.f, 0.f, 0.f, 0.f};
#pragma unroll
    for (int ks = 0; ks < 4; ++ks) { const bf16x8 av = ldfrag(YV, 136, 16 * sg, 32 * ks, lane);
        bf16x8 ad = av; if (I.br == 0) ad = ldfrag(YV, 136, 128, 32 * ks, lane);
#pragma unroll
        for (int nt = 0; nt < 4; ++nt) { const bf16x8 bx = ldfrag(XA, 136, 16 * nt, 32 * ks, lane);
            acc[nt] = __builtin_amdgcn_mfma_f32_16x16x32_bf16(av, bx, acc[nt], 0, 0, 0);
            if (I.br == 0) accd[nt] = __builtin_amdgcn_mfma_f32_16x16x32_bf16(ad, bx, accd[nt], 0, 0, 0); } }
#pragma unroll
    for (int nt = 0; nt < 4; ++nt) { const int t = 16 * nt + (lane & 15); f32x4 o = acc[nt];
        if (I.br == 0) { const float den = __shfl(accd[nt][0], lane & 15); const float dn = fmaxf(fabsf(den), __expf(-MT[t])); o = o * (1.0f / dn); }
        osum[nt] = osum[nt] + o; }
    __syncthreads();
#undef RV
  }
    LAS float* RED = TOT;
#pragma unroll
    for (int nt = 0; nt < 4; ++nt) { float ss = (osum[nt][0] * osum[nt][0] + osum[nt][1] * osum[nt][1]) + (osum[nt][2] * osum[nt][2] + osum[nt][3] * osum[nt][3]);
        ss += __shfl_xor(ss, 16); ss += __shfl_xor(ss, 32);
        if (lane < 16) RED[sg * 64 + 16 * nt + lane] = ss; }
    LDS_WAIT(); __syncthreads();
    const int e0 = 16 * sg + 4 * (lane >> 4); const int gcol = (I.br == 0 ? C_MO : (I.br == 1 ? C_GR : C_HG)) + I.head * 128 + e0;
    const f32x4 hw = *(const f32x4*)(inp(a, I_HN) + (size_t)(l * 3 + I.br) * 512 + I.head * 128 + e0);
    bf16_t* YSo = (bf16_t*)(a.ws + WS_A) + (size_t)g * GROWS * 1536;
#pragma unroll
    for (int nt = 0; nt < 4; ++nt) { const int t = 16 * nt + (lane & 15); float tot = 0.f;
#pragma unroll
        for (int w = 0; w < 8; ++w) tot += RED[w * 64 + t];
        const float rr = rsqrtf(tot * (1.0f / 128.0f) + EPSN);
        const int lr = I.seq * I.T + 64 * cn + t;
        const u32x2 gt = *(const u32x2*)(P + (size_t)lr * PN + gcol);
        const float gv[4] = {bflo(gt.x), bfhi(gt.x), bflo(gt.y), bfhi(gt.y)}; float y[4];
#pragma unroll
        for (int r = 0; r < 4; ++r) { const float gg = I.br == 0 ? sigmoidf_(gv[r]) : siluf_(gv[r]); y[r] = gg * (osum[nt][r] * rr) * hw[r]; }
        u32x2 w; w.x = pk2(y[0], y[1]); w.y = pk2(y[2], y[3]);
        *(u32x2*)(YSo + (size_t)lr * 1536 + I.br * 512 + I.head * 128 + e0) = w; }
    __syncthreads();
}


enum { ST_F1IN = 0, ST_F1OUT = 1, ST_ROWA = 2, ST_G0 = 3, ST_BR = 15, ST_MG = 16, ST_OUT = 17, ST_ROWB = 18, ST_F2IN = 19, ST_F2OUT = 20, ST_ROWC = 21, NST = 22 };
#ifndef REP_S1
#define REP_S1 1
#endif
#ifndef REP_S3
#define REP_S3 1
#endif
#ifndef REP_G
#define REP_G 1
#endif
template <int M_, int N_, int K_, int LDA_, int LDB_, int ADIV, int AMUL, int KS, class Epi>
__device__ __forceinline__ void run_gemm(LAS unsigned char* lds, const bf16_t* A, const bf16_t* Bt, const Epi& E) {
    typedef pg8::GemmT<M_, N_, K_, LDA_, LDB_> GT; GT g{A, Bt}; typedef pg8::StaticOrderT<M_, N_, ADIV, AMUL, KS> SO; SO S; S.init((int)gridDim.x, (int)blockIdx.x);
    pg8::gemm_phase<GT, Epi, SO, true, true>((PG8_LAS unsigned char*)lds, g, S, E);
}

__global__ void __launch_bounds__(512, 2) mk_fwd(Args a) {
    extern __shared__ __attribute__((aligned(16))) unsigned char lds_raw[];
    LAS unsigned char* lds = (LAS unsigned char*)lds_raw;
    cg::grid_group grid = cg::this_grid();
    for (int u = threadIdx.x; u < (LDS_BYTES - 131072) / 4; u += 512) ((LAS unsigned*)(lds + 131072))[u] = 0u;
    __syncthreads();
    (void)xcd_barrier_post((unsigned*)a.ws, (volatile LAS unsigned*)(lds + 131072 + 352));
    const int tid = threadIdx.x, lane = tid & 63, wave = __builtin_amdgcn_readfirstlane(tid >> 6);
    const int G = gridDim.x, gw = blockIdx.x * 8 + wave, NGW = G * 8;
    unsigned char* ws = a.ws;
    float* mod = (float*)(ws + WS_MOD);

#ifndef SKIP_PRO
    convert_weights(a, lds, 0, gw, NGW, lane, wave);
    ada_partial(a, gw, NGW, lane);
    { float* pos = (float*)(ws + WS_POS);
      for (int i = blockIdx.x * 512 + tid; i < 64 * 512; i += G * 512) { const int v = i >> 9, j = i & 511, fi = j & 255;
          const float fr = expf((-9.210340371976184f * (float)fi) / 256.0f); const float ang = (float)v * fr; pos[i] = j < 256 ? sinf(ang) : cosf(ang); } }
    grid.sync();
    { const float* modp = (const float*)(ws + WS_MODP);
      for (int i = blockIdx.x * 512 + tid; i < 2 * 5 * 9216; i += G * 512) { const int col = i % 9216, l = i / (5 * 9216); float s = inp(a, I_BADA)[l * 9216 + col];
#pragma unroll
          for (int ks = 0; ks < 8; ++ks) s += modp[(size_t)ks * (2 * 5 * 9216) + i]; mod[i] = s; } }
    xcd_barrier_ni((unsigned*)a.ws, 131072 + 352);
    { RowOp op{}; op.src_input = 1; op.has_y = 0; op.has_xn = 1; op.npre = inp(a, I_NPRE); op.md_base = mod; op.si = 0; op.add_pos = 0;
      rowwise_all(a, op, gw, NGW, lane); }
    xcd_barrier_ni((unsigned*)a.ws, 131072 + 352);
#endif

    for (int l = 0; l < 2; ++l) {
        for (int st = 0; st < NST; ++st) {
            int tid = threadIdx.x; asm volatile("" : "+v"(tid));
            const int lane = tid & 63, wave = __builtin_amdgcn_readfirstlane(tid >> 6), gw = blockIdx.x * 8 + wave;
            unsigned char* ws = a.ws; asm volatile("" : "+s"(ws));
            float* mod = (float*)(ws + WS_MOD); const float* modl = mod + (size_t)l * 5 * 9216;
            bf16_t* XN = (bf16_t*)(ws + WS_XN); bf16_t* BIG = (bf16_t*)(ws + WS_BIG); float* Y = (float*)(ws + WS_A); bf16_t* YS = (bf16_t*)(ws + WS_A);
            unsigned char* wb = ws + WS_W; const int G = gridDim.x, NGW = G * 8;
            const int kind = (st == ST_F1IN || st == ST_F2IN) ? 0 : (st == ST_F1OUT || st == ST_OUT || st == ST_F2OUT) ? 1 : (st == ST_ROWA || st == ST_ROWB || st == ST_ROWC) ? 2 : (st == ST_BR) ? 3 : (st == ST_MG) ? 4 : 5 + ((st - ST_G0) % 4);
            const int g = (st >= ST_G0 && st < ST_BR) ? (st - ST_G0) / 4 : 0;
            switch (kind) {
            case 0: {
#ifndef SKIP_G0
                const int f = st == ST_F1IN ? 0 : 1; EpiSwiGLU E{BIG, DFF};
                for (int rep = 0; rep < REP_G; ++rep) run_gemm<MTOT, NFF2, D, D, D, 0, 0, 1>(lds, XN, (const bf16_t*)(wb + W_FFIN) + (size_t)f * NFF2 * D, E);
#endif
                break; }
            case 1: {
#ifndef SKIP_G1
                EpiBf16 E{(bf16_t*)Y, D, 4, (size_t)MTOT * D};
                for (int rep = 0; rep < REP_G; ++rep)
                if (st == ST_OUT) run_gemm<MTOT, 2 * D, 1536, 3072, 3072, 4, 1536, 2>(lds, BIG, (const bf16_t*)(wb + W_O3), E);
                else run_gemm<MTOT, 2 * D, DFF / 2, DFF, DFF, 4, DFF / 2, 2>(lds, BIG, (const bf16_t*)(wb + W_FFOUT) + (size_t)(st == ST_F1OUT ? 0 : 1) * D * DFF, E);
#endif
                break; }
            case 2: {
#ifndef SKIP_ROW
                RowOp op{}; op.has_y = 1; op.mdg_base = modl + (st == ST_ROWA ? 2 : st == ST_ROWB ? 5 : 8) * D; op.coef = st == ST_ROWB ? 1.0f : 0.5f;
                op.npost = inp(a, I_NPOST) + (size_t)(l * 3 + (st == ST_ROWA ? 0 : st == ST_ROWB ? 1 : 2)) * D; op.src_input = (l == 0 && st == ST_ROWA) ? 1 : 0;
                if (st == ST_ROWA) { op.has_xn = 1; op.npre = inp(a, I_NPRE) + (size_t)(l * 3 + 1) * D; op.md_base = modl; op.si = 3; op.add_pos = 1; }
                else if (st == ST_ROWB) { op.has_xn = 1; op.npre = inp(a, I_NPRE) + (size_t)(l * 3 + 2) * D; op.md_base = modl; op.si = 6; op.add_pos = 0; }
                else { op.has_xn = (l == 0) ? 1 : 0; op.npre = inp(a, I_NPRE) + (size_t)3 * D; op.md_base = mod + (size_t)5 * 9216; op.si = 0; op.add_pos = 0; }
                rowwise_all(a, op, gw, NGW, lane);
                if (st == ST_ROWC && l == 0) { __syncthreads(); convert_weights(a, lds, 1, gw, NGW, lane, wave); }
#endif
                break; }
            case 3: {
#ifndef SKIP_G3
                EpiBf16 E{BIG, 3072, 0, 0};
                for (int rep = 0; rep < REP_G; ++rep) run_gemm<MTOT, 3072, 512, 1536, 512, 4, 512, 1>(lds, YS, (const bf16_t*)(wb + W_B), E);
#endif
                break; }
            case 4: {
#ifndef SKIP_G4
                EpiGateMul E{BIG, 3072};
                run_gemm<MTOT, MGN, D, D, D, 0, 0, 1>(lds, XN, (const bf16_t*)(wb + W_MG), E);
#endif
                break; }
            case 5: {
#ifndef SKIP_G3
                EpiBf16 E{BIG, PN, 0, 0};
                for (int rep = 0; rep < REP_G; ++rep) run_gemm<GROWS, PN, D, D, D, 0, 0, 1>(lds, XN + (size_t)g * GROWS * D, (const bf16_t*)(wb + W_P), E);
#endif
                break; }
            case 6: {
#ifndef SKIP_S1
                { const bf16_t* Pp = (const bf16_t*)(ws + WS_BIG); Raw R = {}; u32x4 v0 = {0u, 0u, 0u, 0u}, v1 = v0; int it = blockIdx.x;
                  { const int itc = it < 3072 ? it : 3071; const ItemInfo I0 = item_info(g, itc); raw_load<false, false>(a, Pp, I0, l, itc, tid, R); v_load(Pp, I0, tid, v0, v1); }
                  for (; it < 3072; it += G) { const int itn = it + G < 3072 ? it + G : 3071; Raw Rn = {}; u32x4 vn0, vn1;
                      { const ItemInfo I1 = item_info(g, itn); raw_load<false, false>(a, Pp, I1, l, itn, tid, Rn); v_load(Pp, I1, tid, vn0, vn1); }
                      scan_s1(a, lds, l, g, it, R, v0, v1); R = Rn; v0 = vn0; v1 = vn1; } }
#endif
                break; }
            case 7: {
#ifndef SKIP_S2
                scan_s2(a, l, g);
#endif
                break; }
            case 8: {
#ifndef SKIP_S3
                { const bf16_t* Pp = (const bf16_t*)(ws + WS_BIG); Raw R = {}; u32x4 v0 = {0u, 0u, 0u, 0u}, v1 = v0; int it = blockIdx.x;
                  { const int itc = it < 1536 ? it : 1535; const int hb = itc % 12, cgl = itc / 12; ItemInfo I0; I0.br = hb >> 2; I0.head = hb & 3; I0.T = g < 2 ? 4096 : 256; I0.NC = I0.T >> 6; I0.seq = cgl / I0.NC; I0.c = cgl % I0.NC; I0.dir = 0;
                    raw_load<true, true>(a, Pp, I0, l, (I0.seq * I0.NC + I0.c) * 24 + I0.br * 8 + I0.head, tid, R); v_load(Pp, I0, tid, v0, v1); }
                  for (; it < 1536; it += G) { const int itn = it + G < 1536 ? it + G : 1535; scan_s3(a, lds, l, g, it, itn, R, v0, v1); } }
#endif
                break; }
            default: break;
            }
            if (st != ST_BR) xcd_barrier_ni((unsigned*)a.ws, 131072 + 352); else { asm volatile("s_waitcnt vmcnt(0)" ::: "memory"); __syncthreads(); }
#ifdef EXTRA_SYNC
            xcd_barrier_ni((unsigned*)a.ws, 131072 + 352);
#endif
        }
    }
}

extern "C" void kernel_launch(void* const* d_in, const int* in_sizes, int n_in, void* d_out, int out_size, void* d_ws, size_t ws_size, hipStream_t stream) {
    static int grid = 0;
    if (grid == 0) {
        if (n_in != 23 || ws_size < WS_END) { fprintf(stderr, "kernel_launch: unexpected n_in %d / ws_size %zu (need %zu)\n", n_in, ws_size, (size_t)WS_END); grid = -1; return; }
        int dev = 0, cus = 0, per_cu = 0;
        hipGetDevice(&dev); hipDeviceGetAttribute(&cus, hipDeviceAttributeMultiprocessorCount, dev);
        hipFuncSetAttribute((const void*)mk_fwd, hipFuncAttributeMaxDynamicSharedMemorySize, LDS_BYTES);
        hipOccupancyMaxActiveBlocksPerMultiprocessor(&per_cu, (const void*)mk_fwd, 512, LDS_BYTES);
        (void)hipGetLastError();
        if (per_cu < 1) per_cu = 1;
        grid = cus;
    }
    if (grid < 0) return;
    if (hipMemsetAsync(d_ws, 0, 16384, stream) != hipSuccess) { fprintf(stderr, "memset failed\n"); return; }
    Args a{};
    for (int i = 0; i < 23; ++i) a.in[i] = (const float*)d_in[i];
    a.out = (float*)d_out; a.ws = (unsigned char*)d_ws;
    void* args[] = {&a};
    hipError_t e = hipLaunchCooperativeKernel((const void*)mk_fwd, dim3(grid), dim3(512), args, LDS_BYTES, stream);
    if (e != hipSuccess) fprintf(stderr, "cooperative launch failed: %s (grid %d)\n", hipGetErrorString(e), grid);
}
```

```cpp
#include <hip/hip_runtime.h>
#include <hip/hip_cooperative_groups.h>
#include <cstdio>
#include <cstdint>
namespace cg = cooperative_groups;

namespace pg8 {
#define PG8_LAS __attribute__((address_space(3)))
typedef unsigned short bf16_t;
typedef short bf16x8 __attribute__((ext_vector_type(8)));
typedef float f32x4 __attribute__((ext_vector_type(4)));
typedef unsigned u32x4 __attribute__((ext_vector_type(4)));
typedef unsigned u32x2 __attribute__((ext_vector_type(2)));
constexpr int BM = 256, BK = 64, HALF = 128, HTB = HALF * BK * 2, STAGE_BYTES = 8 * HTB, NXCD = 8, WGM = 8;

__host__ __device__ __forceinline__ int lds_byte(int r, int c) { const int st = (r >> 4) * 2 + (c >> 5), rr = r & 15, cc = c & 31, ob = rr * 64 + cc * 2; return st * 1024 + (ob ^ (((ob >> 9) & 1) << 5)); }
__host__ __device__ __forceinline__ void stage_rc(int b, int& R, int& C) { const int st = b / 1024, sb = b % 1024, swz = sb ^ (((sb >> 9) & 1) << 5); R = (st >> 1) * 16 + swz / 64; C = (st & 1) * 32 + (swz % 64) / 2; }
__host__ __device__ __forceinline__ int perm32(int rho) { const int n = rho >> 4, i = rho & 15; return 8 * (i >> 2) + 4 * n + (i & 3); }

struct Unit { int pm, pn; };
template <int M_, int N_, int K_, int LDA_, int LDB_> struct GemmT { const bf16_t* A; const bf16_t* Bt; static constexpr int M = M_, N = N_, K = K_, lda = LDA_, ldb = LDB_; };

template <int M_, int N_, int ADIV, int AMUL, int KS = 1> struct StaticOrderT {
    static constexpr int nM = M_ / BM, nN = N_ / BM, nwg = nM * nN;
    int G, c;
    __device__ void init(int G_, int c_) { G = G_; c = c_; }
    __device__ __forceinline__ bool next(int i, Unit& u) const {
        const int L = i * G + c; if (L >= nwg) return false;
        int wgid = L; { constexpr int q = nwg / NXCD, r = nwg % NXCD; const int xcd = wgid % NXCD, off = wgid / NXCD; wgid = (xcd < r ? xcd * (q + 1) : r * (q + 1) + (xcd - r) * q) + off; }
        constexpr int nig = WGM * nN; const int gid = wgid / nig, fm = gid * WGM, gsz = (nM - fm) < WGM ? (nM - fm) : WGM;
        u.pm = fm + ((wgid % nig) % gsz); u.pn = (wgid % nig) / gsz; return true;
    }
    __device__ __forceinline__ int a_off(const Unit& u) const { return ADIV > 0 ? (u.pn / (ADIV > 0 ? ADIV : 1)) * AMUL : 0; }
    __device__ __forceinline__ int b_tile(const Unit& u) const { return KS > 1 ? u.pn % (nN / KS) : u.pn; }
    __device__ __forceinline__ int b_koff(const Unit& u) const { return KS > 1 ? (u.pn / (nN / KS)) * AMUL : 0; }
    __device__ __forceinline__ void a_ready(const Unit&) const {}
    __device__ __forceinline__ void done(const Unit&) const {}
};

template <class GT, class Epi, class Sched, bool ALIGN_EPI = false, bool SP2 = false>
__device__ __forceinline__ void gemm_phase(PG8_LAS unsigned char* lds, const GT g, const Sched& S, const Epi& E) {
    int tid_ = threadIdx.x; asm volatile("" : "+v"(tid_));
    const int tid = tid_, wid = __builtin_amdgcn_readfirstlane(tid >> 6), lane = tid & 63, wr = wid >> 2, wc = wid & 3, fr = lane & 15, fq = lane >> 4;
    constexpr int K = GT::K, nt = K / BK;
    unsigned voffA[2], voffB[2];
#pragma unroll
    for (int i = 0; i < 2; ++i) { int R, C; stage_rc(tid * 16 + i * 8192, R, C); const int Rb = Epi::PERM ? ((R & ~31) + perm32(R & 31)) : R;
        voffA[i] = (unsigned)(R * GT::lda + C) * 2u; voffB[i] = (unsigned)(Rb * GT::ldb + C) * 2u; }
    constexpr size_t kstep = (size_t)(BK * 2);
    constexpr size_t hstepA = (size_t)HALF * GT::lda * 2, hstepB = (size_t)HALF * GT::ldb * 2;
    constexpr size_t tstepA = 2 * hstepA, tstepB = 2 * hstepB;
    const unsigned ldsw = (unsigned)wid * 1024u;
    const int aoff = lds_byte(wr * 64 + fr, fq * 8), boff = lds_byte(wc * 32 + fr, fq * 8);
#define PG8_SA(b, h) (((b) * 2 + (h)) * HTB)
#define PG8_SB(b, h) ((4 + (b) * 2 + (h)) * HTB)
#define PG8_STAGE(bufoff, gbase, voff) do { _Pragma("unroll") for (int _i = 0; _i < 2; ++_i) \
        __builtin_amdgcn_global_load_lds((const unsigned*)((const char*)(gbase) + (voff)[_i]), (PG8_LAS unsigned*)(lds + (bufoff) + ldsw + _i * 8192), 16, 0, 0); } while (0)
#define PG8_LDA(dst, b, h) do { _Pragma("unroll") for (int m = 0; m < 4; ++m) _Pragma("unroll") for (int k = 0; k < 2; ++k) dst[m][k] = *(const PG8_LAS bf16x8*)(lds + PG8_SA(b, h) + aoff + m * 2048 + k * 1024); } while (0)
#define PG8_LDB(dst, b, h) do { _Pragma("unroll") for (int n = 0; n < 2; ++n) _Pragma("unroll") for (int k = 0; k < 2; ++k) dst[n][k] = *(const PG8_LAS bf16x8*)(lds + PG8_SB(b, h) + boff + n * 2048 + k * 1024); } while (0)
#define PG8_MMA(ai, bj, At, Bt) do { __builtin_amdgcn_s_setprio(1); _Pragma("unroll") for (int m = 0; m < 4; ++m) _Pragma("unroll") for (int n = 0; n < 2; ++n) _Pragma("unroll") for (int k = 0; k < 2; ++k) \
        acc[ai][bj][m][n] = __builtin_amdgcn_mfma_f32_16x16x32_bf16(Bt[n][k], At[m][k], acc[ai][bj][m][n], 0, 0, 0); __builtin_amdgcn_s_setprio(0); } while (0)
#define PG8_WAIT_V(n) asm volatile("s_waitcnt vmcnt(" #n ")" ::: "memory")
#define PG8_WAIT_L(n) asm volatile("s_waitcnt lgkmcnt(" #n ")" ::: "memory")
#define PG8_BAR __builtin_amdgcn_s_barrier()
#define PG8_SCHED __builtin_amdgcn_sched_barrier(0)
    Unit cur, nxt; int ui = 0;
    if (!S.next(0, cur)) return;
    f32x4 acc[2][2][4][2];
#pragma unroll
    for (int a = 0; a < 2; ++a)
#pragma unroll
        for (int b = 0; b < 2; ++b)
#pragma unroll
            for (int m = 0; m < 4; ++m)
#pragma unroll
                for (int n = 0; n < 2; ++n) acc[a][b][m][n] = (f32x4){0.f, 0.f, 0.f, 0.f};
    bf16x8 At[4][2], B0[2][2], B1[2][2];
    const char* cA = (const char*)g.A + (size_t)cur.pm * tstepA + (size_t)S.a_off(cur) * 2; const char* cB = (const char*)g.Bt + (size_t)S.b_tile(cur) * tstepB + (size_t)S.b_koff(cur) * 2;
    S.a_ready(cur);
    if constexpr (SP2) {
        PG8_STAGE(PG8_SB(0, 0), cB, voffB); PG8_STAGE(PG8_SB(0, 1), cB + hstepB, voffB); PG8_STAGE(PG8_SA(0, 0), cA, voffA); PG8_STAGE(PG8_SA(0, 1), cA + hstepA, voffA);
        if (wr == 1) PG8_BAR;
        PG8_WAIT_V(2); PG8_BAR;
        PG8_STAGE(PG8_SB(1, 0), cB + kstep, voffB); PG8_STAGE(PG8_SA(1, 0), cA + kstep, voffA); PG8_STAGE(PG8_SB(1, 1), cB + hstepB + kstep, voffB);
        PG8_WAIT_V(6); PG8_BAR;
    } else {
        PG8_STAGE(PG8_SB(0, 0), cB, voffB); PG8_STAGE(PG8_SA(0, 0), cA, voffA); PG8_STAGE(PG8_SB(0, 1), cB + hstepB, voffB); PG8_STAGE(PG8_SA(0, 1), cA + hstepA, voffA);
        if (wr == 1) PG8_BAR;
        PG8_WAIT_V(4); PG8_BAR;
        PG8_STAGE(PG8_SB(1, 0), cB + kstep, voffB); PG8_STAGE(PG8_SA(1, 0), cA + kstep, voffA); PG8_STAGE(PG8_SB(1, 1), cB + hstepB + kstep, voffB);
        PG8_WAIT_V(6); PG8_BAR;
    }
    for (;;) {
        const bool has_next = S.next(ui + 1, nxt);
        const char* nA = has_next ? (const char*)g.A + (size_t)nxt.pm * tstepA + (size_t)S.a_off(nxt) * 2 : cA; const char* nB = has_next ? (const char*)g.Bt + (size_t)S.b_tile(nxt) * tstepB + (size_t)S.b_koff(nxt) * 2 : cB;
        for (int t = 0; t < nt; t += 2) {
            const bool last = (t == nt - 2);
            const char* a1 = cA + (size_t)(t + 1) * kstep;
            const char* a2 = last ? nA : cA + (size_t)(t + 2) * kstep; const char* b2 = last ? nB : cB + (size_t)(t + 2) * kstep;
            const char* a3 = a2 + kstep; const char* b3 = b2 + kstep;
            if (last && has_next) S.a_ready(nxt);
            if constexpr (SP2) {
            PG8_LDB(B0, 0, 0); PG8_LDB(B1, 0, 1); PG8_SCHED; PG8_LDA(At, 0, 0); PG8_STAGE(PG8_SA(1, 1), a1 + hstepA, voffA);
            PG8_WAIT_V(8); PG8_WAIT_L(0); PG8_BAR; PG8_MMA(0, 0, At, B0); PG8_MMA(0, 1, At, B1); PG8_BAR; PG8_SCHED;
            PG8_LDA(At, 0, 1); PG8_STAGE(PG8_SB(0, 0), b2, voffB); PG8_STAGE(PG8_SB(0, 1), b2 + hstepB, voffB); PG8_STAGE(PG8_SA(0, 0), a2, voffA);
            PG8_WAIT_V(8); PG8_WAIT_L(0); PG8_BAR; PG8_MMA(1, 0, At, B0); PG8_MMA(1, 1, At, B1); PG8_BAR; PG8_SCHED;
            PG8_LDB(B0, 1, 0); PG8_LDB(B1, 1, 1); PG8_SCHED; PG8_LDA(At, 1, 0); PG8_STAGE(PG8_SA(0, 1), a2 + hstepA, voffA);
            PG8_WAIT_V(8); PG8_WAIT_L(0); PG8_BAR; PG8_MMA(0, 0, At, B0); PG8_MMA(0, 1, At, B1); PG8_BAR; PG8_SCHED;
            PG8_LDA(At, 1, 1); PG8_STAGE(PG8_SB(1, 0), b3, voffB); PG8_STAGE(PG8_SB(1, 1), b3 + hstepB, voffB); PG8_STAGE(PG8_SA(1, 0), a3, voffA);
            PG8_WAIT_V(8); PG8_WAIT_L(0); PG8_BAR; PG8_MMA(1, 0, At, B0); PG8_MMA(1, 1, At, B1); PG8_BAR; PG8_SCHED;
            } else {
            PG8_LDB(B0, 0, 0); PG8_SCHED; PG8_LDA(At, 0, 0); PG8_STAGE(PG8_SA(1, 1), a1 + hstepA, voffA);
            PG8_WAIT_L(8); PG8_BAR; PG8_WAIT_L(0); PG8_MMA(0, 0, At, B0); PG8_BAR; PG8_SCHED;
            PG8_LDB(B1, 0, 1); PG8_STAGE(PG8_SB(0, 0), b2, voffB);
            PG8_BAR; PG8_WAIT_L(0); PG8_MMA(0, 1, At, B1); PG8_BAR;
            PG8_LDA(At, 0, 1); PG8_STAGE(PG8_SA(0, 0), a2, voffA);
            PG8_BAR; PG8_WAIT_L(0); PG8_MMA(1, 0, At, B0); PG8_BAR; PG8_SCHED;
            PG8_STAGE(PG8_SB(0, 1), b2 + hstepB, voffB);
            PG8_WAIT_V(6); PG8_BAR; PG8_MMA(1, 1, At, B1); PG8_BAR;
            PG8_LDB(B0, 1, 0); PG8_SCHED; PG8_LDA(At, 1, 0); PG8_STAGE(PG8_SA(0, 1), a2 + hstepA, voffA);
            PG8_WAIT_L(8); PG8_BAR; PG8_WAIT_L(0); PG8_MMA(0, 0, At, B0); PG8_BAR; PG8_SCHED;
            PG8_LDB(B1, 1, 1); PG8_STAGE(PG8_SB(1, 0), b3, voffB);
            PG8_BAR; PG8_WAIT_L(0); PG8_MMA(0, 1, At, B1); PG8_BAR;
            PG8_LDA(At, 1, 1); PG8_STAGE(PG8_SA(1, 0), a3, voffA);
            PG8_BAR; PG8_WAIT_L(0); PG8_MMA(1, 0, At, B0); PG8_BAR; PG8_SCHED;
            PG8_STAGE(PG8_SB(1, 1), b3 + hstepB, voffB);
            PG8_WAIT_V(6); PG8_BAR; PG8_MMA(1, 1, At, B1); PG8_BAR;
            }
        }
        if constexpr (ALIGN_EPI) { if (wr == 0) PG8_BAR; }
        if constexpr (!Epi::AFTER_DRAIN) { E(acc, cur, wr, wc, fr, fq); S.done(cur); }
        if (!has_next) break;
#pragma unroll
        for (int a = 0; a < 2; ++a)
#pragma unroll
            for (int b = 0; b < 2; ++b)
#pragma unroll
                for (int m = 0; m < 4; ++m)
#pragma unroll
                    for (int n = 0; n < 2; ++n) acc[a][b][m][n] = (f32x4){0.f, 0.f, 0.f, 0.f};
        cur = nxt; cA = nA; cB = nB; ++ui;
        if constexpr (ALIGN_EPI) { if (wr == 1) PG8_BAR; }
    }
    PG8_WAIT_V(0);
    if constexpr (!ALIGN_EPI) { if (wr == 0) PG8_BAR; }
    PG8_BAR;
    if constexpr (Epi::AFTER_DRAIN) { E.fused(acc, cur, wr, wc, fr, fq, lds, wid, lane); S.done(cur); }
#undef PG8_SA
#undef PG8_SB
#undef PG8_STAGE
#undef PG8_LDA
#undef PG8_LDB
#undef PG8_MMA
#undef PG8_WAIT_V
#undef PG8_WAIT_L
#undef PG8_BAR
#undef PG8_SCHED
}
}

#define LAS __attribute__((address_space(3)))
typedef unsigned short bf16_t;
typedef short bf16x8 __attribute__((ext_vector_type(8)));
typedef float f32x4 __attribute__((ext_vector_type(4)));
typedef unsigned u32x4 __attribute__((ext_vector_type(4)));
typedef unsigned u32x2 __attribute__((ext_vector_type(2)));

constexpr int D = 1024, DFF = 2816, NFF2 = 5632, INC = 7984, PN = 5120, PREAL = 4912, MGN = 3072;
constexpr int MTOT = 24576, MLAT = 16384, GROWS = 8192;
constexpr float EPSN = 1e-6f;
constexpr size_t MiB = 1u << 20;
constexpr size_t WS_MOD = 1 * MiB, WS_MODP = 2 * MiB, WS_POS = 5 * MiB, WS_DEC = 6 * MiB, WS_SC = 7 * MiB;
constexpr size_t WS_W = 8 * MiB;
constexpr size_t W_FFIN = 0, W_FFOUT = W_FFIN + 2ull * NFF2 * D * 2, W_P = W_FFOUT + 2ull * D * DFF * 2, W_MG = W_P + (size_t)PN * D * 2,
                 W_B = W_MG + (size_t)MGN * D * 2, W_O3 = W_B + 3072ull * 512 * 2, W_END = W_O3 + 1024ull * 3072 * 2;
static_assert(W_END <= 58 * MiB, "weights region");
constexpr size_t WS_XN = 66 * MiB, WS_A = 114 * MiB, WS_BIG = 210 * MiB, WS_END = 370 * MiB;
constexpr size_t BIG_US = 80 * MiB, BIG_OB = 128 * MiB;
constexpr size_t OFF_YP = 0, OFF_YS = 8388608, OFF_C = 25165824, OFF_N = 29360128, OFF_M = 29392896, OFF_G = 29393408, OFF_H = 33587712;
constexpr int LDS_BYTES = 147456;

struct Args { const float* in[23]; float* out; unsigned char* ws; };
enum { I_XP = 0, I_XS, I_C, I_SC, I_SN, I_SM, I_SG, I_SH, I_CCTX, I_WADA, I_BADA, I_NPRE, I_NPOST, I_WFIN, I_WFOUT, I_WIN, I_GB, I_GWUP, I_GLB, I_HGAM, I_HN, I_WBR, I_WOUT };
__device__ __forceinline__ const float* inp(const Args& a, int i) { asm volatile("" : "+s"(i)); return a.in[i]; }

typedef float f32x2_t __attribute__((ext_vector_type(2))); typedef __bf16 bf16x2_t __attribute__((ext_vector_type(2)));
__device__ __forceinline__ unsigned pk2(float lo, float hi) { f32x2_t v = {lo, hi}; bf16x2_t b = __builtin_convertvector(v, bf16x2_t); return __builtin_bit_cast(unsigned, b); }
__device__ __forceinline__ unsigned f2bf(float f) { return pk2(f, 0.f) & 0xffffu; }
__device__ __forceinline__ float bf2f(bf16_t h) { return __uint_as_float(((unsigned)h) << 16); }
__device__ __forceinline__ float bflo(unsigned w) { return __uint_as_float(w << 16); }
__device__ __forceinline__ float bfhi(unsigned w) { return __uint_as_float(w & 0xffff0000u); }
__device__ __forceinline__ float sigmoidf_(float x) { return __builtin_amdgcn_rcpf(1.0f + __expf(-x)); }
__device__ __forceinline__ float siluf_(float x) { return x * __builtin_amdgcn_rcpf(1.0f + __expf(-x)); }
__device__ __forceinline__ float logsigf_(float x) { return fminf(x, 0.f) - __logf(1.0f + __expf(-fabsf(x))); }
__device__ __forceinline__ float wave_sum(float v) {
#pragma unroll
    for (int o = 1; o < 64; o <<= 1) v += __shfl_xor(v, o);
    return v;
}
#define LDS_WAIT() asm volatile("s_waitcnt lgkmcnt(0)" ::: "memory")
#ifndef NO_WT
__device__ __forceinline__ void st_wt8(void* p, u32x2 v) { __hip_atomic_store((unsigned long long*)p, ((unsigned long long)v.y << 32) | v.x, __ATOMIC_RELAXED, __HIP_MEMORY_SCOPE_AGENT); }
__device__ __forceinline__ void st_wt16(void* p, u32x4 v) { st_wt8(p, (u32x2){v.x, v.y}); st_wt8((char*)p + 8, (u32x2){v.z, v.w}); }
#else
__device__ __forceinline__ void st_wt8(void* p, u32x2 v) { *(u32x2*)p = v; }
__device__ __forceinline__ void st_wt16(void* p, u32x4 v) { *(u32x4*)p = v; }
#endif

#define XB_TMO      128
#define XB_XCNT(j)  (256  + 64 * (j))
#define XB_XSUB(j)  (1280 + 64 * (j))
#define XB_XGEN(j)  (2304 + 64 * (j))
#define XB_TOP      3328
#define XB_TOPGEN   3392
#define XCD_BAR_WORDS 3456
#define XB_SPIN_CAP (1u << 18)

__device__ __forceinline__ unsigned xb_ld(unsigned* p)              { return __hip_atomic_load(p, __ATOMIC_RELAXED, __HIP_MEMORY_SCOPE_AGENT); }
__device__ __forceinline__ unsigned xb_add(unsigned* p, unsigned v) { return __hip_atomic_fetch_add(p, v, __ATOMIC_RELAXED, __HIP_MEMORY_SCOPE_AGENT); }
__device__ __forceinline__ unsigned xb_xcc_id() { return (unsigned)__builtin_amdgcn_s_getreg((3 << 11) | 20) & 0xFu; }
#define XB_SPIN(cond, bar) do { unsigned _sp = 0; while (cond) { __builtin_amdgcn_s_sleep(1); \
    if ((++_sp & 255u) == 0u) { if (xb_ld(&(bar)[XB_TMO])) break; if (_sp > XB_SPIN_CAP) { atomicAdd(&(bar)[XB_TMO], 1u); break; } } } } while (0)

struct XcdBarrier {
    unsigned* bar; unsigned x;
    volatile LAS unsigned* st;
};

__device__ __forceinline__ XcdBarrier xcd_barrier_post(unsigned* bar, volatile LAS unsigned* st) {
    XcdBarrier b; b.bar = bar; b.x = xb_xcc_id(); b.st = st;
    if (threadIdx.x == 0) (void)xb_add(&bar[XB_XCNT(b.x)], 1u);
    return b;
}
__device__ __forceinline__ void xcd_barrier_complete(unsigned* bar, unsigned x, unsigned& nloc, unsigned& nx) {
    const unsigned G = gridDim.x * gridDim.y * gridDim.z;
    unsigned sum, cnt, mine, sp = 0u;
    for (;;) {
        sum = 0u; cnt = 0u; mine = 0u;
#pragma unroll
        for (unsigned j = 0; j < 16; ++j) { const unsigned c = xb_ld(&bar[XB_XCNT(j)]); sum += c; cnt += (c > 0u) ? 1u : 0u; mine = (j == x) ? c : mine; }
        if (sum == G) break;
        __builtin_amdgcn_s_sleep(1);
        if ((++sp & 255u) == 0u) { if (xb_ld(&bar[XB_TMO])) break; if (sp > XB_SPIN_CAP) { atomicAdd(&bar[XB_TMO], 1u); break; } }
    }
    nloc = mine > 0u ? mine : 1u; nx = cnt > 0u ? cnt : 1u;
}

__device__ __attribute__((noinline)) void xcd_barrier_ni(unsigned* bar_, unsigned st_off) {
    XcdBarrier b; b.bar = bar_; b.x = xb_xcc_id(); b.st = (volatile LAS unsigned*)(size_t)st_off;
    asm volatile("s_waitcnt vmcnt(0)" ::: "memory");
    __syncthreads();
    if (threadIdx.x == 0) {
        unsigned* bar = b.bar;
        __builtin_amdgcn_s_waitcnt(0);
        unsigned nloc = b.st[0], nx = b.st[1];
        if (nloc == 0u) { xcd_barrier_complete(bar, b.x, nloc, nx); b.st[0] = nloc; b.st[1] = nx; }
        const unsigned old = xb_add(&bar[XB_XSUB(b.x)], 1u);
        const unsigned gen = old / nloc;
        if (old + 1u == (gen + 1u) * nloc) {
            __builtin_amdgcn_fence(__ATOMIC_RELEASE, "agent");
            asm volatile("s_waitcnt vmcnt(0)" ::: "memory");
            const unsigned og = xb_add(&bar[XB_TOP], 1u);
            const unsigned tg = og / nx;
            if (og + 1u == (tg + 1u) * nx) xb_add(&bar[XB_TOPGEN], 1u);
            else XB_SPIN(xb_ld(&bar[XB_TOPGEN]) == tg, bar);
            __builtin_amdgcn_fence(__ATOMIC_ACQUIRE, "agent");
            xb_add(&bar[XB_XGEN(b.x)], 1u);
            asm volatile("s_waitcnt vmcnt(0)" ::: "memory");
        } else {
            XB_SPIN(xb_ld(&bar[XB_XGEN(b.x)]) == gen, bar);
            __builtin_amdgcn_fence(__ATOMIC_ACQUIRE, "agent");
            asm volatile("s_waitcnt vmcnt(0)" ::: "memory");
        }
    }
    __syncthreads();
}


struct EpiBf16 {
    static constexpr bool PERM = true, AFTER_DRAIN = false;
    bf16_t* O; int ldc; int nsplit; size_t sstride;
    __device__ __forceinline__ void operator()(const f32x4 (&acc)[2][2][4][2], const pg8::Unit& u, int wr, int wc, int fr, int fq) const {
        int pn = u.pn; bf16_t* Ob = O; if (nsplit) { Ob += (size_t)(pn / nsplit) * sstride; pn = pn % nsplit; }
        const int row0 = u.pm * 256 + wr * 64 + fr, col0 = pn * 256 + wc * 32 + 8 * fq;
#pragma unroll
        for (int ai = 0; ai < 2; ++ai)
#pragma unroll
            for (int m = 0; m < 4; ++m) { bf16_t* rowp = Ob + (size_t)(row0 + ai * 128 + m * 16) * ldc + col0;
#pragma unroll
                for (int bj = 0; bj < 2; ++bj) { const f32x4 v0 = acc[ai][bj][m][0], v1 = acc[ai][bj][m][1];
                    u32x4 w; w.x = pk2(v0[0], v0[1]); w.y = pk2(v0[2], v0[3]); w.z = pk2(v1[0], v1[1]); w.w = pk2(v1[2], v1[3]);
                    *(u32x4*)(rowp + bj * 128) = w; } }
    }
};
struct EpiGateMul {
    static constexpr bool PERM = true, AFTER_DRAIN = false;
    bf16_t* O; int ldc;
    __device__ __forceinline__ void operator()(const f32x4 (&acc)[2][2][4][2], const pg8::Unit& u, int wr, int wc, int fr, int fq) const {
        const int row0 = u.pm * 256 + wr * 64 + fr, col0 = u.pn * 256 + wc * 32 + 8 * fq;
        u32x4 bb[2][4][2];
#pragma unroll
        for (int ai = 0; ai < 2; ++ai)
#pragma unroll
            for (int m = 0; m < 4; ++m) { const bf16_t* rowp = O + (size_t)(row0 + ai * 128 + m * 16) * ldc + col0;
#pragma unroll
                for (int bj = 0; bj < 2; ++bj) bb[ai][m][bj] = *(const u32x4*)(rowp + bj * 128); }
#pragma unroll
        for (int ai = 0; ai < 2; ++ai)
#pragma unroll
            for (int m = 0; m < 4; ++m) { bf16_t* rowp = O + (size_t)(row0 + ai * 128 + m * 16) * ldc + col0;
#pragma unroll
                for (int bj = 0; bj < 2; ++bj) { const f32x4 v0 = acc[ai][bj][m][0], v1 = acc[ai][bj][m][1];
                    const u32x4 b = bb[ai][m][bj];
                    u32x4 w; w.x = pk2(sigmoidf_(v0[0]) * bflo(b.x), sigmoidf_(v0[1]) * bfhi(b.x)); w.y = pk2(sigmoidf_(v0[2]) * bflo(b.y), sigmoidf_(v0[3]) * bfhi(b.y));
                    w.z = pk2(sigmoidf_(v1[0]) * bflo(b.z), sigmoidf_(v1[1]) * bfhi(b.z)); w.w = pk2(sigmoidf_(v1[2]) * bflo(b.w), sigmoidf_(v1[3]) * bfhi(b.w));
                    *(u32x4*)(rowp + bj * 128) = w; } }
    }
};
struct EpiSwiGLU {
    static constexpr bool PERM = true, AFTER_DRAIN = false;
    bf16_t* H; int ldh;
    __device__ __forceinline__ void operator()(const f32x4 (&acc)[2][2][4][2], const pg8::Unit& u, int wr, int wc, int fr, int fq) const {
        const int row0 = u.pm * 256 + wr * 64 + fr, col0 = u.pn * 128 + wc * 32 + 8 * fq;
#pragma unroll
        for (int ai = 0; ai < 2; ++ai)
#pragma unroll
            for (int m = 0; m < 4; ++m) { bf16_t* rowp = H + (size_t)(row0 + ai * 128 + m * 16) * ldh + col0;
                const f32x4 g0 = acc[ai][0][m][0], g1 = acc[ai][0][m][1], u0 = acc[ai][1][m][0], u1 = acc[ai][1][m][1];
                u32x4 w; w.x = pk2(siluf_(g0[0]) * u0[0], siluf_(g0[1]) * u0[1]); w.y = pk2(siluf_(g0[2]) * u0[2], siluf_(g0[3]) * u0[3]);
                w.z = pk2(siluf_(g1[0]) * u1[0], siluf_(g1[1]) * u1[1]); w.w = pk2(siluf_(g1[2]) * u1[2], siluf_(g1[3]) * u1[3]);
                *(u32x4*)rowp = w; }
    }
};
struct EpiF32 {
    static constexpr bool PERM = false, AFTER_DRAIN = false;
    float* Y; int ldc;
    __device__ __forceinline__ void operator()(const f32x4 (&acc)[2][2][4][2], const pg8::Unit& u, int wr, int wc, int fr, int fq) const {
        const int row0 = u.pm * 256 + wr * 64 + fr, col0 = u.pn * 256 + wc * 32 + 4 * fq;
#pragma unroll
        for (int ai = 0; ai < 2; ++ai)
#pragma unroll
            for (int m = 0; m < 4; ++m) { float* rowp = Y + (size_t)(row0 + ai * 128 + m * 16) * ldc + col0;
#pragma unroll
                for (int bj = 0; bj < 2; ++bj)
#pragma unroll
                    for (int n = 0; n < 2; ++n) *(f32x4*)(rowp + bj * 128 + n * 16) = acc[ai][bj][m][n]; }
    }
};

template <class Map>
__device__ __forceinline__ void transpose_item(const float* W, int K, int N, LAS float* scr, int item, int lane, const Map& map) {
    const int nblk = (N + 31) / 32, kb = item / nblk, nb = item % nblk, k0 = 64 * kb, n0 = 32 * nb;
    const int nn = n0 + (lane & 31); const bool ok = nn < N;
    float wv[32];
#pragma unroll
    for (int i = 0; i < 32; ++i) { const int kk = 2 * i + (lane >> 5); wv[i] = W[(size_t)(k0 + kk) * N + (ok ? nn : 0)]; }
#pragma unroll
    for (int i = 0; i < 32; ++i) { const int kk = 2 * i + (lane >> 5); scr[kk * 33 + (lane & 31)] = ok ? wv[i] : 0.f; }
    LDS_WAIT(); asm volatile("" ::: "memory");
    const int c = lane & 7;
#pragma unroll
    for (int j = 0; j < 4; ++j) { const int n = (lane >> 3) + 8 * j; const LAS float* s = scr + (8 * c) * 33 + n;
        u32x4 o; o.x = pk2(s[0 * 33], s[1 * 33]); o.y = pk2(s[2 * 33], s[3 * 33]); o.z = pk2(s[4 * 33], s[5 * 33]); o.w = pk2(s[6 * 33], s[7 * 33]);
        if (n0 + n < N) map(n0 + n, k0 + 8 * c, o); }
    LDS_WAIT(); asm volatile("" ::: "memory");
}

__device__ __forceinline__ void convert_weights(const Args& a, LAS unsigned char* lds, int l, int lo, int hi, int dopad, int gw, int NGW, int lane, int wave) {
    LAS float* scr = (LAS float*)(lds + wave * 16384);
    unsigned char* wb = a.ws + WS_W;
    constexpr int I_FI = 16 * 176, I_FO = 44 * 32, I_IN = 16 * 250, I_BR = 8 * 32, I_OU = 16 * 32;
    constexpr int NITEMS = 2 * I_FI + 2 * I_FO + I_IN + 3 * I_BR + I_OU;
    static_assert(NITEMS == 13728, "item ranges used by the callers");
    for (int it = lo + gw; it < hi; it += NGW) {
        int r = it;
        if (r < 2 * I_FI) { const int f = r / I_FI; r -= f * I_FI; bf16_t* dst = (bf16_t*)(wb + W_FFIN) + (size_t)f * NFF2 * D;
            transpose_item(inp(a, I_WFIN) + (size_t)(l * 2 + f) * D * NFF2, D, NFF2, scr, r, lane,
                [=](int n, int k, u32x4 o) { const int h = n < DFF ? n : n - DFF; const int row = 256 * (h >> 7) + (n < DFF ? 0 : 128) + (h & 127); *(u32x4*)(dst + (size_t)row * D + k) = o; });
            continue; }
        r -= 2 * I_FI;
        if (r < 2 * I_FO) { const int f = r / I_FO; r -= f * I_FO; bf16_t* dst = (bf16_t*)(wb + W_FFOUT) + (size_t)f * D * DFF;
            transpose_item(inp(a, I_WFOUT) + (size_t)(l * 2 + f) * DFF * D, DFF, D, scr, r, lane,
                [=](int n, int k, u32x4 o) { *(u32x4*)(dst + (size_t)n * DFF + k) = o; });
            continue; }
        r -= 2 * I_FO;
        if (r < I_IN) { bf16_t* dp = (bf16_t*)(wb + W_P); bf16_t* dm = (bf16_t*)(wb + W_MG);
            transpose_item(inp(a, I_WIN) + (size_t)l * D * INC, D, INC, scr, r, lane,
                [=](int n, int k, u32x4 o) { if (n < PREAL) *(u32x4*)(dp + (size_t)n * D + k) = o; else *(u32x4*)(dm + (size_t)(n - PREAL) * D + k) = o; });
            continue; }
        r -= I_IN;
        if (r < 3 * I_BR) { const int nb = r / I_BR; r -= nb * I_BR; bf16_t* dst = (bf16_t*)(wb + W_B) + (size_t)nb * 1024 * 512;
            transpose_item(inp(a, I_WBR) + (size_t)(l * 3 + nb) * 512 * D, 512, D, scr, r, lane,
                [=](int n, int k, u32x4 o) { *(u32x4*)(dst + (size_t)n * 512 + k) = o; });
            continue; }
        r -= 3 * I_BR;
        { bf16_t* dst = (bf16_t*)(wb + W_O3);
            transpose_item(inp(a, I_WOUT) + (size_t)l * D * D, D, D, scr, r, lane,
                [=](int n, int k, u32x4 o) { bf16_t* p = dst + (size_t)n * 3072 + k; *(u32x4*)p = o; *(u32x4*)(p + 1024) = o; *(u32x4*)(p + 2048) = o; }); }
    }
    if (dopad) { u32x4* z = (u32x4*)((bf16_t*)(wb + W_P) + (size_t)PREAL * D); const int nz = (PN - PREAL) * D * 2 / 16;
      for (int i = gw * 64 + lane; i < nz; i += NGW * 64) z[i] = (u32x4){0u, 0u, 0u, 0u}; }
}

__device__ __forceinline__ void ada_partial(const Args& a, LAS unsigned char* lds, int gw, int NGW, int lane, int wave) {
    float* modp = (float*)(a.ws + WS_MODP);
    LAS float* sv = (LAS float*)(lds + wave * 16384);
    for (int it = gw; it < 2 * 144 * 8; it += NGW) {
        const int ks = it & 7, cgp = (it >> 3) % 144, l = it / (8 * 144);
        const int col = cgp * 64 + lane;
#pragma unroll
        for (int h = 0; h < 2; ++h) { const int kk = ks * 128 + lane + 64 * h;
            sv[lane + 64 * h] = siluf_(inp(a, I_CCTX)[kk]);
#pragma unroll
            for (int i = 0; i < 4; ++i) sv[(1 + i) * 128 + lane + 64 * h] = siluf_(inp(a, I_C)[i * D + kk]); }
        LDS_WAIT(); asm volatile("" ::: "memory");
        const float* w = inp(a, I_WADA) + ((size_t)l * D + ks * 128) * 9216 + col;
        float acc[5] = {0.f, 0.f, 0.f, 0.f, 0.f};
#pragma unroll 1
        for (int k0 = 0; k0 < 128; k0 += 32) { float wv[32];
#pragma unroll
            for (int k = 0; k < 32; ++k) wv[k] = w[(size_t)(k0 + k) * 9216];
#pragma unroll
            for (int k = 0; k < 32; ++k) {
#pragma unroll
                for (int i = 0; i < 5; ++i) acc[i] += sv[i * 128 + k0 + k] * wv[k]; } }
#pragma unroll
        for (int i = 0; i < 5; ++i) modp[((size_t)(ks * 2 + l) * 5 + i) * 9216 + col] = acc[i];
        LDS_WAIT(); asm volatile("" ::: "memory");
    }
}

struct RowOp { int src_input, has_y; float coef; const float* npost; const float* mdg_base; int has_xn; const float* npre; const float* md_base; int si; int add_pos; };
template <int NR>
__device__ __forceinline__ void rowwise(const Args& a, const RowOp& op, const int (&rs)[NR], int lane) {
    f32x4 v[NR][4]; u32x2 yb[NR][4], yb2[NR][4]; float* xd[NR]; bool lat[NR]; int cv[NR];
#pragma unroll
    for (int q = 0; q < NR; ++q) { const int r = rs[q]; lat[q] = r < MLAT; cv[q] = lat[q] ? 1 + (r >> 12) : 0;
        const float* xs = op.src_input ? (lat[q] ? inp(a, I_XS) + (size_t)r * D : inp(a, I_XP) + (size_t)(r - MLAT) * D)
                                       : (lat[q] ? a.out + OFF_YS + (size_t)r * D : a.out + OFF_YP + (size_t)(r - MLAT) * D);
        xd[q] = lat[q] ? a.out + OFF_YS + (size_t)r * D : a.out + OFF_YP + (size_t)(r - MLAT) * D;
#pragma unroll
        for (int j = 0; j < 4; ++j) v[q][j] = __builtin_nontemporal_load((const f32x4*)(xs + 4 * lane + 256 * j));
        if (op.has_y) { const bf16_t* yr = (const bf16_t*)(a.ws + WS_A) + (size_t)r * D;
#pragma unroll
            for (int j = 0; j < 4; ++j) { yb[q][j] = __builtin_nontemporal_load((const u32x2*)(yr + 4 * lane + 256 * j)); yb2[q][j] = __builtin_nontemporal_load((const u32x2*)(yr + (size_t)MTOT * D + 4 * lane + 256 * j)); } } }
    f32x4 wpr[4], s1v[NR][4], s0v[NR][4], ppv[NR][4];
    if (op.has_xn) {
#pragma unroll
        for (int j = 0; j < 4; ++j) wpr[j] = *(const f32x4*)(op.npre + 4 * lane + 256 * j);
#pragma unroll
        for (int q = 0; q < NR; ++q) { const float* sh = op.md_base + (size_t)cv[q] * 9216 + (size_t)op.si * D; const float* sc = sh + D;
            const float* pos = (const float*)(a.ws + WS_POS); const int t = rs[q] & 4095;
#pragma unroll
            for (int j = 0; j < 4; ++j) { const int c = 4 * lane + 256 * j; s1v[q][j] = *(const f32x4*)(sc + c); s0v[q][j] = *(const f32x4*)(sh + c);
                if (op.add_pos && lat[q]) ppv[q][j] = *(const f32x4*)((c < 512) ? pos + (size_t)(t >> 6) * 512 + c : pos + (size_t)(t & 63) * 512 + (c - 512)); } } }
#pragma unroll
    for (int q = 0; q < NR; ++q) { const int r = rs[q];
        if (op.has_y) {
            f32x4 y[4]; float ss = 0.f;
#pragma unroll
            for (int j = 0; j < 4; ++j) { y[j] = (f32x4){bflo(yb[q][j].x) + bflo(yb2[q][j].x), bfhi(yb[q][j].x) + bfhi(yb2[q][j].x), bflo(yb[q][j].y) + bflo(yb2[q][j].y), bfhi(yb[q][j].y) + bfhi(yb2[q][j].y)}; ss += (y[j].x * y[j].x + y[j].y * y[j].y) + (y[j].z * y[j].z + y[j].w * y[j].w); }
            const float rr = rsqrtf(wave_sum(ss) * (1.f / D) + EPSN) * op.coef;
            const float* gp = op.mdg_base + (size_t)cv[q] * 9216;
#pragma unroll
            for (int j = 0; j < 4; ++j) { const f32x4 w = *(const f32x4*)(op.npost + 4 * lane + 256 * j), gg = *(const f32x4*)(gp + 4 * lane + 256 * j);
                v[q][j] = v[q][j] + gg * (y[j] * rr) * w; __builtin_nontemporal_store(v[q][j], (f32x4*)(xd[q] + 4 * lane + 256 * j)); }
        }
        if (op.has_xn) {
            float ss = 0.f;
#pragma unroll
            for (int j = 0; j < 4; ++j) ss += (v[q][j].x * v[q][j].x + v[q][j].y * v[q][j].y) + (v[q][j].z * v[q][j].z + v[q][j].w * v[q][j].w);
            const float rr = rsqrtf(wave_sum(ss) * (1.f / D) + EPSN);
            bf16_t* xo = (bf16_t*)(a.ws + WS_XN) + (size_t)r * D;
#pragma unroll
            for (int j = 0; j < 4; ++j) { const int c = 4 * lane + 256 * j;
                f32x4 o = (v[q][j] * rr) * wpr[j] * (s1v[q][j] + 1.0f) + s0v[q][j];
                if (op.add_pos && lat[q]) o = o + ppv[q][j];
                u32x2 pk; pk.x = pk2(o.x, o.y); pk.y = pk2(o.z, o.w); *(u32x2*)(xo + c) = pk; }
        }
    }
}
__device__ __forceinline__ void rowwise_all(const Args& a, const RowOp& op, int gw, int NGW, int lane) {
    int r = gw;
    for (; r + NGW < MTOT; r += 2 * NGW) { const int rs[2] = {r, r + NGW}; rowwise<2>(a, op, rs, lane); }
    if (r < MTOT) { const int rs[1] = {r}; rowwise<1>(a, op, rs, lane); }
}

constexpr int C_MQ = 0, C_MK = 256, C_MV = 512, C_MO = 1024, C_MIF = 1536, C_GQ = 1552, C_GK = 1808, C_GV = 2064, C_GR = 2576, C_GLR = 3088, C_HQ = 3120, C_HF = 3376, C_HV = 3888, C_HG = 4400;

struct ItemInfo { int br, dir, head, seq, c, T, NC; };
__device__ __forceinline__ ItemInfo item_info(int g, int it) { ItemInfo I; const int hdb = it % 24, cgl = it / 24; I.br = hdb >> 3; I.dir = (hdb >> 2) & 1; I.head = hdb & 3;
    I.T = g < 2 ? 4096 : 256; I.NC = I.T >> 6; I.seq = cgl / I.NC; I.c = cgl % I.NC; return I; }
__device__ __forceinline__ int item_row(const ItemInfo& I, int s) { const int tau = I.c * 64 + s; return I.seq * I.T + (I.dir ? I.T - 1 - tau : tau); }
__device__ __forceinline__ float lb_of(const Args& a, int l, int ch) { if (l == 0) return 0.f; const float g0 = inp(a, I_HGAM)[ch], g1 = inp(a, I_HGAM)[256 + ch]; return 1.0f / (1.0f + expf(g0 - g1)); }

template <bool NEEDQ>
__device__ __forceinline__ void load_gated(const Args& a, const bf16_t* P, const ItemInfo& I, int l, int d, int sg, float (&qv)[8], float (&kv)[8], float (&la)[8]) {
    const int ch = I.head * 64 + d;
    if (I.br == 1) {
        float wup[16];
        const float* wp = inp(a, I_GWUP) + ((size_t)(l * 2 + I.dir) * 16) * 256 + ch;
#pragma unroll
        for (int r = 0; r < 16; ++r) wup[r] = wp[r * 256];
        const float gb = inp(a, I_GLB)[(l * 2 + I.dir) * 256 + ch];
#pragma unroll
        for (int i = 0; i < 8; ++i) { const bf16_t* pr = P + (size_t)item_row(I, 8 * sg + i) * PN;
            const u32x4 g0 = *(const u32x4*)(pr + C_GLR + I.dir * 16), g1 = *(const u32x4*)(pr + C_GLR + I.dir * 16 + 8);
            float z = gb;
            z += bflo(g0.x) * wup[0] + bfhi(g0.x) * wup[1] + bflo(g0.y) * wup[2] + bfhi(g0.y) * wup[3] + bflo(g0.z) * wup[4] + bfhi(g0.z) * wup[5] + bflo(g0.w) * wup[6] + bfhi(g0.w) * wup[7];
            z += bflo(g1.x) * wup[8] + bfhi(g1.x) * wup[9] + bflo(g1.y) * wup[10] + bfhi(g1.y) * wup[11] + bflo(g1.z) * wup[12] + bfhi(g1.z) * wup[13] + bflo(g1.w) * wup[14] + bfhi(g1.w) * wup[15];
            la[i] = logsigf_(z) * (1.0f / 16.0f);
            if (NEEDQ) qv[i] = bf2f(pr[C_GQ + ch]) * 0.125f; kv[i] = bf2f(pr[C_GK + ch]); }
    } else {
        const float lb = lb_of(a, l, ch);
#pragma unroll
        for (int i = 0; i < 8; ++i) { const bf16_t* pr = P + (size_t)item_row(I, 8 * sg + i) * PN;
            const float z = bf2f(pr[C_HF + I.dir * 256 + ch]); const float sg_ = sigmoidf_(z);
            la[i] = (lb == 0.f) ? logsigf_(z) : __logf(lb + (1.0f - lb) * sg_);
            if (NEEDQ) qv[i] = bf2f(pr[C_HQ + ch]) * 1.0f;
            kv[i] = (1.0f - lb) * (1.0f - sg_); }
    }
}
template <bool NEEDQ>
__device__ __forceinline__ void load_mlstm(const Args& a, const bf16_t* P, const ItemInfo& I, int l, int d, int sg, float (&qv)[8], float (&kv)[8], float (&lf)[8], float (&li)[8]) {
    const float bi = inp(a, I_GB)[((l * 2 + I.dir) * 2 + 0) * 4 + I.head], bf_ = inp(a, I_GB)[((l * 2 + I.dir) * 2 + 1) * 4 + I.head];
#pragma unroll
    for (int i = 0; i < 8; ++i) { const bf16_t* pr = P + (size_t)item_row(I, 8 * sg + i) * PN;
        li[i] = bf2f(pr[C_MIF + I.dir * 8 + I.head]) + bi; lf[i] = logsigf_(bf2f(pr[C_MIF + I.dir * 8 + 4 + I.head]) + bf_);
        if (NEEDQ) qv[i] = bf2f(pr[C_MQ + I.head * 64 + d]) * 0.125f; kv[i] = bf2f(pr[C_MK + I.head * 64 + d]); }
}
__device__ __forceinline__ bf16x8 ldfrag(const LAS bf16_t* T, int pitch, int row0, int k0, int lane) { return *(const LAS bf16x8*)(T + (row0 + (lane & 15)) * pitch + k0 + 8 * (lane >> 4)); }

struct Raw { bf16_t q[8], k[8], z[8]; unsigned g0, g1; float wup[16]; float p0, p1, nc, mc; u32x4 s0, s1; };
template <bool NEEDQ, bool NEEDS>
__device__ __forceinline__ void raw_load(const Args& a, const bf16_t* P, const ItemInfo& I, int l, int it, int tid, Raw& R) {
    const int d = tid & 63, lane = d, sg = __builtin_amdgcn_readfirstlane(tid >> 6), ch = I.head * 64 + d;
    const int qc = I.br == 0 ? C_MQ : (I.br == 1 ? C_GQ : C_HQ), kc = I.br == 0 ? C_MK : (I.br == 1 ? C_GK : C_HF + I.dir * 256);
#pragma unroll
    for (int i = 0; i < 8; ++i) { const bf16_t* pr = P + (size_t)item_row(I, 8 * sg + i) * PN;
        if (NEEDQ) R.q[i] = pr[qc + ch];
        R.k[i] = pr[kc + ch]; }
    if (I.br == 1) {
        R.g0 = P[(size_t)item_row(I, 8 * sg + (lane >> 4)) * PN + C_GLR + I.dir * 16 + (lane & 15)];
        R.g1 = P[(size_t)item_row(I, 8 * sg + 4 + (lane >> 4)) * PN + C_GLR + I.dir * 16 + (lane & 15)];
        const float* wp = inp(a, I_GWUP) + ((size_t)(l * 2 + I.dir) * 16) * 256 + ch;
#pragma unroll
        for (int r = 0; r < 16; ++r) R.wup[r] = wp[r * 256];
        R.p0 = inp(a, I_GLB)[(l * 2 + I.dir) * 256 + ch];
    } else if (I.br == 0) {
        R.g0 = P[(size_t)item_row(I, 8 * sg + (lane & 7)) * PN + C_MIF + I.dir * 8 + ((lane >> 3) & 1) * 4 + I.head];
        R.p0 = inp(a, I_GB)[((l * 2 + I.dir) * 2 + 0) * 4 + I.head]; R.p1 = inp(a, I_GB)[((l * 2 + I.dir) * 2 + 1) * 4 + I.head];
    } else R.p0 = lb_of(a, l, ch);
    if (NEEDS) { const bf16_t* US = (const bf16_t*)(a.ws + WS_BIG + BIG_US) + (size_t)it * 8192; const int e = tid >> 2, part = tid & 3;
        R.s0 = *(const u32x4*)(US + e * 64 + 16 * part); R.s1 = *(const u32x4*)(US + e * 64 + 16 * part + 8);
        if (I.br == 0) { R.nc = ((const float*)(a.ws + WS_DEC))[(size_t)it * 64 + d]; R.mc = ((const float*)(a.ws + WS_SC))[(size_t)it * 4 + 2]; } }
}
__device__ __forceinline__ float rl_bf(unsigned v, int ln) { return __uint_as_float(((unsigned)__builtin_amdgcn_readlane((int)v, ln)) << 16); }
template <bool NEEDQ>
__device__ __forceinline__ void gated_from_raw(const Raw& R, const ItemInfo& I, float (&qv)[8], float (&kv)[8], float (&la)[8]) {
    if (I.br == 1) {
#pragma unroll
        for (int i = 0; i < 8; ++i) { float z = R.p0; const unsigned src = i < 4 ? R.g0 : R.g1;
#pragma unroll
            for (int r = 0; r < 16; ++r) z += rl_bf(src, (i & 3) * 16 + r) * R.wup[r];
            la[i] = logsigf_(z) * (1.0f / 16.0f);
            if (NEEDQ) qv[i] = bf2f(R.q[i]) * 0.125f; kv[i] = bf2f(R.k[i]); }
    } else { const float lb = R.p0;
#pragma unroll
        for (int i = 0; i < 8; ++i) { const float z = bf2f(R.k[i]); const float sg_ = sigmoidf_(z);
            la[i] = (lb == 0.f) ? logsigf_(z) : __logf(lb + (1.0f - lb) * sg_);
            if (NEEDQ) qv[i] = bf2f(R.q[i]) * 1.0f;
            kv[i] = (1.0f - lb) * (1.0f - sg_); }
    }
}
template <bool NEEDQ>
__device__ __forceinline__ void mlstm_from_raw(const Raw& R, float (&qv)[8], float (&kv)[8], float (&lf)[8], float (&li)[8]) {
#pragma unroll
    for (int i = 0; i < 8; ++i) { li[i] = rl_bf(R.g0, i) + R.p0; lf[i] = logsigf_(rl_bf(R.g0, 8 + i) + R.p1);
        if (NEEDQ) qv[i] = bf2f(R.q[i]) * 0.125f; kv[i] = bf2f(R.k[i]); }
}
template <int SK>
__device__ __forceinline__ bf16x8 ldfragY(const LAS bf16_t* T, int pitch, int row0, int k0, int lane) { return *(const LAS bf16x8*)(T + (row0 + (lane & 15)) * pitch + (row0 >> 4) * SK + k0 + 8 * (lane >> 4)); }
__device__ __forceinline__ void v_load(const bf16_t* P, const ItemInfo& I, int tid, u32x4& v0, u32x4& v1) {
    const int s = tid >> 3, eg = tid & 7; const int vb = I.br == 0 ? C_MV : (I.br == 1 ? C_GV : C_HV);
    const bf16_t* pv = P + (size_t)item_row(I, s) * PN + vb + I.head * 128 + 16 * eg; v0 = *(const u32x4*)pv; v1 = *(const u32x4*)(pv + 8);
}
template <int SK>
__device__ __forceinline__ void v_store(int br, LAS bf16_t* Y, int pitch, int tid, const u32x4& v0, const u32x4& v1) {
    const int s = tid >> 3, eg = tid & 7; const unsigned wds[8] = {v0.x, v0.y, v0.z, v0.w, v1.x, v1.y, v1.z, v1.w};
#pragma unroll
    for (int i = 0; i < 8; ++i) { float x0 = bflo(wds[i]), x1 = bfhi(wds[i]); if (br == 2) { x0 = siluf_(x0); x1 = siluf_(x1); }
        Y[(16 * eg + 2 * i) * pitch + SK * eg + s] = (bf16_t)f2bf(x0); Y[(16 * eg + 2 * i + 1) * pitch + SK * eg + s] = (bf16_t)f2bf(x1); }
}

__device__ __forceinline__ void scan_s1(const Args& a, LAS unsigned char* lds, int l, int g, int it, const Raw& R, const u32x4& pv0, const u32x4& pv1) {
    int tid_ = threadIdx.x; asm volatile("" : "+v"(tid_)); const int tid = tid_, d = tid & 63, lane = d, sg = __builtin_amdgcn_readfirstlane(tid >> 6);
    const ItemInfo I = item_info(g, it);
    const bf16_t* P = (const bf16_t*)(a.ws + WS_BIG);
    bf16_t* US = (bf16_t*)(a.ws + WS_BIG + BIG_US) + (size_t)it * 8192;
    float* DEC = (float*)(a.ws + WS_DEC) + (size_t)it * 64; float* SC = (float*)(a.ws + WS_SC) + (size_t)it * 4;
    LAS bf16_t* XT = (LAS bf16_t*)lds;
    LAS bf16_t* YV = (LAS bf16_t*)(lds + 9216);
    LAS float* TOT = (LAS float*)(lds + 9216 + 20736 + 256);
    LAS float* TMX = TOT + 512;
    float qv[8], kv[8], x0[8], x1[8];
    if (I.br == 0) {
        mlstm_from_raw<false>(R, qv, kv, x0, x1);
        float run = 0.f;
#pragma unroll
        for (int i = 0; i < 8; ++i) { run += x0[i]; x0[i] = run; }
        TOT[sg * 64 + d] = run; LDS_WAIT(); __syncthreads();
        float pre = 0.f, tot = 0.f;
#pragma unroll
        for (int w = 0; w < 8; ++w) { const float t = TOT[w * 64 + d]; if (w < sg) pre += t; tot += t; }
        float mx = -3.0e38f;
#pragma unroll
        for (int i = 0; i < 8; ++i) { x0[i] = tot - (pre + x0[i]) + x1[i]; mx = fmaxf(mx, x0[i]); }
        TMX[sg * 64 + d] = mx; LDS_WAIT(); __syncthreads();
        float mlw = -3.0e38f;
#pragma unroll
        for (int w = 0; w < 8; ++w) mlw = fmaxf(mlw, TMX[w * 64 + d]);
#pragma unroll
        for (int i = 0; i < 8; ++i) kv[i] *= __expf(x0[i] - mlw);
        if (tid == 0) { SC[0] = mlw; SC[1] = tot; }
        for (int idx = tid; idx < 16 * 64; idx += 512) YV[(128 + (idx >> 6)) * 72 + 64 + (idx & 63)] = (bf16_t)((idx >> 6) == 0 ? 0x3F80 : 0);
    } else {
        gated_from_raw<false>(R, I, qv, kv, x0);
        float run = 0.f;
#pragma unroll
        for (int i = 0; i < 8; ++i) { run += x0[i]; x0[i] = run; }
        TOT[sg * 64 + d] = run; LDS_WAIT(); __syncthreads();
        float pre = 0.f, tot = 0.f;
#pragma unroll
        for (int w = 0; w < 8; ++w) { const float t = TOT[w * 64 + d]; if (w < sg) pre += t; tot += t; }
#pragma unroll
        for (int i = 0; i < 8; ++i) kv[i] *= __expf(tot - (pre + x0[i]));
        if (sg == 0) DEC[d] = __expf(tot);
    }
    { u32x4 w; w.x = pk2(kv[0], kv[1]); w.y = pk2(kv[2], kv[3]); w.z = pk2(kv[4], kv[5]); w.w = pk2(kv[6], kv[7]); *(LAS u32x4*)(XT + d * 72 + 8 * sg) = w; }
    v_store<8>(I.br, YV, 72, tid, pv0, pv1);
    LDS_WAIT(); __syncthreads();
    f32x4 acc[4];
#pragma unroll
    for (int mt = 0; mt < 4; ++mt) acc[mt] = (f32x4){0.f, 0.f, 0.f, 0.f};
#pragma unroll
    for (int ks = 0; ks < 2; ++ks) { const bf16x8 b = ldfragY<8>(YV, 72, 16 * sg, 32 * ks, lane);
#pragma unroll
        for (int mt = 0; mt < 4; ++mt) acc[mt] = __builtin_amdgcn_mfma_f32_16x16x32_bf16(ldfrag(XT, 72, 16 * mt, 32 * ks, lane), b, acc[mt], 0, 0, 0); }
    { const int e = 16 * sg + (lane & 15);
#pragma unroll
      for (int mt = 0; mt < 4; ++mt) { u32x2 o; o.x = pk2(acc[mt][0], acc[mt][1]); o.y = pk2(acc[mt][2], acc[mt][3]); *(u32x2*)(US + e * 64 + 16 * mt + 4 * (lane >> 4)) = o; } }
    if (I.br == 0 && sg < 4) {
        f32x4 an = (f32x4){0.f, 0.f, 0.f, 0.f};
#pragma unroll
        for (int ks = 0; ks < 2; ++ks) an = __builtin_amdgcn_mfma_f32_16x16x32_bf16(ldfrag(XT, 72, 16 * sg, 32 * ks, lane), ldfragY<8>(YV, 72, 128, 32 * ks, lane), an, 0, 0, 0);
        if ((lane & 15) == 0) { const int d0 = 16 * sg + 4 * (lane >> 4); DEC[d0] = an[0]; DEC[d0 + 1] = an[1]; DEC[d0 + 2] = an[2]; DEC[d0 + 3] = an[3]; }
    }
    __syncthreads();
}

template <int S2B>
__device__ __forceinline__ void s2_slot(const Args& a, int l, int g, int slot) {
    const int T = g < 2 ? 4096 : 256, NC = T >> 6;
    bf16_t* USb = (bf16_t*)(a.ws + WS_BIG + BIG_US); float* DECb = (float*)(a.ws + WS_DEC); float* SCb = (float*)(a.ws + WS_SC);
    {
        const int sub = slot & 1023, stream = slot >> 10, hdb = stream % 24, seq = stream / 24, br = hdb >> 3, dir = (hdb >> 2) & 1, head = hdb & 3;
        const int e = sub >> 3, d0 = (sub & 7) * 8;
        float S[8], nst[8], mst = 0.f;
#pragma unroll
        for (int i = 0; i < 8; ++i) { S[i] = 0.f; nst[i] = 0.f; }
        if (g < 2) { const int b = g * 2 + seq; const size_t sidx = (size_t)((b * 2 + l) * 2 + dir) * 4 + head;
            const float* sp = (br == 0 ? inp(a, I_SC) : (br == 1 ? inp(a, I_SG) : inp(a, I_SH))) + sidx * 8192;
#pragma unroll
            for (int i = 0; i < 8; ++i) S[i] = sp[(d0 + i) * 128 + e];
            if (br == 0) { mst = inp(a, I_SM)[sidx];
#pragma unroll
                for (int i = 0; i < 8; ++i) nst[i] = inp(a, I_SN)[sidx * 64 + d0 + i]; } }
        const bool nrow = (br == 0) && (e == 0);
        for (int c0 = 0; c0 < NC; c0 += S2B) {
            u32x4 ub[S2B]; f32x4 q0[S2B], q1[S2B]; float m0[S2B], m1[S2B];
#pragma unroll
            for (int j = 0; j < S2B; ++j) { const size_t it = (size_t)(seq * NC + c0 + j) * 24 + hdb;
                ub[j] = *(const u32x4*)(USb + it * 8192 + e * 64 + d0);
                if (br == 0) { m0[j] = SCb[it * 4]; m1[j] = SCb[it * 4 + 1]; }
                if (br != 0 || nrow) { q0[j] = *(const f32x4*)(DECb + it * 64 + d0); q1[j] = *(const f32x4*)(DECb + it * 64 + d0 + 4); } }
#pragma unroll
            for (int j = 0; j < S2B; ++j) { const size_t it = (size_t)(seq * NC + c0 + j) * 24 + hdb;
                bf16_t* p = USb + it * 8192 + e * 64 + d0; float* dec = DECb + it * 64 + d0; float* sc = SCb + it * 4;
                const u32x4 u = ub[j];
                const float uu[8] = {bflo(u.x), bfhi(u.x), bflo(u.y), bfhi(u.y), bflo(u.z), bfhi(u.z), bflo(u.w), bfhi(u.w)};
                { u32x4 w; w.x = pk2(S[0], S[1]); w.y = pk2(S[2], S[3]); w.z = pk2(S[4], S[5]); w.w = pk2(S[6], S[7]); *(u32x4*)p = w; }
                if (br == 0) {
                    const float mlw = m0[j], bl = m1[j]; const float mn = fmaxf(bl + mst, mlw); const float fa = __expf(bl + mst - mn), fb = __expf(mlw - mn);
                    if (nrow) { const f32x4 n0 = q0[j], n1 = q1[j];
                        *(f32x4*)dec = (f32x4){nst[0], nst[1], nst[2], nst[3]}; *(f32x4*)(dec + 4) = (f32x4){nst[4], nst[5], nst[6], nst[7]};
                        const float nn[8] = {n0.x, n0.y, n0.z, n0.w, n1.x, n1.y, n1.z, n1.w};
#pragma unroll
                        for (int i = 0; i < 8; ++i) nst[i] = fa * nst[i] + fb * nn[i];
                        if (d0 == 0) sc[2] = mst; }
#pragma unroll
                    for (int i = 0; i < 8; ++i) S[i] = fa * S[i] + fb * uu[i];
                    mst = mn;
                } else {
                    const f32x4 a0 = q0[j], a1 = q1[j]; const float dd[8] = {a0.x, a0.y, a0.z, a0.w, a1.x, a1.y, a1.z, a1.w};
#pragma unroll
                    for (int i = 0; i < 8; ++i) S[i] = dd[i] * S[i] + uu[i];
                }
            }
        }
        if (g == 2) { const size_t sidx = (size_t)((seq * 2 + l) * 2 + dir) * 4 + head;
            float* op = a.out + (br == 0 ? OFF_C : (br == 1 ? OFF_G : OFF_H)) + sidx * 8192;
#pragma unroll
            for (int i = 0; i < 8; ++i) op[(d0 + i) * 128 + e] = S[i];
            if (nrow) {
#pragma unroll
                for (int i = 0; i < 8; ++i) a.out[OFF_N + sidx * 64 + d0 + i] = nst[i];
                if (d0 == 0) a.out[OFF_M + sidx] = mst; } }
    }
}
template <int S2B>
__device__ __forceinline__ void scan_s2(const Args& a, int l, int g) {
    const int nslot = (g < 2 ? 2 : 32) * 24 * 1024;
    int tid_ = threadIdx.x; asm volatile("" : "+v"(tid_));
    for (int slot = blockIdx.x * 512 + tid_; slot < nslot; slot += gridDim.x * 512) s2_slot<S2B>(a, l, g, slot);
}

constexpr int S3_QO = 0, S3_KO = 23040, S3_G = 41472, S3_XA = 57856, S3_YV = 75264, S3_TOT = 114432 + 256, S3_VEC = 116480 + 256;
__device__ __forceinline__ void scan_s3(const Args& a, LAS unsigned char* lds, int l, int g, int it2, int it2n, Raw& Rc, u32x4& pv0, u32x4& pv1) {
    int tid_ = threadIdx.x; asm volatile("" : "+v"(tid_)); const int tid = tid_, d = tid & 63, lane = d, sg = __builtin_amdgcn_readfirstlane(tid >> 6);
    const int hb = it2 % 12, cgl = it2 / 12; ItemInfo I; I.br = hb >> 2; I.head = hb & 3; I.T = g < 2 ? 4096 : 256; I.NC = I.T >> 6; I.seq = cgl / I.NC; const int cn = cgl % I.NC; I.dir = 0; I.c = cn;
    const bf16_t* P = (const bf16_t*)(a.ws + WS_BIG);
    LAS bf16_t* QO = (LAS bf16_t*)(lds + S3_QO); LAS bf16_t* KO = (LAS bf16_t*)(lds + S3_KO); LAS float* G = (LAS float*)(lds + S3_G);
    LAS bf16_t* XA = (LAS bf16_t*)(lds + S3_XA); LAS bf16_t* YV = (LAS bf16_t*)(lds + S3_YV); LAS float* TOT = (LAS float*)(lds + S3_TOT);
    LAS float* Bv = (LAS float*)(lds + S3_VEC); LAS float* LIv = Bv + 64; LAS float* MT = Bv + 128; LAS float* EI = Bv + 192;
    v_store<8>(I.br, YV, 136, tid, pv0, pv1);
    ItemInfo In; { const int hbn = it2n % 12, cgn = it2n / 12; In.br = hbn >> 2; In.head = hbn & 3; In.T = I.T; In.NC = I.NC; In.seq = cgn / I.NC; In.c = cgn % I.NC; In.dir = 0; }
    v_load(P, In, tid, pv0, pv1);
    f32x4 osum[4];
#pragma unroll
    for (int nt = 0; nt < 4; ++nt) osum[nt] = (f32x4){0.f, 0.f, 0.f, 0.f};
    const int e0 = 16 * sg + 4 * (lane >> 4); const int gcol = (I.br == 0 ? C_MO : (I.br == 1 ? C_GR : C_HG)) + I.head * 128 + e0;
    u32x2 gts[4];
#pragma unroll
    for (int nt = 0; nt < 4; ++nt) gts[nt] = *(const u32x2*)(P + (size_t)(I.seq * I.T + 64 * cn + 16 * nt + (lane & 15)) * PN + gcol);
    const f32x4 hw = *(const f32x4*)(inp(a, I_HN) + (size_t)(l * 3 + I.br) * 512 + I.head * 128 + e0);
  for (int dir = 0; dir < 2; ++dir) {
    I.dir = dir; I.c = dir ? I.NC - 1 - cn : cn;
    const int it = (I.seq * I.NC + I.c) * 24 + I.br * 8 + dir * 4 + I.head;
#define RV(x) (dir ? 63 - (x) : (x))
    float qv[8], kv[8], x0[8], x1[8];
    const Raw R = Rc;
    { const int e = tid >> 2, part = tid & 3; *(LAS u32x4*)(YV + e * 136 + (e >> 4) * 8 + 64 + 16 * part) = R.s0; *(LAS u32x4*)(YV + e * 136 + (e >> 4) * 8 + 64 + 16 * part + 8) = R.s1; }
    { ItemInfo It = dir ? In : I; if (!dir) { It.dir = 1; It.c = I.NC - 1 - cn; }
      const int itt = (It.seq * It.NC + It.c) * 24 + It.br * 8 + It.dir * 4 + It.head;
      raw_load<true, true>(a, P, It, l, itt, tid, Rc); }
    const int bi = sg >> 1;
    f32x4 acc[4];
#pragma unroll
    for (int nt = 0; nt < 4; ++nt) acc[nt] = (f32x4){0.f, 0.f, 0.f, 0.f};
    if (I.br != 0) {
        gated_from_raw<true>(R, I, qv, kv, x0);
        float run = 0.f;
#pragma unroll
        for (int i = 0; i < 8; ++i) { run += x0[i]; x0[i] = run; }
        TOT[sg * 64 + d] = run; LDS_WAIT(); __syncthreads();
        float pre = 0.f, gs = 0.f, geo = 0.f, gej[3] = {0.f, 0.f, 0.f};
#pragma unroll
        for (int w = 0; w < 8; ++w) { const float t = TOT[w * 64 + d]; if (w < sg) pre += t; if (w < 2 * bi) gs += t; if (w < 2 * bi + 2) geo += t;
            if (w < 2) gej[0] += t; if (w < 4) gej[1] += t; if (w < 6) gej[2] += t; }
#pragma unroll
        for (int i = 0; i < 8; ++i) { x0[i] += pre; const int s = 8 * sg + i; XA[RV(s) * 136 + 64 + d] = (bf16_t)f2bf(qv[i] * __expf(x0[i])); }
        float dfac[2];
#pragma unroll
        for (int j = 0; j < 2; ++j) dfac[j] = __expf(fminf(gs - gej[j], 0.f));
#pragma unroll
        for (int i = 0; i < 8; ++i) { const int tt = 8 * (sg & 1) + i;
            QO[(6 + bi) * 1152 + tt * 72 + d] = (bf16_t)f2bf(qv[i] * __expf(x0[i] - gs));
            KO[(4 + bi) * 1152 + tt * 72 + d] = (bf16_t)f2bf(kv[i] * __expf(fminf(gs - x0[i], 80.f)));
            if (bi < 3) KO[bi * 1152 + tt * 72 + d] = (bf16_t)f2bf(kv[i] * __expf(geo - x0[i]));
            const float qd = qv[i] * __expf(x0[i] - gs);
#pragma unroll
            for (int j = 0; j < 2; ++j) if (j + 1 < bi) QO[(bi * (bi - 1) / 2 + j) * 1152 + tt * 72 + d] = (bf16_t)f2bf(qd * dfac[j]); }
        LDS_WAIT(); __syncthreads();
#pragma unroll
        for (int jj = 0; jj < 2; ++jj) { const int j = 2 * (sg & 1) + jj; f32x4 t = (f32x4){0.f, 0.f, 0.f, 0.f};
            if (j <= bi) { const int qt = (j + 1 >= bi) ? 6 + bi : bi * (bi - 1) / 2 + j, kt = (j == bi) ? 4 + bi : j;
#pragma unroll
                for (int ks = 0; ks < 2; ++ks) t = __builtin_amdgcn_mfma_f32_16x16x32_bf16(ldfrag(QO + qt * 1152, 72, 0, 32 * ks, lane), ldfrag(KO + kt * 1152, 72, 0, 32 * ks, lane), t, 0, 0, 0); }
#pragma unroll
            for (int r = 0; r < 4; ++r) { const int tl = 4 * (lane >> 4) + r, sl = lane & 15; float v = t[r]; if (j == bi && sl > tl) v = 0.f;
                XA[RV(16 * bi + tl) * 136 + RV(16 * j + sl)] = (bf16_t)f2bf(v); } }
        LDS_WAIT(); __syncthreads();
    } else {
        mlstm_from_raw<true>(R, qv, kv, x0, x1);
        float run = 0.f;
#pragma unroll
        for (int i = 0; i < 8; ++i) { run += x0[i]; x0[i] = run; }
        TOT[sg * 64 + d] = run;
        for (int idx = tid; idx < 16 * 128; idx += 512) { const int r = idx >> 7, k = idx & 127; YV[(128 + r) * 136 + 64 + k] = (bf16_t)(r == 0 ? (k < 64 ? 0x3F80u : 0u) : 0u); }
        LDS_WAIT(); __syncthreads();
        float pre = 0.f;
#pragma unroll
        for (int w = 0; w < 8; ++w) { const float t = TOT[w * 64 + d]; if (w < sg) pre += t; }
#pragma unroll
        for (int i = 0; i < 8; ++i) { x0[i] += pre; const int s = 8 * sg + i; if (d == 0) { Bv[s] = x0[i]; LIv[s] = x1[i]; }
            if (i == 0 && sg == 1) YV[128 * 136 + 64 + 64 + d] = (bf16_t)f2bf(R.nc);
            QO[s * 72 + d] = (bf16_t)f2bf(qv[i]); KO[s * 72 + d] = (bf16_t)f2bf(kv[i]); }
        LDS_WAIT(); __syncthreads();
        if (tid < 64) { float rn = LIv[tid] - Bv[tid];
#pragma unroll
            for (int off = 1; off < 64; off <<= 1) { const float u = __shfl_up(rn, off); if (tid >= off) rn = fmaxf(rn, u); }
            const float bt = Bv[tid], inter = bt + R.mc, mt = fmaxf(inter, bt + rn); MT[RV(tid)] = mt; EI[RV(tid)] = __expf(inter - mt); }
        f32x4 t2[2];
#pragma unroll
        for (int jj = 0; jj < 2; ++jj) { const int j = 2 * (sg & 1) + jj; t2[jj] = (f32x4){0.f, 0.f, 0.f, 0.f};
            if (j <= bi) {
#pragma unroll
                for (int ks = 0; ks < 2; ++ks) t2[jj] = __builtin_amdgcn_mfma_f32_16x16x32_bf16(ldfrag(QO, 72, 16 * bi, 32 * ks, lane), ldfrag(KO, 72, 16 * j, 32 * ks, lane), t2[jj], 0, 0, 0); } }
        LDS_WAIT(); __syncthreads();
#pragma unroll
        for (int jj = 0; jj < 2; ++jj) { const int j = 2 * (sg & 1) + jj;
#pragma unroll
            for (int r = 0; r < 4; ++r) { const int t = 16 * bi + 4 * (lane >> 4) + r, s = 16 * j + (lane & 15); float v = 0.f;
                if (s <= t) v = t2[jj][r] * __expf(Bv[t] - Bv[s] + LIv[s] - MT[RV(t)]);
                XA[RV(t) * 136 + RV(s)] = (bf16_t)f2bf(v); } }
#pragma unroll
        for (int i = 0; i < 8; ++i) { const int s = 8 * sg + i; XA[RV(s) * 136 + 64 + d] = (bf16_t)f2bf(qv[i] * EI[RV(s)]); }
        LDS_WAIT(); __syncthreads();
    }
    f32x4 accd[4];
#pragma unroll
    for (int nt = 0; nt < 4; ++nt) accd[nt] = (f32x4){0.f, 0.f, 0.f, 0.f};
#pragma unroll
    for (int ks = 0; ks < 4; ++ks) { const bf16x8 av = ldfragY<8>(YV, 136, 16 * sg, 32 * ks, lane);
        bf16x8 ad = av; if (I.br == 0) ad = ldfragY<8>(YV, 136, 128, 32 * ks, lane);
#pragma unroll
        for (int nt = 0; nt < 4; ++nt) { const bf16x8 bx = ldfrag(XA, 136, 16 * nt, 32 * ks, lane);
            acc[nt] = __builtin_amdgcn_mfma_f32_16x16x32_bf16(av, bx, acc[nt], 0, 0, 0);
            if (I.br == 0) accd[nt] = __builtin_amdgcn_mfma_f32_16x16x32_bf16(ad, bx, accd[nt], 0, 0, 0); } }
#pragma unroll
    for (int nt = 0; nt < 4; ++nt) { const int t = 16 * nt + (lane & 15); f32x4 o = acc[nt];
        if (I.br == 0) { const float den = __shfl(accd[nt][0], lane & 15); const float dn = fmaxf(fabsf(den), __expf(-MT[t])); o = o * __builtin_amdgcn_rcpf(dn); }
        osum[nt] = osum[nt] + o; }
    __syncthreads();
#undef RV
  }
    LAS float* RED = TOT;
#pragma unroll
    for (int nt = 0; nt < 4; ++nt) { float ss = (osum[nt][0] * osum[nt][0] + osum[nt][1] * osum[nt][1]) + (osum[nt][2] * osum[nt][2] + osum[nt][3] * osum[nt][3]);
        ss += __shfl_xor(ss, 16); ss += __shfl_xor(ss, 32);
        if (lane < 16) RED[sg * 64 + 16 * nt + lane] = ss; }
    LDS_WAIT(); __syncthreads();
    bf16_t* YSo = (bf16_t*)(a.ws + WS_A) + (size_t)g * GROWS * 1536;
#pragma unroll
    for (int nt = 0; nt < 4; ++nt) { const int t = 16 * nt + (lane & 15); float tot = 0.f;
#pragma unroll
        for (int w = 0; w < 8; ++w) tot += RED[w * 64 + t];
        const float rr = rsqrtf(tot * (1.0f / 128.0f) + EPSN);
        const int lr = I.seq * I.T + 64 * cn + t;
        const u32x2 gt = gts[nt];
        const float gv[4] = {bflo(gt.x), bfhi(gt.x), bflo(gt.y), bfhi(gt.y)}; float y[4];
#pragma unroll
        for (int r = 0; r < 4; ++r) { const float gg = I.br == 0 ? sigmoidf_(gv[r]) : siluf_(gv[r]); y[r] = gg * (osum[nt][r] * rr) * hw[r]; }
        u32x2 w; w.x = pk2(y[0], y[1]); w.y = pk2(y[2], y[3]);
        *(u32x2*)(YSo + (size_t)lr * 1536 + I.br * 512 + I.head * 128 + e0) = w; }
    __syncthreads();
}


enum { ST_F1IN = 0, ST_F1OUT = 1, ST_ROWA = 2, ST_G0 = 3, ST_BR = 15, ST_MG = 16, ST_OUT = 17, ST_ROWB = 18, ST_F2IN = 19, ST_F2OUT = 20, ST_ROWC = 21, NST = 22 };
#ifndef REP_S1
#define REP_S1 1
#endif
#ifndef REP_S3
#define REP_S3 1
#endif
#ifndef REP_G
#define REP_G 1
#endif
template <int M_, int N_, int K_, int LDA_, int LDB_, int ADIV, int AMUL, int KS, class Epi>
__device__ __forceinline__ void run_gemm(LAS unsigned char* lds, const bf16_t* A, const bf16_t* Bt, const Epi& E) {
    typedef pg8::GemmT<M_, N_, K_, LDA_, LDB_> GT; GT g{A, Bt}; typedef pg8::StaticOrderT<M_, N_, ADIV, AMUL, KS> SO; SO S; S.init((int)gridDim.x, (int)blockIdx.x);
    pg8::gemm_phase<GT, Epi, SO, true, true>((PG8_LAS unsigned char*)lds, g, S, E);
}

__global__ void __launch_bounds__(512, 2) mk_fwd(Args a) {
    extern __shared__ __attribute__((aligned(16))) unsigned char lds_raw[];
    LAS unsigned char* lds = (LAS unsigned char*)lds_raw;
    cg::grid_group grid = cg::this_grid();
    for (int u = threadIdx.x; u < (LDS_BYTES - 131072) / 4; u += 512) ((LAS unsigned*)(lds + 131072))[u] = 0u;
    __syncthreads();
    (void)xcd_barrier_post((unsigned*)a.ws, (volatile LAS unsigned*)(lds + 131072 + 352));
    const int tid = threadIdx.x, lane = tid & 63, wave = __builtin_amdgcn_readfirstlane(tid >> 6);
    const int G = gridDim.x, gw = blockIdx.x * 8 + wave, NGW = G * 8;
    unsigned char* ws = a.ws;
    float* mod = (float*)(ws + WS_MOD);

#ifndef SKIP_PRO
#ifdef SPIN_MASK
    const unsigned long long pro_t0 = __builtin_amdgcn_s_memrealtime();
#endif
    convert_weights(a, lds, 0, 0, 13728, 1, gw, NGW, lane, wave);
    __syncthreads();
    ada_partial(a, lds, gw, NGW, lane, wave);
    { float* pos = (float*)(ws + WS_POS);
      for (int i = blockIdx.x * 512 + tid; i < 64 * 512; i += G * 512) { const int v = i >> 9, j = i & 511, fi = j & 255;
          const float fr = expf((-9.210340371976184f * (float)fi) / 256.0f); const float ang = (float)v * fr; pos[i] = j < 256 ? sinf(ang) : cosf(ang); } }
    if (a.ws == nullptr) grid.sync();
    xcd_barrier_ni((unsigned*)a.ws, 131072 + 352);
    { const float* modp = (const float*)(ws + WS_MODP);
      for (int i = blockIdx.x * 512 + tid; i < 2 * 5 * 9216; i += G * 512) { const int col = i % 9216, l = i / (5 * 9216); float s = inp(a, I_BADA)[l * 9216 + col];
#pragma unroll
          for (int ks = 0; ks < 8; ++ks) s += modp[(size_t)ks * (2 * 5 * 9216) + i]; mod[i] = s; } }
    xcd_barrier_ni((unsigned*)a.ws, 131072 + 352);
    { RowOp op{}; op.src_input = 1; op.has_y = 0; op.has_xn = 1; op.npre = inp(a, I_NPRE); op.md_base = mod; op.si = 0; op.add_pos = 0;
      rowwise_all(a, op, gw, NGW, lane); }
    xcd_barrier_ni((unsigned*)a.ws, 131072 + 352);
#ifdef SPIN_MASK
    if ((SPIN_MASK >> 10) & 1) { const unsigned long long t1 = __builtin_amdgcn_s_memrealtime(); while (__builtin_amdgcn_s_memrealtime() - t1 < t1 - pro_t0) __builtin_amdgcn_s_sleep(4); }
#endif
#endif

    for (int l = 0; l < 2; ++l) {
        for (int st = 0; st < NST; ++st) {
            int tid = threadIdx.x; asm volatile("" : "+v"(tid));
            const int lane = tid & 63, wave = __builtin_amdgcn_readfirstlane(tid >> 6), gw = blockIdx.x * 8 + wave;
            unsigned char* ws = a.ws; asm volatile("" : "+s"(ws));
            float* mod = (float*)(ws + WS_MOD); const float* modl = mod + (size_t)l * 5 * 9216;
            bf16_t* XN = (bf16_t*)(ws + WS_XN); bf16_t* BIG = (bf16_t*)(ws + WS_BIG); float* Y = (float*)(ws + WS_A); bf16_t* YS = (bf16_t*)(ws + WS_A);
            unsigned char* wb = ws + WS_W; const int G = gridDim.x, NGW = G * 8;
            const int kind = (st == ST_F1IN || st == ST_F2IN) ? 0 : (st == ST_F1OUT || st == ST_OUT || st == ST_F2OUT) ? 1 : (st == ST_ROWA || st == ST_ROWB || st == ST_ROWC) ? 2 : (st == ST_BR) ? 3 : (st == ST_MG) ? 4 : 5 + ((st - ST_G0) % 4);
            const int g = (st >= ST_G0 && st < ST_BR) ? (st - ST_G0) / 4 : 0;
#ifdef SPIN_MASK
            const unsigned long long spin_t0 = __builtin_amdgcn_s_memrealtime();
#endif
            switch (kind) {
            case 0: {
#ifndef SKIP_G0
                const int f = st == ST_F1IN ? 0 : 1; EpiSwiGLU E{BIG, DFF};
                for (int rep = 0; rep < REP_G; ++rep) run_gemm<MTOT, NFF2, D, D, D, 0, 0, 1>(lds, XN, (const bf16_t*)(wb + W_FFIN) + (size_t)f * NFF2 * D, E);
                if (blockIdx.x >= 64) { const int vw = (blockIdx.x - 64) * 8 + wave, vn = (G - 64) * 8;
                    if (l == 0 && st == ST_F2IN) convert_weights(a, lds, 1, 8448, 13728, 1, vw, vn, lane, wave);
                    if (l == 1 && st == ST_F1IN) { convert_weights(a, lds, 1, 2816, 5632, 0, vw, vn, lane, wave); convert_weights(a, lds, 1, 7040, 8448, 0, vw, vn, lane, wave); } }
#endif
                break; }
            case 1: {
#ifndef SKIP_G1
                EpiBf16 E{(bf16_t*)Y, D, 4, (size_t)MTOT * D};
                for (int rep = 0; rep < REP_G; ++rep)
                if (st == ST_OUT) run_gemm<MTOT, 2 * D, 1536, 3072, 3072, 4, 1536, 2>(lds, BIG, (const bf16_t*)(wb + W_O3), E);
                else run_gemm<MTOT, 2 * D, DFF / 2, DFF, DFF, 4, DFF / 2, 2>(lds, BIG, (const bf16_t*)(wb + W_FFOUT) + (size_t)(st == ST_F1OUT ? 0 : 1) * D * DFF, E);
#endif
                break; }
            case 2: {
#ifndef SKIP_ROW
                RowOp op{}; op.has_y = 1; op.mdg_base = modl + (st == ST_ROWA ? 2 : st == ST_ROWB ? 5 : 8) * D; op.coef = st == ST_ROWB ? 1.0f : 0.5f;
                op.npost = inp(a, I_NPOST) + (size_t)(l * 3 + (st == ST_ROWA ? 0 : st == ST_ROWB ? 1 : 2)) * D; op.src_input = (l == 0 && st == ST_ROWA) ? 1 : 0;
                if (st == ST_ROWA) { op.has_xn = 1; op.npre = inp(a, I_NPRE) + (size_t)(l * 3 + 1) * D; op.md_base = modl; op.si = 3; op.add_pos = 1; }
                else if (st == ST_ROWB) { op.has_xn = 1; op.npre = inp(a, I_NPRE) + (size_t)(l * 3 + 2) * D; op.md_base = modl; op.si = 6; op.add_pos = 0; }
                else { op.has_xn = (l == 0) ? 1 : 0; op.npre = inp(a, I_NPRE) + (size_t)3 * D; op.md_base = mod + (size_t)5 * 9216; op.si = 0; op.add_pos = 0; }
                rowwise_all(a, op, gw, NGW, lane);
#endif
                break; }
            case 3: {
#ifndef SKIP_G3
                EpiBf16 E{BIG, 3072, 0, 0};
                for (int rep = 0; rep < REP_G; ++rep) run_gemm<MTOT, 3072, 512, 1536, 512, 4, 512, 1>(lds, YS, (const bf16_t*)(wb + W_B), E);
#endif
                break; }
            case 4: {
#ifndef SKIP_G4
                EpiGateMul E{BIG, 3072};
                run_gemm<MTOT, MGN, D, D, D, 0, 0, 1>(lds, XN, (const bf16_t*)(wb + W_MG), E);
#endif
                break; }
            case 5: {
#ifndef SKIP_G3
                EpiBf16 E{BIG, PN, 0, 0};
                for (int rep = 0; rep < REP_G; ++rep) run_gemm<GROWS, PN, D, D, D, 0, 0, 1>(lds, XN + (size_t)g * GROWS * D, (const bf16_t*)(wb + W_P), E);
                if (l == 0 && blockIdx.x >= 128 && g < 2) { const int vw = (blockIdx.x - 128) * 8 + wave, vn = (G - 128) * 8;
                    if (g == 0) convert_weights(a, lds, 1, 0, 2816, 0, vw, vn, lane, wave); else convert_weights(a, lds, 1, 5632, 7040, 0, vw, vn, lane, wave); }
#endif
                break; }
            case 6: {
#ifndef SKIP_S1
                if (g < 2) {
                { const bf16_t* Pp = (const bf16_t*)(ws + WS_BIG); Raw R = {}; u32x4 v0 = {0u, 0u, 0u, 0u}, v1 = v0; int it = blockIdx.x;
                  { const int itc = it < 3072 ? it : 3071; const ItemInfo I0 = item_info(g, itc); raw_load<false, false>(a, Pp, I0, l, itc, tid, R); v_load(Pp, I0, tid, v0, v1); }
                  for (; it < 3072; it += G) { const int itn = it + G < 3072 ? it + G : 3071; Raw Rn = {}; u32x4 vn0, vn1;
                      { const ItemInfo I1 = item_info(g, itn); raw_load<false, false>(a, Pp, I1, l, itn, tid, Rn); v_load(Pp, I1, tid, vn0, vn1); }
                      scan_s1(a, lds, l, g, it, R, v0, v1); R = Rn; v0 = vn0; v1 = vn1; } }
                } else {
                  const bf16_t* Pp = (const bf16_t*)(ws + WS_BIG); Raw R = {}; u32x4 v0 = {0u, 0u, 0u, 0u}, v1 = v0;
                  int j = 0, stream = blockIdx.x, it = stream < 768 ? ((stream / 24) * 4) * 24 + (stream % 24) : -1;
                  { const int itc = it >= 0 ? it : 0; const ItemInfo I0 = item_info(g, itc); raw_load<false, false>(a, Pp, I0, l, itc, tid, R); v_load(Pp, I0, tid, v0, v1); }
                  while (it >= 0) {
                      const int jn = j + 1, sn = blockIdx.x + G * (jn >> 2); const int itn = sn < 768 ? ((sn / 24) * 4 + (jn & 3)) * 24 + (sn % 24) : -1;
                      const int itl = itn >= 0 ? itn : it; Raw Rn = {}; u32x4 vn0, vn1;
                      { const ItemInfo I1 = item_info(g, itl); raw_load<false, false>(a, Pp, I1, l, itl, tid, Rn); v_load(Pp, I1, tid, vn0, vn1); }
                      scan_s1(a, lds, l, g, it, R, v0, v1); R = Rn; v0 = vn0; v1 = vn1;
                      if ((j & 3) == 3) {
                          asm volatile("s_waitcnt vmcnt(0)" ::: "memory"); __syncthreads();
                          const int st_ = blockIdx.x + G * (j >> 2);
                          s2_slot<4>(a, l, g, st_ * 1024 + tid); s2_slot<4>(a, l, g, st_ * 1024 + 512 + tid);
                      }
                      j = jn; it = itn; }
                }
#endif
                break; }
            case 7: {
#ifndef SKIP_S2
                if (g < 2) scan_s2<8>(a, l, g);
#endif
                break; }
            case 8: {
#ifndef SKIP_S3
                { const bf16_t* Pp = (const bf16_t*)(ws + WS_BIG); Raw R = {}; u32x4 v0 = {0u, 0u, 0u, 0u}, v1 = v0; int it = blockIdx.x;
                  { const int itc = it < 1536 ? it : 1535; const int hb = itc % 12, cgl = itc / 12; ItemInfo I0; I0.br = hb >> 2; I0.head = hb & 3; I0.T = g < 2 ? 4096 : 256; I0.NC = I0.T >> 6; I0.seq = cgl / I0.NC; I0.c = cgl % I0.NC; I0.dir = 0;
                    raw_load<true, true>(a, Pp, I0, l, (I0.seq * I0.NC + I0.c) * 24 + I0.br * 8 + I0.head, tid, R); v_load(Pp, I0, tid, v0, v1); }
                  for (; it < 1536; it += G) { const int itn = it + G < 1536 ? it + G : 1535; scan_s3(a, lds, l, g, it, itn, R, v0, v1); } }
#endif
                break; }
            default: break;
            }
#ifdef SPIN_MASK
            if ((SPIN_MASK >> kind) & 1) { const unsigned long long t1 = __builtin_amdgcn_s_memrealtime(); while (__builtin_amdgcn_s_memrealtime() - t1 < t1 - spin_t0) __builtin_amdgcn_s_sleep(4); }
#endif
#ifdef BAR_PROBE
            if (st != ST_BR) { unsigned long long* la = (unsigned long long*)(a.ws + 8192);
                asm volatile("s_waitcnt vmcnt(0)" ::: "memory"); __syncthreads();
                if (threadIdx.x == 0) __hip_atomic_fetch_max(la, (unsigned long long)__builtin_amdgcn_s_memrealtime(), __ATOMIC_RELAXED, __HIP_MEMORY_SCOPE_AGENT);
                xcd_barrier_ni((unsigned*)a.ws, 131072 + 352);
                const unsigned long long tr = __builtin_amdgcn_s_memrealtime(), tl = __hip_atomic_load(la, __ATOMIC_RELAXED, __HIP_MEMORY_SCOPE_AGENT);
                while (__builtin_amdgcn_s_memrealtime() - tr < tr - tl) __builtin_amdgcn_s_sleep(2);
                __syncthreads(); } else {
#else
            if (st != ST_BR && !(kind == 7 && g == 2)) xcd_barrier_ni((unsigned*)a.ws, 131072 + 352); else {
#endif
            asm volatile("s_waitcnt vmcnt(0)" ::: "memory"); __syncthreads(); }
#ifdef EXTRA_SYNC
            xcd_barrier_ni((unsigned*)a.ws, 131072 + 352);
#endif
        }
    }
}

extern "C" void kernel_launch(void* const* d_in, const int* in_sizes, int n_in, void* d_out, int out_size, void* d_ws, size_t ws_size, hipStream_t stream) {
    static int grid = 0;
    if (grid == 0) {
        if (n_in != 23 || ws_size < WS_END) { fprintf(stderr, "kernel_launch: unexpected n_in %d / ws_size %zu (need %zu)\n", n_in, ws_size, (size_t)WS_END); grid = -1; return; }
        int dev = 0, cus = 0, per_cu = 0;
        hipGetDevice(&dev); hipDeviceGetAttribute(&cus, hipDeviceAttributeMultiprocessorCount, dev);
        hipFuncSetAttribute((const void*)mk_fwd, hipFuncAttributeMaxDynamicSharedMemorySize, LDS_BYTES);
        hipOccupancyMaxActiveBlocksPerMultiprocessor(&per_cu, (const void*)mk_fwd, 512, LDS_BYTES);
        (void)hipGetLastError();
        if (per_cu < 1) per_cu = 1;
        grid = cus;
    }
    if (grid < 0) return;
    if (hipMemsetAsync(d_ws, 0, 16384, stream) != hipSuccess) { fprintf(stderr, "memset failed\n"); return; }
    Args a{};
    for (int i = 0; i < 23; ++i) a.in[i] = (const float*)d_in[i];
    a.out = (float*)d_out; a.ws = (unsigned char*)d_ws;
    void* args[] = {&a};
    hipError_t e = hipLaunchCooperativeKernel((const void*)mk_fwd, dim3(grid), dim3(512), args, LDS_BYTES, stream);
    if (e != hipSuccess) fprintf(stderr, "cooperative launch failed: %s (grid %d)\n", hipGetErrorString(e), grid);
}
```

```cpp
#include <hip/hip_runtime.h>
#include <hip/hip_cooperative_groups.h>
#include <cstdio>
#include <cstdint>
namespace cg = cooperative_groups;

namespace pg8 {
#define PG8_LAS __attribute__((address_space(3)))
typedef unsigned short bf16_t;
typedef short bf16x8 __attribute__((ext_vector_type(8)));
typedef float f32x4 __attribute__((ext_vector_type(4)));
typedef unsigned u32x4 __attribute__((ext_vector_type(4)));
typedef unsigned u32x2 __attribute__((ext_vector_type(2)));
constexpr int BM = 256, BK = 64, HALF = 128, HTB = HALF * BK * 2, STAGE_BYTES = 8 * HTB, NXCD = 8, WGM = 8;

__host__ __device__ __forceinline__ int lds_byte(int r, int c) { const int st = (r >> 4) * 2 + (c >> 5), rr = r & 15, cc = c & 31, ob = rr * 64 + cc * 2; return st * 1024 + (ob ^ (((ob >> 9) & 1) << 5)); }
__host__ __device__ __forceinline__ void stage_rc(int b, int& R, int& C) { const int st = b / 1024, sb = b % 1024, swz = sb ^ (((sb >> 9) & 1) << 5); R = (st >> 1) * 16 + swz / 64; C = (st & 1) * 32 + (swz % 64) / 2; }
__host__ __device__ __forceinline__ int perm32(int rho) { const int n = rho >> 4, i = rho & 15; return 8 * (i >> 2) + 4 * n + (i & 3); }

struct Unit { int pm, pn; };
template <int M_, int N_, int K_, int LDA_, int LDB_> struct GemmT { const bf16_t* A; const bf16_t* Bt; static constexpr int M = M_, N = N_, K = K_, lda = LDA_, ldb = LDB_; };

struct TripleOrder {
    int G, c;
    __device__ __forceinline__ bool next(int i, Unit& u) const { const int tr = c + G * (i / 3); if (tr >= 384) return false; u.pm = tr >> 2; u.pn = (i % 3) * 4 + (tr & 3); return true; }
    __device__ __forceinline__ int a_off(const Unit&) const { return 0; }
    __device__ __forceinline__ int b_tile(const Unit& u) const { return u.pn; }
    __device__ __forceinline__ int b_koff(const Unit&) const { return 0; }
    __device__ __forceinline__ void a_ready(const Unit&) const {}
    __device__ __forceinline__ void done(const Unit&) const {}
};
template <int M_, int N_, int ADIV, int AMUL, int KS = 1> struct StaticOrderT {
    static constexpr int nM = M_ / BM, nN = N_ / BM, nwg = nM * nN;
    int G, c;
    __device__ void init(int G_, int c_) { G = G_; c = c_; }
    __device__ __forceinline__ bool next(int i, Unit& u) const {
        const int L = i * G + c; if (L >= nwg) return false;
        int wgid = L; { constexpr int q = nwg / NXCD, r = nwg % NXCD; const int xcd = wgid % NXCD, off = wgid / NXCD; wgid = (xcd < r ? xcd * (q + 1) : r * (q + 1) + (xcd - r) * q) + off; }
        constexpr int nig = WGM * nN; const int gid = wgid / nig, fm = gid * WGM, gsz = (nM - fm) < WGM ? (nM - fm) : WGM;
        u.pm = fm + ((wgid % nig) % gsz); u.pn = (wgid % nig) / gsz; return true;
    }
    __device__ __forceinline__ int a_off(const Unit& u) const { return ADIV > 0 ? (u.pn / (ADIV > 0 ? ADIV : 1)) * AMUL : 0; }
    __device__ __forceinline__ int b_tile(const Unit& u) const { return KS > 1 ? u.pn % (nN / KS) : u.pn; }
    __device__ __forceinline__ int b_koff(const Unit& u) const { return KS > 1 ? (u.pn / (nN / KS)) * AMUL : 0; }
    __device__ __forceinline__ void a_ready(const Unit&) const {}
    __device__ __forceinline__ void done(const Unit&) const {}
};

template <class GT, class Epi, class Sched, bool ALIGN_EPI = false, bool SP2 = false>
__device__ __forceinline__ void gemm_phase(PG8_LAS unsigned char* lds, const GT g, const Sched& S, const Epi& E) {
    int tid_ = threadIdx.x; asm volatile("" : "+v"(tid_));
    const int tid = tid_, wid = __builtin_amdgcn_readfirstlane(tid >> 6), lane = tid & 63, wr = wid >> 2, wc = wid & 3, fr = lane & 15, fq = lane >> 4;
    constexpr int K = GT::K, nt = K / BK;
    unsigned voffA[2], voffB[2];
#pragma unroll
    for (int i = 0; i < 2; ++i) { int R, C; stage_rc(tid * 16 + i * 8192, R, C); const int Rb = Epi::PERM ? ((R & ~31) + perm32(R & 31)) : R;
        voffA[i] = (unsigned)(R * GT::lda + C) * 2u; voffB[i] = (unsigned)(Rb * GT::ldb + C) * 2u; }
    constexpr size_t kstep = (size_t)(BK * 2);
    constexpr size_t hstepA = (size_t)HALF * GT::lda * 2, hstepB = (size_t)HALF * GT::ldb * 2;
    constexpr size_t tstepA = 2 * hstepA, tstepB = 2 * hstepB;
    const unsigned ldsw = (unsigned)wid * 1024u;
    const int aoff = lds_byte(wr * 64 + fr, fq * 8), boff = lds_byte(wc * 32 + fr, fq * 8);
#define PG8_SA(b, h) (((b) * 2 + (h)) * HTB)
#define PG8_SB(b, h) ((4 + (b) * 2 + (h)) * HTB)
#define PG8_STAGE(bufoff, gbase, voff) do { _Pragma("unroll") for (int _i = 0; _i < 2; ++_i) \
        __builtin_amdgcn_global_load_lds((const unsigned*)((const char*)(gbase) + (voff)[_i]), (PG8_LAS unsigned*)(lds + (bufoff) + ldsw + _i * 8192), 16, 0, 0); } while (0)
#define PG8_LDA(dst, b, h) do { _Pragma("unroll") for (int m = 0; m < 4; ++m) _Pragma("unroll") for (int k = 0; k < 2; ++k) dst[m][k] = *(const PG8_LAS bf16x8*)(lds + PG8_SA(b, h) + aoff + m * 2048 + k * 1024); } while (0)
#define PG8_LDB(dst, b, h) do { _Pragma("unroll") for (int n = 0; n < 2; ++n) _Pragma("unroll") for (int k = 0; k < 2; ++k) dst[n][k] = *(const PG8_LAS bf16x8*)(lds + PG8_SB(b, h) + boff + n * 2048 + k * 1024); } while (0)
#define PG8_MMA(ai, bj, At, Bt) do { __builtin_amdgcn_s_setprio(1); _Pragma("unroll") for (int m = 0; m < 4; ++m) _Pragma("unroll") for (int n = 0; n < 2; ++n) _Pragma("unroll") for (int k = 0; k < 2; ++k) \
        acc[ai][bj][m][n] = __builtin_amdgcn_mfma_f32_16x16x32_bf16(Bt[n][k], At[m][k], acc[ai][bj][m][n], 0, 0, 0); __builtin_amdgcn_s_setprio(0); } while (0)
#define PG8_WAIT_V(n) asm volatile("s_waitcnt vmcnt(" #n ")" ::: "memory")
#define PG8_WAIT_L(n) asm volatile("s_waitcnt lgkmcnt(" #n ")" ::: "memory")
#define PG8_BAR __builtin_amdgcn_s_barrier()
#define PG8_SCHED __builtin_amdgcn_sched_barrier(0)
    Unit cur, nxt; int ui = 0;
    if (!S.next(0, cur)) return;
    f32x4 acc[2][2][4][2];
#pragma unroll
    for (int a = 0; a < 2; ++a)
#pragma unroll
        for (int b = 0; b < 2; ++b)
#pragma unroll
            for (int m = 0; m < 4; ++m)
#pragma unroll
                for (int n = 0; n < 2; ++n) acc[a][b][m][n] = (f32x4){0.f, 0.f, 0.f, 0.f};
    bf16x8 At[4][2], B0[2][2], B1[2][2];
    const char* cA = (const char*)g.A + (size_t)cur.pm * tstepA + (size_t)S.a_off(cur) * 2; const char* cB = (const char*)g.Bt + (size_t)S.b_tile(cur) * tstepB + (size_t)S.b_koff(cur) * 2;
    S.a_ready(cur);
    if constexpr (SP2) {
        PG8_STAGE(PG8_SB(0, 0), cB, voffB); PG8_STAGE(PG8_SB(0, 1), cB + hstepB, voffB); PG8_STAGE(PG8_SA(0, 0), cA, voffA); PG8_STAGE(PG8_SA(0, 1), cA + hstepA, voffA);
        if (wr == 1) PG8_BAR;
        PG8_WAIT_V(2); PG8_BAR;
        PG8_STAGE(PG8_SB(1, 0), cB + kstep, voffB); PG8_STAGE(PG8_SA(1, 0), cA + kstep, voffA); PG8_STAGE(PG8_SB(1, 1), cB + hstepB + kstep, voffB);
        PG8_WAIT_V(6); PG8_BAR;
    } else {
        PG8_STAGE(PG8_SB(0, 0), cB, voffB); PG8_STAGE(PG8_SA(0, 0), cA, voffA); PG8_STAGE(PG8_SB(0, 1), cB + hstepB, voffB); PG8_STAGE(PG8_SA(0, 1), cA + hstepA, voffA);
        if (wr == 1) PG8_BAR;
        PG8_WAIT_V(4); PG8_BAR;
        PG8_STAGE(PG8_SB(1, 0), cB + kstep, voffB); PG8_STAGE(PG8_SA(1, 0), cA + kstep, voffA); PG8_STAGE(PG8_SB(1, 1), cB + hstepB + kstep, voffB);
        PG8_WAIT_V(6); PG8_BAR;
    }
    for (;;) {
        const bool has_next = S.next(ui + 1, nxt);
        const char* nA = has_next ? (const char*)g.A + (size_t)nxt.pm * tstepA + (size_t)S.a_off(nxt) * 2 : cA; const char* nB = has_next ? (const char*)g.Bt + (size_t)S.b_tile(nxt) * tstepB + (size_t)S.b_koff(nxt) * 2 : cB;
        for (int t = 0; t < nt; t += 2) {
            const bool last = (t == nt - 2);
            const char* a1 = cA + (size_t)(t + 1) * kstep;
            const char* a2 = last ? nA : cA + (size_t)(t + 2) * kstep; const char* b2 = last ? nB : cB + (size_t)(t + 2) * kstep;
            const char* a3 = a2 + kstep; const char* b3 = b2 + kstep;
            if (last && has_next) S.a_ready(nxt);
            if constexpr (SP2) {
            PG8_LDB(B0, 0, 0); PG8_LDB(B1, 0, 1); PG8_SCHED; PG8_LDA(At, 0, 0); PG8_STAGE(PG8_SA(1, 1), a1 + hstepA, voffA);
            PG8_WAIT_V(8); PG8_WAIT_L(0); PG8_BAR; PG8_MMA(0, 0, At, B0); PG8_MMA(0, 1, At, B1); PG8_BAR; PG8_SCHED;
            PG8_LDA(At, 0, 1); PG8_STAGE(PG8_SB(0, 0), b2, voffB); PG8_STAGE(PG8_SB(0, 1), b2 + hstepB, voffB); PG8_STAGE(PG8_SA(0, 0), a2, voffA);
            PG8_WAIT_V(8); PG8_WAIT_L(0); PG8_BAR; PG8_MMA(1, 0, At, B0); PG8_MMA(1, 1, At, B1); PG8_BAR; PG8_SCHED;
            PG8_LDB(B0, 1, 0); PG8_LDB(B1, 1, 1); PG8_SCHED; PG8_LDA(At, 1, 0); PG8_STAGE(PG8_SA(0, 1), a2 + hstepA, voffA);
            PG8_WAIT_V(8); PG8_WAIT_L(0); PG8_BAR; PG8_MMA(0, 0, At, B0); PG8_MMA(0, 1, At, B1); PG8_BAR; PG8_SCHED;
            PG8_LDA(At, 1, 1); PG8_STAGE(PG8_SB(1, 0), b3, voffB); PG8_STAGE(PG8_SB(1, 1), b3 + hstepB, voffB); PG8_STAGE(PG8_SA(1, 0), a3, voffA);
            PG8_WAIT_V(8); PG8_WAIT_L(0); PG8_BAR; PG8_MMA(1, 0, At, B0); PG8_MMA(1, 1, At, B1); PG8_BAR; PG8_SCHED;
            } else {
            PG8_LDB(B0, 0, 0); PG8_SCHED; PG8_LDA(At, 0, 0); PG8_STAGE(PG8_SA(1, 1), a1 + hstepA, voffA);
            PG8_WAIT_L(8); PG8_BAR; PG8_WAIT_L(0); PG8_MMA(0, 0, At, B0); PG8_BAR; PG8_SCHED;
            PG8_LDB(B1, 0, 1); PG8_STAGE(PG8_SB(0, 0), b2, voffB);
            PG8_BAR; PG8_WAIT_L(0); PG8_MMA(0, 1, At, B1); PG8_BAR;
            PG8_LDA(At, 0, 1); PG8_STAGE(PG8_SA(0, 0), a2, voffA);
            PG8_BAR; PG8_WAIT_L(0); PG8_MMA(1, 0, At, B0); PG8_BAR; PG8_SCHED;
            PG8_STAGE(PG8_SB(0, 1), b2 + hstepB, voffB);
            PG8_WAIT_V(6); PG8_BAR; PG8_MMA(1, 1, At, B1); PG8_BAR;
            PG8_LDB(B0, 1, 0); PG8_SCHED; PG8_LDA(At, 1, 0); PG8_STAGE(PG8_SA(0, 1), a2 + hstepA, voffA);
            PG8_WAIT_L(8); PG8_BAR; PG8_WAIT_L(0); PG8_MMA(0, 0, At, B0); PG8_BAR; PG8_SCHED;
            PG8_LDB(B1, 1, 1); PG8_STAGE(PG8_SB(1, 0), b3, voffB);
            PG8_BAR; PG8_WAIT_L(0); PG8_MMA(0, 1, At, B1); PG8_BAR;
            PG8_LDA(At, 1, 1); PG8_STAGE(PG8_SA(1, 0), a3, voffA);
            PG8_BAR; PG8_WAIT_L(0); PG8_MMA(1, 0, At, B0); PG8_BAR; PG8_SCHED;
            PG8_STAGE(PG8_SB(1, 1), b3 + hstepB, voffB);
            PG8_WAIT_V(6); PG8_BAR; PG8_MMA(1, 1, At, B1); PG8_BAR;
            }
        }
        if constexpr (ALIGN_EPI) { if (wr == 0) PG8_BAR; }
        if constexpr (!Epi::AFTER_DRAIN) { E(acc, cur, wr, wc, fr, fq); S.done(cur); }
        if (!has_next) break;
#pragma unroll
        for (int a = 0; a < 2; ++a)
#pragma unroll
            for (int b = 0; b < 2; ++b)
#pragma unroll
                for (int m = 0; m < 4; ++m)
#pragma unroll
                    for (int n = 0; n < 2; ++n) acc[a][b][m][n] = (f32x4){0.f, 0.f, 0.f, 0.f};
        cur = nxt; cA = nA; cB = nB; ++ui;
        if constexpr (ALIGN_EPI) { if (wr == 1) PG8_BAR; }
    }
    PG8_WAIT_V(0);
    if constexpr (!ALIGN_EPI) { if (wr == 0) PG8_BAR; }
    PG8_BAR;
    if constexpr (Epi::AFTER_DRAIN) { E.fused(acc, cur, wr, wc, fr, fq, lds, wid, lane); S.done(cur); }
#undef PG8_SA
#undef PG8_SB
#undef PG8_STAGE
#undef PG8_LDA
#undef PG8_LDB
#undef PG8_MMA
#undef PG8_WAIT_V
#undef PG8_WAIT_L
#undef PG8_BAR
#undef PG8_SCHED
}
}

#define LAS __attribute__((address_space(3)))
typedef unsigned short bf16_t;
typedef short bf16x8 __attribute__((ext_vector_type(8)));
typedef float f32x4 __attribute__((ext_vector_type(4)));
typedef unsigned u32x4 __attribute__((ext_vector_type(4)));
typedef unsigned u32x2 __attribute__((ext_vector_type(2)));

constexpr int D = 1024, DFF = 2816, NFF2 = 5632, INC = 7984, PN = 5120, PREAL = 4912, MGN = 3072;
constexpr int MTOT = 24576, MLAT = 16384, GROWS = 8192;
constexpr float EPSN = 1e-6f;
constexpr size_t MiB = 1u << 20;
constexpr size_t WS_MOD = 1 * MiB, WS_MODP = 2 * MiB, WS_POS = 5 * MiB, WS_DEC = 6 * MiB, WS_SC = 7 * MiB;
constexpr size_t WS_W = 8 * MiB;
constexpr size_t W_FFIN = 0, W_FFOUT = W_FFIN + 2ull * NFF2 * D * 2, W_P = W_FFOUT + 2ull * D * DFF * 2, W_MG = W_P + (size_t)PN * D * 2,
                 W_B = W_MG + (size_t)MGN * D * 2, W_O3 = W_B + 3072ull * 512 * 2, W_END = W_O3 + 1024ull * 3072 * 2;
static_assert(W_END <= 58 * MiB, "weights region");
constexpr size_t WS_XN = 66 * MiB, WS_A = 114 * MiB, WS_BIG = 210 * MiB, WS_END = 370 * MiB;
constexpr size_t BIG_US = 80 * MiB, BIG_OB = 128 * MiB;
constexpr size_t OFF_YP = 0, OFF_YS = 8388608, OFF_C = 25165824, OFF_N = 29360128, OFF_M = 29392896, OFF_G = 29393408, OFF_H = 33587712;
constexpr int LDS_BYTES = 147456;

struct Args { const float* in[23]; float* out; unsigned char* ws; };
enum { I_XP = 0, I_XS, I_C, I_SC, I_SN, I_SM, I_SG, I_SH, I_CCTX, I_WADA, I_BADA, I_NPRE, I_NPOST, I_WFIN, I_WFOUT, I_WIN, I_GB, I_GWUP, I_GLB, I_HGAM, I_HN, I_WBR, I_WOUT };
__device__ __forceinline__ const float* inp(const Args& a, int i) { asm volatile("" : "+s"(i)); return a.in[i]; }

typedef float f32x2_t __attribute__((ext_vector_type(2))); typedef __bf16 bf16x2_t __attribute__((ext_vector_type(2)));
__device__ __forceinline__ unsigned pk2(float lo, float hi) { f32x2_t v = {lo, hi}; bf16x2_t b = __builtin_convertvector(v, bf16x2_t); return __builtin_bit_cast(unsigned, b); }
__device__ __forceinline__ unsigned f2bf(float f) { return pk2(f, 0.f) & 0xffffu; }
__device__ __forceinline__ float bf2f(bf16_t h) { return __uint_as_float(((unsigned)h) << 16); }
__device__ __forceinline__ float bflo(unsigned w) { return __uint_as_float(w << 16); }
__device__ __forceinline__ float bfhi(unsigned w) { return __uint_as_float(w & 0xffff0000u); }
__device__ __forceinline__ float sigmoidf_(float x) { return __builtin_amdgcn_rcpf(1.0f + __expf(-x)); }
__device__ __forceinline__ float siluf_(float x) { return x * __builtin_amdgcn_rcpf(1.0f + __expf(-x)); }
__device__ __forceinline__ float logsigf_(float x) { return fminf(x, 0.f) - __logf(1.0f + __expf(-fabsf(x))); }
__device__ __forceinline__ float wave_sum(float v) {
#pragma unroll
    for (int o = 1; o < 64; o <<= 1) v += __shfl_xor(v, o);
    return v;
}
#define LDS_WAIT() asm volatile("s_waitcnt lgkmcnt(0)" ::: "memory")
#ifndef NO_WT
__device__ __forceinline__ void st_wt8(void* p, u32x2 v) { __hip_atomic_store((unsigned long long*)p, ((unsigned long long)v.y << 32) | v.x, __ATOMIC_RELAXED, __HIP_MEMORY_SCOPE_AGENT); }
__device__ __forceinline__ void st_wt16(void* p, u32x4 v) { st_wt8(p, (u32x2){v.x, v.y}); st_wt8((char*)p + 8, (u32x2){v.z, v.w}); }
#else
__device__ __forceinline__ void st_wt8(void* p, u32x2 v) { *(u32x2*)p = v; }
__device__ __forceinline__ void st_wt16(void* p, u32x4 v) { *(u32x4*)p = v; }
#endif

#define XB_TMO      128
#define XB_XCNT(j)  (256  + 64 * (j))
#define XB_XSUB(j)  (1280 + 64 * (j))
#define XB_XGEN(j)  (2304 + 64 * (j))
#define XB_TOP      3328
#define XB_TOPGEN   3392
#define XCD_BAR_WORDS 3456
#define XB_SPIN_CAP (1u << 18)

__device__ __forceinline__ unsigned xb_ld(unsigned* p)              { return __hip_atomic_load(p, __ATOMIC_RELAXED, __HIP_MEMORY_SCOPE_AGENT); }
__device__ __forceinline__ unsigned xb_add(unsigned* p, unsigned v) { return __hip_atomic_fetch_add(p, v, __ATOMIC_RELAXED, __HIP_MEMORY_SCOPE_AGENT); }
__device__ __forceinline__ unsigned xb_xcc_id() { return (unsigned)__builtin_amdgcn_s_getreg((3 << 11) | 20) & 0xFu; }
#define XB_SPIN(cond, bar) do { unsigned _sp = 0; while (cond) { __builtin_amdgcn_s_sleep(1); \
    if ((++_sp & 255u) == 0u) { if (xb_ld(&(bar)[XB_TMO])) break; if (_sp > XB_SPIN_CAP) { atomicAdd(&(bar)[XB_TMO], 1u); break; } } } } while (0)

struct XcdBarrier {
    unsigned* bar; unsigned x;
    volatile LAS unsigned* st;
};

__device__ __forceinline__ XcdBarrier xcd_barrier_post(unsigned* bar, volatile LAS unsigned* st) {
    XcdBarrier b; b.bar = bar; b.x = xb_xcc_id(); b.st = st;
    if (threadIdx.x == 0) (void)xb_add(&bar[XB_XCNT(b.x)], 1u);
    return b;
}
__device__ __forceinline__ void xcd_barrier_complete(unsigned* bar, unsigned x, unsigned& nloc, unsigned& nx) {
    const unsigned G = gridDim.x * gridDim.y * gridDim.z;
    unsigned sum, cnt, mine, sp = 0u;
    for (;;) {
        sum = 0u; cnt = 0u; mine = 0u;
#pragma unroll
        for (unsigned j = 0; j < 16; ++j) { const unsigned c = xb_ld(&bar[XB_XCNT(j)]); sum += c; cnt += (c > 0u) ? 1u : 0u; mine = (j == x) ? c : mine; }
        if (sum == G) break;
        __builtin_amdgcn_s_sleep(1);
        if ((++sp & 255u) == 0u) { if (xb_ld(&bar[XB_TMO])) break; if (sp > XB_SPIN_CAP) { atomicAdd(&bar[XB_TMO], 1u); break; } }
    }
    nloc = mine > 0u ? mine : 1u; nx = cnt > 0u ? cnt : 1u;
}

__device__ __attribute__((noinline)) void xcd_barrier_ni(unsigned* bar_, unsigned st_off) {
    XcdBarrier b; b.bar = bar_; b.x = xb_xcc_id(); b.st = (volatile LAS unsigned*)(size_t)st_off;
    asm volatile("s_waitcnt vmcnt(0)" ::: "memory");
    __syncthreads();
    if (threadIdx.x == 0) {
        unsigned* bar = b.bar;
        __builtin_amdgcn_s_waitcnt(0);
        unsigned nloc = b.st[0], nx = b.st[1];
        if (nloc == 0u) { xcd_barrier_complete(bar, b.x, nloc, nx); b.st[0] = nloc; b.st[1] = nx; }
        const unsigned old = xb_add(&bar[XB_XSUB(b.x)], 1u);
        const unsigned gen = old / nloc;
        if (old + 1u == (gen + 1u) * nloc) {
            __builtin_amdgcn_fence(__ATOMIC_RELEASE, "agent");
            asm volatile("s_waitcnt vmcnt(0)" ::: "memory");
            const unsigned og = xb_add(&bar[XB_TOP], 1u);
            const unsigned tg = og / nx;
            if (og + 1u == (tg + 1u) * nx) xb_add(&bar[XB_TOPGEN], 1u);
            else XB_SPIN(xb_ld(&bar[XB_TOPGEN]) == tg, bar);
            __builtin_amdgcn_fence(__ATOMIC_ACQUIRE, "agent");
            xb_add(&bar[XB_XGEN(b.x)], 1u);
            asm volatile("s_waitcnt vmcnt(0)" ::: "memory");
        } else {
            XB_SPIN(xb_ld(&bar[XB_XGEN(b.x)]) == gen, bar);
            __builtin_amdgcn_fence(__ATOMIC_ACQUIRE, "agent");
            asm volatile("s_waitcnt vmcnt(0)" ::: "memory");
        }
    }
    __syncthreads();
}


struct EpiBf16 {
    static constexpr bool PERM = true, AFTER_DRAIN = false;
    bf16_t* O; int ldc; int nsplit; size_t sstride;
    __device__ __forceinline__ void operator()(const f32x4 (&acc)[2][2][4][2], const pg8::Unit& u, int wr, int wc, int fr, int fq) const {
        int pn = u.pn; bf16_t* Ob = O; if (nsplit) { Ob += (size_t)(pn / nsplit) * sstride; pn = pn % nsplit; }
        const int row0 = u.pm * 256 + wr * 64 + fr, col0 = pn * 256 + wc * 32 + 8 * fq;
#pragma unroll
        for (int ai = 0; ai < 2; ++ai)
#pragma unroll
            for (int m = 0; m < 4; ++m) { bf16_t* rowp = Ob + (size_t)(row0 + ai * 128 + m * 16) * ldc + col0;
#pragma unroll
                for (int bj = 0; bj < 2; ++bj) { const f32x4 v0 = acc[ai][bj][m][0], v1 = acc[ai][bj][m][1];
                    u32x4 w; w.x = pk2(v0[0], v0[1]); w.y = pk2(v0[2], v0[3]); w.z = pk2(v1[0], v1[1]); w.w = pk2(v1[2], v1[3]);
                    *(u32x4*)(rowp + bj * 128) = w; } }
    }
};
struct EpiGateMul {
    static constexpr bool PERM = true, AFTER_DRAIN = false;
    bf16_t* O; int ldc;
    __device__ __forceinline__ void operator()(const f32x4 (&acc)[2][2][4][2], const pg8::Unit& u, int wr, int wc, int fr, int fq) const {
        const int row0 = u.pm * 256 + wr * 64 + fr, col0 = u.pn * 256 + wc * 32 + 8 * fq;
        u32x4 bb[2][4][2];
#pragma unroll
        for (int ai = 0; ai < 2; ++ai)
#pragma unroll
            for (int m = 0; m < 4; ++m) { const bf16_t* rowp = O + (size_t)(row0 + ai * 128 + m * 16) * ldc + col0;
#pragma unroll
                for (int bj = 0; bj < 2; ++bj) bb[ai][m][bj] = *(const u32x4*)(rowp + bj * 128); }
#pragma unroll
        for (int ai = 0; ai < 2; ++ai)
#pragma unroll
            for (int m = 0; m < 4; ++m) { bf16_t* rowp = O + (size_t)(row0 + ai * 128 + m * 16) * ldc + col0;
#pragma unroll
                for (int bj = 0; bj < 2; ++bj) { const f32x4 v0 = acc[ai][bj][m][0], v1 = acc[ai][bj][m][1];
                    const u32x4 b = bb[ai][m][bj];
                    u32x4 w; w.x = pk2(sigmoidf_(v0[0]) * bflo(b.x), sigmoidf_(v0[1]) * bfhi(b.x)); w.y = pk2(sigmoidf_(v0[2]) * bflo(b.y), sigmoidf_(v0[3]) * bfhi(b.y));
                    w.z = pk2(sigmoidf_(v1[0]) * bflo(b.z), sigmoidf_(v1[1]) * bfhi(b.z)); w.w = pk2(sigmoidf_(v1[2]) * bflo(b.w), sigmoidf_(v1[3]) * bfhi(b.w));
                    *(u32x4*)(rowp + bj * 128) = w; } }
    }
};
struct EpiGateSum {
    static constexpr bool PERM = true, AFTER_DRAIN = false;
    bf16_t* O; int ldc;
    __device__ __forceinline__ void operator()(const f32x4 (&acc)[2][2][4][2], const pg8::Unit& u, int wr, int wc, int fr, int fq) const {
        const int n = u.pn >> 2, dt = u.pn & 3; const int row0 = u.pm * 256 + wr * 64 + fr, col0 = u.pn * 256 + wc * 32 + 8 * fq, cols = dt * 256 + wc * 32 + 8 * fq;
        if (n) asm volatile("s_waitcnt vmcnt(0)" ::: "memory");
#pragma unroll
        for (int ai = 0; ai < 2; ++ai) {
            u32x4 bb[4][2], ss[4][2];
#pragma unroll
            for (int m = 0; m < 4; ++m)
#pragma unroll
                for (int bj = 0; bj < 2; ++bj) { const bf16_t* rp = O + (size_t)(row0 + ai * 128 + m * 16) * ldc; bb[m][bj] = *(const u32x4*)(rp + col0 + bj * 128); if (n) ss[m][bj] = *(const u32x4*)(rp + cols + bj * 128); }
#pragma unroll
            for (int m = 0; m < 4; ++m)
#pragma unroll
                for (int bj = 0; bj < 2; ++bj) { const f32x4 v0 = acc[ai][bj][m][0], v1 = acc[ai][bj][m][1]; const u32x4 b = bb[m][bj];
                    float r[8] = {sigmoidf_(v0[0]) * bflo(b.x), sigmoidf_(v0[1]) * bfhi(b.x), sigmoidf_(v0[2]) * bflo(b.y), sigmoidf_(v0[3]) * bfhi(b.y),
                                  sigmoidf_(v1[0]) * bflo(b.z), sigmoidf_(v1[1]) * bfhi(b.z), sigmoidf_(v1[2]) * bflo(b.w), sigmoidf_(v1[3]) * bfhi(b.w)};
                    if (n) { const u32x4 s = ss[m][bj]; r[0] += bflo(s.x); r[1] += bfhi(s.x); r[2] += bflo(s.y); r[3] += bfhi(s.y); r[4] += bflo(s.z); r[5] += bfhi(s.z); r[6] += bflo(s.w); r[7] += bfhi(s.w); }
                    u32x4 w; w.x = pk2(r[0], r[1]); w.y = pk2(r[2], r[3]); w.z = pk2(r[4], r[5]); w.w = pk2(r[6], r[7]);
                    *(u32x4*)(O + (size_t)(row0 + ai * 128 + m * 16) * ldc + cols + bj * 128) = w; }
        }
    }
};
struct EpiSwiGLU {
    static constexpr bool PERM = true, AFTER_DRAIN = false;
    bf16_t* H; int ldh;
    __device__ __forceinline__ void operator()(const f32x4 (&acc)[2][2][4][2], const pg8::Unit& u, int wr, int wc, int fr, int fq) const {
        const int row0 = u.pm * 256 + wr * 64 + fr, col0 = u.pn * 128 + wc * 32 + 8 * fq;
#pragma unroll
        for (int ai = 0; ai < 2; ++ai)
#pragma unroll
            for (int m = 0; m < 4; ++m) { bf16_t* rowp = H + (size_t)(row0 + ai * 128 + m * 16) * ldh + col0;
                const f32x4 g0 = acc[ai][0][m][0], g1 = acc[ai][0][m][1], u0 = acc[ai][1][m][0], u1 = acc[ai][1][m][1];
                u32x4 w; w.x = pk2(siluf_(g0[0]) * u0[0], siluf_(g0[1]) * u0[1]); w.y = pk2(siluf_(g0[2]) * u0[2], siluf_(g0[3]) * u0[3]);
                w.z = pk2(siluf_(g1[0]) * u1[0], siluf_(g1[1]) * u1[1]); w.w = pk2(siluf_(g1[2]) * u1[2], siluf_(g1[3]) * u1[3]);
                *(u32x4*)rowp = w; }
    }
};
struct EpiF32 {
    static constexpr bool PERM = false, AFTER_DRAIN = false;
    float* Y; int ldc;
    __device__ __forceinline__ void operator()(const f32x4 (&acc)[2][2][4][2], const pg8::Unit& u, int wr, int wc, int fr, int fq) const {
        const int row0 = u.pm * 256 + wr * 64 + fr, col0 = u.pn * 256 + wc * 32 + 4 * fq;
#pragma unroll
        for (int ai = 0; ai < 2; ++ai)
#pragma unroll
            for (int m = 0; m < 4; ++m) { float* rowp = Y + (size_t)(row0 + ai * 128 + m * 16) * ldc + col0;
#pragma unroll
                for (int bj = 0; bj < 2; ++bj)
#pragma unroll
                    for (int n = 0; n < 2; ++n) *(f32x4*)(rowp + bj * 128 + n * 16) = acc[ai][bj][m][n]; }
    }
};

template <class Map>
__device__ __forceinline__ void transpose_item(const float* W, int K, int N, LAS float* scr, int item, int lane, const Map& map) {
    const int nblk = (N + 31) / 32, kb = item / nblk, nb = item % nblk, k0 = 64 * kb, n0 = 32 * nb;
    const int nn = n0 + (lane & 31); const bool ok = nn < N;
    float wv[32];
#pragma unroll
    for (int i = 0; i < 32; ++i) { const int kk = 2 * i + (lane >> 5); wv[i] = W[(size_t)(k0 + kk) * N + (ok ? nn : 0)]; }
#pragma unroll
    for (int i = 0; i < 32; ++i) { const int kk = 2 * i + (lane >> 5); scr[kk * 33 + (lane & 31)] = ok ? wv[i] : 0.f; }
    LDS_WAIT(); asm volatile("" ::: "memory");
    const int c = lane & 7;
#pragma unroll
    for (int j = 0; j < 4; ++j) { const int n = (lane >> 3) + 8 * j; const LAS float* s = scr + (8 * c) * 33 + n;
        u32x4 o; o.x = pk2(s[0 * 33], s[1 * 33]); o.y = pk2(s[2 * 33], s[3 * 33]); o.z = pk2(s[4 * 33], s[5 * 33]); o.w = pk2(s[6 * 33], s[7 * 33]);
        if (n0 + n < N) map(n0 + n, k0 + 8 * c, o); }
    LDS_WAIT(); asm volatile("" ::: "memory");
}

__device__ __forceinline__ void convert_weights(const Args& a, LAS unsigned char* lds, int l, int lo, int hi, int dopad, int gw, int NGW, int lane, int wave) {
    LAS float* scr = (LAS float*)(lds + wave * 16384);
    unsigned char* wb = a.ws + WS_W;
    constexpr int I_FI = 16 * 176, I_FO = 44 * 32, I_IN = 16 * 250, I_BR = 8 * 32, I_OU = 16 * 32;
    constexpr int NITEMS = 2 * I_FI + 2 * I_FO + I_IN + 3 * I_BR + I_OU;
    static_assert(NITEMS == 13728, "item ranges used by the callers");
    for (int it = lo + gw; it < hi; it += NGW) {
        int r = it;
        if (r < 2 * I_FI) { const int f = r / I_FI; r -= f * I_FI; bf16_t* dst = (bf16_t*)(wb + W_FFIN) + (size_t)f * NFF2 * D;
            transpose_item(inp(a, I_WFIN) + (size_t)(l * 2 + f) * D * NFF2, D, NFF2, scr, r, lane,
                [=](int n, int k, u32x4 o) { const int h = n < DFF ? n : n - DFF; const int row = 256 * (h >> 7) + (n < DFF ? 0 : 128) + (h & 127); *(u32x4*)(dst + (size_t)row * D + k) = o; });
            continue; }
        r -= 2 * I_FI;
        if (r < 2 * I_FO) { const int f = r / I_FO; r -= f * I_FO; bf16_t* dst = (bf16_t*)(wb + W_FFOUT) + (size_t)f * D * DFF;
            transpose_item(inp(a, I_WFOUT) + (size_t)(l * 2 + f) * DFF * D, DFF, D, scr, r, lane,
                [=](int n, int k, u32x4 o) { *(u32x4*)(dst + (size_t)n * DFF + k) = o; });
            continue; }
        r -= 2 * I_FO;
        if (r < I_IN) { bf16_t* dp = (bf16_t*)(wb + W_P); bf16_t* dm = (bf16_t*)(wb + W_MG);
            transpose_item(inp(a, I_WIN) + (size_t)l * D * INC, D, INC, scr, r, lane,
                [=](int n, int k, u32x4 o) { if (n < PREAL) *(u32x4*)(dp + (size_t)n * D + k) = o; else *(u32x4*)(dm + (size_t)(n - PREAL) * D + k) = o; });
            continue; }
        r -= I_IN;
        if (r < 3 * I_BR) { const int nb = r / I_BR; r -= nb * I_BR; bf16_t* dst = (bf16_t*)(wb + W_B) + (size_t)nb * 1024 * 512;
            transpose_item(inp(a, I_WBR) + (size_t)(l * 3 + nb) * 512 * D, 512, D, scr, r, lane,
                [=](int n, int k, u32x4 o) { *(u32x4*)(dst + (size_t)n * 512 + k) = o; });
            continue; }
        r -= 3 * I_BR;
        { bf16_t* dst = (bf16_t*)(wb + W_O3);
            transpose_item(inp(a, I_WOUT) + (size_t)l * D * D, D, D, scr, r, lane,
                [=](int n, int k, u32x4 o) { bf16_t* p = dst + (size_t)n * 3072 + k; *(u32x4*)p = o; *(u32x4*)(p + 1024) = o; *(u32x4*)(p + 2048) = o; }); }
    }
    if (dopad) { u32x4* z = (u32x4*)((bf16_t*)(wb + W_P) + (size_t)PREAL * D); const int nz = (PN - PREAL) * D * 2 / 16;
      for (int i = gw * 64 + lane; i < nz; i += NGW * 64) z[i] = (u32x4){0u, 0u, 0u, 0u}; }
}

__device__ __forceinline__ void ada_partial(const Args& a, LAS unsigned char* lds, int gw, int NGW, int lane, int wave) {
    float* modp = (float*)(a.ws + WS_MODP);
    LAS float* sv = (LAS float*)(lds + wave * 16384);
    for (int it = gw; it < 2 * 144 * 8; it += NGW) {
        const int ks = it & 7, cgp = (it >> 3) % 144, l = it / (8 * 144);
        const int col = cgp * 64 + lane;
#pragma unroll
        for (int h = 0; h < 2; ++h) { const int kk = ks * 128 + lane + 64 * h;
            sv[lane + 64 * h] = siluf_(inp(a, I_CCTX)[kk]);
#pragma unroll
            for (int i = 0; i < 4; ++i) sv[(1 + i) * 128 + lane + 64 * h] = siluf_(inp(a, I_C)[i * D + kk]); }
        LDS_WAIT(); asm volatile("" ::: "memory");
        const float* w = inp(a, I_WADA) + ((size_t)l * D + ks * 128) * 9216 + col;
        float acc[5] = {0.f, 0.f, 0.f, 0.f, 0.f};
#pragma unroll 1
        for (int k0 = 0; k0 < 128; k0 += 32) { float wv[32];
#pragma unroll
            for (int k = 0; k < 32; ++k) wv[k] = w[(size_t)(k0 + k) * 9216];
#pragma unroll
            for (int k = 0; k < 32; ++k) {
#pragma unroll
                for (int i = 0; i < 5; ++i) acc[i] += sv[i * 128 + k0 + k] * wv[k]; } }
#pragma unroll
        for (int i = 0; i < 5; ++i) modp[((size_t)(ks * 2 + l) * 5 + i) * 9216 + col] = acc[i];
        LDS_WAIT(); asm volatile("" ::: "memory");
    }
}

struct RowOp { int src_input, has_y; float coef; const float* npost; const float* mdg_base; int has_xn; const float* npre; const float* md_base; int si; int add_pos; };
template <int NR>
__device__ __forceinline__ void rowwise(const Args& a, const RowOp& op, const int (&rs)[NR], int lane) {
    f32x4 v[NR][4]; u32x2 yb[NR][4], yb2[NR][4]; float* xd[NR]; bool lat[NR]; int cv[NR];
#pragma unroll
    for (int q = 0; q < NR; ++q) { const int r = rs[q]; lat[q] = r < MLAT; cv[q] = lat[q] ? 1 + (r >> 12) : 0;
        const float* xs = op.src_input ? (lat[q] ? inp(a, I_XS) + (size_t)r * D : inp(a, I_XP) + (size_t)(r - MLAT) * D)
                                       : (lat[q] ? a.out + OFF_YS + (size_t)r * D : a.out + OFF_YP + (size_t)(r - MLAT) * D);
        xd[q] = lat[q] ? a.out + OFF_YS + (size_t)r * D : a.out + OFF_YP + (size_t)(r - MLAT) * D;
#pragma unroll
        for (int j = 0; j < 4; ++j) v[q][j] = __builtin_nontemporal_load((const f32x4*)(xs + 4 * lane + 256 * j));
        if (op.has_y) { const bf16_t* yr = (const bf16_t*)(a.ws + WS_A) + (size_t)r * D;
#pragma unroll
            for (int j = 0; j < 4; ++j) { yb[q][j] = __builtin_nontemporal_load((const u32x2*)(yr + 4 * lane + 256 * j)); yb2[q][j] = __builtin_nontemporal_load((const u32x2*)(yr + (size_t)MTOT * D + 4 * lane + 256 * j)); } } }
    f32x4 wpr[4], s1v[NR][4], s0v[NR][4], ppv[NR][4];
    if (op.has_xn) {
#pragma unroll
        for (int j = 0; j < 4; ++j) wpr[j] = *(const f32x4*)(op.npre + 4 * lane + 256 * j);
#pragma unroll
        for (int q = 0; q < NR; ++q) { const float* sh = op.md_base + (size_t)cv[q] * 9216 + (size_t)op.si * D; const float* sc = sh + D;
            const float* pos = (const float*)(a.ws + WS_POS); const int t = rs[q] & 4095;
#pragma unroll
            for (int j = 0; j < 4; ++j) { const int c = 4 * lane + 256 * j; s1v[q][j] = *(const f32x4*)(sc + c); s0v[q][j] = *(const f32x4*)(sh + c);
                if (op.add_pos && lat[q]) ppv[q][j] = *(const f32x4*)((c < 512) ? pos + (size_t)(t >> 6) * 512 + c : pos + (size_t)(t & 63) * 512 + (c - 512)); } } }
#pragma unroll
    for (int q = 0; q < NR; ++q) { const int r = rs[q];
        if (op.has_y) {
            f32x4 y[4]; float ss = 0.f;
#pragma unroll
            for (int j = 0; j < 4; ++j) { y[j] = (f32x4){bflo(yb[q][j].x) + bflo(yb2[q][j].x), bfhi(yb[q][j].x) + bfhi(yb2[q][j].x), bflo(yb[q][j].y) + bflo(yb2[q][j].y), bfhi(yb[q][j].y) + bfhi(yb2[q][j].y)}; ss += (y[j].x * y[j].x + y[j].y * y[j].y) + (y[j].z * y[j].z + y[j].w * y[j].w); }
            const float rr = rsqrtf(wave_sum(ss) * (1.f / D) + EPSN) * op.coef;
            const float* gp = op.mdg_base + (size_t)cv[q] * 9216;
#pragma unroll
            for (int j = 0; j < 4; ++j) { const f32x4 w = *(const f32x4*)(op.npost + 4 * lane + 256 * j), gg = *(const f32x4*)(gp + 4 * lane + 256 * j);
                v[q][j] = v[q][j] + gg * (y[j] * rr) * w; __builtin_nontemporal_store(v[q][j], (f32x4*)(xd[q] + 4 * lane + 256 * j)); }
        }
        if (op.has_xn) {
            float ss = 0.f;
#pragma unroll
            for (int j = 0; j < 4; ++j) ss += (v[q][j].x * v[q][j].x + v[q][j].y * v[q][j].y) + (v[q][j].z * v[q][j].z + v[q][j].w * v[q][j].w);
            const float rr = rsqrtf(wave_sum(ss) * (1.f / D) + EPSN);
            bf16_t* xo = (bf16_t*)(a.ws + WS_XN) + (size_t)r * D;
#pragma unroll
            for (int j = 0; j < 4; ++j) { const int c = 4 * lane + 256 * j;
                f32x4 o = (v[q][j] * rr) * wpr[j] * (s1v[q][j] + 1.0f) + s0v[q][j];
                if (op.add_pos && lat[q]) o = o + ppv[q][j];
                u32x2 pk; pk.x = pk2(o.x, o.y); pk.y = pk2(o.z, o.w); *(u32x2*)(xo + c) = pk; }
        }
    }
}
__device__ __forceinline__ void rowwise_all(const Args& a, const RowOp& op, int gw, int NGW, int lane) {
    int r = gw;
    for (; r + NGW < MTOT; r += 2 * NGW) { const int rs[2] = {r, r + NGW}; rowwise<2>(a, op, rs, lane); }
    if (r < MTOT) { const int rs[1] = {r}; rowwise<1>(a, op, rs, lane); }
}

constexpr int C_MQ = 0, C_MK = 256, C_MV = 512, C_MO = 1024, C_MIF = 1536, C_GQ = 1552, C_GK = 1808, C_GV = 2064, C_GR = 2576, C_GLR = 3088, C_HQ = 3120, C_HF = 3376, C_HV = 3888, C_HG = 4400;

struct ItemInfo { int br, dir, head, seq, c, T, NC; };
__device__ __forceinline__ ItemInfo item_info(int g, int it) { ItemInfo I; const int hdb = it % 24, cgl = it / 24; I.br = hdb >> 3; I.dir = (hdb >> 2) & 1; I.head = hdb & 3;
    I.T = g < 2 ? 4096 : 256; I.NC = I.T >> 6; I.seq = cgl / I.NC; I.c = cgl % I.NC; return I; }
__device__ __forceinline__ int item_row(const ItemInfo& I, int s) { const int tau = I.c * 64 + s; return I.seq * I.T + (I.dir ? I.T - 1 - tau : tau); }
__device__ __forceinline__ float lb_of(const Args& a, int l, int ch) { if (l == 0) return 0.f; const float g0 = inp(a, I_HGAM)[ch], g1 = inp(a, I_HGAM)[256 + ch]; return 1.0f / (1.0f + expf(g0 - g1)); }

template <bool NEEDQ>
__device__ __forceinline__ void load_gated(const Args& a, const bf16_t* P, const ItemInfo& I, int l, int d, int sg, float (&qv)[8], float (&kv)[8], float (&la)[8]) {
    const int ch = I.head * 64 + d;
    if (I.br == 1) {
        float wup[16];
        const float* wp = inp(a, I_GWUP) + ((size_t)(l * 2 + I.dir) * 16) * 256 + ch;
#pragma unroll
        for (int r = 0; r < 16; ++r) wup[r] = wp[r * 256];
        const float gb = inp(a, I_GLB)[(l * 2 + I.dir) * 256 + ch];
#pragma unroll
        for (int i = 0; i < 8; ++i) { const bf16_t* pr = P + (size_t)item_row(I, 8 * sg + i) * PN;
            const u32x4 g0 = *(const u32x4*)(pr + C_GLR + I.dir * 16), g1 = *(const u32x4*)(pr + C_GLR + I.dir * 16 + 8);
            float z = gb;
            z += bflo(g0.x) * wup[0] + bfhi(g0.x) * wup[1] + bflo(g0.y) * wup[2] + bfhi(g0.y) * wup[3] + bflo(g0.z) * wup[4] + bfhi(g0.z) * wup[5] + bflo(g0.w) * wup[6] + bfhi(g0.w) * wup[7];
            z += bflo(g1.x) * wup[8] + bfhi(g1.x) * wup[9] + bflo(g1.y) * wup[10] + bfhi(g1.y) * wup[11] + bflo(g1.z) * wup[12] + bfhi(g1.z) * wup[13] + bflo(g1.w) * wup[14] + bfhi(g1.w) * wup[15];
            la[i] = logsigf_(z) * (1.0f / 16.0f);
            if (NEEDQ) qv[i] = bf2f(pr[C_GQ + ch]) * 0.125f; kv[i] = bf2f(pr[C_GK + ch]); }
    } else {
        const float lb = lb_of(a, l, ch);
#pragma unroll
        for (int i = 0; i < 8; ++i) { const bf16_t* pr = P + (size_t)item_row(I, 8 * sg + i) * PN;
            const float z = bf2f(pr[C_HF + I.dir * 256 + ch]); const float sg_ = sigmoidf_(z);
            la[i] = (lb == 0.f) ? logsigf_(z) : __logf(lb + (1.0f - lb) * sg_);
            if (NEEDQ) qv[i] = bf2f(pr[C_HQ + ch]) * 1.0f;
            kv[i] = (1.0f - lb) * (1.0f - sg_); }
    }
}
template <bool NEEDQ>
__device__ __forceinline__ void load_mlstm(const Args& a, const bf16_t* P, const ItemInfo& I, int l, int d, int sg, float (&qv)[8], float (&kv)[8], float (&lf)[8], float (&li)[8]) {
    const float bi = inp(a, I_GB)[((l * 2 + I.dir) * 2 + 0) * 4 + I.head], bf_ = inp(a, I_GB)[((l * 2 + I.dir) * 2 + 1) * 4 + I.head];
#pragma unroll
    for (int i = 0; i < 8; ++i) { const bf16_t* pr = P + (size_t)item_row(I, 8 * sg + i) * PN;
        li[i] = bf2f(pr[C_MIF + I.dir * 8 + I.head]) + bi; lf[i] = logsigf_(bf2f(pr[C_MIF + I.dir * 8 + 4 + I.head]) + bf_);
        if (NEEDQ) qv[i] = bf2f(pr[C_MQ + I.head * 64 + d]) * 0.125f; kv[i] = bf2f(pr[C_MK + I.head * 64 + d]); }
}
__device__ __forceinline__ bf16x8 ldfrag(const LAS bf16_t* T, int pitch, int row0, int k0, int lane) { return *(const LAS bf16x8*)(T + (row0 + (lane & 15)) * pitch + k0 + 8 * (lane >> 4)); }

struct Raw { bf16_t q[8], k[8], z[8]; unsigned g0, g1; float wup[16]; float p0, p1, nc, mc; u32x4 s0, s1; };
template <bool NEEDQ, bool NEEDS>
__device__ __forceinline__ void raw_load(const Args& a, const bf16_t* P, const ItemInfo& I, int l, int it, int tid, Raw& R) {
    const int d = tid & 63, lane = d, sg = __builtin_amdgcn_readfirstlane(tid >> 6), ch = I.head * 64 + d;
    const int qc = I.br == 0 ? C_MQ : (I.br == 1 ? C_GQ : C_HQ), kc = I.br == 0 ? C_MK : (I.br == 1 ? C_GK : C_HF + I.dir * 256);
#pragma unroll
    for (int i = 0; i < 8; ++i) { const bf16_t* pr = P + (size_t)item_row(I, 8 * sg + i) * PN;
        if (NEEDQ) R.q[i] = pr[qc + ch];
        R.k[i] = pr[kc + ch]; }
    if (I.br == 1) {
        R.g0 = P[(size_t)item_row(I, 8 * sg + (lane >> 4)) * PN + C_GLR + I.dir * 16 + (lane & 15)];
        R.g1 = P[(size_t)item_row(I, 8 * sg + 4 + (lane >> 4)) * PN + C_GLR + I.dir * 16 + (lane & 15)];
        const float* wp = inp(a, I_GWUP) + ((size_t)(l * 2 + I.dir) * 16) * 256 + ch;
#pragma unroll
        for (int r = 0; r < 16; ++r) R.wup[r] = wp[r * 256];
        R.p0 = inp(a, I_GLB)[(l * 2 + I.dir) * 256 + ch];
    } else if (I.br == 0) {
        R.g0 = P[(size_t)item_row(I, 8 * sg + (lane & 7)) * PN + C_MIF + I.dir * 8 + ((lane >> 3) & 1) * 4 + I.head];
        R.p0 = inp(a, I_GB)[((l * 2 + I.dir) * 2 + 0) * 4 + I.head]; R.p1 = inp(a, I_GB)[((l * 2 + I.dir) * 2 + 1) * 4 + I.head];
    } else R.p0 = lb_of(a, l, ch);
    if (NEEDS) { const bf16_t* US = (const bf16_t*)(a.ws + WS_BIG + BIG_US) + (size_t)it * 8192; const int e = tid >> 2, part = tid & 3;
        R.s0 = *(const u32x4*)(US + e * 64 + 16 * part); R.s1 = *(const u32x4*)(US + e * 64 + 16 * part + 8);
        if (I.br == 0) { R.nc = ((const float*)(a.ws + WS_DEC))[(size_t)it * 64 + d]; R.mc = ((const float*)(a.ws + WS_SC))[(size_t)it * 4 + 2]; } }
}
__device__ __forceinline__ float rl_bf(unsigned v, int ln) { return __uint_as_float(((unsigned)__builtin_amdgcn_readlane((int)v, ln)) << 16); }
template <bool NEEDQ>
__device__ __forceinline__ void gated_from_raw(const Raw& R, const ItemInfo& I, float (&qv)[8], float (&kv)[8], float (&la)[8]) {
    if (I.br == 1) {
#pragma unroll
        for (int i = 0; i < 8; ++i) { float z = R.p0; const unsigned src = i < 4 ? R.g0 : R.g1;
#pragma unroll
            for (int r = 0; r < 16; ++r) z += rl_bf(src, (i & 3) * 16 + r) * R.wup[r];
            la[i] = logsigf_(z) * (1.0f / 16.0f);
            if (NEEDQ) qv[i] = bf2f(R.q[i]) * 0.125f; kv[i] = bf2f(R.k[i]); }
    } else { const float lb = R.p0;
#pragma unroll
        for (int i = 0; i < 8; ++i) { const float z = bf2f(R.k[i]); const float sg_ = sigmoidf_(z);
            la[i] = (lb == 0.f) ? logsigf_(z) : __logf(lb + (1.0f - lb) * sg_);
            if (NEEDQ) qv[i] = bf2f(R.q[i]) * 1.0f;
            kv[i] = (1.0f - lb) * (1.0f - sg_); }
    }
}
template <bool NEEDQ>
__device__ __forceinline__ void mlstm_from_raw(const Raw& R, float (&qv)[8], float (&kv)[8], float (&lf)[8], float (&li)[8]) {
#pragma unroll
    for (int i = 0; i < 8; ++i) { li[i] = rl_bf(R.g0, i) + R.p0; lf[i] = logsigf_(rl_bf(R.g0, 8 + i) + R.p1);
        if (NEEDQ) qv[i] = bf2f(R.q[i]) * 0.125f; kv[i] = bf2f(R.k[i]); }
}
template <int SK>
__device__ __forceinline__ bf16x8 ldfragY(const LAS bf16_t* T, int pitch, int row0, int k0, int lane) { return *(const LAS bf16x8*)(T + (row0 + (lane & 15)) * pitch + (row0 >> 4) * SK + k0 + 8 * (lane >> 4)); }
__device__ __forceinline__ void v_load(const bf16_t* P, const ItemInfo& I, int tid, u32x4& v0, u32x4& v1) {
    const int s = tid >> 3, eg = tid & 7; const int vb = I.br == 0 ? C_MV : (I.br == 1 ? C_GV : C_HV);
    const bf16_t* pv = P + (size_t)item_row(I, s) * PN + vb + I.head * 128 + 16 * eg; v0 = *(const u32x4*)pv; v1 = *(const u32x4*)(pv + 8);
}
template <int SK>
__device__ __forceinline__ void v_store(int br, LAS bf16_t* Y, int pitch, int tid, const u32x4& v0, const u32x4& v1) {
    const int s = tid >> 3, eg = tid & 7; const unsigned wds[8] = {v0.x, v0.y, v0.z, v0.w, v1.x, v1.y, v1.z, v1.w};
#pragma unroll
    for (int i = 0; i < 8; ++i) { float x0 = bflo(wds[i]), x1 = bfhi(wds[i]); if (br == 2) { x0 = siluf_(x0); x1 = siluf_(x1); }
        Y[(16 * eg + 2 * i) * pitch + SK * eg + s] = (bf16_t)f2bf(x0); Y[(16 * eg + 2 * i + 1) * pitch + SK * eg + s] = (bf16_t)f2bf(x1); }
}

__device__ __forceinline__ void scan_s1(const Args& a, LAS unsigned char* lds, int l, int g, int it, const Raw& R, const u32x4& pv0, const u32x4& pv1) {
    int tid_ = threadIdx.x; asm volatile("" : "+v"(tid_)); const int tid = tid_, d = tid & 63, lane = d, sg = __builtin_amdgcn_readfirstlane(tid >> 6);
    const ItemInfo I = item_info(g, it);
    const bf16_t* P = (const bf16_t*)(a.ws + WS_BIG);
    bf16_t* US = (bf16_t*)(a.ws + WS_BIG + BIG_US) + (size_t)it * 8192;
    float* DEC = (float*)(a.ws + WS_DEC) + (size_t)it * 64; float* SC = (float*)(a.ws + WS_SC) + (size_t)it * 4;
    LAS bf16_t* XT = (LAS bf16_t*)lds;
    LAS bf16_t* YV = (LAS bf16_t*)(lds + 9216);
    LAS float* TOT = (LAS float*)(lds + 9216 + 20736 + 256);
    LAS float* TMX = TOT + 512;
    float qv[8], kv[8], x0[8], x1[8];
    if (I.br == 0) {
        mlstm_from_raw<false>(R, qv, kv, x0, x1);
        float run = 0.f;
#pragma unroll
        for (int i = 0; i < 8; ++i) { run += x0[i]; x0[i] = run; }
        TOT[sg * 64 + d] = run; LDS_WAIT(); __syncthreads();
        float pre = 0.f, tot = 0.f;
#pragma unroll
        for (int w = 0; w < 8; ++w) { const float t = TOT[w * 64 + d]; if (w < sg) pre += t; tot += t; }
        float mx = -3.0e38f;
#pragma unroll
        for (int i = 0; i < 8; ++i) { x0[i] = tot - (pre + x0[i]) + x1[i]; mx = fmaxf(mx, x0[i]); }
        TMX[sg * 64 + d] = mx; LDS_WAIT(); __syncthreads();
        float mlw = -3.0e38f;
#pragma unroll
        for (int w = 0; w < 8; ++w) mlw = fmaxf(mlw, TMX[w * 64 + d]);
#pragma unroll
        for (int i = 0; i < 8; ++i) kv[i] *= __expf(x0[i] - mlw);
        if (tid == 0) { SC[0] = mlw; SC[1] = tot; }
        for (int idx = tid; idx < 16 * 64; idx += 512) YV[(128 + (idx >> 6)) * 72 + 64 + (idx & 63)] = (bf16_t)((idx >> 6) == 0 ? 0x3F80 : 0);
    } else {
        gated_from_raw<false>(R, I, qv, kv, x0);
        float run = 0.f;
#pragma unroll
        for (int i = 0; i < 8; ++i) { run += x0[i]; x0[i] = run; }
        TOT[sg * 64 + d] = run; LDS_WAIT(); __syncthreads();
        float pre = 0.f, tot = 0.f;
#pragma unroll
        for (int w = 0; w < 8; ++w) { const float t = TOT[w * 64 + d]; if (w < sg) pre += t; tot += t; }
#pragma unroll
        for (int i = 0; i < 8; ++i) kv[i] *= __expf(tot - (pre + x0[i]));
        if (sg == 0) DEC[d] = __expf(tot);
    }
    { u32x4 w; w.x = pk2(kv[0], kv[1]); w.y = pk2(kv[2], kv[3]); w.z = pk2(kv[4], kv[5]); w.w = pk2(kv[6], kv[7]); *(LAS u32x4*)(XT + d * 72 + 8 * sg) = w; }
    v_store<8>(I.br, YV, 72, tid, pv0, pv1);
    LDS_WAIT(); __syncthreads();
    f32x4 acc[4];
#pragma unroll
    for (int mt = 0; mt < 4; ++mt) acc[mt] = (f32x4){0.f, 0.f, 0.f, 0.f};
#pragma unroll
    for (int ks = 0; ks < 2; ++ks) { const bf16x8 b = ldfragY<8>(YV, 72, 16 * sg, 32 * ks, lane);
#pragma unroll
        for (int mt = 0; mt < 4; ++mt) acc[mt] = __builtin_amdgcn_mfma_f32_16x16x32_bf16(ldfrag(XT, 72, 16 * mt, 32 * ks, lane), b, acc[mt], 0, 0, 0); }
    { const int e = 16 * sg + (lane & 15);
#pragma unroll
      for (int mt = 0; mt < 4; ++mt) { u32x2 o; o.x = pk2(acc[mt][0], acc[mt][1]); o.y = pk2(acc[mt][2], acc[mt][3]); *(u32x2*)(US + e * 64 + 16 * mt + 4 * (lane >> 4)) = o; } }
    if (I.br == 0 && sg < 4) {
        f32x4 an = (f32x4){0.f, 0.f, 0.f, 0.f};
#pragma unroll
        for (int ks = 0; ks < 2; ++ks) an = __builtin_amdgcn_mfma_f32_16x16x32_bf16(ldfrag(XT, 72, 16 * sg, 32 * ks, lane), ldfragY<8>(YV, 72, 128, 32 * ks, lane), an, 0, 0, 0);
        if ((lane & 15) == 0) { const int d0 = 16 * sg + 4 * (lane >> 4); DEC[d0] = an[0]; DEC[d0 + 1] = an[1]; DEC[d0 + 2] = an[2]; DEC[d0 + 3] = an[3]; }
    }
    __syncthreads();
}

template <int S2B>
__device__ __forceinline__ void scan_s2(const Args& a, int l, int g) {
    const int T = g < 2 ? 4096 : 256, NC = T >> 6, nseq = g < 2 ? 2 : 32, nslot = nseq * 24 * 1024;
    bf16_t* USb = (bf16_t*)(a.ws + WS_BIG + BIG_US); float* DECb = (float*)(a.ws + WS_DEC); float* SCb = (float*)(a.ws + WS_SC);
    int tid_ = threadIdx.x; asm volatile("" : "+v"(tid_));
    for (int slot = blockIdx.x * 512 + tid_; slot < nslot; slot += gridDim.x * 512) {
        const int sub = slot & 1023, stream = slot >> 10, hdb = stream % 24, seq = stream / 24, br = hdb >> 3, dir = (hdb >> 2) & 1, head = hdb & 3;
        const int e = sub >> 3, d0 = (sub & 7) * 8;
        float S[8], nst[8], mst = 0.f;
#pragma unroll
        for (int i = 0; i < 8; ++i) { S[i] = 0.f; nst[i] = 0.f; }
        if (g < 2) { const int b = g * 2 + seq; const size_t sidx = (size_t)((b * 2 + l) * 2 + dir) * 4 + head;
            const float* sp = (br == 0 ? inp(a, I_SC) : (br == 1 ? inp(a, I_SG) : inp(a, I_SH))) + sidx * 8192;
#pragma unroll
            for (int i = 0; i < 8; ++i) S[i] = sp[(d0 + i) * 128 + e];
            if (br == 0) { mst = inp(a, I_SM)[sidx];
#pragma unroll
                for (int i = 0; i < 8; ++i) nst[i] = inp(a, I_SN)[sidx * 64 + d0 + i]; } }
        const bool nrow = (br == 0) && (e == 0);
        for (int c0 = 0; c0 < NC; c0 += S2B) {
            u32x4 ub[S2B]; f32x4 q0[S2B], q1[S2B]; float m0[S2B], m1[S2B];
#pragma unroll
            for (int j = 0; j < S2B; ++j) { const size_t it = (size_t)(seq * NC + c0 + j) * 24 + hdb;
                ub[j] = *(const u32x4*)(USb + it * 8192 + e * 64 + d0);
                if (br == 0) { m0[j] = SCb[it * 4]; m1[j] = SCb[it * 4 + 1]; }
                if (br != 0 || nrow) { q0[j] = *(const f32x4*)(DECb + it * 64 + d0); q1[j] = *(const f32x4*)(DECb + it * 64 + d0 + 4); } }
#pragma unroll
            for (int j = 0; j < S2B; ++j) { const size_t it = (size_t)(seq * NC + c0 + j) * 24 + hdb;
                bf16_t* p = USb + it * 8192 + e * 64 + d0; float* dec = DECb + it * 64 + d0; float* sc = SCb + it * 4;
                const u32x4 u = ub[j];
                const float uu[8] = {bflo(u.x), bfhi(u.x), bflo(u.y), bfhi(u.y), bflo(u.z), bfhi(u.z), bflo(u.w), bfhi(u.w)};
                { u32x4 w; w.x = pk2(S[0], S[1]); w.y = pk2(S[2], S[3]); w.z = pk2(S[4], S[5]); w.w = pk2(S[6], S[7]); *(u32x4*)p = w; }
                if (br == 0) {
                    const float mlw = m0[j], bl = m1[j]; const float mn = fmaxf(bl + mst, mlw); const float fa = __expf(bl + mst - mn), fb = __expf(mlw - mn);
                    if (nrow) { const f32x4 n0 = q0[j], n1 = q1[j];
                        *(f32x4*)dec = (f32x4){nst[0], nst[1], nst[2], nst[3]}; *(f32x4*)(dec + 4) = (f32x4){nst[4], nst[5], nst[6], nst[7]};
                        const float nn[8] = {n0.x, n0.y, n0.z, n0.w, n1.x, n1.y, n1.z, n1.w};
#pragma unroll
                        for (int i = 0; i < 8; ++i) nst[i] = fa * nst[i] + fb * nn[i];
                        if (d0 == 0) sc[2] = mst; }
#pragma unroll
                    for (int i = 0; i < 8; ++i) S[i] = fa * S[i] + fb * uu[i];
                    mst = mn;
                } else {
                    const f32x4 a0 = q0[j], a1 = q1[j]; const float dd[8] = {a0.x, a0.y, a0.z, a0.w, a1.x, a1.y, a1.z, a1.w};
#pragma unroll
                    for (int i = 0; i < 8; ++i) S[i] = dd[i] * S[i] + uu[i];
                }
            }
        }
        if (g == 2) { const size_t sidx = (size_t)((seq * 2 + l) * 2 + dir) * 4 + head;
            float* op = a.out + (br == 0 ? OFF_C : (br == 1 ? OFF_G : OFF_H)) + sidx * 8192;
#pragma unroll
            for (int i = 0; i < 8; ++i) op[(d0 + i) * 128 + e] = S[i];
            if (nrow) {
#pragma unroll
                for (int i = 0; i < 8; ++i) a.out[OFF_N + sidx * 64 + d0 + i] = nst[i];
                if (d0 == 0) a.out[OFF_M + sidx] = mst; } }
    }
}

constexpr int S3_QO = 0, S3_KO = 23040, S3_G = 41472, S3_XA = 57856, S3_YV = 75264, S3_TOT = 114432 + 256, S3_VEC = 116480 + 256;
__device__ __forceinline__ void scan_s3(const Args& a, LAS unsigned char* lds, int l, int g, int it2, int it2n, Raw& Rc, u32x4& pv0, u32x4& pv1) {
    int tid_ = threadIdx.x; asm volatile("" : "+v"(tid_)); const int tid = tid_, d = tid & 63, lane = d, sg = __builtin_amdgcn_readfirstlane(tid >> 6);
    const int hb = it2 % 12, cgl = it2 / 12; ItemInfo I; I.br = hb >> 2; I.head = hb & 3; I.T = g < 2 ? 4096 : 256; I.NC = I.T >> 6; I.seq = cgl / I.NC; const int cn = cgl % I.NC; I.dir = 0; I.c = cn;
    const bf16_t* P = (const bf16_t*)(a.ws + WS_BIG);
    LAS bf16_t* QO = (LAS bf16_t*)(lds + S3_QO); LAS bf16_t* KO = (LAS bf16_t*)(lds + S3_KO); LAS float* G = (LAS float*)(lds + S3_G);
    LAS bf16_t* XA = (LAS bf16_t*)(lds + S3_XA); LAS bf16_t* YV = (LAS bf16_t*)(lds + S3_YV); LAS float* TOT = (LAS float*)(lds + S3_TOT);
    LAS float* Bv = (LAS float*)(lds + S3_VEC); LAS float* LIv = Bv + 64; LAS float* MT = Bv + 128; LAS float* EI = Bv + 192;
    v_store<8>(I.br, YV, 136, tid, pv0, pv1);
    ItemInfo In; { const int hbn = it2n % 12, cgn = it2n / 12; In.br = hbn >> 2; In.head = hbn & 3; In.T = I.T; In.NC = I.NC; In.seq = cgn / I.NC; In.c = cgn % I.NC; In.dir = 0; }
    v_load(P, In, tid, pv0, pv1);
    f32x4 osum[4];
#pragma unroll
    for (int nt = 0; nt < 4; ++nt) osum[nt] = (f32x4){0.f, 0.f, 0.f, 0.f};
    const int e0 = 16 * sg + 4 * (lane >> 4); const int gcol = (I.br == 0 ? C_MO : (I.br == 1 ? C_GR : C_HG)) + I.head * 128 + e0;
    u32x2 gts[4];
#pragma unroll
    for (int nt = 0; nt < 4; ++nt) gts[nt] = *(const u32x2*)(P + (size_t)(I.seq * I.T + 64 * cn + 16 * nt + (lane & 15)) * PN + gcol);
    const f32x4 hw = *(const f32x4*)(inp(a, I_HN) + (size_t)(l * 3 + I.br) * 512 + I.head * 128 + e0);
  for (int dir = 0; dir < 2; ++dir) {
    I.dir = dir; I.c = dir ? I.NC - 1 - cn : cn;
    const int it = (I.seq * I.NC + I.c) * 24 + I.br * 8 + dir * 4 + I.head;
#define RV(x) (dir ? 63 - (x) : (x))
    float qv[8], kv[8], x0[8], x1[8];
    const Raw R = Rc;
    { const int e = tid >> 2, part = tid & 3; *(LAS u32x4*)(YV + e * 136 + (e >> 4) * 8 + 64 + 16 * part) = R.s0; *(LAS u32x4*)(YV + e * 136 + (e >> 4) * 8 + 64 + 16 * part + 8) = R.s1; }
    { ItemInfo It = dir ? In : I; if (!dir) { It.dir = 1; It.c = I.NC - 1 - cn; }
      const int itt = (It.seq * It.NC + It.c) * 24 + It.br * 8 + It.dir * 4 + It.head;
      raw_load<true, true>(a, P, It, l, itt, tid, Rc); }
    const int bi = sg >> 1;
    f32x4 acc[4];
#pragma unroll
    for (int nt = 0; nt < 4; ++nt) acc[nt] = (f32x4){0.f, 0.f, 0.f, 0.f};
    if (I.br != 0) {
        gated_from_raw<true>(R, I, qv, kv, x0);
        float run = 0.f;
#pragma unroll
        for (int i = 0; i < 8; ++i) { run += x0[i]; x0[i] = run; }
        TOT[sg * 64 + d] = run; LDS_WAIT(); __syncthreads();
        float pre = 0.f, gs = 0.f, geo = 0.f, gej[3] = {0.f, 0.f, 0.f};
#pragma unroll
        for (int w = 0; w < 8; ++w) { const float t = TOT[w * 64 + d]; if (w < sg) pre += t; if (w < 2 * bi) gs += t; if (w < 2 * bi + 2) geo += t;
            if (w < 2) gej[0] += t; if (w < 4) gej[1] += t; if (w < 6) gej[2] += t; }
#pragma unroll
        for (int i = 0; i < 8; ++i) { x0[i] += pre; const int s = 8 * sg + i; XA[RV(s) * 136 + 64 + d] = (bf16_t)f2bf(qv[i] * __expf(x0[i])); }
        float dfac[2];
#pragma unroll
        for (int j = 0; j < 2; ++j) dfac[j] = __expf(fminf(gs - gej[j], 0.f));
#pragma unroll
        for (int i = 0; i < 8; ++i) { const int tt = 8 * (sg & 1) + i;
            QO[(6 + bi) * 1152 + tt * 72 + d] = (bf16_t)f2bf(qv[i] * __expf(x0[i] - gs));
            KO[(4 + bi) * 1152 + tt * 72 + d] = (bf16_t)f2bf(kv[i] * __expf(fminf(gs - x0[i], 80.f)));
            if (bi < 3) KO[bi * 1152 + tt * 72 + d] = (bf16_t)f2bf(kv[i] * __expf(geo - x0[i]));
            const float qd = qv[i] * __expf(x0[i] - gs);
#pragma unroll
            for (int j = 0; j < 2; ++j) if (j + 1 < bi) QO[(bi * (bi - 1) / 2 + j) * 1152 + tt * 72 + d] = (bf16_t)f2bf(qd * dfac[j]); }
        LDS_WAIT(); __syncthreads();
#pragma unroll
        for (int jj = 0; jj < 2; ++jj) { const int j = 2 * (sg & 1) + jj; f32x4 t = (f32x4){0.f, 0.f, 0.f, 0.f};
            if (j <= bi) { const int qt = (j + 1 >= bi) ? 6 + bi : bi * (bi - 1) / 2 + j, kt = (j == bi) ? 4 + bi : j;
#pragma unroll
                for (int ks = 0; ks < 2; ++ks) t = __builtin_amdgcn_mfma_f32_16x16x32_bf16(ldfrag(QO + qt * 1152, 72, 0, 32 * ks, lane), ldfrag(KO + kt * 1152, 72, 0, 32 * ks, lane), t, 0, 0, 0); }
#pragma unroll
            for (int r = 0; r < 4; ++r) { const int tl = 4 * (lane >> 4) + r, sl = lane & 15; float v = t[r]; if (j == bi && sl > tl) v = 0.f;
                XA[RV(16 * bi + tl) * 136 + RV(16 * j + sl)] = (bf16_t)f2bf(v); } }
        LDS_WAIT(); __syncthreads();
    } else {
        mlstm_from_raw<true>(R, qv, kv, x0, x1);
        float run = 0.f;
#pragma unroll
        for (int i = 0; i < 8; ++i) { run += x0[i]; x0[i] = run; }
        TOT[sg * 64 + d] = run;
        for (int idx = tid; idx < 16 * 128; idx += 512) { const int r = idx >> 7, k = idx & 127; YV[(128 + r) * 136 + 64 + k] = (bf16_t)(r == 0 ? (k < 64 ? 0x3F80u : 0u) : 0u); }
        LDS_WAIT(); __syncthreads();
        float pre = 0.f;
#pragma unroll
        for (int w = 0; w < 8; ++w) { const float t = TOT[w * 64 + d]; if (w < sg) pre += t; }
#pragma unroll
        for (int i = 0; i < 8; ++i) { x0[i] += pre; const int s = 8 * sg + i; if (d == 0) { Bv[s] = x0[i]; LIv[s] = x1[i]; }
            if (i == 0 && sg == 1) YV[128 * 136 + 64 + 64 + d] = (bf16_t)f2bf(R.nc);
            QO[s * 72 + d] = (bf16_t)f2bf(qv[i]); KO[s * 72 + d] = (bf16_t)f2bf(kv[i]); }
        LDS_WAIT(); __syncthreads();
        if (tid < 64) { float rn = LIv[tid] - Bv[tid];
#pragma unroll
            for (int off = 1; off < 64; off <<= 1) { const float u = __shfl_up(rn, off); if (tid >= off) rn = fmaxf(rn, u); }
            const float bt = Bv[tid], inter = bt + R.mc, mt = fmaxf(inter, bt + rn); MT[RV(tid)] = mt; EI[RV(tid)] = __expf(inter - mt); }
        f32x4 t2[2];
#pragma unroll
        for (int jj = 0; jj < 2; ++jj) { const int j = 2 * (sg & 1) + jj; t2[jj] = (f32x4){0.f, 0.f, 0.f, 0.f};
            if (j <= bi) {
#pragma unroll
                for (int ks = 0; ks < 2; ++ks) t2[jj] = __builtin_amdgcn_mfma_f32_16x16x32_bf16(ldfrag(QO, 72, 16 * bi, 32 * ks, lane), ldfrag(KO, 72, 16 * j, 32 * ks, lane), t2[jj], 0, 0, 0); } }
        LDS_WAIT(); __syncthreads();
#pragma unroll
        for (int jj = 0; jj < 2; ++jj) { const int j = 2 * (sg & 1) + jj;
#pragma unroll
            for (int r = 0; r < 4; ++r) { const int t = 16 * bi + 4 * (lane >> 4) + r, s = 16 * j + (lane & 15); float v = 0.f;
                if (s <= t) v = t2[jj][r] * __expf(Bv[t] - Bv[s] + LIv[s] - MT[RV(t)]);
                XA[RV(t) * 136 + RV(s)] = (bf16_t)f2bf(v); } }
#pragma unroll
        for (int i = 0; i < 8; ++i) { const int s = 8 * sg + i; XA[RV(s) * 136 + 64 + d] = (bf16_t)f2bf(qv[i] * EI[RV(s)]); }
        LDS_WAIT(); __syncthreads();
    }
    f32x4 accd[4];
#pragma unroll
    for (int nt = 0; nt < 4; ++nt) accd[nt] = (f32x4){0.f, 0.f, 0.f, 0.f};
#pragma unroll
    for (int ks = 0; ks < 4; ++ks) { const bf16x8 av = ldfragY<8>(YV, 136, 16 * sg, 32 * ks, lane);
        bf16x8 ad = av; if (I.br == 0) ad = ldfragY<8>(YV, 136, 128, 32 * ks, lane);
#pragma unroll
        for (int nt = 0; nt < 4; ++nt) { const bf16x8 bx = ldfrag(XA, 136, 16 * nt, 32 * ks, lane);
            acc[nt] = __builtin_amdgcn_mfma_f32_16x16x32_bf16(av, bx, acc[nt], 0, 0, 0);
            if (I.br == 0) accd[nt] = __builtin_amdgcn_mfma_f32_16x16x32_bf16(ad, bx, accd[nt], 0, 0, 0); } }
#pragma unroll
    for (int nt = 0; nt < 4; ++nt) { const int t = 16 * nt + (lane & 15); f32x4 o = acc[nt];
        if (I.br == 0) { const float den = __shfl(accd[nt][0], lane & 15); const float dn = fmaxf(fabsf(den), __expf(-MT[t])); o = o * __builtin_amdgcn_rcpf(dn); }
        osum[nt] = osum[nt] + o; }
    __syncthreads();
#undef RV
  }
    LAS float* RED = TOT;
#pragma unroll
    for (int nt = 0; nt < 4; ++nt) { float ss = (osum[nt][0] * osum[nt][0] + osum[nt][1] * osum[nt][1]) + (osum[nt][2] * osum[nt][2] + osum[nt][3] * osum[nt][3]);
        ss += __shfl_xor(ss, 16); ss += __shfl_xor(ss, 32);
        if (lane < 16) RED[sg * 64 + 16 * nt + lane] = ss; }
    LDS_WAIT(); __syncthreads();
    bf16_t* YSo = (bf16_t*)(a.ws + WS_A) + (size_t)g * GROWS * 1536;
#pragma unroll
    for (int nt = 0; nt < 4; ++nt) { const int t = 16 * nt + (lane & 15); float tot = 0.f;
#pragma unroll
        for (int w = 0; w < 8; ++w) tot += RED[w * 64 + t];
        const float rr = rsqrtf(tot * (1.0f / 128.0f) + EPSN);
        const int lr = I.seq * I.T + 64 * cn + t;
        const u32x2 gt = gts[nt];
        const float gv[4] = {bflo(gt.x), bfhi(gt.x), bflo(gt.y), bfhi(gt.y)}; float y[4];
#pragma unroll
        for (int r = 0; r < 4; ++r) { const float gg = I.br == 0 ? sigmoidf_(gv[r]) : siluf_(gv[r]); y[r] = gg * (osum[nt][r] * rr) * hw[r]; }
        u32x2 w; w.x = pk2(y[0], y[1]); w.y = pk2(y[2], y[3]);
        *(u32x2*)(YSo + (size_t)lr * 1536 + I.br * 512 + I.head * 128 + e0) = w; }
    __syncthreads();
}


enum { ST_F1IN = 0, ST_F1OUT = 1, ST_ROWA = 2, ST_G0 = 3, ST_BR = 15, ST_MG = 16, ST_OUT = 17, ST_ROWB = 18, ST_F2IN = 19, ST_F2OUT = 20, ST_ROWC = 21, NST = 22 };
#ifndef REP_S1
#define REP_S1 1
#endif
#ifndef REP_S3
#define REP_S3 1
#endif
#ifndef REP_G
#define REP_G 1
#endif
template <int M_, int N_, int K_, int LDA_, int LDB_, int ADIV, int AMUL, int KS, class Epi>
__device__ __forceinline__ void run_gemm(LAS unsigned char* lds, const bf16_t* A, const bf16_t* Bt, const Epi& E) {
    typedef pg8::GemmT<M_, N_, K_, LDA_, LDB_> GT; GT g{A, Bt}; typedef pg8::StaticOrderT<M_, N_, ADIV, AMUL, KS> SO; SO S; S.init((int)gridDim.x, (int)blockIdx.x);
    pg8::gemm_phase<GT, Epi, SO, true, true>((PG8_LAS unsigned char*)lds, g, S, E);
}

__global__ void __launch_bounds__(512, 2) mk_fwd(Args a) {
    extern __shared__ __attribute__((aligned(16))) unsigned char lds_raw[];
    LAS unsigned char* lds = (LAS unsigned char*)lds_raw;
    cg::grid_group grid = cg::this_grid();
    for (int u = threadIdx.x; u < (LDS_BYTES - 131072) / 4; u += 512) ((LAS unsigned*)(lds + 131072))[u] = 0u;
    __syncthreads();
    (void)xcd_barrier_post((unsigned*)a.ws, (volatile LAS unsigned*)(lds + 131072 + 352));
    const int tid = threadIdx.x, lane = tid & 63, wave = __builtin_amdgcn_readfirstlane(tid >> 6);
    const int G = gridDim.x, gw = blockIdx.x * 8 + wave, NGW = G * 8;
    unsigned char* ws = a.ws;
    float* mod = (float*)(ws + WS_MOD);

#ifndef SKIP_PRO
#ifdef SPIN_MASK
    const unsigned long long pro_t0 = __builtin_amdgcn_s_memrealtime();
#endif
    convert_weights(a, lds, 0, 0, 13728, 1, gw, NGW, lane, wave);
    __syncthreads();
    ada_partial(a, lds, gw, NGW, lane, wave);
    { float* pos = (float*)(ws + WS_POS);
      for (int i = blockIdx.x * 512 + tid; i < 64 * 512; i += G * 512) { const int v = i >> 9, j = i & 511, fi = j & 255;
          const float fr = expf((-9.210340371976184f * (float)fi) / 256.0f); const float ang = (float)v * fr; pos[i] = j < 256 ? sinf(ang) : cosf(ang); } }
    if (a.ws == nullptr) grid.sync();
    xcd_barrier_ni((unsigned*)a.ws, 131072 + 352);
    { const float* modp = (const float*)(ws + WS_MODP);
      for (int i = blockIdx.x * 512 + tid; i < 2 * 5 * 9216; i += G * 512) { const int col = i % 9216, l = i / (5 * 9216); float s = inp(a, I_BADA)[l * 9216 + col];
#pragma unroll
          for (int ks = 0; ks < 8; ++ks) s += modp[(size_t)ks * (2 * 5 * 9216) + i]; mod[i] = s; } }
    xcd_barrier_ni((unsigned*)a.ws, 131072 + 352);
    { RowOp op{}; op.src_input = 1; op.has_y = 0; op.has_xn = 1; op.npre = inp(a, I_NPRE); op.md_base = mod; op.si = 0; op.add_pos = 0;
      rowwise_all(a, op, gw, NGW, lane); }
    xcd_barrier_ni((unsigned*)a.ws, 131072 + 352);
#ifdef SPIN_MASK
    if ((SPIN_MASK >> 10) & 1) { const unsigned long long t1 = __builtin_amdgcn_s_memrealtime(); while (__builtin_amdgcn_s_memrealtime() - t1 < t1 - pro_t0) __builtin_amdgcn_s_sleep(4); }
#endif
#endif

    for (int l = 0; l < 2; ++l) {
        for (int st = 0; st < NST; ++st) {
            int tid = threadIdx.x; asm volatile("" : "+v"(tid));
            const int lane = tid & 63, wave = __builtin_amdgcn_readfirstlane(tid >> 6), gw = blockIdx.x * 8 + wave;
            unsigned char* ws = a.ws; asm volatile("" : "+s"(ws));
            float* mod = (float*)(ws + WS_MOD); const float* modl = mod + (size_t)l * 5 * 9216;
            bf16_t* XN = (bf16_t*)(ws + WS_XN); bf16_t* BIG = (bf16_t*)(ws + WS_BIG); float* Y = (float*)(ws + WS_A); bf16_t* YS = (bf16_t*)(ws + WS_A);
            unsigned char* wb = ws + WS_W; const int G = gridDim.x, NGW = G * 8;
            const int kind = (st == ST_F1IN || st == ST_F2IN) ? 0 : (st == ST_F1OUT || st == ST_OUT || st == ST_F2OUT) ? 1 : (st == ST_ROWA || st == ST_ROWB || st == ST_ROWC) ? 2 : (st == ST_BR) ? 3 : (st == ST_MG) ? 4 : 5 + ((st - ST_G0) % 4);
            const int g = (st >= ST_G0 && st < ST_BR) ? (st - ST_G0) / 4 : 0;
#ifdef SPIN_MASK
            const unsigned long long spin_t0 = __builtin_amdgcn_s_memrealtime();
#endif
            switch (kind) {
            case 0: {
#ifndef SKIP_G0
                const int f = st == ST_F1IN ? 0 : 1; EpiSwiGLU E{BIG, DFF};
                for (int rep = 0; rep < REP_G; ++rep) run_gemm<MTOT, NFF2, D, D, D, 0, 0, 1>(lds, XN, (const bf16_t*)(wb + W_FFIN) + (size_t)f * NFF2 * D, E);
                if (blockIdx.x >= 64) { const int vw = (blockIdx.x - 64) * 8 + wave, vn = (G - 64) * 8;
                    if (l == 0 && st == ST_F2IN) convert_weights(a, lds, 1, 8448, 13728, 1, vw, vn, lane, wave);
                    if (l == 1 && st == ST_F1IN) { convert_weights(a, lds, 1, 2816, 5632, 0, vw, vn, lane, wave); convert_weights(a, lds, 1, 7040, 8448, 0, vw, vn, lane, wave); } }
#endif
                break; }
            case 1: {
#ifndef SKIP_G1
                EpiBf16 E{(bf16_t*)Y, D, 4, (size_t)MTOT * D};
                for (int rep = 0; rep < REP_G; ++rep)
                if (st == ST_OUT) run_gemm<MTOT, 2 * D, 512, 3072, 3072, 4, 512, 2>(lds, BIG, (const bf16_t*)(wb + W_O3), E);
                else run_gemm<MTOT, 2 * D, DFF / 2, DFF, DFF, 4, DFF / 2, 2>(lds, BIG, (const bf16_t*)(wb + W_FFOUT) + (size_t)(st == ST_F1OUT ? 0 : 1) * D * DFF, E);
#endif
                break; }
            case 2: {
#ifndef SKIP_ROW
                RowOp op{}; op.has_y = 1; op.mdg_base = modl + (st == ST_ROWA ? 2 : st == ST_ROWB ? 5 : 8) * D; op.coef = st == ST_ROWB ? 1.0f : 0.5f;
                op.npost = inp(a, I_NPOST) + (size_t)(l * 3 + (st == ST_ROWA ? 0 : st == ST_ROWB ? 1 : 2)) * D; op.src_input = (l == 0 && st == ST_ROWA) ? 1 : 0;
                if (st == ST_ROWA) { op.has_xn = 1; op.npre = inp(a, I_NPRE) + (size_t)(l * 3 + 1) * D; op.md_base = modl; op.si = 3; op.add_pos = 1; }
                else if (st == ST_ROWB) { op.has_xn = 1; op.npre = inp(a, I_NPRE) + (size_t)(l * 3 + 2) * D; op.md_base = modl; op.si = 6; op.add_pos = 0; }
                else { op.has_xn = (l == 0) ? 1 : 0; op.npre = inp(a, I_NPRE) + (size_t)3 * D; op.md_base = mod + (size_t)5 * 9216; op.si = 0; op.add_pos = 0; }
                rowwise_all(a, op, gw, NGW, lane);
#endif
                break; }
            case 3: {
#ifndef SKIP_G3
                EpiBf16 E{BIG, 3072, 0, 0};
                for (int rep = 0; rep < REP_G; ++rep) run_gemm<MTOT, 3072, 512, 1536, 512, 4, 512, 1>(lds, YS, (const bf16_t*)(wb + W_B), E);
#endif
                break; }
            case 4: {
#ifndef SKIP_G4
                EpiGateSum E{BIG, 3072};
                { typedef pg8::GemmT<MTOT, MGN, D, D, D> GT3; GT3 g3{XN, (const bf16_t*)(wb + W_MG)}; pg8::TripleOrder S3{(int)gridDim.x, (int)blockIdx.x};
                  pg8::gemm_phase<GT3, EpiGateSum, pg8::TripleOrder, true, true>((PG8_LAS unsigned char*)lds, g3, S3, E); }
#endif
                break; }
            case 5: {
#ifndef SKIP_G3
                EpiBf16 E{BIG, PN, 0, 0};
                for (int rep = 0; rep < REP_G; ++rep) run_gemm<GROWS, PN, D, D, D, 0, 0, 1>(lds, XN + (size_t)g * GROWS * D, (const bf16_t*)(wb + W_P), E);
                if (l == 0 && blockIdx.x >= 128 && g < 2) { const int vw = (blockIdx.x - 128) * 8 + wave, vn = (G - 128) * 8;
                    if (g == 0) convert_weights(a, lds, 1, 0, 2816, 0, vw, vn, lane, wave); else convert_weights(a, lds, 1, 5632, 7040, 0, vw, vn, lane, wave); }
#endif
                break; }
            case 6: {
#ifndef SKIP_S1
                { const bf16_t* Pp = (const bf16_t*)(ws + WS_BIG); Raw R = {}; u32x4 v0 = {0u, 0u, 0u, 0u}, v1 = v0; int it = blockIdx.x;
                  { const int itc = it < 3072 ? it : 3071; const ItemInfo I0 = item_info(g, itc); raw_load<false, false>(a, Pp, I0, l, itc, tid, R); v_load(Pp, I0, tid, v0, v1); }
                  for (; it < 3072; it += G) { const int itn = it + G < 3072 ? it + G : 3071; Raw Rn = {}; u32x4 vn0, vn1;
                      { const ItemInfo I1 = item_info(g, itn); raw_load<false, false>(a, Pp, I1, l, itn, tid, Rn); v_load(Pp, I1, tid, vn0, vn1); }
                      scan_s1(a, lds, l, g, it, R, v0, v1); R = Rn; v0 = vn0; v1 = vn1; } }
#endif
                break; }
            case 7: {
#ifndef SKIP_S2
                if (g < 2) scan_s2<8>(a, l, g); else scan_s2<4>(a, l, g);
#endif
                break; }
            case 8: {
#ifndef SKIP_S3
                { const bf16_t* Pp = (const bf16_t*)(ws + WS_BIG); Raw R = {}; u32x4 v0 = {0u, 0u, 0u, 0u}, v1 = v0; int it = blockIdx.x;
                  { const int itc = it < 1536 ? it : 1535; const int hb = itc % 12, cgl = itc / 12; ItemInfo I0; I0.br = hb >> 2; I0.head = hb & 3; I0.T = g < 2 ? 4096 : 256; I0.NC = I0.T >> 6; I0.seq = cgl / I0.NC; I0.c = cgl % I0.NC; I0.dir = 0;
                    raw_load<true, true>(a, Pp, I0, l, (I0.seq * I0.NC + I0.c) * 24 + I0.br * 8 + I0.head, tid, R); v_load(Pp, I0, tid, v0, v1); }
                  for (; it < 1536; it += G) { const int itn = it + G < 1536 ? it + G : 1535; scan_s3(a, lds, l, g, it, itn, R, v0, v1); } }
#endif
                break; }
            default: break;
            }
#ifdef SPIN_MASK
            if ((SPIN_MASK >> kind) & 1) { const unsigned long long t1 = __builtin_amdgcn_s_memrealtime(); while (__builtin_amdgcn_s_memrealtime() - t1 < t1 - spin_t0) __builtin_amdgcn_s_sleep(4); }
#endif
#ifdef BAR_PROBE
            if (st != ST_BR) { unsigned long long* la = (unsigned long long*)(a.ws + 8192);
                asm volatile("s_waitcnt vmcnt(0)" ::: "memory"); __syncthreads();
                if (threadIdx.x == 0) __hip_atomic_fetch_max(la, (unsigned long long)__builtin_amdgcn_s_memrealtime(), __ATOMIC_RELAXED, __HIP_MEMORY_SCOPE_AGENT);
                xcd_barrier_ni((unsigned*)a.ws, 131072 + 352);
                const unsigned long long tr = __builtin_amdgcn_s_memrealtime(), tl = __hip_atomic_load(la, __ATOMIC_RELAXED, __HIP_MEMORY_SCOPE_AGENT);
                while (__builtin_amdgcn_s_memrealtime() - tr < tr - tl) __builtin_amdgcn_s_sleep(2);
                __syncthreads(); } else {
#else
            if (true) xcd_barrier_ni((unsigned*)a.ws, 131072 + 352); else {
#endif
            asm volatile("s_waitcnt vmcnt(0)" ::: "memory"); __syncthreads(); }
#ifdef EXTRA_SYNC
            xcd_barrier_ni((unsigned*)a.ws, 131072 + 352);
#endif
        }
    }
}

extern "C" void kernel_launch(void* const* d_in, const int* in_sizes, int n_in, void* d_out, int out_size, void* d_ws, size_t ws_size, hipStream_t stream) {
    static int grid = 0;
    if (grid == 0) {
        if (n_in != 23 || ws_size < WS_END) { fprintf(stderr, "kernel_launch: unexpected n_in %d / ws_size %zu (need %zu)\n", n_in, ws_size, (size_t)WS_END); grid = -1; return; }
        int dev = 0, cus = 0, per_cu = 0;
        hipGetDevice(&dev); hipDeviceGetAttribute(&cus, hipDeviceAttributeMultiprocessorCount, dev);
        hipFuncSetAttribute((const void*)mk_fwd, hipFuncAttributeMaxDynamicSharedMemorySize, LDS_BYTES);
        hipOccupancyMaxActiveBlocksPerMultiprocessor(&per_cu, (const void*)mk_fwd, 512, LDS_BYTES);
        (void)hipGetLastError();
        if (per_cu < 1) per_cu = 1;
        grid = cus;
    }
    if (grid < 0) return;
    if (hipMemsetAsync(d_ws, 0, 16384, stream) != hipSuccess) { fprintf(stderr, "memset failed\n"); return; }
    Args a{};
    for (int i = 0; i < 23; ++i) a.in[i] = (const float*)d_in[i];
    a.out = (float*)d_out; a.ws = (unsigned char*)d_ws;
    void* args[] = {&a};
    hipError_t e = hipLaunchCooperativeKernel((const void*)mk_fwd, dim3(grid), dim3(512), args, LDS_BYTES, stream);
    if (e != hipSuccess) fprintf(stderr, "cooperative launch failed: %s (grid %d)\n", hipGetErrorString(e), grid);
}
```

```cpp
#include <hip/hip_runtime.h>
#include <hip/hip_cooperative_groups.h>
#include <cstdio>
#include <cstdint>
namespace cg = cooperative_groups;

namespace pg8 {
#define PG8_LAS __attribute__((address_space(3)))
typedef unsigned short bf16_t;
typedef short bf16x8 __attribute__((ext_vector_type(8)));
typedef float f32x4 __attribute__((ext_vector_type(4)));
typedef unsigned u32x4 __attribute__((ext_vector_type(4)));
typedef unsigned u32x2 __attribute__((ext_vector_type(2)));
constexpr int BM = 256, BK = 64, HALF = 128, HTB = HALF * BK * 2, STAGE_BYTES = 8 * HTB, NXCD = 8, WGM = 8;

__host__ __device__ __forceinline__ int lds_byte(int r, int c) { const int st = (r >> 4) * 2 + (c >> 5), rr = r & 15, cc = c & 31, ob = rr * 64 + cc * 2; return st * 1024 + (ob ^ (((ob >> 9) & 1) << 5)); }
__host__ __device__ __forceinline__ void stage_rc(int b, int& R, int& C) { const int st = b / 1024, sb = b % 1024, swz = sb ^ (((sb >> 9) & 1) << 5); R = (st >> 1) * 16 + swz / 64; C = (st & 1) * 32 + (swz % 64) / 2; }
__host__ __device__ __forceinline__ int perm32(int rho) { const int n = rho >> 4, i = rho & 15; return 8 * (i >> 2) + 4 * n + (i & 3); }

struct Unit { int pm, pn; };
template <int M_, int N_, int K_, int LDA_, int LDB_> struct GemmT { const bf16_t* A; const bf16_t* Bt; static constexpr int M = M_, N = N_, K = K_, lda = LDA_, ldb = LDB_; };

struct TripleOrder {
    int G, c;
    __device__ __forceinline__ bool next(int i, Unit& u) const { const int tr = c + G * (i / 3); if (tr >= 384) return false; u.pm = tr >> 2; u.pn = (i % 3) * 4 + (tr & 3); return true; }
    __device__ __forceinline__ int a_off(const Unit&) const { return 0; }
    __device__ __forceinline__ int b_tile(const Unit& u) const { return u.pn; }
    __device__ __forceinline__ int b_koff(const Unit&) const { return 0; }
    __device__ __forceinline__ void a_ready(const Unit&) const {}
    __device__ __forceinline__ void done(const Unit&) const {}
};
template <int M_, int N_, int ADIV, int AMUL, int KS = 1> struct StaticOrderT {
    static constexpr int nM = M_ / BM, nN = N_ / BM, nwg = nM * nN;
    int G, c;
    __device__ void init(int G_, int c_) { G = G_; c = c_; }
    __device__ __forceinline__ bool next(int i, Unit& u) const {
        const int L = i * G + c; if (L >= nwg) return false;
        int wgid = L; { constexpr int q = nwg / NXCD, r = nwg % NXCD; const int xcd = wgid % NXCD, off = wgid / NXCD; wgid = (xcd < r ? xcd * (q + 1) : r * (q + 1) + (xcd - r) * q) + off; }
        constexpr int nig = WGM * nN; const int gid = wgid / nig, fm = gid * WGM, gsz = (nM - fm) < WGM ? (nM - fm) : WGM;
        u.pm = fm + ((wgid % nig) % gsz); u.pn = (wgid % nig) / gsz; return true;
    }
    __device__ __forceinline__ int a_off(const Unit& u) const { return ADIV > 0 ? (u.pn / (ADIV > 0 ? ADIV : 1)) * AMUL : 0; }
    __device__ __forceinline__ int b_tile(const Unit& u) const { return KS > 1 ? u.pn % (nN / KS) : u.pn; }
    __device__ __forceinline__ int b_koff(const Unit& u) const { return KS > 1 ? (u.pn / (nN / KS)) * AMUL : 0; }
    __device__ __forceinline__ void a_ready(const Unit&) const {}
    __device__ __forceinline__ void done(const Unit&) const {}
};

template <class GT, class Epi, class Sched, bool ALIGN_EPI = false, bool SP2 = false>
__device__ __forceinline__ void gemm_phase(PG8_LAS unsigned char* lds, const GT g, const Sched& S, const Epi& E) {
    int tid_ = threadIdx.x; asm volatile("" : "+v"(tid_));
    const int tid = tid_, wid = __builtin_amdgcn_readfirstlane(tid >> 6), lane = tid & 63, wr = wid >> 2, wc = wid & 3, fr = lane & 15, fq = lane >> 4;
    constexpr int K = GT::K, nt = K / BK;
    unsigned voffA[2], voffB[2];
#pragma unroll
    for (int i = 0; i < 2; ++i) { int R, C; stage_rc(tid * 16 + i * 8192, R, C); const int Rb = Epi::PERM ? ((R & ~31) + perm32(R & 31)) : R;
        voffA[i] = (unsigned)(R * GT::lda + C) * 2u; voffB[i] = (unsigned)(Rb * GT::ldb + C) * 2u; }
    constexpr size_t kstep = (size_t)(BK * 2);
    constexpr size_t hstepA = (size_t)HALF * GT::lda * 2, hstepB = (size_t)HALF * GT::ldb * 2;
    constexpr size_t tstepA = 2 * hstepA, tstepB = 2 * hstepB;
    const unsigned ldsw = (unsigned)wid * 1024u;
    const int aoff = lds_byte(wr * 64 + fr, fq * 8), boff = lds_byte(wc * 32 + fr, fq * 8);
#define PG8_SA(b, h) (((b) * 2 + (h)) * HTB)
#define PG8_SB(b, h) ((4 + (b) * 2 + (h)) * HTB)
#define PG8_STAGE(bufoff, gbase, voff) do { _Pragma("unroll") for (int _i = 0; _i < 2; ++_i) \
        __builtin_amdgcn_global_load_lds((const unsigned*)((const char*)(gbase) + (voff)[_i]), (PG8_LAS unsigned*)(lds + (bufoff) + ldsw + _i * 8192), 16, 0, 0); } while (0)
#define PG8_LDA(dst, b, h) do { _Pragma("unroll") for (int m = 0; m < 4; ++m) _Pragma("unroll") for (int k = 0; k < 2; ++k) dst[m][k] = *(const PG8_LAS bf16x8*)(lds + PG8_SA(b, h) + aoff + m * 2048 + k * 1024); } while (0)
#define PG8_LDB(dst, b, h) do { _Pragma("unroll") for (int n = 0; n < 2; ++n) _Pragma("unroll") for (int k = 0; k < 2; ++k) dst[n][k] = *(const PG8_LAS bf16x8*)(lds + PG8_SB(b, h) + boff + n * 2048 + k * 1024); } while (0)
#define PG8_MMA(ai, bj, At, Bt) do { __builtin_amdgcn_s_setprio(1); _Pragma("unroll") for (int m = 0; m < 4; ++m) _Pragma("unroll") for (int n = 0; n < 2; ++n) _Pragma("unroll") for (int k = 0; k < 2; ++k) \
        acc[ai][bj][m][n] = __builtin_amdgcn_mfma_f32_16x16x32_bf16(Bt[n][k], At[m][k], acc[ai][bj][m][n], 0, 0, 0); __builtin_amdgcn_s_setprio(0); } while (0)
#define PG8_WAIT_V(n) asm volatile("s_waitcnt vmcnt(" #n ")" ::: "memory")
#define PG8_WAIT_L(n) asm volatile("s_waitcnt lgkmcnt(" #n ")" ::: "memory")
#define PG8_BAR __builtin_amdgcn_s_barrier()
#define PG8_SCHED __builtin_amdgcn_sched_barrier(0)
    Unit cur, nxt; int ui = 0;
    if (!S.next(0, cur)) return;
    f32x4 acc[2][2][4][2];
#pragma unroll
    for (int a = 0; a < 2; ++a)
#pragma unroll
        for (int b = 0; b < 2; ++b)
#pragma unroll
            for (int m = 0; m < 4; ++m)
#pragma unroll
                for (int n = 0; n < 2; ++n) acc[a][b][m][n] = (f32x4){0.f, 0.f, 0.f, 0.f};
    bf16x8 At[4][2], B0[2][2], B1[2][2];
    const char* cA = (const char*)g.A + (size_t)cur.pm * tstepA + (size_t)S.a_off(cur) * 2; const char* cB = (const char*)g.Bt + (size_t)S.b_tile(cur) * tstepB + (size_t)S.b_koff(cur) * 2;
    S.a_ready(cur);
    if constexpr (SP2) {
        PG8_STAGE(PG8_SB(0, 0), cB, voffB); PG8_STAGE(PG8_SB(0, 1), cB + hstepB, voffB); PG8_STAGE(PG8_SA(0, 0), cA, voffA); PG8_STAGE(PG8_SA(0, 1), cA + hstepA, voffA);
        if (wr == 1) PG8_BAR;
        PG8_WAIT_V(2); PG8_BAR;
        PG8_STAGE(PG8_SB(1, 0), cB + kstep, voffB); PG8_STAGE(PG8_SA(1, 0), cA + kstep, voffA); PG8_STAGE(PG8_SB(1, 1), cB + hstepB + kstep, voffB);
        PG8_WAIT_V(6); PG8_BAR;
    } else {
        PG8_STAGE(PG8_SB(0, 0), cB, voffB); PG8_STAGE(PG8_SA(0, 0), cA, voffA); PG8_STAGE(PG8_SB(0, 1), cB + hstepB, voffB); PG8_STAGE(PG8_SA(0, 1), cA + hstepA, voffA);
        if (wr == 1) PG8_BAR;
        PG8_WAIT_V(4); PG8_BAR;
        PG8_STAGE(PG8_SB(1, 0), cB + kstep, voffB); PG8_STAGE(PG8_SA(1, 0), cA + kstep, voffA); PG8_STAGE(PG8_SB(1, 1), cB + hstepB + kstep, voffB);
        PG8_WAIT_V(6); PG8_BAR;
    }
    for (;;) {
        const bool has_next = S.next(ui + 1, nxt);
        const char* nA = has_next ? (const char*)g.A + (size_t)nxt.pm * tstepA + (size_t)S.a_off(nxt) * 2 : cA; const char* nB = has_next ? (const char*)g.Bt + (size_t)S.b_tile(nxt) * tstepB + (size_t)S.b_koff(nxt) * 2 : cB;
        for (int t = 0; t < nt; t += 2) {
            const bool last = (t == nt - 2);
            const char* a1 = cA + (size_t)(t + 1) * kstep;
            const char* a2 = last ? nA : cA + (size_t)(t + 2) * kstep; const char* b2 = last ? nB : cB + (size_t)(t + 2) * kstep;
            const char* a3 = a2 + kstep; const char* b3 = b2 + kstep;
            if (last && has_next) S.a_ready(nxt);
            if constexpr (SP2) {
            PG8_LDB(B0, 0, 0); PG8_LDB(B1, 0, 1); PG8_SCHED; PG8_LDA(At, 0, 0); PG8_STAGE(PG8_SA(1, 1), a1 + hstepA, voffA);
            PG8_WAIT_V(8); PG8_WAIT_L(0); PG8_BAR; PG8_MMA(0, 0, At, B0); PG8_MMA(0, 1, At, B1); PG8_BAR; PG8_SCHED;
            PG8_LDA(At, 0, 1); PG8_STAGE(PG8_SB(0, 0), b2, voffB); PG8_STAGE(PG8_SB(0, 1), b2 + hstepB, voffB); PG8_STAGE(PG8_SA(0, 0), a2, voffA);
            PG8_WAIT_V(8); PG8_WAIT_L(0); PG8_BAR; PG8_MMA(1, 0, At, B0); PG8_MMA(1, 1, At, B1); PG8_BAR; PG8_SCHED;
            PG8_LDB(B0, 1, 0); PG8_LDB(B1, 1, 1); PG8_SCHED; PG8_LDA(At, 1, 0); PG8_STAGE(PG8_SA(0, 1), a2 + hstepA, voffA);
            PG8_WAIT_V(8); PG8_WAIT_L(0); PG8_BAR; PG8_MMA(0, 0, At, B0); PG8_MMA(0, 1, At, B1); PG8_BAR; PG8_SCHED;
            PG8_LDA(At, 1, 1); PG8_STAGE(PG8_SB(1, 0), b3, voffB); PG8_STAGE(PG8_SB(1, 1), b3 + hstepB, voffB); PG8_STAGE(PG8_SA(1, 0), a3, voffA);
            PG8_WAIT_V(8); PG8_WAIT_L(0); PG8_BAR; PG8_MMA(1, 0, At, B0); PG8_MMA(1, 1, At, B1); PG8_BAR; PG8_SCHED;
            } else {
            PG8_LDB(B0, 0, 0); PG8_SCHED; PG8_LDA(At, 0, 0); PG8_STAGE(PG8_SA(1, 1), a1 + hstepA, voffA);
            PG8_WAIT_L(8); PG8_BAR; PG8_WAIT_L(0); PG8_MMA(0, 0, At, B0); PG8_BAR; PG8_SCHED;
            PG8_LDB(B1, 0, 1); PG8_STAGE(PG8_SB(0, 0), b2, voffB);
            PG8_BAR; PG8_WAIT_L(0); PG8_MMA(0, 1, At, B1); PG8_BAR;
            PG8_LDA(At, 0, 1); PG8_STAGE(PG8_SA(0, 0), a2, voffA);
            PG8_BAR; PG8_WAIT_L(0); PG8_MMA(1, 0, At, B0); PG8_BAR; PG8_SCHED;
            PG8_STAGE(PG8_SB(0, 1), b2 + hstepB, voffB);
            PG8_WAIT_V(6); PG8_BAR; PG8_MMA(1, 1, At, B1); PG8_BAR;
            PG8_LDB(B0, 1, 0); PG8_SCHED; PG8_LDA(At, 1, 0); PG8_STAGE(PG8_SA(0, 1), a2 + hstepA, voffA);
            PG8_WAIT_L(8); PG8_BAR; PG8_WAIT_L(0); PG8_MMA(0, 0, At, B0); PG8_BAR; PG8_SCHED;
            PG8_LDB(B1, 1, 1); PG8_STAGE(PG8_SB(1, 0), b3, voffB);
            PG8_BAR; PG8_WAIT_L(0); PG8_MMA(0, 1, At, B1); PG8_BAR;
            PG8_LDA(At, 1, 1); PG8_STAGE(PG8_SA(1, 0), a3, voffA);
            PG8_BAR; PG8_WAIT_L(0); PG8_MMA(1, 0, At, B0); PG8_BAR; PG8_SCHED;
            PG8_STAGE(PG8_SB(1, 1), b3 + hstepB, voffB);
            PG8_WAIT_V(6); PG8_BAR; PG8_MMA(1, 1, At, B1); PG8_BAR;
            }
        }
        if constexpr (ALIGN_EPI) { if (wr == 0) PG8_BAR; }
        if constexpr (!Epi::AFTER_DRAIN) { E(acc, cur, wr, wc, fr, fq); S.done(cur); }
        if (!has_next) break;
#pragma unroll
        for (int a = 0; a < 2; ++a)
#pragma unroll
            for (int b = 0; b < 2; ++b)
#pragma unroll
                for (int m = 0; m < 4; ++m)
#pragma unroll
                    for (int n = 0; n < 2; ++n) acc[a][b][m][n] = (f32x4){0.f, 0.f, 0.f, 0.f};
        cur = nxt; cA = nA; cB = nB; ++ui;
        if constexpr (ALIGN_EPI) { if (wr == 1) PG8_BAR; }
    }
    PG8_WAIT_V(0);
    if constexpr (!ALIGN_EPI) { if (wr == 0) PG8_BAR; }
    PG8_BAR;
    if constexpr (Epi::AFTER_DRAIN) { E.fused(acc, cur, wr, wc, fr, fq, lds, wid, lane); S.done(cur); }
#undef PG8_SA
#undef PG8_SB
#undef PG8_STAGE
#undef PG8_LDA
#undef PG8_LDB
#undef PG8_MMA
#undef PG8_WAIT_V
#undef PG8_WAIT_L
#undef PG8_BAR
#undef PG8_SCHED
}
}

#define LAS __attribute__((address_space(3)))
typedef unsigned short bf16_t;
typedef short bf16x8 __attribute__((ext_vector_type(8)));
typedef float f32x4 __attribute__((ext_vector_type(4)));
typedef unsigned u32x4 __attribute__((ext_vector_type(4)));
typedef unsigned u32x2 __attribute__((ext_vector_type(2)));

constexpr int D = 1024, DFF = 2816, NFF2 = 5632, INC = 7984, PN = 5120, PREAL = 4912, MGN = 3072;
constexpr int MTOT = 24576, MLAT = 16384, GROWS = 8192;
constexpr float EPSN = 1e-6f;
constexpr size_t MiB = 1u << 20;
constexpr size_t WS_MOD = 1 * MiB, WS_MODP = 2 * MiB, WS_POS = 5 * MiB, WS_DEC = 6 * MiB, WS_SC = 7 * MiB;
constexpr size_t WS_W = 8 * MiB;
constexpr size_t W_FFIN = 0, W_FFOUT = W_FFIN + 2ull * NFF2 * D * 2, W_P = W_FFOUT + 2ull * D * DFF * 2, W_MG = W_P + (size_t)PN * D * 2,
                 W_B = W_MG + (size_t)MGN * D * 2, W_O3 = W_B + 3072ull * 512 * 2, W_END = W_O3 + 1024ull * 3072 * 2;
static_assert(W_END <= 58 * MiB, "weights region");
constexpr size_t WS_XN = 66 * MiB, WS_A = 114 * MiB, WS_BIG = 210 * MiB, WS_END = 370 * MiB;
constexpr size_t BIG_US = 80 * MiB, BIG_OB = 128 * MiB;
constexpr size_t OFF_YP = 0, OFF_YS = 8388608, OFF_C = 25165824, OFF_N = 29360128, OFF_M = 29392896, OFF_G = 29393408, OFF_H = 33587712;
constexpr int LDS_BYTES = 147456;

struct Args { const float* in[23]; float* out; unsigned char* ws; };
enum { I_XP = 0, I_XS, I_C, I_SC, I_SN, I_SM, I_SG, I_SH, I_CCTX, I_WADA, I_BADA, I_NPRE, I_NPOST, I_WFIN, I_WFOUT, I_WIN, I_GB, I_GWUP, I_GLB, I_HGAM, I_HN, I_WBR, I_WOUT };
__device__ __forceinline__ const float* inp(const Args& a, int i) { asm volatile("" : "+s"(i)); return a.in[i]; }

typedef float f32x2_t __attribute__((ext_vector_type(2))); typedef __bf16 bf16x2_t __attribute__((ext_vector_type(2)));
__device__ __forceinline__ unsigned pk2(float lo, float hi) { f32x2_t v = {lo, hi}; bf16x2_t b = __builtin_convertvector(v, bf16x2_t); return __builtin_bit_cast(unsigned, b); }
__device__ __forceinline__ unsigned f2bf(float f) { return pk2(f, 0.f) & 0xffffu; }
__device__ __forceinline__ float bf2f(bf16_t h) { return __uint_as_float(((unsigned)h) << 16); }
__device__ __forceinline__ float bflo(unsigned w) { return __uint_as_float(w << 16); }
__device__ __forceinline__ float bfhi(unsigned w) { return __uint_as_float(w & 0xffff0000u); }
__device__ __forceinline__ float sigmoidf_(float x) { return __builtin_amdgcn_rcpf(1.0f + __expf(-x)); }
__device__ __forceinline__ float siluf_(float x) { return x * __builtin_amdgcn_rcpf(1.0f + __expf(-x)); }
__device__ __forceinline__ float logsigf_(float x) { return fminf(x, 0.f) - __logf(1.0f + __expf(-fabsf(x))); }
__device__ __forceinline__ float wave_sum(float v) {
#pragma unroll
    for (int o = 1; o < 64; o <<= 1) v += __shfl_xor(v, o);
    return v;
}
#define LDS_WAIT() asm volatile("s_waitcnt lgkmcnt(0)" ::: "memory")
#ifndef NO_WT
__device__ __forceinline__ void st_wt8(void* p, u32x2 v) { __hip_atomic_store((unsigned long long*)p, ((unsigned long long)v.y << 32) | v.x, __ATOMIC_RELAXED, __HIP_MEMORY_SCOPE_AGENT); }
__device__ __forceinline__ void st_wt16(void* p, u32x4 v) { st_wt8(p, (u32x2){v.x, v.y}); st_wt8((char*)p + 8, (u32x2){v.z, v.w}); }
#else
__device__ __forceinline__ void st_wt8(void* p, u32x2 v) { *(u32x2*)p = v; }
__device__ __forceinline__ void st_wt16(void* p, u32x4 v) { *(u32x4*)p = v; }
#endif

#define XB_TMO      128
#define XB_XCNT(j)  (256  + 64 * (j))
#define XB_XSUB(j)  (1280 + 64 * (j))
#define XB_XGEN(j)  (2304 + 64 * (j))
#define XB_TOP      3328
#define XB_TOPGEN   3392
#define XCD_BAR_WORDS 3456
#define XB_SPIN_CAP (1u << 18)

__device__ __forceinline__ unsigned xb_ld(unsigned* p)              { return __hip_atomic_load(p, __ATOMIC_RELAXED, __HIP_MEMORY_SCOPE_AGENT); }
__device__ __forceinline__ unsigned xb_add(unsigned* p, unsigned v) { return __hip_atomic_fetch_add(p, v, __ATOMIC_RELAXED, __HIP_MEMORY_SCOPE_AGENT); }
__device__ __forceinline__ unsigned xb_xcc_id() { return (unsigned)__builtin_amdgcn_s_getreg((3 << 11) | 20) & 0xFu; }
#define XB_SPIN(cond, bar) do { unsigned _sp = 0; while (cond) { __builtin_amdgcn_s_sleep(1); \
    if ((++_sp & 255u) == 0u) { if (xb_ld(&(bar)[XB_TMO])) break; if (_sp > XB_SPIN_CAP) { atomicAdd(&(bar)[XB_TMO], 1u); break; } } } } while (0)

struct XcdBarrier {
    unsigned* bar; unsigned x;
    volatile LAS unsigned* st;
};

__device__ __forceinline__ XcdBarrier xcd_barrier_post(unsigned* bar, volatile LAS unsigned* st) {
    XcdBarrier b; b.bar = bar; b.x = xb_xcc_id(); b.st = st;
    if (threadIdx.x == 0) (void)xb_add(&bar[XB_XCNT(b.x)], 1u);
    return b;
}
__device__ __forceinline__ void xcd_barrier_complete(unsigned* bar, unsigned x, unsigned& nloc, unsigned& nx) {
    const unsigned G = gridDim.x * gridDim.y * gridDim.z;
    unsigned sum, cnt, mine, sp = 0u;
    for (;;) {
        sum = 0u; cnt = 0u; mine = 0u;
#pragma unroll
        for (unsigned j = 0; j < 16; ++j) { const unsigned c = xb_ld(&bar[XB_XCNT(j)]); sum += c; cnt += (c > 0u) ? 1u : 0u; mine = (j == x) ? c : mine; }
        if (sum == G) break;
        __builtin_amdgcn_s_sleep(1);
        if ((++sp & 255u) == 0u) { if (xb_ld(&bar[XB_TMO])) break; if (sp > XB_SPIN_CAP) { atomicAdd(&bar[XB_TMO], 1u); break; } }
    }
    nloc = mine > 0u ? mine : 1u; nx = cnt > 0u ? cnt : 1u;
}

__device__ __attribute__((noinline)) void xcd_barrier_ni(unsigned* bar_, unsigned st_off) {
    XcdBarrier b; b.bar = bar_; b.x = xb_xcc_id(); b.st = (volatile LAS unsigned*)(size_t)st_off;
    asm volatile("s_waitcnt vmcnt(0)" ::: "memory");
    __syncthreads();
    if (threadIdx.x == 0) {
        unsigned* bar = b.bar;
        __builtin_amdgcn_s_waitcnt(0);
        unsigned nloc = b.st[0], nx = b.st[1];
        if (nloc == 0u) { xcd_barrier_complete(bar, b.x, nloc, nx); b.st[0] = nloc; b.st[1] = nx; }
        const unsigned old = xb_add(&bar[XB_XSUB(b.x)], 1u);
        const unsigned gen = old / nloc;
        if (old + 1u == (gen + 1u) * nloc) {
            __builtin_amdgcn_fence(__ATOMIC_RELEASE, "agent");
            asm volatile("s_waitcnt vmcnt(0)" ::: "memory");
            const unsigned og = xb_add(&bar[XB_TOP], 1u);
            const unsigned tg = og / nx;
            if (og + 1u == (tg + 1u) * nx) xb_add(&bar[XB_TOPGEN], 1u);
            else XB_SPIN(xb_ld(&bar[XB_TOPGEN]) == tg, bar);
            __builtin_amdgcn_fence(__ATOMIC_ACQUIRE, "agent");
            xb_add(&bar[XB_XGEN(b.x)], 1u);
            asm volatile("s_waitcnt vmcnt(0)" ::: "memory");
        } else {
            XB_SPIN(xb_ld(&bar[XB_XGEN(b.x)]) == gen, bar);
            __builtin_amdgcn_fence(__ATOMIC_ACQUIRE, "agent");
            asm volatile("s_waitcnt vmcnt(0)" ::: "memory");
        }
    }
    __syncthreads();
}


struct EpiBf16 {
    static constexpr bool PERM = true, AFTER_DRAIN = false;
    bf16_t* O; int ldc; int nsplit; size_t sstride;
    __device__ __forceinline__ void operator()(const f32x4 (&acc)[2][2][4][2], const pg8::Unit& u, int wr, int wc, int fr, int fq) const {
        int pn = u.pn; bf16_t* Ob = O; if (nsplit) { Ob += (size_t)(pn / nsplit) * sstride; pn = pn % nsplit; }
        const int row0 = u.pm * 256 + wr * 64 + fr, col0 = pn * 256 + wc * 32 + 8 * fq;
#pragma unroll
        for (int ai = 0; ai < 2; ++ai)
#pragma unroll
            for (int m = 0; m < 4; ++m) { bf16_t* rowp = Ob + (size_t)(row0 + ai * 128 + m * 16) * ldc + col0;
#pragma unroll
                for (int bj = 0; bj < 2; ++bj) { const f32x4 v0 = acc[ai][bj][m][0], v1 = acc[ai][bj][m][1];
                    u32x4 w; w.x = pk2(v0[0], v0[1]); w.y = pk2(v0[2], v0[3]); w.z = pk2(v1[0], v1[1]); w.w = pk2(v1[2], v1[3]);
                    *(u32x4*)(rowp + bj * 128) = w; } }
    }
};
struct EpiGateMul {
    static constexpr bool PERM = true, AFTER_DRAIN = false;
    bf16_t* O; int ldc;
    __device__ __forceinline__ void operator()(const f32x4 (&acc)[2][2][4][2], const pg8::Unit& u, int wr, int wc, int fr, int fq) const {
        const int row0 = u.pm * 256 + wr * 64 + fr, col0 = u.pn * 256 + wc * 32 + 8 * fq;
        u32x4 bb[2][4][2];
#pragma unroll
        for (int ai = 0; ai < 2; ++ai)
#pragma unroll
            for (int m = 0; m < 4; ++m) { const bf16_t* rowp = O + (size_t)(row0 + ai * 128 + m * 16) * ldc + col0;
#pragma unroll
                for (int bj = 0; bj < 2; ++bj) bb[ai][m][bj] = *(const u32x4*)(rowp + bj * 128); }
#pragma unroll
        for (int ai = 0; ai < 2; ++ai)
#pragma unroll
            for (int m = 0; m < 4; ++m) { bf16_t* rowp = O + (size_t)(row0 + ai * 128 + m * 16) * ldc + col0;
#pragma unroll
                for (int bj = 0; bj < 2; ++bj) { const f32x4 v0 = acc[ai][bj][m][0], v1 = acc[ai][bj][m][1];
                    const u32x4 b = bb[ai][m][bj];
                    u32x4 w; w.x = pk2(sigmoidf_(v0[0]) * bflo(b.x), sigmoidf_(v0[1]) * bfhi(b.x)); w.y = pk2(sigmoidf_(v0[2]) * bflo(b.y), sigmoidf_(v0[3]) * bfhi(b.y));
                    w.z = pk2(sigmoidf_(v1[0]) * bflo(b.z), sigmoidf_(v1[1]) * bfhi(b.z)); w.w = pk2(sigmoidf_(v1[2]) * bflo(b.w), sigmoidf_(v1[3]) * bfhi(b.w));
                    *(u32x4*)(rowp + bj * 128) = w; } }
    }
};
struct EpiGateSum {
    static constexpr bool PERM = true, AFTER_DRAIN = false;
    bf16_t* O; int ldc;
    __device__ __forceinline__ void operator()(const f32x4 (&acc)[2][2][4][2], const pg8::Unit& u, int wr, int wc, int fr, int fq) const {
        const int n = u.pn >> 2, dt = u.pn & 3; const int row0 = u.pm * 256 + wr * 64 + fr, col0 = u.pn * 256 + wc * 32 + 8 * fq, cols = dt * 256 + wc * 32 + 8 * fq;
        if (n) asm volatile("s_waitcnt vmcnt(0)" ::: "memory");
#pragma unroll
        for (int ai = 0; ai < 2; ++ai) {
            u32x4 bb[4][2], ss[4][2];
#pragma unroll
            for (int m = 0; m < 4; ++m)
#pragma unroll
                for (int bj = 0; bj < 2; ++bj) { const bf16_t* rp = O + (size_t)(row0 + ai * 128 + m * 16) * ldc; bb[m][bj] = *(const u32x4*)(rp + col0 + bj * 128); if (n) ss[m][bj] = *(const u32x4*)(rp + cols + bj * 128); }
#pragma unroll
            for (int m = 0; m < 4; ++m)
#pragma unroll
                for (int bj = 0; bj < 2; ++bj) { const f32x4 v0 = acc[ai][bj][m][0], v1 = acc[ai][bj][m][1]; const u32x4 b = bb[m][bj];
                    float r[8] = {sigmoidf_(v0[0]) * bflo(b.x), sigmoidf_(v0[1]) * bfhi(b.x), sigmoidf_(v0[2]) * bflo(b.y), sigmoidf_(v0[3]) * bfhi(b.y),
                                  sigmoidf_(v1[0]) * bflo(b.z), sigmoidf_(v1[1]) * bfhi(b.z), sigmoidf_(v1[2]) * bflo(b.w), sigmoidf_(v1[3]) * bfhi(b.w)};
                    if (n) { const u32x4 s = ss[m][bj]; r[0] += bflo(s.x); r[1] += bfhi(s.x); r[2] += bflo(s.y); r[3] += bfhi(s.y); r[4] += bflo(s.z); r[5] += bfhi(s.z); r[6] += bflo(s.w); r[7] += bfhi(s.w); }
                    u32x4 w; w.x = pk2(r[0], r[1]); w.y = pk2(r[2], r[3]); w.z = pk2(r[4], r[5]); w.w = pk2(r[6], r[7]);
                    *(u32x4*)(O + (size_t)(row0 + ai * 128 + m * 16) * ldc + cols + bj * 128) = w; }
        }
    }
};
struct EpiSwiGLU {
    static constexpr bool PERM = true, AFTER_DRAIN = false;
    bf16_t* H; int ldh;
    __device__ __forceinline__ void operator()(const f32x4 (&acc)[2][2][4][2], const pg8::Unit& u, int wr, int wc, int fr, int fq) const {
        const int row0 = u.pm * 256 + wr * 64 + fr, col0 = u.pn * 128 + wc * 32 + 8 * fq;
#pragma unroll
        for (int ai = 0; ai < 2; ++ai)
#pragma unroll
            for (int m = 0; m < 4; ++m) { bf16_t* rowp = H + (size_t)(row0 + ai * 128 + m * 16) * ldh + col0;
                const f32x4 g0 = acc[ai][0][m][0], g1 = acc[ai][0][m][1], u0 = acc[ai][1][m][0], u1 = acc[ai][1][m][1];
                u32x4 w; w.x = pk2(siluf_(g0[0]) * u0[0], siluf_(g0[1]) * u0[1]); w.y = pk2(siluf_(g0[2]) * u0[2], siluf_(g0[3]) * u0[3]);
                w.z = pk2(siluf_(g1[0]) * u1[0], siluf_(g1[1]) * u1[1]); w.w = pk2(siluf_(g1[2]) * u1[2], siluf_(g1[3]) * u1[3]);
                *(u32x4*)rowp = w; }
    }
};
struct EpiF32 {
    static constexpr bool PERM = false, AFTER_DRAIN = false;
    float* Y; int ldc;
    __device__ __forceinline__ void operator()(const f32x4 (&acc)[2][2][4][2], const pg8::Unit& u, int wr, int wc, int fr, int fq) const {
        const int row0 = u.pm * 256 + wr * 64 + fr, col0 = u.pn * 256 + wc * 32 + 4 * fq;
#pragma unroll
        for (int ai = 0; ai < 2; ++ai)
#pragma unroll
            for (int m = 0; m < 4; ++m) { float* rowp = Y + (size_t)(row0 + ai * 128 + m * 16) * ldc + col0;
#pragma unroll
                for (int bj = 0; bj < 2; ++bj)
#pragma unroll
                    for (int n = 0; n < 2; ++n) *(f32x4*)(rowp + bj * 128 + n * 16) = acc[ai][bj][m][n]; }
    }
};

template <class Map>
__device__ __forceinline__ void transpose_item(const float* W, int K, int N, LAS float* scr, int item, int lane, const Map& map) {
    const int nblk = (N + 31) / 32, kb = item / nblk, nb = item % nblk, k0 = 64 * kb, n0 = 32 * nb;
    const int nn = n0 + (lane & 31); const bool ok = nn < N;
    float wv[32];
#pragma unroll
    for (int i = 0; i < 32; ++i) { const int kk = 2 * i + (lane >> 5); wv[i] = W[(size_t)(k0 + kk) * N + (ok ? nn : 0)]; }
#pragma unroll
    for (int i = 0; i < 32; ++i) { const int kk = 2 * i + (lane >> 5); scr[kk * 33 + (lane & 31)] = ok ? wv[i] : 0.f; }
    LDS_WAIT(); asm volatile("" ::: "memory");
    const int c = lane & 7;
#pragma unroll
    for (int j = 0; j < 4; ++j) { const int n = (lane >> 3) + 8 * j; const LAS float* s = scr + (8 * c) * 33 + n;
        u32x4 o; o.x = pk2(s[0 * 33], s[1 * 33]); o.y = pk2(s[2 * 33], s[3 * 33]); o.z = pk2(s[4 * 33], s[5 * 33]); o.w = pk2(s[6 * 33], s[7 * 33]);
        if (n0 + n < N) map(n0 + n, k0 + 8 * c, o); }
    LDS_WAIT(); asm volatile("" ::: "memory");
}

__device__ __forceinline__ void convert_weights(const Args& a, LAS unsigned char* lds, int l, int lo, int hi, int dopad, int gw, int NGW, int lane, int wave) {
    LAS float* scr = (LAS float*)(lds + wave * 16384);
    unsigned char* wb = a.ws + WS_W;
    constexpr int I_FI = 16 * 176, I_FO = 44 * 32, I_IN = 16 * 250, I_BR = 8 * 32, I_OU = 16 * 32;
    constexpr int NITEMS = 2 * I_FI + 2 * I_FO + I_IN + 3 * I_BR + I_OU;
    static_assert(NITEMS == 13728, "item ranges used by the callers");
    for (int it = lo + gw; it < hi; it += NGW) {
        int r = it;
        if (r < 2 * I_FI) { const int f = r / I_FI; r -= f * I_FI; bf16_t* dst = (bf16_t*)(wb + W_FFIN) + (size_t)f * NFF2 * D;
            transpose_item(inp(a, I_WFIN) + (size_t)(l * 2 + f) * D * NFF2, D, NFF2, scr, r, lane,
                [=](int n, int k, u32x4 o) { const int h = n < DFF ? n : n - DFF; const int row = 256 * (h >> 7) + (n < DFF ? 0 : 128) + (h & 127); *(u32x4*)(dst + (size_t)row * D + k) = o; });
            continue; }
        r -= 2 * I_FI;
        if (r < 2 * I_FO) { const int f = r / I_FO; r -= f * I_FO; bf16_t* dst = (bf16_t*)(wb + W_FFOUT) + (size_t)f * D * DFF;
            transpose_item(inp(a, I_WFOUT) + (size_t)(l * 2 + f) * DFF * D, DFF, D, scr, r, lane,
                [=](int n, int k, u32x4 o) { *(u32x4*)(dst + (size_t)n * DFF + k) = o; });
            continue; }
        r -= 2 * I_FO;
        if (r < I_IN) { bf16_t* dp = (bf16_t*)(wb + W_P); bf16_t* dm = (bf16_t*)(wb + W_MG);
            transpose_item(inp(a, I_WIN) + (size_t)l * D * INC, D, INC, scr, r, lane,
                [=](int n, int k, u32x4 o) { if (n < PREAL) *(u32x4*)(dp + (size_t)n * D + k) = o; else *(u32x4*)(dm + (size_t)(n - PREAL) * D + k) = o; });
            continue; }
        r -= I_IN;
        if (r < 3 * I_BR) { const int nb = r / I_BR; r -= nb * I_BR; bf16_t* dst = (bf16_t*)(wb + W_B) + (size_t)nb * 1024 * 512;
            transpose_item(inp(a, I_WBR) + (size_t)(l * 3 + nb) * 512 * D, 512, D, scr, r, lane,
                [=](int n, int k, u32x4 o) { *(u32x4*)(dst + (size_t)n * 512 + k) = o; });
            continue; }
        r -= 3 * I_BR;
        { bf16_t* dst = (bf16_t*)(wb + W_O3);
            transpose_item(inp(a, I_WOUT) + (size_t)l * D * D, D, D, scr, r, lane,
                [=](int n, int k, u32x4 o) { bf16_t* p = dst + (size_t)n * 3072 + k; *(u32x4*)p = o; *(u32x4*)(p + 1024) = o; *(u32x4*)(p + 2048) = o; }); }
    }
    if (dopad) { u32x4* z = (u32x4*)((bf16_t*)(wb + W_P) + (size_t)PREAL * D); const int nz = (PN - PREAL) * D * 2 / 16;
      for (int i = gw * 64 + lane; i < nz; i += NGW * 64) z[i] = (u32x4){0u, 0u, 0u, 0u}; }
}

__device__ __forceinline__ void ada_partial(const Args& a, LAS unsigned char* lds, int gw, int NGW, int lane, int wave) {
    float* modp = (float*)(a.ws + WS_MODP);
    LAS float* sv = (LAS float*)(lds + wave * 16384);
    for (int it = gw; it < 2 * 144 * 8; it += NGW) {
        const int ks = it & 7, cgp = (it >> 3) % 144, l = it / (8 * 144);
        const int col = cgp * 64 + lane;
#pragma unroll
        for (int h = 0; h < 2; ++h) { const int kk = ks * 128 + lane + 64 * h;
            sv[lane + 64 * h] = siluf_(inp(a, I_CCTX)[kk]);
#pragma unroll
            for (int i = 0; i < 4; ++i) sv[(1 + i) * 128 + lane + 64 * h] = siluf_(inp(a, I_C)[i * D + kk]); }
        LDS_WAIT(); asm volatile("" ::: "memory");
        const float* w = inp(a, I_WADA) + ((size_t)l * D + ks * 128) * 9216 + col;
        float acc[5] = {0.f, 0.f, 0.f, 0.f, 0.f};
#pragma unroll 1
        for (int k0 = 0; k0 < 128; k0 += 32) { float wv[32];
#pragma unroll
            for (int k = 0; k < 32; ++k) wv[k] = w[(size_t)(k0 + k) * 9216];
#pragma unroll
            for (int k = 0; k < 32; ++k) {
#pragma unroll
                for (int i = 0; i < 5; ++i) acc[i] += sv[i * 128 + k0 + k] * wv[k]; } }
#pragma unroll
        for (int i = 0; i < 5; ++i) modp[((size_t)(ks * 2 + l) * 5 + i) * 9216 + col] = acc[i];
        LDS_WAIT(); asm volatile("" ::: "memory");
    }
}

struct RowOp { int src_input, has_y, ysplit; float coef; const float* npost; const float* mdg_base; int has_xn; const float* npre; const float* md_base; int si; int add_pos; };
template <int NR>
__device__ __forceinline__ void rowwise(const Args& a, const RowOp& op, const int (&rs)[NR], int lane) {
    f32x4 v[NR][4]; u32x2 yb[NR][4], yb2[NR][4]; float* xd[NR]; bool lat[NR]; int cv[NR];
#pragma unroll
    for (int q = 0; q < NR; ++q) { const int r = rs[q]; lat[q] = r < MLAT; cv[q] = lat[q] ? 1 + (r >> 12) : 0;
        const float* xs = op.src_input ? (lat[q] ? inp(a, I_XS) + (size_t)r * D : inp(a, I_XP) + (size_t)(r - MLAT) * D)
                                       : (lat[q] ? a.out + OFF_YS + (size_t)r * D : a.out + OFF_YP + (size_t)(r - MLAT) * D);
        xd[q] = lat[q] ? a.out + OFF_YS + (size_t)r * D : a.out + OFF_YP + (size_t)(r - MLAT) * D;
#pragma unroll
        for (int j = 0; j < 4; ++j) v[q][j] = __builtin_nontemporal_load((const f32x4*)(xs + 4 * lane + 256 * j));
        if (op.has_y) { const bf16_t* yr = (const bf16_t*)(a.ws + WS_A) + (size_t)r * D;
#pragma unroll
            for (int j = 0; j < 4; ++j) { yb[q][j] = __builtin_nontemporal_load((const u32x2*)(yr + 4 * lane + 256 * j)); yb2[q][j] = op.ysplit ? __builtin_nontemporal_load((const u32x2*)(yr + (size_t)MTOT * D + 4 * lane + 256 * j)) : (u32x2){0u, 0u}; } } }
    f32x4 wpr[4], s1v[NR][4], s0v[NR][4], ppv[NR][4];
    if (op.has_xn) {
#pragma unroll
        for (int j = 0; j < 4; ++j) wpr[j] = *(const f32x4*)(op.npre + 4 * lane + 256 * j);
#pragma unroll
        for (int q = 0; q < NR; ++q) { const float* sh = op.md_base + (size_t)cv[q] * 9216 + (size_t)op.si * D; const float* sc = sh + D;
            const float* pos = (const float*)(a.ws + WS_POS); const int t = rs[q] & 4095;
#pragma unroll
            for (int j = 0; j < 4; ++j) { const int c = 4 * lane + 256 * j; s1v[q][j] = *(const f32x4*)(sc + c); s0v[q][j] = *(const f32x4*)(sh + c);
                if (op.add_pos && lat[q]) ppv[q][j] = *(const f32x4*)((c < 512) ? pos + (size_t)(t >> 6) * 512 + c : pos + (size_t)(t & 63) * 512 + (c - 512)); } } }
#pragma unroll
    for (int q = 0; q < NR; ++q) { const int r = rs[q];
        if (op.has_y) {
            f32x4 y[4]; float ss = 0.f;
#pragma unroll
            for (int j = 0; j < 4; ++j) { y[j] = (f32x4){bflo(yb[q][j].x) + bflo(yb2[q][j].x), bfhi(yb[q][j].x) + bfhi(yb2[q][j].x), bflo(yb[q][j].y) + bflo(yb2[q][j].y), bfhi(yb[q][j].y) + bfhi(yb2[q][j].y)}; ss += (y[j].x * y[j].x + y[j].y * y[j].y) + (y[j].z * y[j].z + y[j].w * y[j].w); }
            const float rr = rsqrtf(wave_sum(ss) * (1.f / D) + EPSN) * op.coef;
            const float* gp = op.mdg_base + (size_t)cv[q] * 9216;
#pragma unroll
            for (int j = 0; j < 4; ++j) { const f32x4 w = *(const f32x4*)(op.npost + 4 * lane + 256 * j), gg = *(const f32x4*)(gp + 4 * lane + 256 * j);
                v[q][j] = v[q][j] + gg * (y[j] * rr) * w; __builtin_nontemporal_store(v[q][j], (f32x4*)(xd[q] + 4 * lane + 256 * j)); }
        }
        if (op.has_xn) {
            float ss = 0.f;
#pragma unroll
            for (int j = 0; j < 4; ++j) ss += (v[q][j].x * v[q][j].x + v[q][j].y * v[q][j].y) + (v[q][j].z * v[q][j].z + v[q][j].w * v[q][j].w);
            const float rr = rsqrtf(wave_sum(ss) * (1.f / D) + EPSN);
            bf16_t* xo = (bf16_t*)(a.ws + WS_XN) + (size_t)r * D;
#pragma unroll
            for (int j = 0; j < 4; ++j) { const int c = 4 * lane + 256 * j;
                f32x4 o = (v[q][j] * rr) * wpr[j] * (s1v[q][j] + 1.0f) + s0v[q][j];
                if (op.add_pos && lat[q]) o = o + ppv[q][j];
                u32x2 pk; pk.x = pk2(o.x, o.y); pk.y = pk2(o.z, o.w); *(u32x2*)(xo + c) = pk; }
        }
    }
}
__device__ __forceinline__ void rowwise_all(const Args& a, const RowOp& op, int gw, int NGW, int lane) {
    int r = gw;
    for (; r + NGW < MTOT; r += 2 * NGW) { const int rs[2] = {r, r + NGW}; rowwise<2>(a, op, rs, lane); }
    if (r < MTOT) { const int rs[1] = {r}; rowwise<1>(a, op, rs, lane); }
}

constexpr int C_MQ = 0, C_MK = 256, C_MV = 512, C_MO = 1024, C_MIF = 1536, C_GQ = 1552, C_GK = 1808, C_GV = 2064, C_GR = 2576, C_GLR = 3088, C_HQ = 3120, C_HF = 3376, C_HV = 3888, C_HG = 4400;

struct ItemInfo { int br, dir, head, seq, c, T, NC; };
__device__ __forceinline__ ItemInfo item_info(int g, int it) { ItemInfo I; const int hdb = it % 24, cgl = it / 24; I.br = hdb >> 3; I.dir = (hdb >> 2) & 1; I.head = hdb & 3;
    I.T = g < 2 ? 4096 : 256; I.NC = I.T >> 6; I.seq = cgl / I.NC; I.c = cgl % I.NC; return I; }
__device__ __forceinline__ int item_row(const ItemInfo& I, int s) { const int tau = I.c * 64 + s; return I.seq * I.T + (I.dir ? I.T - 1 - tau : tau); }
__device__ __forceinline__ float lb_of(const Args& a, int l, int ch) { if (l == 0) return 0.f; const float g0 = inp(a, I_HGAM)[ch], g1 = inp(a, I_HGAM)[256 + ch]; return 1.0f / (1.0f + expf(g0 - g1)); }

template <bool NEEDQ>
__device__ __forceinline__ void load_gated(const Args& a, const bf16_t* P, const ItemInfo& I, int l, int d, int sg, float (&qv)[8], float (&kv)[8], float (&la)[8]) {
    const int ch = I.head * 64 + d;
    if (I.br == 1) {
        float wup[16];
        const float* wp = inp(a, I_GWUP) + ((size_t)(l * 2 + I.dir) * 16) * 256 + ch;
#pragma unroll
        for (int r = 0; r < 16; ++r) wup[r] = wp[r * 256];
        const float gb = inp(a, I_GLB)[(l * 2 + I.dir) * 256 + ch];
#pragma unroll
        for (int i = 0; i < 8; ++i) { const bf16_t* pr = P + (size_t)item_row(I, 8 * sg + i) * PN;
            const u32x4 g0 = *(const u32x4*)(pr + C_GLR + I.dir * 16), g1 = *(const u32x4*)(pr + C_GLR + I.dir * 16 + 8);
            float z = gb;
            z += bflo(g0.x) * wup[0] + bfhi(g0.x) * wup[1] + bflo(g0.y) * wup[2] + bfhi(g0.y) * wup[3] + bflo(g0.z) * wup[4] + bfhi(g0.z) * wup[5] + bflo(g0.w) * wup[6] + bfhi(g0.w) * wup[7];
            z += bflo(g1.x) * wup[8] + bfhi(g1.x) * wup[9] + bflo(g1.y) * wup[10] + bfhi(g1.y) * wup[11] + bflo(g1.z) * wup[12] + bfhi(g1.z) * wup[13] + bflo(g1.w) * wup[14] + bfhi(g1.w) * wup[15];
            la[i] = logsigf_(z) * (1.0f / 16.0f);
            if (NEEDQ) qv[i] = bf2f(pr[C_GQ + ch]) * 0.125f; kv[i] = bf2f(pr[C_GK + ch]); }
    } else {
        const float lb = lb_of(a, l, ch);
#pragma unroll
        for (int i = 0; i < 8; ++i) { const bf16_t* pr = P + (size_t)item_row(I, 8 * sg + i) * PN;
            const float z = bf2f(pr[C_HF + I.dir * 256 + ch]); const float sg_ = sigmoidf_(z);
            la[i] = (lb == 0.f) ? logsigf_(z) : __logf(lb + (1.0f - lb) * sg_);
            if (NEEDQ) qv[i] = bf2f(pr[C_HQ + ch]) * 1.0f;
            kv[i] = (1.0f - lb) * (1.0f - sg_); }
    }
}
template <bool NEEDQ>
__device__ __forceinline__ void load_mlstm(const Args& a, const bf16_t* P, const ItemInfo& I, int l, int d, int sg, float (&qv)[8], float (&kv)[8], float (&lf)[8], float (&li)[8]) {
    const float bi = inp(a, I_GB)[((l * 2 + I.dir) * 2 + 0) * 4 + I.head], bf_ = inp(a, I_GB)[((l * 2 + I.dir) * 2 + 1) * 4 + I.head];
#pragma unroll
    for (int i = 0; i < 8; ++i) { const bf16_t* pr = P + (size_t)item_row(I, 8 * sg + i) * PN;
        li[i] = bf2f(pr[C_MIF + I.dir * 8 + I.head]) + bi; lf[i] = logsigf_(bf2f(pr[C_MIF + I.dir * 8 + 4 + I.head]) + bf_);
        if (NEEDQ) qv[i] = bf2f(pr[C_MQ + I.head * 64 + d]) * 0.125f; kv[i] = bf2f(pr[C_MK + I.head * 64 + d]); }
}
__device__ __forceinline__ bf16x8 ldfrag(const LAS bf16_t* T, int pitch, int row0, int k0, int lane) { return *(const LAS bf16x8*)(T + (row0 + (lane & 15)) * pitch + k0 + 8 * (lane >> 4)); }

struct Raw { bf16_t q[8], k[8], z[8]; unsigned g0, g1; float wup[16]; float p0, p1, nc, mc; u32x4 s0, s1; };
template <bool NEEDQ, bool NEEDS>
__device__ __forceinline__ void raw_load(const Args& a, const bf16_t* P, const ItemInfo& I, int l, int it, int tid, Raw& R) {
    const int d = tid & 63, lane = d, sg = __builtin_amdgcn_readfirstlane(tid >> 6), ch = I.head * 64 + d;
    const int qc = I.br == 0 ? C_MQ : (I.br == 1 ? C_GQ : C_HQ), kc = I.br == 0 ? C_MK : (I.br == 1 ? C_GK : C_HF + I.dir * 256);
#pragma unroll
    for (int i = 0; i < 8; ++i) { const bf16_t* pr = P + (size_t)item_row(I, 8 * sg + i) * PN;
        if (NEEDQ) R.q[i] = pr[qc + ch];
        R.k[i] = pr[kc + ch]; }
    if (I.br == 1) {
        R.g0 = P[(size_t)item_row(I, 8 * sg + (lane >> 4)) * PN + C_GLR + I.dir * 16 + (lane & 15)];
        R.g1 = P[(size_t)item_row(I, 8 * sg + 4 + (lane >> 4)) * PN + C_GLR + I.dir * 16 + (lane & 15)];
        const float* wp = inp(a, I_GWUP) + ((size_t)(l * 2 + I.dir) * 16) * 256 + ch;
#pragma unroll
        for (int r = 0; r < 16; ++r) R.wup[r] = wp[r * 256];
        R.p0 = inp(a, I_GLB)[(l * 2 + I.dir) * 256 + ch];
    } else if (I.br == 0) {
        R.g0 = P[(size_t)item_row(I, 8 * sg + (lane & 7)) * PN + C_MIF + I.dir * 8 + ((lane >> 3) & 1) * 4 + I.head];
        R.p0 = inp(a, I_GB)[((l * 2 + I.dir) * 2 + 0) * 4 + I.head]; R.p1 = inp(a, I_GB)[((l * 2 + I.dir) * 2 + 1) * 4 + I.head];
    } else R.p0 = lb_of(a, l, ch);
    if (NEEDS) { const bf16_t* US = (const bf16_t*)(a.ws + WS_BIG + BIG_US) + (size_t)it * 8192; const int e = tid >> 2, part = tid & 3;
        R.s0 = *(const u32x4*)(US + e * 64 + 16 * part); R.s1 = *(const u32x4*)(US + e * 64 + 16 * part + 8);
        if (I.br == 0) { R.nc = ((const float*)(a.ws + WS_DEC))[(size_t)it * 64 + d]; R.mc = ((const float*)(a.ws + WS_SC))[(size_t)it * 4 + 2]; } }
}
__device__ __forceinline__ float rl_bf(unsigned v, int ln) { return __uint_as_float(((unsigned)__builtin_amdgcn_readlane((int)v, ln)) << 16); }
template <bool NEEDQ>
__device__ __forceinline__ void gated_from_raw(const Raw& R, const ItemInfo& I, float (&qv)[8], float (&kv)[8], float (&la)[8]) {
    if (I.br == 1) {
#pragma unroll
        for (int i = 0; i < 8; ++i) { float z = R.p0; const unsigned src = i < 4 ? R.g0 : R.g1;
#pragma unroll
            for (int r = 0; r < 16; ++r) z += rl_bf(src, (i & 3) * 16 + r) * R.wup[r];
            la[i] = logsigf_(z) * (1.0f / 16.0f);
            if (NEEDQ) qv[i] = bf2f(R.q[i]) * 0.125f; kv[i] = bf2f(R.k[i]); }
    } else { const float lb = R.p0;
#pragma unroll
        for (int i = 0; i < 8; ++i) { const float z = bf2f(R.k[i]); const float sg_ = sigmoidf_(z);
            la[i] = (lb == 0.f) ? logsigf_(z) : __logf(lb + (1.0f - lb) * sg_);
            if (NEEDQ) qv[i] = bf2f(R.q[i]) * 1.0f;
            kv[i] = (1.0f - lb) * (1.0f - sg_); }
    }
}
template <bool NEEDQ>
__device__ __forceinline__ void mlstm_from_raw(const Raw& R, float (&qv)[8], float (&kv)[8], float (&lf)[8], float (&li)[8]) {
#pragma unroll
    for (int i = 0; i < 8; ++i) { li[i] = rl_bf(R.g0, i) + R.p0; lf[i] = logsigf_(rl_bf(R.g0, 8 + i) + R.p1);
        if (NEEDQ) qv[i] = bf2f(R.q[i]) * 0.125f; kv[i] = bf2f(R.k[i]); }
}
template <int SK>
__device__ __forceinline__ bf16x8 ldfragY(const LAS bf16_t* T, int pitch, int row0, int k0, int lane) { return *(const LAS bf16x8*)(T + (row0 + (lane & 15)) * pitch + (row0 >> 4) * SK + k0 + 8 * (lane >> 4)); }
__device__ __forceinline__ void v_load(const bf16_t* P, const ItemInfo& I, int tid, u32x4& v0, u32x4& v1) {
    const int s = tid >> 3, eg = tid & 7; const int vb = I.br == 0 ? C_MV : (I.br == 1 ? C_GV : C_HV);
    const bf16_t* pv = P + (size_t)item_row(I, s) * PN + vb + I.head * 128 + 16 * eg; v0 = *(const u32x4*)pv; v1 = *(const u32x4*)(pv + 8);
}
template <int SK>
__device__ __forceinline__ void v_store(int br, LAS bf16_t* Y, int pitch, int tid, const u32x4& v0, const u32x4& v1) {
    const int s = tid >> 3, eg = tid & 7; const unsigned wds[8] = {v0.x, v0.y, v0.z, v0.w, v1.x, v1.y, v1.z, v1.w};
#pragma unroll
    for (int i = 0; i < 8; ++i) { float x0 = bflo(wds[i]), x1 = bfhi(wds[i]); if (br == 2) { x0 = siluf_(x0); x1 = siluf_(x1); }
        Y[(16 * eg + 2 * i) * pitch + SK * eg + s] = (bf16_t)f2bf(x0); Y[(16 * eg + 2 * i + 1) * pitch + SK * eg + s] = (bf16_t)f2bf(x1); }
}

__device__ __forceinline__ void scan_s1(const Args& a, LAS unsigned char* lds, int l, int g, int it, const Raw& R, const u32x4& pv0, const u32x4& pv1) {
    int tid_ = threadIdx.x; asm volatile("" : "+v"(tid_)); const int tid = tid_, d = tid & 63, lane = d, sg = __builtin_amdgcn_readfirstlane(tid >> 6);
    const ItemInfo I = item_info(g, it);
    const bf16_t* P = (const bf16_t*)(a.ws + WS_BIG);
    bf16_t* US = (bf16_t*)(a.ws + WS_BIG + BIG_US) + (size_t)it * 8192;
    float* DEC = (float*)(a.ws + WS_DEC) + (size_t)it * 64; float* SC = (float*)(a.ws + WS_SC) + (size_t)it * 4;
    LAS bf16_t* XT = (LAS bf16_t*)lds;
    LAS bf16_t* YV = (LAS bf16_t*)(lds + 9216);
    LAS float* TOT = (LAS float*)(lds + 9216 + 20736 + 256);
    LAS float* TMX = TOT + 512;
    float qv[8], kv[8], x0[8], x1[8];
    if (I.br == 0) {
        mlstm_from_raw<false>(R, qv, kv, x0, x1);
        float run = 0.f;
#pragma unroll
        for (int i = 0; i < 8; ++i) { run += x0[i]; x0[i] = run; }
        TOT[sg * 64 + d] = run; LDS_WAIT(); __syncthreads();
        float pre = 0.f, tot = 0.f;
#pragma unroll
        for (int w = 0; w < 8; ++w) { const float t = TOT[w * 64 + d]; if (w < sg) pre += t; tot += t; }
        float mx = -3.0e38f;
#pragma unroll
        for (int i = 0; i < 8; ++i) { x0[i] = tot - (pre + x0[i]) + x1[i]; mx = fmaxf(mx, x0[i]); }
        TMX[sg * 64 + d] = mx; LDS_WAIT(); __syncthreads();
        float mlw = -3.0e38f;
#pragma unroll
        for (int w = 0; w < 8; ++w) mlw = fmaxf(mlw, TMX[w * 64 + d]);
#pragma unroll
        for (int i = 0; i < 8; ++i) kv[i] *= __expf(x0[i] - mlw);
        if (tid == 0) { SC[0] = mlw; SC[1] = tot; }
        for (int idx = tid; idx < 16 * 64; idx += 512) YV[(128 + (idx >> 6)) * 72 + 64 + (idx & 63)] = (bf16_t)((idx >> 6) == 0 ? 0x3F80 : 0);
    } else {
        gated_from_raw<false>(R, I, qv, kv, x0);
        float run = 0.f;
#pragma unroll
        for (int i = 0; i < 8; ++i) { run += x0[i]; x0[i] = run; }
        TOT[sg * 64 + d] = run; LDS_WAIT(); __syncthreads();
        float pre = 0.f, tot = 0.f;
#pragma unroll
        for (int w = 0; w < 8; ++w) { const float t = TOT[w * 64 + d]; if (w < sg) pre += t; tot += t; }
#pragma unroll
        for (int i = 0; i < 8; ++i) kv[i] *= __expf(tot - (pre + x0[i]));
        if (sg == 0) DEC[d] = __expf(tot);
    }
    { u32x4 w; w.x = pk2(kv[0], kv[1]); w.y = pk2(kv[2], kv[3]); w.z = pk2(kv[4], kv[5]); w.w = pk2(kv[6], kv[7]); *(LAS u32x4*)(XT + d * 72 + 8 * sg) = w; }
    v_store<8>(I.br, YV, 72, tid, pv0, pv1);
    LDS_WAIT(); __syncthreads();
    f32x4 acc[4];
#pragma unroll
    for (int mt = 0; mt < 4; ++mt) acc[mt] = (f32x4){0.f, 0.f, 0.f, 0.f};
#pragma unroll
    for (int ks = 0; ks < 2; ++ks) { const bf16x8 b = ldfragY<8>(YV, 72, 16 * sg, 32 * ks, lane);
#pragma unroll
        for (int mt = 0; mt < 4; ++mt) acc[mt] = __builtin_amdgcn_mfma_f32_16x16x32_bf16(ldfrag(XT, 72, 16 * mt, 32 * ks, lane), b, acc[mt], 0, 0, 0); }
    { const int e = 16 * sg + (lane & 15);
#pragma unroll
      for (int mt = 0; mt < 4; ++mt) { u32x2 o; o.x = pk2(acc[mt][0], acc[mt][1]); o.y = pk2(acc[mt][2], acc[mt][3]); *(u32x2*)(US + e * 64 + 16 * mt + 4 * (lane >> 4)) = o; } }
    if (I.br == 0 && sg < 4) {
        f32x4 an = (f32x4){0.f, 0.f, 0.f, 0.f};
#pragma unroll
        for (int ks = 0; ks < 2; ++ks) an = __builtin_amdgcn_mfma_f32_16x16x32_bf16(ldfrag(XT, 72, 16 * sg, 32 * ks, lane), ldfragY<8>(YV, 72, 128, 32 * ks, lane), an, 0, 0, 0);
        if ((lane & 15) == 0) { const int d0 = 16 * sg + 4 * (lane >> 4); DEC[d0] = an[0]; DEC[d0 + 1] = an[1]; DEC[d0 + 2] = an[2]; DEC[d0 + 3] = an[3]; }
    }
    __syncthreads();
}

template <int S2B>
__device__ __forceinline__ void scan_s2(const Args& a, int l, int g) {
    const int T = g < 2 ? 4096 : 256, NC = T >> 6, nseq = g < 2 ? 2 : 32, nslot = nseq * 24 * 1024;
    bf16_t* USb = (bf16_t*)(a.ws + WS_BIG + BIG_US); float* DECb = (float*)(a.ws + WS_DEC); float* SCb = (float*)(a.ws + WS_SC);
    int tid_ = threadIdx.x; asm volatile("" : "+v"(tid_));
    for (int slot = blockIdx.x * 512 + tid_; slot < nslot; slot += gridDim.x * 512) {
        const int sub = slot & 1023, stream = slot >> 10, hdb = stream % 24, seq = stream / 24, br = hdb >> 3, dir = (hdb >> 2) & 1, head = hdb & 3;
        const int e = sub >> 3, d0 = (sub & 7) * 8;
        float S[8], nst[8], mst = 0.f;
#pragma unroll
        for (int i = 0; i < 8; ++i) { S[i] = 0.f; nst[i] = 0.f; }
        if (g < 2) { const int b = g * 2 + seq; const size_t sidx = (size_t)((b * 2 + l) * 2 + dir) * 4 + head;
            const float* sp = (br == 0 ? inp(a, I_SC) : (br == 1 ? inp(a, I_SG) : inp(a, I_SH))) + sidx * 8192;
#pragma unroll
            for (int i = 0; i < 8; ++i) S[i] = sp[(d0 + i) * 128 + e];
            if (br == 0) { mst = inp(a, I_SM)[sidx];
#pragma unroll
                for (int i = 0; i < 8; ++i) nst[i] = inp(a, I_SN)[sidx * 64 + d0 + i]; } }
        const bool nrow = (br == 0) && (e == 0);
        for (int c0 = 0; c0 < NC; c0 += S2B) {
            u32x4 ub[S2B]; f32x4 q0[S2B], q1[S2B]; float m0[S2B], m1[S2B];
#pragma unroll
            for (int j = 0; j < S2B; ++j) { const size_t it = (size_t)(seq * NC + c0 + j) * 24 + hdb;
                ub[j] = *(const u32x4*)(USb + it * 8192 + e * 64 + d0);
                if (br == 0) { m0[j] = SCb[it * 4]; m1[j] = SCb[it * 4 + 1]; }
                if (br != 0 || nrow) { q0[j] = *(const f32x4*)(DECb + it * 64 + d0); q1[j] = *(const f32x4*)(DECb + it * 64 + d0 + 4); } }
#pragma unroll
            for (int j = 0; j < S2B; ++j) { const size_t it = (size_t)(seq * NC + c0 + j) * 24 + hdb;
                bf16_t* p = USb + it * 8192 + e * 64 + d0; float* dec = DECb + it * 64 + d0; float* sc = SCb + it * 4;
                const u32x4 u = ub[j];
                const float uu[8] = {bflo(u.x), bfhi(u.x), bflo(u.y), bfhi(u.y), bflo(u.z), bfhi(u.z), bflo(u.w), bfhi(u.w)};
                { u32x4 w; w.x = pk2(S[0], S[1]); w.y = pk2(S[2], S[3]); w.z = pk2(S[4], S[5]); w.w = pk2(S[6], S[7]); *(u32x4*)p = w; }
                if (br == 0) {
                    const float mlw = m0[j], bl = m1[j]; const float mn = fmaxf(bl + mst, mlw); const float fa = __expf(bl + mst - mn), fb = __expf(mlw - mn);
                    if (nrow) { const f32x4 n0 = q0[j], n1 = q1[j];
                        *(f32x4*)dec = (f32x4){nst[0], nst[1], nst[2], nst[3]}; *(f32x4*)(dec + 4) = (f32x4){nst[4], nst[5], nst[6], nst[7]};
                        const float nn[8] = {n0.x, n0.y, n0.z, n0.w, n1.x, n1.y, n1.z, n1.w};
#pragma unroll
                        for (int i = 0; i < 8; ++i) nst[i] = fa * nst[i] + fb * nn[i];
                        if (d0 == 0) sc[2] = mst; }
#pragma unroll
                    for (int i = 0; i < 8; ++i) S[i] = fa * S[i] + fb * uu[i];
                    mst = mn;
                } else {
                    const f32x4 a0 = q0[j], a1 = q1[j]; const float dd[8] = {a0.x, a0.y, a0.z, a0.w, a1.x, a1.y, a1.z, a1.w};
#pragma unroll
                    for (int i = 0; i < 8; ++i) S[i] = dd[i] * S[i] + uu[i];
                }
            }
        }
        if (g == 2) { const size_t sidx = (size_t)((seq * 2 + l) * 2 + dir) * 4 + head;
            float* op = a.out + (br == 0 ? OFF_C : (br == 1 ? OFF_G : OFF_H)) + sidx * 8192;
#pragma unroll
            for (int i = 0; i < 8; ++i) op[(d0 + i) * 128 + e] = S[i];
            if (nrow) {
#pragma unroll
                for (int i = 0; i < 8; ++i) a.out[OFF_N + sidx * 64 + d0 + i] = nst[i];
                if (d0 == 0) a.out[OFF_M + sidx] = mst; } }
    }
}

constexpr int S3_QO = 0, S3_KO = 23040, S3_G = 41472, S3_XA = 57856, S3_YV = 75264, S3_TOT = 114432 + 256, S3_VEC = 116480 + 256;
__device__ __forceinline__ void scan_s3(const Args& a, LAS unsigned char* lds, int l, int g, int it2, int it2n, Raw& Rc, u32x4& pv0, u32x4& pv1) {
    int tid_ = threadIdx.x; asm volatile("" : "+v"(tid_)); const int tid = tid_, d = tid & 63, lane = d, sg = __builtin_amdgcn_readfirstlane(tid >> 6);
    const int hb = it2 % 12, cgl = it2 / 12; ItemInfo I; I.br = hb >> 2; I.head = hb & 3; I.T = g < 2 ? 4096 : 256; I.NC = I.T >> 6; I.seq = cgl / I.NC; const int cn = cgl % I.NC; I.dir = 0; I.c = cn;
    const bf16_t* P = (const bf16_t*)(a.ws + WS_BIG);
    LAS bf16_t* QO = (LAS bf16_t*)(lds + S3_QO); LAS bf16_t* KO = (LAS bf16_t*)(lds + S3_KO); LAS float* G = (LAS float*)(lds + S3_G);
    LAS bf16_t* XA = (LAS bf16_t*)(lds + S3_XA); LAS bf16_t* YV = (LAS bf16_t*)(lds + S3_YV); LAS float* TOT = (LAS float*)(lds + S3_TOT);
    LAS float* Bv = (LAS float*)(lds + S3_VEC); LAS float* LIv = Bv + 64; LAS float* MT = Bv + 128; LAS float* EI = Bv + 192;
    v_store<8>(I.br, YV, 136, tid, pv0, pv1);
    ItemInfo In; { const int hbn = it2n % 12, cgn = it2n / 12; In.br = hbn >> 2; In.head = hbn & 3; In.T = I.T; In.NC = I.NC; In.seq = cgn / I.NC; In.c = cgn % I.NC; In.dir = 0; }
    v_load(P, In, tid, pv0, pv1);
    f32x4 osum[4];
#pragma unroll
    for (int nt = 0; nt < 4; ++nt) osum[nt] = (f32x4){0.f, 0.f, 0.f, 0.f};
    const int e0 = 16 * sg + 4 * (lane >> 4); const int gcol = (I.br == 0 ? C_MO : (I.br == 1 ? C_GR : C_HG)) + I.head * 128 + e0;
    u32x2 gts[4];
#pragma unroll
    for (int nt = 0; nt < 4; ++nt) gts[nt] = *(const u32x2*)(P + (size_t)(I.seq * I.T + 64 * cn + 16 * nt + (lane & 15)) * PN + gcol);
    const f32x4 hw = *(const f32x4*)(inp(a, I_HN) + (size_t)(l * 3 + I.br) * 512 + I.head * 128 + e0);
  for (int dir = 0; dir < 2; ++dir) {
    I.dir = dir; I.c = dir ? I.NC - 1 - cn : cn;
    const int it = (I.seq * I.NC + I.c) * 24 + I.br * 8 + dir * 4 + I.head;
#define RV(x) (dir ? 63 - (x) : (x))
    float qv[8], kv[8], x0[8], x1[8];
    const Raw R = Rc;
    { const int e = tid >> 2, part = tid & 3; *(LAS u32x4*)(YV + e * 136 + (e >> 4) * 8 + 64 + 16 * part) = R.s0; *(LAS u32x4*)(YV + e * 136 + (e >> 4) * 8 + 64 + 16 * part + 8) = R.s1; }
    { ItemInfo It = dir ? In : I; if (!dir) { It.dir = 1; It.c = I.NC - 1 - cn; }
      const int itt = (It.seq * It.NC + It.c) * 24 + It.br * 8 + It.dir * 4 + It.head;
      raw_load<true, true>(a, P, It, l, itt, tid, Rc); }
    const int bi = sg >> 1;
    f32x4 acc[4];
#pragma unroll
    for (int nt = 0; nt < 4; ++nt) acc[nt] = (f32x4){0.f, 0.f, 0.f, 0.f};
    if (I.br != 0) {
        gated_from_raw<true>(R, I, qv, kv, x0);
        float run = 0.f;
#pragma unroll
        for (int i = 0; i < 8; ++i) { run += x0[i]; x0[i] = run; }
        TOT[sg * 64 + d] = run; LDS_WAIT(); __syncthreads();
        float pre = 0.f, gs = 0.f, geo = 0.f, gej[3] = {0.f, 0.f, 0.f};
#pragma unroll
        for (int w = 0; w < 8; ++w) { const float t = TOT[w * 64 + d]; if (w < sg) pre += t; if (w < 2 * bi) gs += t; if (w < 2 * bi + 2) geo += t;
            if (w < 2) gej[0] += t; if (w < 4) gej[1] += t; if (w < 6) gej[2] += t; }
#pragma unroll
        for (int i = 0; i < 8; ++i) { x0[i] += pre; const int s = 8 * sg + i; XA[RV(s) * 136 + 64 + d] = (bf16_t)f2bf(qv[i] * __expf(x0[i])); }
        float dfac[2];
#pragma unroll
        for (int j = 0; j < 2; ++j) dfac[j] = __expf(fminf(gs - gej[j], 0.f));
#pragma unroll
        for (int i = 0; i < 8; ++i) { const int tt = 8 * (sg & 1) + i;
            QO[(6 + bi) * 1152 + tt * 72 + d] = (bf16_t)f2bf(qv[i] * __expf(x0[i] - gs));
            KO[(4 + bi) * 1152 + tt * 72 + d] = (bf16_t)f2bf(kv[i] * __expf(fminf(gs - x0[i], 80.f)));
            if (bi < 3) KO[bi * 1152 + tt * 72 + d] = (bf16_t)f2bf(kv[i] * __expf(geo - x0[i]));
            const float qd = qv[i] * __expf(x0[i] - gs);
#pragma unroll
            for (int j = 0; j < 2; ++j) if (j + 1 < bi) QO[(bi * (bi - 1) / 2 + j) * 1152 + tt * 72 + d] = (bf16_t)f2bf(qd * dfac[j]); }
        LDS_WAIT(); __syncthreads();
#pragma unroll
        for (int jj = 0; jj < 2; ++jj) { const int j = 2 * (sg & 1) + jj; f32x4 t = (f32x4){0.f, 0.f, 0.f, 0.f};
            if (j <= bi) { const int qt = (j + 1 >= bi) ? 6 + bi : bi * (bi - 1) / 2 + j, kt = (j == bi) ? 4 + bi : j;
#pragma unroll
                for (int ks = 0; ks < 2; ++ks) t = __builtin_amdgcn_mfma_f32_16x16x32_bf16(ldfrag(QO + qt * 1152, 72, 0, 32 * ks, lane), ldfrag(KO + kt * 1152, 72, 0, 32 * ks, lane), t, 0, 0, 0); }
#pragma unroll
            for (int r = 0; r < 4; ++r) { const int tl = 4 * (lane >> 4) + r, sl = lane & 15; float v = t[r]; if (j == bi && sl > tl) v = 0.f;
                XA[RV(16 * bi + tl) * 136 + RV(16 * j + sl)] = (bf16_t)f2bf(v); } }
        LDS_WAIT(); __syncthreads();
    } else {
        mlstm_from_raw<true>(R, qv, kv, x0, x1);
        float run = 0.f;
#pragma unroll
        for (int i = 0; i < 8; ++i) { run += x0[i]; x0[i] = run; }
        TOT[sg * 64 + d] = run;
        for (int idx = tid; idx < 16 * 128; idx += 512) { const int r = idx >> 7, k = idx & 127; YV[(128 + r) * 136 + 64 + k] = (bf16_t)(r == 0 ? (k < 64 ? 0x3F80u : 0u) : 0u); }
        LDS_WAIT(); __syncthreads();
        float pre = 0.f;
#pragma unroll
        for (int w = 0; w < 8; ++w) { const float t = TOT[w * 64 + d]; if (w < sg) pre += t; }
#pragma unroll
        for (int i = 0; i < 8; ++i) { x0[i] += pre; const int s = 8 * sg + i; if (d == 0) { Bv[s] = x0[i]; LIv[s] = x1[i]; }
            if (i == 0 && sg == 1) YV[128 * 136 + 64 + 64 + d] = (bf16_t)f2bf(R.nc);
            QO[s * 72 + d] = (bf16_t)f2bf(qv[i]); KO[s * 72 + d] = (bf16_t)f2bf(kv[i]); }
        LDS_WAIT(); __syncthreads();
        if (tid < 64) { float rn = LIv[tid] - Bv[tid];
#pragma unroll
            for (int off = 1; off < 64; off <<= 1) { const float u = __shfl_up(rn, off); if (tid >= off) rn = fmaxf(rn, u); }
            const float bt = Bv[tid], inter = bt + R.mc, mt = fmaxf(inter, bt + rn); MT[RV(tid)] = mt; EI[RV(tid)] = __expf(inter - mt); }
        f32x4 t2[2];
#pragma unroll
        for (int jj = 0; jj < 2; ++jj) { const int j = 2 * (sg & 1) + jj; t2[jj] = (f32x4){0.f, 0.f, 0.f, 0.f};
            if (j <= bi) {
#pragma unroll
                for (int ks = 0; ks < 2; ++ks) t2[jj] = __builtin_amdgcn_mfma_f32_16x16x32_bf16(ldfrag(QO, 72, 16 * bi, 32 * ks, lane), ldfrag(KO, 72, 16 * j, 32 * ks, lane), t2[jj], 0, 0, 0); } }
        LDS_WAIT(); __syncthreads();
#pragma unroll
        for (int jj = 0; jj < 2; ++jj) { const int j = 2 * (sg & 1) + jj;
#pragma unroll
            for (int r = 0; r < 4; ++r) { const int t = 16 * bi + 4 * (lane >> 4) + r, s = 16 * j + (lane & 15); float v = 0.f;
                if (s <= t) v = t2[jj][r] * __expf(Bv[t] - Bv[s] + LIv[s] - MT[RV(t)]);
                XA[RV(t) * 136 + RV(s)] = (bf16_t)f2bf(v); } }
#pragma unroll
        for (int i = 0; i < 8; ++i) { const int s = 8 * sg + i; XA[RV(s) * 136 + 64 + d] = (bf16_t)f2bf(qv[i] * EI[RV(s)]); }
        LDS_WAIT(); __syncthreads();
    }
    f32x4 accd[4];
#pragma unroll
    for (int nt = 0; nt < 4; ++nt) accd[nt] = (f32x4){0.f, 0.f, 0.f, 0.f};
#pragma unroll
    for (int ks = 0; ks < 4; ++ks) { const bf16x8 av = ldfragY<8>(YV, 136, 16 * sg, 32 * ks, lane);
        bf16x8 ad = av; if (I.br == 0) ad = ldfragY<8>(YV, 136, 128, 32 * ks, lane);
#pragma unroll
        for (int nt = 0; nt < 4; ++nt) { const bf16x8 bx = ldfrag(XA, 136, 16 * nt, 32 * ks, lane);
            acc[nt] = __builtin_amdgcn_mfma_f32_16x16x32_bf16(av, bx, acc[nt], 0, 0, 0);
            if (I.br == 0) accd[nt] = __builtin_amdgcn_mfma_f32_16x16x32_bf16(ad, bx, accd[nt], 0, 0, 0); } }
#pragma unroll
    for (int nt = 0; nt < 4; ++nt) { const int t = 16 * nt + (lane & 15); f32x4 o = acc[nt];
        if (I.br == 0) { const float den = __shfl(accd[nt][0], lane & 15); const float dn = fmaxf(fabsf(den), __expf(-MT[t])); o = o * __builtin_amdgcn_rcpf(dn); }
        osum[nt] = osum[nt] + o; }
    __syncthreads();
#undef RV
  }
    LAS float* RED = TOT;
#pragma unroll
    for (int nt = 0; nt < 4; ++nt) { float ss = (osum[nt][0] * osum[nt][0] + osum[nt][1] * osum[nt][1]) + (osum[nt][2] * osum[nt][2] + osum[nt][3] * osum[nt][3]);
        ss += __shfl_xor(ss, 16); ss += __shfl_xor(ss, 32);
        if (lane < 16) RED[sg * 64 + 16 * nt + lane] = ss; }
    LDS_WAIT(); __syncthreads();
    bf16_t* YSo = (bf16_t*)(a.ws + WS_A) + (size_t)g * GROWS * 1536;
#pragma unroll
    for (int nt = 0; nt < 4; ++nt) { const int t = 16 * nt + (lane & 15); float tot = 0.f;
#pragma unroll
        for (int w = 0; w < 8; ++w) tot += RED[w * 64 + t];
        const float rr = rsqrtf(tot * (1.0f / 128.0f) + EPSN);
        const int lr = I.seq * I.T + 64 * cn + t;
        const u32x2 gt = gts[nt];
        const float gv[4] = {bflo(gt.x), bfhi(gt.x), bflo(gt.y), bfhi(gt.y)}; float y[4];
#pragma unroll
        for (int r = 0; r < 4; ++r) { const float gg = I.br == 0 ? sigmoidf_(gv[r]) : siluf_(gv[r]); y[r] = gg * (osum[nt][r] * rr) * hw[r]; }
        u32x2 w; w.x = pk2(y[0], y[1]); w.y = pk2(y[2], y[3]);
        *(u32x2*)(YSo + (size_t)lr * 1536 + I.br * 512 + I.head * 128 + e0) = w; }
    __syncthreads();
}


enum { ST_F1IN = 0, ST_F1OUT = 1, ST_ROWA = 2, ST_G0 = 3, ST_BR = 15, ST_MG = 16, ST_OUT = 17, ST_ROWB = 18, ST_F2IN = 19, ST_F2OUT = 20, ST_ROWC = 21, NST = 22 };
#ifndef REP_S1
#define REP_S1 1
#endif
#ifndef REP_S3
#define REP_S3 1
#endif
#ifndef REP_G
#define REP_G 1
#endif
template <int M_, int N_, int K_, int LDA_, int LDB_, int ADIV, int AMUL, int KS, class Epi>
__device__ __forceinline__ void run_gemm(LAS unsigned char* lds, const bf16_t* A, const bf16_t* Bt, const Epi& E) {
    typedef pg8::GemmT<M_, N_, K_, LDA_, LDB_> GT; GT g{A, Bt}; typedef pg8::StaticOrderT<M_, N_, ADIV, AMUL, KS> SO; SO S; S.init((int)gridDim.x, (int)blockIdx.x);
    pg8::gemm_phase<GT, Epi, SO, true, true>((PG8_LAS unsigned char*)lds, g, S, E);
}

__global__ void __launch_bounds__(512, 2) mk_fwd(Args a) {
    extern __shared__ __attribute__((aligned(16))) unsigned char lds_raw[];
    LAS unsigned char* lds = (LAS unsigned char*)lds_raw;
    cg::grid_group grid = cg::this_grid();
    for (int u = threadIdx.x; u < (LDS_BYTES - 131072) / 4; u += 512) ((LAS unsigned*)(lds + 131072))[u] = 0u;
    __syncthreads();
    (void)xcd_barrier_post((unsigned*)a.ws, (volatile LAS unsigned*)(lds + 131072 + 352));
    const int tid = threadIdx.x, lane = tid & 63, wave = __builtin_amdgcn_readfirstlane(tid >> 6);
    const int G = gridDim.x, gw = blockIdx.x * 8 + wave, NGW = G * 8;
    unsigned char* ws = a.ws;
    float* mod = (float*)(ws + WS_MOD);

#ifndef SKIP_PRO
#ifdef SPIN_MASK
    const unsigned long long pro_t0 = __builtin_amdgcn_s_memrealtime();
#endif
    convert_weights(a, lds, 0, 0, 13728, 1, gw, NGW, lane, wave);
    __syncthreads();
    ada_partial(a, lds, gw, NGW, lane, wave);
    { float* pos = (float*)(ws + WS_POS);
      for (int i = blockIdx.x * 512 + tid; i < 64 * 512; i += G * 512) { const int v = i >> 9, j = i & 511, fi = j & 255;
          const float fr = expf((-9.210340371976184f * (float)fi) / 256.0f); const float ang = (float)v * fr; pos[i] = j < 256 ? sinf(ang) : cosf(ang); } }
    if (a.ws == nullptr) grid.sync();
    xcd_barrier_ni((unsigned*)a.ws, 131072 + 352);
    { const float* modp = (const float*)(ws + WS_MODP);
      for (int i = blockIdx.x * 512 + tid; i < 2 * 5 * 9216; i += G * 512) { const int col = i % 9216, l = i / (5 * 9216); float s = inp(a, I_BADA)[l * 9216 + col];
#pragma unroll
          for (int ks = 0; ks < 8; ++ks) s += modp[(size_t)ks * (2 * 5 * 9216) + i]; mod[i] = s; } }
    xcd_barrier_ni((unsigned*)a.ws, 131072 + 352);
    { RowOp op{}; op.src_input = 1; op.has_y = 0; op.has_xn = 1; op.npre = inp(a, I_NPRE); op.md_base = mod; op.si = 0; op.add_pos = 0;
      rowwise_all(a, op, gw, NGW, lane); }
    xcd_barrier_ni((unsigned*)a.ws, 131072 + 352);
#ifdef SPIN_MASK
    if ((SPIN_MASK >> 10) & 1) { const unsigned long long t1 = __builtin_amdgcn_s_memrealtime(); while (__builtin_amdgcn_s_memrealtime() - t1 < t1 - pro_t0) __builtin_amdgcn_s_sleep(4); }
#endif
#endif

    for (int l = 0; l < 2; ++l) {
        for (int st = 0; st < NST; ++st) {
            int tid = threadIdx.x; asm volatile("" : "+v"(tid));
            const int lane = tid & 63, wave = __builtin_amdgcn_readfirstlane(tid >> 6), gw = blockIdx.x * 8 + wave;
            unsigned char* ws = a.ws; asm volatile("" : "+s"(ws));
            float* mod = (float*)(ws + WS_MOD); const float* modl = mod + (size_t)l * 5 * 9216;
            bf16_t* XN = (bf16_t*)(ws + WS_XN); bf16_t* BIG = (bf16_t*)(ws + WS_BIG); float* Y = (float*)(ws + WS_A); bf16_t* YS = (bf16_t*)(ws + WS_A);
            unsigned char* wb = ws + WS_W; const int G = gridDim.x, NGW = G * 8;
            const int kind = (st == ST_F1IN || st == ST_F2IN) ? 0 : (st == ST_F1OUT || st == ST_OUT || st == ST_F2OUT) ? 1 : (st == ST_ROWA || st == ST_ROWB || st == ST_ROWC) ? 2 : (st == ST_BR) ? 3 : (st == ST_MG) ? 4 : 5 + ((st - ST_G0) % 4);
            const int g = (st >= ST_G0 && st < ST_BR) ? (st - ST_G0) / 4 : 0;
#ifdef SPIN_MASK
            const unsigned long long spin_t0 = __builtin_amdgcn_s_memrealtime();
#endif
            switch (kind) {
            case 0: {
#ifndef SKIP_G0
                const int f = st == ST_F1IN ? 0 : 1; EpiSwiGLU E{BIG, DFF};
                for (int rep = 0; rep < REP_G; ++rep) run_gemm<MTOT, NFF2, D, D, D, 0, 0, 1>(lds, XN, (const bf16_t*)(wb + W_FFIN) + (size_t)f * NFF2 * D, E);
                if (blockIdx.x >= 64) { const int vw = (blockIdx.x - 64) * 8 + wave, vn = (G - 64) * 8;
                    if (l == 0 && st == ST_F2IN) convert_weights(a, lds, 1, 8448, 13728, 1, vw, vn, lane, wave);
                    if (l == 1 && st == ST_F1IN) { convert_weights(a, lds, 1, 2816, 5632, 0, vw, vn, lane, wave); convert_weights(a, lds, 1, 7040, 8448, 0, vw, vn, lane, wave); } }
#endif
                break; }
            case 1: {
#ifndef SKIP_G1
                EpiBf16 E{(bf16_t*)Y, D, 4, (size_t)MTOT * D};
                for (int rep = 0; rep < REP_G; ++rep)
                if (st == ST_OUT) { EpiBf16 E1{(bf16_t*)Y, D, 0, 0}; run_gemm<MTOT, D, D, 3072, 3072, 0, 0, 1>(lds, BIG, (const bf16_t*)(wb + W_O3), E1); }
                else run_gemm<MTOT, 2 * D, DFF / 2, DFF, DFF, 4, DFF / 2, 2>(lds, BIG, (const bf16_t*)(wb + W_FFOUT) + (size_t)(st == ST_F1OUT ? 0 : 1) * D * DFF, E);
#endif
                break; }
            case 2: {
#ifndef SKIP_ROW
                RowOp op{}; op.has_y = 1; op.ysplit = (st == ST_ROWB) ? 0 : 1; op.mdg_base = modl + (st == ST_ROWA ? 2 : st == ST_ROWB ? 5 : 8) * D; op.coef = st == ST_ROWB ? 1.0f : 0.5f;
                op.npost = inp(a, I_NPOST) + (size_t)(l * 3 + (st == ST_ROWA ? 0 : st == ST_ROWB ? 1 : 2)) * D; op.src_input = (l == 0 && st == ST_ROWA) ? 1 : 0;
                if (st == ST_ROWA) { op.has_xn = 1; op.npre = inp(a, I_NPRE) + (size_t)(l * 3 + 1) * D; op.md_base = modl; op.si = 3; op.add_pos = 1; }
                else if (st == ST_ROWB) { op.has_xn = 1; op.npre = inp(a, I_NPRE) + (size_t)(l * 3 + 2) * D; op.md_base = modl; op.si = 6; op.add_pos = 0; }
                else { op.has_xn = (l == 0) ? 1 : 0; op.npre = inp(a, I_NPRE) + (size_t)3 * D; op.md_base = mod + (size_t)5 * 9216; op.si = 0; op.add_pos = 0; }
                rowwise_all(a, op, gw, NGW, lane);
#endif
                break; }
            case 3: {
#ifndef SKIP_G3
                EpiBf16 E{BIG, 3072, 0, 0};
                for (int rep = 0; rep < REP_G; ++rep) run_gemm<MTOT, 3072, 512, 1536, 512, 4, 512, 1>(lds, YS, (const bf16_t*)(wb + W_B), E);
#endif
                break; }
            case 4: {
#ifndef SKIP_G4
                EpiGateSum E{BIG, 3072};
                { typedef pg8::GemmT<MTOT, MGN, D, D, D> GT3; GT3 g3{XN, (const bf16_t*)(wb + W_MG)}; pg8::TripleOrder S3{(int)gridDim.x, (int)blockIdx.x};
                  pg8::gemm_phase<GT3, EpiGateSum, pg8::TripleOrder, true, true>((PG8_LAS unsigned char*)lds, g3, S3, E); }
#endif
                break; }
            case 5: {
#ifndef SKIP_G3
                EpiBf16 E{BIG, PN, 0, 0};
                for (int rep = 0; rep < REP_G; ++rep) run_gemm<GROWS, PN, D, D, D, 0, 0, 1>(lds, XN + (size_t)g * GROWS * D, (const bf16_t*)(wb + W_P), E);
                if (l == 0 && blockIdx.x >= 128 && g < 2) { const int vw = (blockIdx.x - 128) * 8 + wave, vn = (G - 128) * 8;
                    if (g == 0) convert_weights(a, lds, 1, 0, 2816, 0, vw, vn, lane, wave); else convert_weights(a, lds, 1, 5632, 7040, 0, vw, vn, lane, wave); }
#endif
                break; }
            case 6: {
#ifndef SKIP_S1
                { const bf16_t* Pp = (const bf16_t*)(ws + WS_BIG); Raw R = {}; u32x4 v0 = {0u, 0u, 0u, 0u}, v1 = v0; int it = blockIdx.x;
                  { const int itc = it < 3072 ? it : 3071; const ItemInfo I0 = item_info(g, itc); raw_load<false, false>(a, Pp, I0, l, itc, tid, R); v_load(Pp, I0, tid, v0, v1); }
                  for (; it < 3072; it += G) { const int itn = it + G < 3072 ? it + G : 3071; Raw Rn = {}; u32x4 vn0, vn1;
                      { const ItemInfo I1 = item_info(g, itn); raw_load<false, false>(a, Pp, I1, l, itn, tid, Rn); v_load(Pp, I1, tid, vn0, vn1); }
                      scan_s1(a, lds, l, g, it, R, v0, v1); R = Rn; v0 = vn0; v1 = vn1; } }
#endif
                break; }
            case 7: {
#ifndef SKIP_S2
                if (g < 2) scan_s2<8>(a, l, g); else scan_s2<4>(a, l, g);
#endif
                break; }
            case 8: {
#ifndef SKIP_S3
                { const bf16_t* Pp = (const bf16_t*)(ws + WS_BIG); Raw R = {}; u32x4 v0 = {0u, 0u, 0u, 0u}, v1 = v0; int it = blockIdx.x;
                  { const int itc = it < 1536 ? it : 1535; const int hb = itc % 12, cgl = itc / 12; ItemInfo I0; I0.br = hb >> 2; I0.head = hb & 3; I0.T = g < 2 ? 4096 : 256; I0.NC = I0.T >> 6; I0.seq = cgl / I0.NC; I0.c = cgl % I0.NC; I0.dir = 0;
                    raw_load<true, true>(a, Pp, I0, l, (I0.seq * I0.NC + I0.c) * 24 + I0.br * 8 + I0.head, tid, R); v_load(Pp, I0, tid, v0, v1); }
                  for (; it < 1536; it += G) { const int itn = it + G < 1536 ? it + G : 1535; scan_s3(a, lds, l, g, it, itn, R, v0, v1); } }
#endif
                break; }
            default: break;
            }
#ifdef SPIN_MASK
            if ((SPIN_MASK >> kind) & 1) { const unsigned long long t1 = __builtin_amdgcn_s_memrealtime(); while (__builtin_amdgcn_s_memrealtime() - t1 < t1 - spin_t0) __builtin_amdgcn_s_sleep(4); }
#endif
#ifdef BAR_PROBE
            if (st != ST_BR) { unsigned long long* la = (unsigned long long*)(a.ws + 8192);
                asm volatile("s_waitcnt vmcnt(0)" ::: "memory"); __syncthreads();
                if (threadIdx.x == 0) __hip_atomic_fetch_max(la, (unsigned long long)__builtin_amdgcn_s_memrealtime(), __ATOMIC_RELAXED, __HIP_MEMORY_SCOPE_AGENT);
                xcd_barrier_ni((unsigned*)a.ws, 131072 + 352);
                const unsigned long long tr = __builtin_amdgcn_s_memrealtime(), tl = __hip_atomic_load(la, __ATOMIC_RELAXED, __HIP_MEMORY_SCOPE_AGENT);
                while (__builtin_amdgcn_s_memrealtime() - tr < tr - tl) __builtin_amdgcn_s_sleep(2);
                __syncthreads(); } else {
#else
            if (true) xcd_barrier_ni((unsigned*)a.ws, 131072 + 352); else {
#endif
            asm volatile("s_waitcnt vmcnt(0)" ::: "memory"); __syncthreads(); }
#ifdef EXTRA_SYNC
            xcd_barrier_ni((unsigned*)a.ws, 131072 + 352);
#endif
        }
    }
}

extern "C" void kernel_launch(void* const* d_in, const int* in_sizes, int n_in, void* d_out, int out_size, void* d_ws, size_t ws_size, hipStream_t stream) {
    static int grid = 0;
    if (grid == 0) {
        if (n_in != 23 || ws_size < WS_END) { fprintf(stderr, "kernel_launch: unexpected n_in %d / ws_size %zu (need %zu)\n", n_in, ws_size, (size_t)WS_END); grid = -1; return; }
        int dev = 0, cus = 0, per_cu = 0;
        hipGetDevice(&dev); hipDeviceGetAttribute(&cus, hipDeviceAttributeMultiprocessorCount, dev);
        hipFuncSetAttribute((const void*)mk_fwd, hipFuncAttributeMaxDynamicSharedMemorySize, LDS_BYTES);
        hipOccupancyMaxActiveBlocksPerMultiprocessor(&per_cu, (const void*)mk_fwd, 512, LDS_BYTES);
        (void)hipGetLastError();
        if (per_cu < 1) per_cu = 1;
        grid = cus;
    }
    if (grid < 0) return;
    if (hipMemsetAsync(d_ws, 0, 16384, stream) != hipSuccess) { fprintf(stderr, "memset failed\n"); return; }
    Args a{};
    for (int i = 0; i < 23; ++i) a.in[i] = (const float*)d_in[i];
    a.out = (float*)d_out; a.ws = (unsigned char*)d_ws;
    void* args[] = {&a};
    hipError_t e = hipLaunchCooperativeKernel((const void*)mk_fwd, dim3(grid), dim3(512), args, LDS_BYTES, stream);
    if (e != hipSuccess) fprintf(stderr, "cooperative launch failed: %s (grid %d)\n", hipGetErrorString(e), grid);
}
```

```cpp
#include <hip/hip_runtime.h>
#include <hip/hip_cooperative_groups.h>
#include <cstdio>
#include <cstdint>
namespace cg = cooperative_groups;

namespace pg8 {
#define PG8_LAS __attribute__((address_space(3)))
typedef unsigned short bf16_t;
typedef short bf16x8 __attribute__((ext_vector_type(8)));
typedef float f32x4 __attribute__((ext_vector_type(4)));
typedef unsigned u32x4 __attribute__((ext_vector_type(4)));
typedef unsigned u32x2 __attribute__((ext_vector_type(2)));
constexpr int BM = 256, BK = 64, HALF = 128, HTB = HALF * BK * 2, STAGE_BYTES = 8 * HTB, NXCD = 8, WGM = 8;

__host__ __device__ __forceinline__ int lds_byte(int r, int c) { const int st = (r >> 4) * 2 + (c >> 5), rr = r & 15, cc = c & 31, ob = rr * 64 + cc * 2; return st * 1024 + (ob ^ (((ob >> 9) & 1) << 5)); }
__host__ __device__ __forceinline__ void stage_rc(int b, int& R, int& C) { const int st = b / 1024, sb = b % 1024, swz = sb ^ (((sb >> 9) & 1) << 5); R = (st >> 1) * 16 + swz / 64; C = (st & 1) * 32 + (swz % 64) / 2; }
__host__ __device__ __forceinline__ int perm32(int rho) { const int n = rho >> 4, i = rho & 15; return 8 * (i >> 2) + 4 * n + (i & 3); }

struct Unit { int pm, pn; };
template <int M_, int N_, int K_, int LDA_, int LDB_> struct GemmT { const bf16_t* A; const bf16_t* Bt; static constexpr int M = M_, N = N_, K = K_, lda = LDA_, ldb = LDB_; };

struct TripleOrder {
    int G, c;
    __device__ __forceinline__ bool next(int i, Unit& u) const { const int tr = c + G * (i / 3); if (tr >= 384) return false; u.pm = tr >> 2; u.pn = (i % 3) * 4 + (tr & 3); return true; }
    __device__ __forceinline__ int a_off(const Unit&) const { return 0; }
    __device__ __forceinline__ int b_tile(const Unit& u) const { return u.pn; }
    __device__ __forceinline__ int b_koff(const Unit&) const { return 0; }
    __device__ __forceinline__ void a_ready(const Unit&) const {}
    __device__ __forceinline__ void done(const Unit&) const {}
};
template <int M_, int N_, int ADIV, int AMUL, int KS = 1> struct StaticOrderT {
    static constexpr int nM = M_ / BM, nN = N_ / BM, nwg = nM * nN;
    int G, c;
    __device__ void init(int G_, int c_) { G = G_; c = c_; }
    __device__ __forceinline__ bool next(int i, Unit& u) const {
        const int L = i * G + c; if (L >= nwg) return false;
        int wgid = L; { constexpr int q = nwg / NXCD, r = nwg % NXCD; const int xcd = wgid % NXCD, off = wgid / NXCD; wgid = (xcd < r ? xcd * (q + 1) : r * (q + 1) + (xcd - r) * q) + off; }
        constexpr int nig = WGM * nN; const int gid = wgid / nig, fm = gid * WGM, gsz = (nM - fm) < WGM ? (nM - fm) : WGM;
        u.pm = fm + ((wgid % nig) % gsz); u.pn = (wgid % nig) / gsz; return true;
    }
    __device__ __forceinline__ int a_off(const Unit& u) const { return ADIV > 0 ? (u.pn / (ADIV > 0 ? ADIV : 1)) * AMUL : 0; }
    __device__ __forceinline__ int b_tile(const Unit& u) const { return KS > 1 ? u.pn % (nN / KS) : u.pn; }
    __device__ __forceinline__ int b_koff(const Unit& u) const { return KS > 1 ? (u.pn / (nN / KS)) * AMUL : 0; }
    __device__ __forceinline__ void a_ready(const Unit&) const {}
    __device__ __forceinline__ void done(const Unit&) const {}
};

template <class GT, class Epi, class Sched, bool ALIGN_EPI = false, bool SP2 = false>
__device__ __forceinline__ void gemm_phase(PG8_LAS unsigned char* lds, const GT g, const Sched& S, const Epi& E) {
    int tid_ = threadIdx.x; asm volatile("" : "+v"(tid_));
    const int tid = tid_, wid = __builtin_amdgcn_readfirstlane(tid >> 6), lane = tid & 63, wr = wid >> 2, wc = wid & 3, fr = lane & 15, fq = lane >> 4;
    constexpr int K = GT::K, nt = K / BK;
    unsigned voffA[2], voffB[2];
#pragma unroll
    for (int i = 0; i < 2; ++i) { int R, C; stage_rc(tid * 16 + i * 8192, R, C); const int Rb = Epi::PERM ? ((R & ~31) + perm32(R & 31)) : R;
        voffA[i] = (unsigned)(R * GT::lda + C) * 2u; voffB[i] = (unsigned)(Rb * GT::ldb + C) * 2u; }
    constexpr size_t kstep = (size_t)(BK * 2);
    constexpr size_t hstepA = (size_t)HALF * GT::lda * 2, hstepB = (size_t)HALF * GT::ldb * 2;
    constexpr size_t tstepA = 2 * hstepA, tstepB = 2 * hstepB;
    const unsigned ldsw = (unsigned)wid * 1024u;
    const int aoff = lds_byte(wr * 64 + fr, fq * 8), boff = lds_byte(wc * 32 + fr, fq * 8);
#define PG8_SA(b, h) (((b) * 2 + (h)) * HTB)
#define PG8_SB(b, h) ((4 + (b) * 2 + (h)) * HTB)
#define PG8_STAGE(bufoff, gbase, voff) do { _Pragma("unroll") for (int _i = 0; _i < 2; ++_i) \
        __builtin_amdgcn_global_load_lds((const unsigned*)((const char*)(gbase) + (voff)[_i]), (PG8_LAS unsigned*)(lds + (bufoff) + ldsw + _i * 8192), 16, 0, 0); } while (0)
#define PG8_LDA(dst, b, h) do { _Pragma("unroll") for (int m = 0; m < 4; ++m) _Pragma("unroll") for (int k = 0; k < 2; ++k) dst[m][k] = *(const PG8_LAS bf16x8*)(lds + PG8_SA(b, h) + aoff + m * 2048 + k * 1024); } while (0)
#define PG8_LDB(dst, b, h) do { _Pragma("unroll") for (int n = 0; n < 2; ++n) _Pragma("unroll") for (int k = 0; k < 2; ++k) dst[n][k] = *(const PG8_LAS bf16x8*)(lds + PG8_SB(b, h) + boff + n * 2048 + k * 1024); } while (0)
#define PG8_MMA(ai, bj, At, Bt) do { __builtin_amdgcn_s_setprio(1); _Pragma("unroll") for (int m = 0; m < 4; ++m) _Pragma("unroll") for (int n = 0; n < 2; ++n) _Pragma("unroll") for (int k = 0; k < 2; ++k) \
        acc[ai][bj][m][n] = __builtin_amdgcn_mfma_f32_16x16x32_bf16(Bt[n][k], At[m][k], acc[ai][bj][m][n], 0, 0, 0); __builtin_amdgcn_s_setprio(0); } while (0)
#define PG8_WAIT_V(n) asm volatile("s_waitcnt vmcnt(" #n ")" ::: "memory")
#define PG8_WAIT_L(n) asm volatile("s_waitcnt lgkmcnt(" #n ")" ::: "memory")
#define PG8_BAR __builtin_amdgcn_s_barrier()
#define PG8_SCHED __builtin_amdgcn_sched_barrier(0)
    Unit cur, nxt; int ui = 0;
    if (!S.next(0, cur)) return;
    f32x4 acc[2][2][4][2];
#pragma unroll
    for (int a = 0; a < 2; ++a)
#pragma unroll
        for (int b = 0; b < 2; ++b)
#pragma unroll
            for (int m = 0; m < 4; ++m)
#pragma unroll
                for (int n = 0; n < 2; ++n) acc[a][b][m][n] = (f32x4){0.f, 0.f, 0.f, 0.f};
    bf16x8 At[4][2], B0[2][2], B1[2][2];
    const char* cA = (const char*)g.A + (size_t)cur.pm * tstepA + (size_t)S.a_off(cur) * 2; const char* cB = (const char*)g.Bt + (size_t)S.b_tile(cur) * tstepB + (size_t)S.b_koff(cur) * 2;
    S.a_ready(cur);
    if constexpr (SP2) {
        PG8_STAGE(PG8_SB(0, 0), cB, voffB); PG8_STAGE(PG8_SB(0, 1), cB + hstepB, voffB); PG8_STAGE(PG8_SA(0, 0), cA, voffA); PG8_STAGE(PG8_SA(0, 1), cA + hstepA, voffA);
        if (wr == 1) PG8_BAR;
        PG8_WAIT_V(2); PG8_BAR;
        PG8_STAGE(PG8_SB(1, 0), cB + kstep, voffB); PG8_STAGE(PG8_SA(1, 0), cA + kstep, voffA); PG8_STAGE(PG8_SB(1, 1), cB + hstepB + kstep, voffB);
        PG8_WAIT_V(6); PG8_BAR;
    } else {
        PG8_STAGE(PG8_SB(0, 0), cB, voffB); PG8_STAGE(PG8_SA(0, 0), cA, voffA); PG8_STAGE(PG8_SB(0, 1), cB + hstepB, voffB); PG8_STAGE(PG8_SA(0, 1), cA + hstepA, voffA);
        if (wr == 1) PG8_BAR;
        PG8_WAIT_V(4); PG8_BAR;
        PG8_STAGE(PG8_SB(1, 0), cB + kstep, voffB); PG8_STAGE(PG8_SA(1, 0), cA + kstep, voffA); PG8_STAGE(PG8_SB(1, 1), cB + hstepB + kstep, voffB);
        PG8_WAIT_V(6); PG8_BAR;
    }
    for (;;) {
        const bool has_next = S.next(ui + 1, nxt);
        const char* nA = has_next ? (const char*)g.A + (size_t)nxt.pm * tstepA + (size_t)S.a_off(nxt) * 2 : cA; const char* nB = has_next ? (const char*)g.Bt + (size_t)S.b_tile(nxt) * tstepB + (size_t)S.b_koff(nxt) * 2 : cB;
        for (int t = 0; t < nt; t += 2) {
            const bool last = (t == nt - 2);
            const char* a1 = cA + (size_t)(t + 1) * kstep;
            const char* a2 = last ? nA : cA + (size_t)(t + 2) * kstep; const char* b2 = last ? nB : cB + (size_t)(t + 2) * kstep;
            const char* a3 = a2 + kstep; const char* b3 = b2 + kstep;
            if (last && has_next) S.a_ready(nxt);
            if constexpr (SP2) {
            PG8_LDB(B0, 0, 0); PG8_LDB(B1, 0, 1); PG8_SCHED; PG8_LDA(At, 0, 0); PG8_STAGE(PG8_SA(1, 1), a1 + hstepA, voffA);
            PG8_WAIT_V(8); PG8_WAIT_L(0); PG8_BAR; PG8_MMA(0, 0, At, B0); PG8_MMA(0, 1, At, B1); PG8_BAR; PG8_SCHED;
            PG8_LDA(At, 0, 1); PG8_STAGE(PG8_SB(0, 0), b2, voffB); PG8_STAGE(PG8_SB(0, 1), b2 + hstepB, voffB); PG8_STAGE(PG8_SA(0, 0), a2, voffA);
            PG8_WAIT_V(8); PG8_WAIT_L(0); PG8_BAR; PG8_MMA(1, 0, At, B0); PG8_MMA(1, 1, At, B1); PG8_BAR; PG8_SCHED;
            PG8_LDB(B0, 1, 0); PG8_LDB(B1, 1, 1); PG8_SCHED; PG8_LDA(At, 1, 0); PG8_STAGE(PG8_SA(0, 1), a2 + hstepA, voffA);
            PG8_WAIT_V(8); PG8_WAIT_L(0); PG8_BAR; PG8_MMA(0, 0, At, B0); PG8_MMA(0, 1, At, B1); PG8_BAR; PG8_SCHED;
            PG8_LDA(At, 1, 1); PG8_STAGE(PG8_SB(1, 0), b3, voffB); PG8_STAGE(PG8_SB(1, 1), b3 + hstepB, voffB); PG8_STAGE(PG8_SA(1, 0), a3, voffA);
            PG8_WAIT_V(8); PG8_WAIT_L(0); PG8_BAR; PG8_MMA(1, 0, At, B0); PG8_MMA(1, 1, At, B1); PG8_BAR; PG8_SCHED;
            } else {
            PG8_LDB(B0, 0, 0); PG8_SCHED; PG8_LDA(At, 0, 0); PG8_STAGE(PG8_SA(1, 1), a1 + hstepA, voffA);
            PG8_WAIT_L(8); PG8_BAR; PG8_WAIT_L(0); PG8_MMA(0, 0, At, B0); PG8_BAR; PG8_SCHED;
            PG8_LDB(B1, 0, 1); PG8_STAGE(PG8_SB(0, 0), b2, voffB);
            PG8_BAR; PG8_WAIT_L(0); PG8_MMA(0, 1, At, B1); PG8_BAR;
            PG8_LDA(At, 0, 1); PG8_STAGE(PG8_SA(0, 0), a2, voffA);
            PG8_BAR; PG8_WAIT_L(0); PG8_MMA(1, 0, At, B0); PG8_BAR; PG8_SCHED;
            PG8_STAGE(PG8_SB(0, 1), b2 + hstepB, voffB);
            PG8_WAIT_V(6); PG8_BAR; PG8_MMA(1, 1, At, B1); PG8_BAR;
            PG8_LDB(B0, 1, 0); PG8_SCHED; PG8_LDA(At, 1, 0); PG8_STAGE(PG8_SA(0, 1), a2 + hstepA, voffA);
            PG8_WAIT_L(8); PG8_BAR; PG8_WAIT_L(0); PG8_MMA(0, 0, At, B0); PG8_BAR; PG8_SCHED;
            PG8_LDB(B1, 1, 1); PG8_STAGE(PG8_SB(1, 0), b3, voffB);
            PG8_BAR; PG8_WAIT_L(0); PG8_MMA(0, 1, At, B1); PG8_BAR;
            PG8_LDA(At, 1, 1); PG8_STAGE(PG8_SA(1, 0), a3, voffA);
            PG8_BAR; PG8_WAIT_L(0); PG8_MMA(1, 0, At, B0); PG8_BAR; PG8_SCHED;
            PG8_STAGE(PG8_SB(1, 1), b3 + hstepB, voffB);
            PG8_WAIT_V(6); PG8_BAR; PG8_MMA(1, 1, At, B1); PG8_BAR;
            }
        }
        if constexpr (ALIGN_EPI) { if (wr == 0) PG8_BAR; }
        if constexpr (!Epi::AFTER_DRAIN) { E(acc, cur, wr, wc, fr, fq); S.done(cur); }
        if (!has_next) break;
#pragma unroll
        for (int a = 0; a < 2; ++a)
#pragma unroll
            for (int b = 0; b < 2; ++b)
#pragma unroll
                for (int m = 0; m < 4; ++m)
#pragma unroll
                    for (int n = 0; n < 2; ++n) acc[a][b][m][n] = (f32x4){0.f, 0.f, 0.f, 0.f};
        cur = nxt; cA = nA; cB = nB; ++ui;
        if constexpr (ALIGN_EPI) { if (wr == 1) PG8_BAR; }
    }
    PG8_WAIT_V(0);
    if constexpr (!ALIGN_EPI) { if (wr == 0) PG8_BAR; }
    PG8_BAR;
    if constexpr (Epi::AFTER_DRAIN) { E.fused(acc, cur, wr, wc, fr, fq, lds, wid, lane); S.done(cur); }
#undef PG8_SA
#undef PG8_SB
#undef PG8_STAGE
#undef PG8_LDA
#undef PG8_LDB
#undef PG8_MMA
#undef PG8_WAIT_V
#undef PG8_WAIT_L
#undef PG8_BAR
#undef PG8_SCHED
}
}

#define LAS __attribute__((address_space(3)))
typedef unsigned short bf16_t;
typedef short bf16x8 __attribute__((ext_vector_type(8)));
typedef float f32x4 __attribute__((ext_vector_type(4)));
typedef unsigned u32x4 __attribute__((ext_vector_type(4)));
typedef unsigned u32x2 __attribute__((ext_vector_type(2)));

constexpr int D = 1024, DFF = 2816, NFF2 = 5632, INC = 7984, PN = 5120, PREAL = 4912, MGN = 3072;
constexpr int MTOT = 24576, MLAT = 16384, GROWS = 8192;
constexpr float EPSN = 1e-6f;
constexpr size_t MiB = 1u << 20;
constexpr size_t WS_MOD = 1 * MiB, WS_MODP = 2 * MiB, WS_POS = 5 * MiB, WS_DEC = 6 * MiB, WS_SC = 7 * MiB;
constexpr size_t WS_W = 8 * MiB;
constexpr size_t W_FFIN = 0, W_FFOUT = W_FFIN + 2ull * NFF2 * D * 2, W_P = W_FFOUT + 2ull * D * DFF * 2, W_MG = W_P + (size_t)PN * D * 2,
                 W_B = W_MG + (size_t)MGN * D * 2, W_O3 = W_B + 3072ull * 512 * 2, W_END = W_O3 + 1024ull * 3072 * 2;
static_assert(W_END <= 58 * MiB, "weights region");
constexpr size_t WS_XN = 66 * MiB, WS_A = 114 * MiB, WS_BIG = 210 * MiB, WS_END = 370 * MiB;
constexpr size_t BIG_US = 80 * MiB, BIG_OB = 128 * MiB;
constexpr size_t OFF_YP = 0, OFF_YS = 8388608, OFF_C = 25165824, OFF_N = 29360128, OFF_M = 29392896, OFF_G = 29393408, OFF_H = 33587712;
constexpr int LDS_BYTES = 147456;

struct Args { const float* in[23]; float* out; unsigned char* ws; };
enum { I_XP = 0, I_XS, I_C, I_SC, I_SN, I_SM, I_SG, I_SH, I_CCTX, I_WADA, I_BADA, I_NPRE, I_NPOST, I_WFIN, I_WFOUT, I_WIN, I_GB, I_GWUP, I_GLB, I_HGAM, I_HN, I_WBR, I_WOUT };
__device__ __forceinline__ const float* inp(const Args& a, int i) { asm volatile("" : "+s"(i)); return a.in[i]; }

typedef float f32x2_t __attribute__((ext_vector_type(2))); typedef __bf16 bf16x2_t __attribute__((ext_vector_type(2)));
__device__ __forceinline__ unsigned pk2(float lo, float hi) { f32x2_t v = {lo, hi}; bf16x2_t b = __builtin_convertvector(v, bf16x2_t); return __builtin_bit_cast(unsigned, b); }
__device__ __forceinline__ unsigned f2bf(float f) { return pk2(f, 0.f) & 0xffffu; }
__device__ __forceinline__ float bf2f(bf16_t h) { return __uint_as_float(((unsigned)h) << 16); }
__device__ __forceinline__ float bflo(unsigned w) { return __uint_as_float(w << 16); }
__device__ __forceinline__ float bfhi(unsigned w) { return __uint_as_float(w & 0xffff0000u); }
__device__ __forceinline__ float sigmoidf_(float x) { return __builtin_amdgcn_rcpf(1.0f + __expf(-x)); }
__device__ __forceinline__ float siluf_(float x) { return x * __builtin_amdgcn_rcpf(1.0f + __expf(-x)); }
__device__ __forceinline__ float logsigf_(float x) { return fminf(x, 0.f) - __logf(1.0f + __expf(-fabsf(x))); }
__device__ __forceinline__ float wave_sum(float v) {
#pragma unroll
    for (int o = 1; o < 64; o <<= 1) v += __shfl_xor(v, o);
    return v;
}
#define LDS_WAIT() asm volatile("s_waitcnt lgkmcnt(0)" ::: "memory")
#ifndef NO_WT
__device__ __forceinline__ void st_wt8(void* p, u32x2 v) { __hip_atomic_store((unsigned long long*)p, ((unsigned long long)v.y << 32) | v.x, __ATOMIC_RELAXED, __HIP_MEMORY_SCOPE_AGENT); }
__device__ __forceinline__ void st_wt16(void* p, u32x4 v) { st_wt8(p, (u32x2){v.x, v.y}); st_wt8((char*)p + 8, (u32x2){v.z, v.w}); }
#else
__device__ __forceinline__ void st_wt8(void* p, u32x2 v) { *(u32x2*)p = v; }
__device__ __forceinline__ void st_wt16(void* p, u32x4 v) { *(u32x4*)p = v; }
#endif

#define XB_TMO      128
#define XB_XCNT(j)  (256  + 64 * (j))
#define XB_XSUB(j)  (1280 + 64 * (j))
#define XB_XGEN(j)  (2304 + 64 * (j))
#define XB_TOP      3328
#define XB_TOPGEN   3392
#define XCD_BAR_WORDS 3456
#define XB_SPIN_CAP (1u << 18)

__device__ __forceinline__ unsigned xb_ld(unsigned* p)              { return __hip_atomic_load(p, __ATOMIC_RELAXED, __HIP_MEMORY_SCOPE_AGENT); }
__device__ __forceinline__ unsigned xb_add(unsigned* p, unsigned v) { return __hip_atomic_fetch_add(p, v, __ATOMIC_RELAXED, __HIP_MEMORY_SCOPE_AGENT); }
__device__ __forceinline__ unsigned xb_xcc_id() { return (unsigned)__builtin_amdgcn_s_getreg((3 << 11) | 20) & 0xFu; }
#define XB_SPIN(cond, bar) do { unsigned _sp = 0; while (cond) { __builtin_amdgcn_s_sleep(1); \
    if ((++_sp & 255u) == 0u) { if (xb_ld(&(bar)[XB_TMO])) break; if (_sp > XB_SPIN_CAP) { atomicAdd(&(bar)[XB_TMO], 1u); break; } } } } while (0)

struct XcdBarrier {
    unsigned* bar; unsigned x;
    volatile LAS unsigned* st;
};

__device__ __forceinline__ XcdBarrier xcd_barrier_post(unsigned* bar, volatile LAS unsigned* st) {
    XcdBarrier b; b.bar = bar; b.x = xb_xcc_id(); b.st = st;
    if (threadIdx.x == 0) (void)xb_add(&bar[XB_XCNT(b.x)], 1u);
    return b;
}
__device__ __forceinline__ void xcd_barrier_complete(unsigned* bar, unsigned x, unsigned& nloc, unsigned& nx) {
    const unsigned G = gridDim.x * gridDim.y * gridDim.z;
    unsigned sum, cnt, mine, sp = 0u;
    for (;;) {
        sum = 0u; cnt = 0u; mine = 0u;
#pragma unroll
        for (unsigned j = 0; j < 16; ++j) { const unsigned c = xb_ld(&bar[XB_XCNT(j)]); sum += c; cnt += (c > 0u) ? 1u : 0u; mine = (j == x) ? c : mine; }
        if (sum == G) break;
        __builtin_amdgcn_s_sleep(1);
        if ((++sp & 255u) == 0u) { if (xb_ld(&bar[XB_TMO])) break; if (sp > XB_SPIN_CAP) { atomicAdd(&bar[XB_TMO], 1u); break; } }
    }
    nloc = mine > 0u ? mine : 1u; nx = cnt > 0u ? cnt : 1u;
}

__device__ __attribute__((noinline)) void xcd_barrier_ni(unsigned* bar_, unsigned st_off) {
    XcdBarrier b; b.bar = bar_; b.x = xb_xcc_id(); b.st = (volatile LAS unsigned*)(size_t)st_off;
    asm volatile("s_waitcnt vmcnt(0)" ::: "memory");
    __syncthreads();
    if (threadIdx.x == 0) {
        unsigned* bar = b.bar;
        __builtin_amdgcn_s_waitcnt(0);
        unsigned nloc = b.st[0], nx = b.st[1];
        if (nloc == 0u) { xcd_barrier_complete(bar, b.x, nloc, nx); b.st[0] = nloc; b.st[1] = nx; }
        const unsigned old = xb_add(&bar[XB_XSUB(b.x)], 1u);
        const unsigned gen = old / nloc;
        if (old + 1u == (gen + 1u) * nloc) {
            __builtin_amdgcn_fence(__ATOMIC_RELEASE, "agent");
            asm volatile("s_waitcnt vmcnt(0)" ::: "memory");
            const unsigned og = xb_add(&bar[XB_TOP], 1u);
            const unsigned tg = og / nx;
            if (og + 1u == (tg + 1u) * nx) xb_add(&bar[XB_TOPGEN], 1u);
            else XB_SPIN(xb_ld(&bar[XB_TOPGEN]) == tg, bar);
            __builtin_amdgcn_fence(__ATOMIC_ACQUIRE, "agent");
            xb_add(&bar[XB_XGEN(b.x)], 1u);
            asm volatile("s_waitcnt vmcnt(0)" ::: "memory");
        } else {
            XB_SPIN(xb_ld(&bar[XB_XGEN(b.x)]) == gen, bar);
            __builtin_amdgcn_fence(__ATOMIC_ACQUIRE, "agent");
            asm volatile("s_waitcnt vmcnt(0)" ::: "memory");
        }
    }
    __syncthreads();
}


struct EpiBf16 {
    static constexpr bool PERM = true, AFTER_DRAIN = false;
    bf16_t* O; int ldc; int nsplit; size_t sstride;
    __device__ __forceinline__ void operator()(const f32x4 (&acc)[2][2][4][2], const pg8::Unit& u, int wr, int wc, int fr, int fq) const {
        int pn = u.pn; bf16_t* Ob = O; if (nsplit) { Ob += (size_t)(pn / nsplit) * sstride; pn = pn % nsplit; }
        const int row0 = u.pm * 256 + wr * 64 + fr, col0 = pn * 256 + wc * 32 + 8 * fq;
#pragma unroll
        for (int ai = 0; ai < 2; ++ai)
#pragma unroll
            for (int m = 0; m < 4; ++m) { bf16_t* rowp = Ob + (size_t)(row0 + ai * 128 + m * 16) * ldc + col0;
#pragma unroll
                for (int bj = 0; bj < 2; ++bj) { const f32x4 v0 = acc[ai][bj][m][0], v1 = acc[ai][bj][m][1];
                    u32x4 w; w.x = pk2(v0[0], v0[1]); w.y = pk2(v0[2], v0[3]); w.z = pk2(v1[0], v1[1]); w.w = pk2(v1[2], v1[3]);
                    *(u32x4*)(rowp + bj * 128) = w; } }
    }
};
struct EpiGateMul {
    static constexpr bool PERM = true, AFTER_DRAIN = false;
    bf16_t* O; int ldc;
    __device__ __forceinline__ void operator()(const f32x4 (&acc)[2][2][4][2], const pg8::Unit& u, int wr, int wc, int fr, int fq) const {
        const int row0 = u.pm * 256 + wr * 64 + fr, col0 = u.pn * 256 + wc * 32 + 8 * fq;
        u32x4 bb[2][4][2];
#pragma unroll
        for (int ai = 0; ai < 2; ++ai)
#pragma unroll
            for (int m = 0; m < 4; ++m) { const bf16_t* rowp = O + (size_t)(row0 + ai * 128 + m * 16) * ldc + col0;
#pragma unroll
                for (int bj = 0; bj < 2; ++bj) bb[ai][m][bj] = *(const u32x4*)(rowp + bj * 128); }
#pragma unroll
        for (int ai = 0; ai < 2; ++ai)
#pragma unroll
            for (int m = 0; m < 4; ++m) { bf16_t* rowp = O + (size_t)(row0 + ai * 128 + m * 16) * ldc + col0;
#pragma unroll
                for (int bj = 0; bj < 2; ++bj) { const f32x4 v0 = acc[ai][bj][m][0], v1 = acc[ai][bj][m][1];
                    const u32x4 b = bb[ai][m][bj];
                    u32x4 w; w.x = pk2(sigmoidf_(v0[0]) * bflo(b.x), sigmoidf_(v0[1]) * bfhi(b.x)); w.y = pk2(sigmoidf_(v0[2]) * bflo(b.y), sigmoidf_(v0[3]) * bfhi(b.y));
                    w.z = pk2(sigmoidf_(v1[0]) * bflo(b.z), sigmoidf_(v1[1]) * bfhi(b.z)); w.w = pk2(sigmoidf_(v1[2]) * bflo(b.w), sigmoidf_(v1[3]) * bfhi(b.w));
                    *(u32x4*)(rowp + bj * 128) = w; } }
    }
};
struct EpiGateSum {
    static constexpr bool PERM = true, AFTER_DRAIN = false;
    bf16_t* O; int ldc;
    __device__ __forceinline__ void operator()(const f32x4 (&acc)[2][2][4][2], const pg8::Unit& u, int wr, int wc, int fr, int fq) const {
        const int n = u.pn >> 2, dt = u.pn & 3; const int row0 = u.pm * 256 + wr * 64 + fr, col0 = u.pn * 256 + wc * 32 + 8 * fq, cols = dt * 256 + wc * 32 + 8 * fq;
        if (n) asm volatile("s_waitcnt vmcnt(0)" ::: "memory");
#pragma unroll
        for (int ai = 0; ai < 2; ++ai) {
            u32x4 bb[4][2], ss[4][2];
#pragma unroll
            for (int m = 0; m < 4; ++m)
#pragma unroll
                for (int bj = 0; bj < 2; ++bj) { const bf16_t* rp = O + (size_t)(row0 + ai * 128 + m * 16) * ldc; bb[m][bj] = *(const u32x4*)(rp + col0 + bj * 128); if (n) ss[m][bj] = *(const u32x4*)(rp + cols + bj * 128); }
#pragma unroll
            for (int m = 0; m < 4; ++m)
#pragma unroll
                for (int bj = 0; bj < 2; ++bj) { const f32x4 v0 = acc[ai][bj][m][0], v1 = acc[ai][bj][m][1]; const u32x4 b = bb[m][bj];
                    float r[8] = {sigmoidf_(v0[0]) * bflo(b.x), sigmoidf_(v0[1]) * bfhi(b.x), sigmoidf_(v0[2]) * bflo(b.y), sigmoidf_(v0[3]) * bfhi(b.y),
                                  sigmoidf_(v1[0]) * bflo(b.z), sigmoidf_(v1[1]) * bfhi(b.z), sigmoidf_(v1[2]) * bflo(b.w), sigmoidf_(v1[3]) * bfhi(b.w)};
                    if (n) { const u32x4 s = ss[m][bj]; r[0] += bflo(s.x); r[1] += bfhi(s.x); r[2] += bflo(s.y); r[3] += bfhi(s.y); r[4] += bflo(s.z); r[5] += bfhi(s.z); r[6] += bflo(s.w); r[7] += bfhi(s.w); }
                    u32x4 w; w.x = pk2(r[0], r[1]); w.y = pk2(r[2], r[3]); w.z = pk2(r[4], r[5]); w.w = pk2(r[6], r[7]);
                    *(u32x4*)(O + (size_t)(row0 + ai * 128 + m * 16) * ldc + cols + bj * 128) = w; }
        }
    }
};
struct EpiSwiGLU {
    static constexpr bool PERM = true, AFTER_DRAIN = false;
    bf16_t* H; int ldh;
    __device__ __forceinline__ void operator()(const f32x4 (&acc)[2][2][4][2], const pg8::Unit& u, int wr, int wc, int fr, int fq) const {
        const int row0 = u.pm * 256 + wr * 64 + fr, col0 = u.pn * 128 + wc * 32 + 8 * fq;
#pragma unroll
        for (int ai = 0; ai < 2; ++ai)
#pragma unroll
            for (int m = 0; m < 4; ++m) { bf16_t* rowp = H + (size_t)(row0 + ai * 128 + m * 16) * ldh + col0;
                const f32x4 g0 = acc[ai][0][m][0], g1 = acc[ai][0][m][1], u0 = acc[ai][1][m][0], u1 = acc[ai][1][m][1];
                u32x4 w; w.x = pk2(siluf_(g0[0]) * u0[0], siluf_(g0[1]) * u0[1]); w.y = pk2(siluf_(g0[2]) * u0[2], siluf_(g0[3]) * u0[3]);
                w.z = pk2(siluf_(g1[0]) * u1[0], siluf_(g1[1]) * u1[1]); w.w = pk2(siluf_(g1[2]) * u1[2], siluf_(g1[3]) * u1[3]);
                *(u32x4*)rowp = w; }
    }
};
struct EpiF32 {
    static constexpr bool PERM = false, AFTER_DRAIN = false;
    float* Y; int ldc;
    __device__ __forceinline__ void operator()(const f32x4 (&acc)[2][2][4][2], const pg8::Unit& u, int wr, int wc, int fr, int fq) const {
        const int row0 = u.pm * 256 + wr * 64 + fr, col0 = u.pn * 256 + wc * 32 + 4 * fq;
#pragma unroll
        for (int ai = 0; ai < 2; ++ai)
#pragma unroll
            for (int m = 0; m < 4; ++m) { float* rowp = Y + (size_t)(row0 + ai * 128 + m * 16) * ldc + col0;
#pragma unroll
                for (int bj = 0; bj < 2; ++bj)
#pragma unroll
                    for (int n = 0; n < 2; ++n) *(f32x4*)(rowp + bj * 128 + n * 16) = acc[ai][bj][m][n]; }
    }
};

template <class Map>
__device__ __forceinline__ void transpose_item(const float* W, int K, int N, LAS float* scr, int item, int lane, const Map& map) {
    const int nblk = (N + 31) / 32, kb = item / nblk, nb = item % nblk, k0 = 64 * kb, n0 = 32 * nb;
    const int nn = n0 + (lane & 31); const bool ok = nn < N;
    float wv[32];
#pragma unroll
    for (int i = 0; i < 32; ++i) { const int kk = 2 * i + (lane >> 5); wv[i] = W[(size_t)(k0 + kk) * N + (ok ? nn : 0)]; }
#pragma unroll
    for (int i = 0; i < 32; ++i) { const int kk = 2 * i + (lane >> 5); scr[kk * 33 + (lane & 31)] = ok ? wv[i] : 0.f; }
    LDS_WAIT(); asm volatile("" ::: "memory");
    const int c = lane & 7;
#pragma unroll
    for (int j = 0; j < 4; ++j) { const int n = (lane >> 3) + 8 * j; const LAS float* s = scr + (8 * c) * 33 + n;
        u32x4 o; o.x = pk2(s[0 * 33], s[1 * 33]); o.y = pk2(s[2 * 33], s[3 * 33]); o.z = pk2(s[4 * 33], s[5 * 33]); o.w = pk2(s[6 * 33], s[7 * 33]);
        if (n0 + n < N) map(n0 + n, k0 + 8 * c, o); }
    LDS_WAIT(); asm volatile("" ::: "memory");
}

__device__ __forceinline__ void convert_weights(const Args& a, LAS unsigned char* lds, int l, int lo, int hi, int dopad, int gw, int NGW, int lane, int wave) {
    LAS float* scr = (LAS float*)(lds + wave * 16384);
    unsigned char* wb = a.ws + WS_W;
    constexpr int I_FI = 16 * 176, I_FO = 44 * 32, I_IN = 16 * 250, I_BR = 8 * 32, I_OU = 16 * 32;
    constexpr int NITEMS = 2 * I_FI + 2 * I_FO + I_IN + 3 * I_BR + I_OU;
    static_assert(NITEMS == 13728, "item ranges used by the callers");
    for (int it = lo + gw; it < hi; it += NGW) {
        int r = it;
        if (r < 2 * I_FI) { const int f = r / I_FI; r -= f * I_FI; bf16_t* dst = (bf16_t*)(wb + W_FFIN) + (size_t)f * NFF2 * D;
            transpose_item(inp(a, I_WFIN) + (size_t)(l * 2 + f) * D * NFF2, D, NFF2, scr, r, lane,
                [=](int n, int k, u32x4 o) { const int h = n < DFF ? n : n - DFF; const int row = 256 * (h >> 7) + (n < DFF ? 0 : 128) + (h & 127); *(u32x4*)(dst + (size_t)row * D + k) = o; });
            continue; }
        r -= 2 * I_FI;
        if (r < 2 * I_FO) { const int f = r / I_FO; r -= f * I_FO; bf16_t* dst = (bf16_t*)(wb + W_FFOUT) + (size_t)f * D * DFF;
            transpose_item(inp(a, I_WFOUT) + (size_t)(l * 2 + f) * DFF * D, DFF, D, scr, r, lane,
                [=](int n, int k, u32x4 o) { *(u32x4*)(dst + (size_t)n * DFF + k) = o; });
            continue; }
        r -= 2 * I_FO;
        if (r < I_IN) { bf16_t* dp = (bf16_t*)(wb + W_P); bf16_t* dm = (bf16_t*)(wb + W_MG);
            transpose_item(inp(a, I_WIN) + (size_t)l * D * INC, D, INC, scr, r, lane,
                [=](int n, int k, u32x4 o) { if (n < PREAL) *(u32x4*)(dp + (size_t)n * D + k) = o; else *(u32x4*)(dm + (size_t)(n - PREAL) * D + k) = o; });
            continue; }
        r -= I_IN;
        if (r < 3 * I_BR) { const int nb = r / I_BR; r -= nb * I_BR; bf16_t* dst = (bf16_t*)(wb + W_B) + (size_t)nb * 1024 * 512;
            transpose_item(inp(a, I_WBR) + (size_t)(l * 3 + nb) * 512 * D, 512, D, scr, r, lane,
                [=](int n, int k, u32x4 o) { *(u32x4*)(dst + (size_t)n * 512 + k) = o; });
            continue; }
        r -= 3 * I_BR;
        { bf16_t* dst = (bf16_t*)(wb + W_O3);
            transpose_item(inp(a, I_WOUT) + (size_t)l * D * D, D, D, scr, r, lane,
                [=](int n, int k, u32x4 o) { bf16_t* p = dst + (size_t)n * 3072 + k; *(u32x4*)p = o; *(u32x4*)(p + 1024) = o; *(u32x4*)(p + 2048) = o; }); }
    }
    if (dopad) { u32x4* z = (u32x4*)((bf16_t*)(wb + W_P) + (size_t)PREAL * D); const int nz = (PN - PREAL) * D * 2 / 16;
      for (int i = gw * 64 + lane; i < nz; i += NGW * 64) z[i] = (u32x4){0u, 0u, 0u, 0u}; }
}

__device__ __forceinline__ void ada_partial(const Args& a, LAS unsigned char* lds, int gw, int NGW, int lane, int wave) {
    float* modp = (float*)(a.ws + WS_MODP);
    LAS float* sv = (LAS float*)(lds + wave * 16384);
    for (int it = gw; it < 2 * 144 * 8; it += NGW) {
        const int ks = it & 7, cgp = (it >> 3) % 144, l = it / (8 * 144);
        const int col = cgp * 64 + lane;
#pragma unroll
        for (int h = 0; h < 2; ++h) { const int kk = ks * 128 + lane + 64 * h;
            sv[lane + 64 * h] = siluf_(inp(a, I_CCTX)[kk]);
#pragma unroll
            for (int i = 0; i < 4; ++i) sv[(1 + i) * 128 + lane + 64 * h] = siluf_(inp(a, I_C)[i * D + kk]); }
        LDS_WAIT(); asm volatile("" ::: "memory");
        const float* w = inp(a, I_WADA) + ((size_t)l * D + ks * 128) * 9216 + col;
        float acc[5] = {0.f, 0.f, 0.f, 0.f, 0.f};
#pragma unroll 1
        for (int k0 = 0; k0 < 128; k0 += 32) { float wv[32];
#pragma unroll
            for (int k = 0; k < 32; ++k) wv[k] = w[(size_t)(k0 + k) * 9216];
#pragma unroll
            for (int k = 0; k < 32; ++k) {
#pragma unroll
                for (int i = 0; i < 5; ++i) acc[i] += sv[i * 128 + k0 + k] * wv[k]; } }
#pragma unroll
        for (int i = 0; i < 5; ++i) modp[((size_t)(ks * 2 + l) * 5 + i) * 9216 + col] = acc[i];
        LDS_WAIT(); asm volatile("" ::: "memory");
    }
}

struct RowOp { int src_input, has_y, ysplit; float coef; const float* npost; const float* mdg_base; int has_xn; const float* npre; const float* md_base; int si; int add_pos; };
template <int NR>
__device__ __forceinline__ void rowwise(const Args& a, const RowOp& op, const int (&rs)[NR], int lane) {
    f32x4 v[NR][4]; u32x2 yb[NR][4], yb2[NR][4]; float* xd[NR]; bool lat[NR]; int cv[NR];
#pragma unroll
    for (int q = 0; q < NR; ++q) { const int r = rs[q]; lat[q] = r < MLAT; cv[q] = lat[q] ? 1 + (r >> 12) : 0;
        const float* xs = op.src_input ? (lat[q] ? inp(a, I_XS) + (size_t)r * D : inp(a, I_XP) + (size_t)(r - MLAT) * D)
                                       : (lat[q] ? a.out + OFF_YS + (size_t)r * D : a.out + OFF_YP + (size_t)(r - MLAT) * D);
        xd[q] = lat[q] ? a.out + OFF_YS + (size_t)r * D : a.out + OFF_YP + (size_t)(r - MLAT) * D;
#pragma unroll
        for (int j = 0; j < 4; ++j) v[q][j] = __builtin_nontemporal_load((const f32x4*)(xs + 4 * lane + 256 * j));
        if (op.has_y) { const bf16_t* yr = (const bf16_t*)(a.ws + WS_A) + (size_t)r * D;
#pragma unroll
            for (int j = 0; j < 4; ++j) { yb[q][j] = __builtin_nontemporal_load((const u32x2*)(yr + 4 * lane + 256 * j)); yb2[q][j] = op.ysplit ? __builtin_nontemporal_load((const u32x2*)(yr + (size_t)MTOT * D + 4 * lane + 256 * j)) : (u32x2){0u, 0u}; } } }
    f32x4 wpr[4], s1v[NR][4], s0v[NR][4], ppv[NR][4];
    if (op.has_xn) {
#pragma unroll
        for (int j = 0; j < 4; ++j) wpr[j] = *(const f32x4*)(op.npre + 4 * lane + 256 * j);
#pragma unroll
        for (int q = 0; q < NR; ++q) { const float* sh = op.md_base + (size_t)cv[q] * 9216 + (size_t)op.si * D; const float* sc = sh + D;
            const float* pos = (const float*)(a.ws + WS_POS); const int t = rs[q] & 4095;
#pragma unroll
            for (int j = 0; j < 4; ++j) { const int c = 4 * lane + 256 * j; s1v[q][j] = *(const f32x4*)(sc + c); s0v[q][j] = *(const f32x4*)(sh + c);
                if (op.add_pos && lat[q]) ppv[q][j] = *(const f32x4*)((c < 512) ? pos + (size_t)(t >> 6) * 512 + c : pos + (size_t)(t & 63) * 512 + (c - 512)); } } }
#pragma unroll
    for (int q = 0; q < NR; ++q) { const int r = rs[q];
        if (op.has_y) {
            f32x4 y[4]; float ss = 0.f;
#pragma unroll
            for (int j = 0; j < 4; ++j) { y[j] = (f32x4){bflo(yb[q][j].x) + bflo(yb2[q][j].x), bfhi(yb[q][j].x) + bfhi(yb2[q][j].x), bflo(yb[q][j].y) + bflo(yb2[q][j].y), bfhi(yb[q][j].y) + bfhi(yb2[q][j].y)}; ss += (y[j].x * y[j].x + y[j].y * y[j].y) + (y[j].z * y[j].z + y[j].w * y[j].w); }
            const float rr = rsqrtf(wave_sum(ss) * (1.f / D) + EPSN) * op.coef;
            const float* gp = op.mdg_base + (size_t)cv[q] * 9216;
#pragma unroll
            for (int j = 0; j < 4; ++j) { const f32x4 w = *(const f32x4*)(op.npost + 4 * lane + 256 * j), gg = *(const f32x4*)(gp + 4 * lane + 256 * j);
                v[q][j] = v[q][j] + gg * (y[j] * rr) * w; __builtin_nontemporal_store(v[q][j], (f32x4*)(xd[q] + 4 * lane + 256 * j)); }
        }
        if (op.has_xn) {
            float ss = 0.f;
#pragma unroll
            for (int j = 0; j < 4; ++j) ss += (v[q][j].x * v[q][j].x + v[q][j].y * v[q][j].y) + (v[q][j].z * v[q][j].z + v[q][j].w * v[q][j].w);
            const float rr = rsqrtf(wave_sum(ss) * (1.f / D) + EPSN);
            bf16_t* xo = (bf16_t*)(a.ws + WS_XN) + (size_t)r * D;
#pragma unroll
            for (int j = 0; j < 4; ++j) { const int c = 4 * lane + 256 * j;
                f32x4 o = (v[q][j] * rr) * wpr[j] * (s1v[q][j] + 1.0f) + s0v[q][j];
                if (op.add_pos && lat[q]) o = o + ppv[q][j];
                u32x2 pk; pk.x = pk2(o.x, o.y); pk.y = pk2(o.z, o.w); *(u32x2*)(xo + c) = pk; }
        }
    }
}
__device__ __forceinline__ void rowwise_all(const Args& a, const RowOp& op, int gw, int NGW, int lane) {
    int r = gw;
    for (; r + NGW < MTOT; r += 2 * NGW) { const int rs[2] = {r, r + NGW}; rowwise<2>(a, op, rs, lane); }
    if (r < MTOT) { const int rs[1] = {r}; rowwise<1>(a, op, rs, lane); }
}

constexpr int C_MQ = 0, C_MK = 256, C_MV = 512, C_MO = 1024, C_MIF = 1536, C_GQ = 1552, C_GK = 1808, C_GV = 2064, C_GR = 2576, C_GLR = 3088, C_HQ = 3120, C_HF = 3376, C_HV = 3888, C_HG = 4400;

struct ItemInfo { int br, dir, head, seq, c, T, NC; };
__device__ __forceinline__ ItemInfo item_info(int g, int it) { ItemInfo I; const int hdb = it % 24, cgl = it / 24; I.br = hdb >> 3; I.dir = (hdb >> 2) & 1; I.head = hdb & 3;
    I.T = g < 2 ? 4096 : 256; I.NC = I.T >> 6; I.seq = cgl / I.NC; I.c = cgl % I.NC; return I; }
__device__ __forceinline__ int item_row(const ItemInfo& I, int s) { const int tau = I.c * 64 + s; return I.seq * I.T + (I.dir ? I.T - 1 - tau : tau); }
__device__ __forceinline__ float lb_of(const Args& a, int l, int ch) { if (l == 0) return 0.f; const float g0 = inp(a, I_HGAM)[ch], g1 = inp(a, I_HGAM)[256 + ch]; return 1.0f / (1.0f + expf(g0 - g1)); }

template <bool NEEDQ>
__device__ __forceinline__ void load_gated(const Args& a, const bf16_t* P, const ItemInfo& I, int l, int d, int sg, float (&qv)[8], float (&kv)[8], float (&la)[8]) {
    const int ch = I.head * 64 + d;
    if (I.br == 1) {
        float wup[16];
        const float* wp = inp(a, I_GWUP) + ((size_t)(l * 2 + I.dir) * 16) * 256 + ch;
#pragma unroll
        for (int r = 0; r < 16; ++r) wup[r] = wp[r * 256];
        const float gb = inp(a, I_GLB)[(l * 2 + I.dir) * 256 + ch];
#pragma unroll
        for (int i = 0; i < 8; ++i) { const bf16_t* pr = P + (size_t)item_row(I, 8 * sg + i) * PN;
            const u32x4 g0 = *(const u32x4*)(pr + C_GLR + I.dir * 16), g1 = *(const u32x4*)(pr + C_GLR + I.dir * 16 + 8);
            float z = gb;
            z += bflo(g0.x) * wup[0] + bfhi(g0.x) * wup[1] + bflo(g0.y) * wup[2] + bfhi(g0.y) * wup[3] + bflo(g0.z) * wup[4] + bfhi(g0.z) * wup[5] + bflo(g0.w) * wup[6] + bfhi(g0.w) * wup[7];
            z += bflo(g1.x) * wup[8] + bfhi(g1.x) * wup[9] + bflo(g1.y) * wup[10] + bfhi(g1.y) * wup[11] + bflo(g1.z) * wup[12] + bfhi(g1.z) * wup[13] + bflo(g1.w) * wup[14] + bfhi(g1.w) * wup[15];
            la[i] = logsigf_(z) * (1.0f / 16.0f);
            if (NEEDQ) qv[i] = bf2f(pr[C_GQ + ch]) * 0.125f; kv[i] = bf2f(pr[C_GK + ch]); }
    } else {
        const float lb = lb_of(a, l, ch);
#pragma unroll
        for (int i = 0; i < 8; ++i) { const bf16_t* pr = P + (size_t)item_row(I, 8 * sg + i) * PN;
            const float z = bf2f(pr[C_HF + I.dir * 256 + ch]); const float sg_ = sigmoidf_(z);
            la[i] = (lb == 0.f) ? logsigf_(z) : __logf(lb + (1.0f - lb) * sg_);
            if (NEEDQ) qv[i] = bf2f(pr[C_HQ + ch]) * 1.0f;
            kv[i] = (1.0f - lb) * (1.0f - sg_); }
    }
}
template <bool NEEDQ>
__device__ __forceinline__ void load_mlstm(const Args& a, const bf16_t* P, const ItemInfo& I, int l, int d, int sg, float (&qv)[8], float (&kv)[8], float (&lf)[8], float (&li)[8]) {
    const float bi = inp(a, I_GB)[((l * 2 + I.dir) * 2 + 0) * 4 + I.head], bf_ = inp(a, I_GB)[((l * 2 + I.dir) * 2 + 1) * 4 + I.head];
#pragma unroll
    for (int i = 0; i < 8; ++i) { const bf16_t* pr = P + (size_t)item_row(I, 8 * sg + i) * PN;
        li[i] = bf2f(pr[C_MIF + I.dir * 8 + I.head]) + bi; lf[i] = logsigf_(bf2f(pr[C_MIF + I.dir * 8 + 4 + I.head]) + bf_);
        if (NEEDQ) qv[i] = bf2f(pr[C_MQ + I.head * 64 + d]) * 0.125f; kv[i] = bf2f(pr[C_MK + I.head * 64 + d]); }
}
__device__ __forceinline__ bf16x8 ldfrag(const LAS bf16_t* T, int pitch, int row0, int k0, int lane) { return *(const LAS bf16x8*)(T + (row0 + (lane & 15)) * pitch + k0 + 8 * (lane >> 4)); }

struct Raw { bf16_t q[8], k[8], z[8]; unsigned g0, g1; float wup[16]; float p0, p1, nc, mc; u32x4 s0, s1; };
template <bool NEEDQ, bool NEEDS>
__device__ __forceinline__ void raw_load(const Args& a, const bf16_t* P, const ItemInfo& I, int l, int it, int tid, Raw& R) {
    const int d = tid & 63, lane = d, sg = __builtin_amdgcn_readfirstlane(tid >> 6), ch = I.head * 64 + d;
    const int qc = I.br == 0 ? C_MQ : (I.br == 1 ? C_GQ : C_HQ), kc = I.br == 0 ? C_MK : (I.br == 1 ? C_GK : C_HF + I.dir * 256);
#pragma unroll
    for (int i = 0; i < 8; ++i) { const bf16_t* pr = P + (size_t)item_row(I, 8 * sg + i) * PN;
        if (NEEDQ) R.q[i] = pr[qc + ch];
        R.k[i] = pr[kc + ch]; }
    if (I.br == 1) {
        R.g0 = P[(size_t)item_row(I, 8 * sg + (lane >> 4)) * PN + C_GLR + I.dir * 16 + (lane & 15)];
        R.g1 = P[(size_t)item_row(I, 8 * sg + 4 + (lane >> 4)) * PN + C_GLR + I.dir * 16 + (lane & 15)];
        const float* wp = inp(a, I_GWUP) + ((size_t)(l * 2 + I.dir) * 16) * 256 + ch;
#pragma unroll
        for (int r = 0; r < 16; ++r) R.wup[r] = wp[r * 256];
        R.p0 = inp(a, I_GLB)[(l * 2 + I.dir) * 256 + ch];
    } else if (I.br == 0) {
        R.g0 = P[(size_t)item_row(I, 8 * sg + (lane & 7)) * PN + C_MIF + I.dir * 8 + ((lane >> 3) & 1) * 4 + I.head];
        R.p0 = inp(a, I_GB)[((l * 2 + I.dir) * 2 + 0) * 4 + I.head]; R.p1 = inp(a, I_GB)[((l * 2 + I.dir) * 2 + 1) * 4 + I.head];
    } else R.p0 = lb_of(a, l, ch);
    if (NEEDS) { const bf16_t* US = (const bf16_t*)(a.ws + WS_BIG + BIG_US) + (size_t)it * 8192; const int e = tid >> 2, part = tid & 3;
        R.s0 = *(const u32x4*)(US + e * 64 + 16 * part); R.s1 = *(const u32x4*)(US + e * 64 + 16 * part + 8);
        if (I.br == 0) { R.nc = ((const float*)(a.ws + WS_DEC))[(size_t)it * 64 + d]; R.mc = ((const float*)(a.ws + WS_SC))[(size_t)it * 4 + 2]; } }
}
__device__ __forceinline__ float rl_bf(unsigned v, int ln) { return __uint_as_float(((unsigned)__builtin_amdgcn_readlane((int)v, ln)) << 16); }
template <bool NEEDQ>
__device__ __forceinline__ void gated_from_raw(const Raw& R, const ItemInfo& I, float (&qv)[8], float (&kv)[8], float (&la)[8]) {
    if (I.br == 1) {
#pragma unroll
        for (int i = 0; i < 8; ++i) { float z = R.p0; const unsigned src = i < 4 ? R.g0 : R.g1;
#pragma unroll
            for (int r = 0; r < 16; ++r) z += rl_bf(src, (i & 3) * 16 + r) * R.wup[r];
            la[i] = logsigf_(z) * (1.0f / 16.0f);
            if (NEEDQ) qv[i] = bf2f(R.q[i]) * 0.125f; kv[i] = bf2f(R.k[i]); }
    } else { const float lb = R.p0;
#pragma unroll
        for (int i = 0; i < 8; ++i) { const float z = bf2f(R.k[i]); const float sg_ = sigmoidf_(z);
            la[i] = (lb == 0.f) ? logsigf_(z) : __logf(lb + (1.0f - lb) * sg_);
            if (NEEDQ) qv[i] = bf2f(R.q[i]) * 1.0f;
            kv[i] = (1.0f - lb) * (1.0f - sg_); }
    }
}
template <bool NEEDQ>
__device__ __forceinline__ void mlstm_from_raw(const Raw& R, float (&qv)[8], float (&kv)[8], float (&lf)[8], float (&li)[8]) {
#pragma unroll
    for (int i = 0; i < 8; ++i) { li[i] = rl_bf(R.g0, i) + R.p0; lf[i] = logsigf_(rl_bf(R.g0, 8 + i) + R.p1);
        if (NEEDQ) qv[i] = bf2f(R.q[i]) * 0.125f; kv[i] = bf2f(R.k[i]); }
}
template <int SK>
__device__ __forceinline__ bf16x8 ldfragY(const LAS bf16_t* T, int pitch, int row0, int k0, int lane) { return *(const LAS bf16x8*)(T + (row0 + (lane & 15)) * pitch + (row0 >> 4) * SK + k0 + 8 * (lane >> 4)); }
__device__ __forceinline__ void v_load(const bf16_t* P, const ItemInfo& I, int tid, u32x4& v0, u32x4& v1) {
    const int s = tid >> 3, eg = tid & 7; const int vb = I.br == 0 ? C_MV : (I.br == 1 ? C_GV : C_HV);
    const bf16_t* pv = P + (size_t)item_row(I, s) * PN + vb + I.head * 128 + 16 * eg; v0 = *(const u32x4*)pv; v1 = *(const u32x4*)(pv + 8);
}
template <int SK>
__device__ __forceinline__ void v_store(int br, LAS bf16_t* Y, int pitch, int tid, const u32x4& v0, const u32x4& v1) {
    const int s = tid >> 3, eg = tid & 7; const unsigned wds[8] = {v0.x, v0.y, v0.z, v0.w, v1.x, v1.y, v1.z, v1.w};
#pragma unroll
    for (int i = 0; i < 8; ++i) { float x0 = bflo(wds[i]), x1 = bfhi(wds[i]); if (br == 2) { x0 = siluf_(x0); x1 = siluf_(x1); }
        Y[(16 * eg + 2 * i) * pitch + SK * eg + s] = (bf16_t)f2bf(x0); Y[(16 * eg + 2 * i + 1) * pitch + SK * eg + s] = (bf16_t)f2bf(x1); }
}

__device__ __forceinline__ void scan_s1(const Args& a, LAS unsigned char* lds, int l, int g, int it, const Raw& R, const u32x4& pv0, const u32x4& pv1) {
    int tid_ = threadIdx.x; asm volatile("" : "+v"(tid_)); const int tid = tid_, d = tid & 63, lane = d, sg = __builtin_amdgcn_readfirstlane(tid >> 6);
    const ItemInfo I = item_info(g, it);
    const bf16_t* P = (const bf16_t*)(a.ws + WS_BIG);
    bf16_t* US = (bf16_t*)(a.ws + WS_BIG + BIG_US) + (size_t)it * 8192;
    float* DEC = (float*)(a.ws + WS_DEC) + (size_t)it * 64; float* SC = (float*)(a.ws + WS_SC) + (size_t)it * 4;
    LAS bf16_t* XT = (LAS bf16_t*)lds;
    LAS bf16_t* YV = (LAS bf16_t*)(lds + 9216);
    LAS float* TOT = (LAS float*)(lds + 9216 + 20736 + 256);
    LAS float* TMX = TOT + 512;
    float qv[8], kv[8], x0[8], x1[8];
    if (I.br == 0) {
        mlstm_from_raw<false>(R, qv, kv, x0, x1);
        float run = 0.f;
#pragma unroll
        for (int i = 0; i < 8; ++i) { run += x0[i]; x0[i] = run; }
        TOT[sg * 64 + d] = run; LDS_WAIT(); __syncthreads();
        float pre = 0.f, tot = 0.f;
#pragma unroll
        for (int w = 0; w < 8; ++w) { const float t = TOT[w * 64 + d]; if (w < sg) pre += t; tot += t; }
        float mx = -3.0e38f;
#pragma unroll
        for (int i = 0; i < 8; ++i) { x0[i] = tot - (pre + x0[i]) + x1[i]; mx = fmaxf(mx, x0[i]); }
        TMX[sg * 64 + d] = mx; LDS_WAIT(); __syncthreads();
        float mlw = -3.0e38f;
#pragma unroll
        for (int w = 0; w < 8; ++w) mlw = fmaxf(mlw, TMX[w * 64 + d]);
#pragma unroll
        for (int i = 0; i < 8; ++i) kv[i] *= __expf(x0[i] - mlw);
        if (tid == 0) { SC[0] = mlw; SC[1] = tot; }
        for (int idx = tid; idx < 16 * 64; idx += 512) YV[(128 + (idx >> 6)) * 72 + 64 + (idx & 63)] = (bf16_t)((idx >> 6) == 0 ? 0x3F80 : 0);
    } else {
        gated_from_raw<false>(R, I, qv, kv, x0);
        float run = 0.f;
#pragma unroll
        for (int i = 0; i < 8; ++i) { run += x0[i]; x0[i] = run; }
        TOT[sg * 64 + d] = run; LDS_WAIT(); __syncthreads();
        float pre = 0.f, tot = 0.f;
#pragma unroll
        for (int w = 0; w < 8; ++w) { const float t = TOT[w * 64 + d]; if (w < sg) pre += t; tot += t; }
#pragma unroll
        for (int i = 0; i < 8; ++i) kv[i] *= __expf(tot - (pre + x0[i]));
        if (sg == 0) DEC[d] = __expf(tot);
    }
    { u32x4 w; w.x = pk2(kv[0], kv[1]); w.y = pk2(kv[2], kv[3]); w.z = pk2(kv[4], kv[5]); w.w = pk2(kv[6], kv[7]); *(LAS u32x4*)(XT + d * 72 + 8 * sg) = w; }
    v_store<8>(I.br, YV, 72, tid, pv0, pv1);
    LDS_WAIT(); __syncthreads();
    f32x4 acc[4];
#pragma unroll
    for (int mt = 0; mt < 4; ++mt) acc[mt] = (f32x4){0.f, 0.f, 0.f, 0.f};
#pragma unroll
    for (int ks = 0; ks < 2; ++ks) { const bf16x8 b = ldfragY<8>(YV, 72, 16 * sg, 32 * ks, lane);
#pragma unroll
        for (int mt = 0; mt < 4; ++mt) acc[mt] = __builtin_amdgcn_mfma_f32_16x16x32_bf16(ldfrag(XT, 72, 16 * mt, 32 * ks, lane), b, acc[mt], 0, 0, 0); }
    { const int e = 16 * sg + (lane & 15);
#pragma unroll
      for (int mt = 0; mt < 4; ++mt) { u32x2 o; o.x = pk2(acc[mt][0], acc[mt][1]); o.y = pk2(acc[mt][2], acc[mt][3]); *(u32x2*)(US + e * 64 + 16 * mt + 4 * (lane >> 4)) = o; } }
    if (I.br == 0 && sg < 4) {
        f32x4 an = (f32x4){0.f, 0.f, 0.f, 0.f};
#pragma unroll
        for (int ks = 0; ks < 2; ++ks) an = __builtin_amdgcn_mfma_f32_16x16x32_bf16(ldfrag(XT, 72, 16 * sg, 32 * ks, lane), ldfragY<8>(YV, 72, 128, 32 * ks, lane), an, 0, 0, 0);
        if ((lane & 15) == 0) { const int d0 = 16 * sg + 4 * (lane >> 4); DEC[d0] = an[0]; DEC[d0 + 1] = an[1]; DEC[d0 + 2] = an[2]; DEC[d0 + 3] = an[3]; }
    }
    __syncthreads();
}

template <int S2B>
__device__ __forceinline__ void scan_s2(const Args& a, int l, int g) {
    const int T = g < 2 ? 4096 : 256, NC = T >> 6, nseq = g < 2 ? 2 : 32, nslot = nseq * 24 * 1024;
    bf16_t* USb = (bf16_t*)(a.ws + WS_BIG + BIG_US); float* DECb = (float*)(a.ws + WS_DEC); float* SCb = (float*)(a.ws + WS_SC);
    int tid_ = threadIdx.x; asm volatile("" : "+v"(tid_));
    for (int slot = blockIdx.x * 512 + tid_; slot < nslot; slot += gridDim.x * 512) {
        const int sub = slot & 1023, stream = slot >> 10, hdb = stream % 24, seq = stream / 24, br = hdb >> 3, dir = (hdb >> 2) & 1, head = hdb & 3;
        const int e = sub >> 3, d0 = (sub & 7) * 8;
        float S[8], nst[8], mst = 0.f;
#pragma unroll
        for (int i = 0; i < 8; ++i) { S[i] = 0.f; nst[i] = 0.f; }
        if (g < 2) { const int b = g * 2 + seq; const size_t sidx = (size_t)((b * 2 + l) * 2 + dir) * 4 + head;
            const float* sp = (br == 0 ? inp(a, I_SC) : (br == 1 ? inp(a, I_SG) : inp(a, I_SH))) + sidx * 8192;
#pragma unroll
            for (int i = 0; i < 8; ++i) S[i] = sp[(d0 + i) * 128 + e];
            if (br == 0) { mst = inp(a, I_SM)[sidx];
#pragma unroll
                for (int i = 0; i < 8; ++i) nst[i] = inp(a, I_SN)[sidx * 64 + d0 + i]; } }
        const bool nrow = (br == 0) && (e == 0);
        for (int c0 = 0; c0 < NC; c0 += S2B) {
            u32x4 ub[S2B]; f32x4 q0[S2B], q1[S2B]; float m0[S2B], m1[S2B];
#pragma unroll
            for (int j = 0; j < S2B; ++j) { const size_t it = (size_t)(seq * NC + c0 + j) * 24 + hdb;
                ub[j] = *(const u32x4*)(USb + it * 8192 + e * 64 + d0);
                if (br == 0) { m0[j] = SCb[it * 4]; m1[j] = SCb[it * 4 + 1]; }
                if (br != 0 || nrow) { q0[j] = *(const f32x4*)(DECb + it * 64 + d0); q1[j] = *(const f32x4*)(DECb + it * 64 + d0 + 4); } }
#pragma unroll
            for (int j = 0; j < S2B; ++j) { const size_t it = (size_t)(seq * NC + c0 + j) * 24 + hdb;
                bf16_t* p = USb + it * 8192 + e * 64 + d0; float* dec = DECb + it * 64 + d0; float* sc = SCb + it * 4;
                const u32x4 u = ub[j];
                const float uu[8] = {bflo(u.x), bfhi(u.x), bflo(u.y), bfhi(u.y), bflo(u.z), bfhi(u.z), bflo(u.w), bfhi(u.w)};
                { u32x4 w; w.x = pk2(S[0], S[1]); w.y = pk2(S[2], S[3]); w.z = pk2(S[4], S[5]); w.w = pk2(S[6], S[7]); *(u32x4*)p = w; }
                if (br == 0) {
                    const float mlw = m0[j], bl = m1[j]; const float mn = fmaxf(bl + mst, mlw); const float fa = __expf(bl + mst - mn), fb = __expf(mlw - mn);
                    if (nrow) { const f32x4 n0 = q0[j], n1 = q1[j];
                        *(f32x4*)dec = (f32x4){nst[0], nst[1], nst[2], nst[3]}; *(f32x4*)(dec + 4) = (f32x4){nst[4], nst[5], nst[6], nst[7]};
                        const float nn[8] = {n0.x, n0.y, n0.z, n0.w, n1.x, n1.y, n1.z, n1.w};
#pragma unroll
                        for (int i = 0; i < 8; ++i) nst[i] = fa * nst[i] + fb * nn[i];
                        if (d0 == 0) sc[2] = mst; }
#pragma unroll
                    for (int i = 0; i < 8; ++i) S[i] = fa * S[i] + fb * uu[i];
                    mst = mn;
                } else {
                    const f32x4 a0 = q0[j], a1 = q1[j]; const float dd[8] = {a0.x, a0.y, a0.z, a0.w, a1.x, a1.y, a1.z, a1.w};
#pragma unroll
                    for (int i = 0; i < 8; ++i) S[i] = dd[i] * S[i] + uu[i];
                }
            }
        }
        if (g == 2) { const size_t sidx = (size_t)((seq * 2 + l) * 2 + dir) * 4 + head;
            float* op = a.out + (br == 0 ? OFF_C : (br == 1 ? OFF_G : OFF_H)) + sidx * 8192;
#pragma unroll
            for (int i = 0; i < 8; ++i) op[(d0 + i) * 128 + e] = S[i];
            if (nrow) {
#pragma unroll
                for (int i = 0; i < 8; ++i) a.out[OFF_N + sidx * 64 + d0 + i] = nst[i];
                if (d0 == 0) a.out[OFF_M + sidx] = mst; } }
    }
}

constexpr int S3_QO = 0, S3_KO = 23040, S3_G = 41472, S3_XA = 57856, S3_YV = 75264, S3_TOT = 114432 + 256, S3_VEC = 116480 + 256;
__device__ __forceinline__ void scan_s3(const Args& a, LAS unsigned char* lds, int l, int g, int it2, int it2n, Raw& Rc, u32x4& pv0, u32x4& pv1) {
    int tid_ = threadIdx.x; asm volatile("" : "+v"(tid_)); const int tid = tid_, d = tid & 63, lane = d, sg = __builtin_amdgcn_readfirstlane(tid >> 6);
    const int hb = it2 % 12, cgl = it2 / 12; ItemInfo I; I.br = hb >> 2; I.head = hb & 3; I.T = g < 2 ? 4096 : 256; I.NC = I.T >> 6; I.seq = cgl / I.NC; const int cn = cgl % I.NC; I.dir = 0; I.c = cn;
    const bf16_t* P = (const bf16_t*)(a.ws + WS_BIG);
    LAS bf16_t* QO = (LAS bf16_t*)(lds + S3_QO); LAS bf16_t* KO = (LAS bf16_t*)(lds + S3_KO); LAS float* G = (LAS float*)(lds + S3_G);
    LAS bf16_t* XA = (LAS bf16_t*)(lds + S3_XA); LAS bf16_t* YV = (LAS bf16_t*)(lds + S3_YV); LAS float* TOT = (LAS float*)(lds + S3_TOT);
    LAS float* Bv = (LAS float*)(lds + S3_VEC); LAS float* LIv = Bv + 64; LAS float* MT = Bv + 128; LAS float* EI = Bv + 192;
    v_store<8>(I.br, YV, 136, tid, pv0, pv1);
    ItemInfo In; { const int hbn = it2n % 12, cgn = it2n / 12; In.br = hbn >> 2; In.head = hbn & 3; In.T = I.T; In.NC = I.NC; In.seq = cgn / I.NC; In.c = cgn % I.NC; In.dir = 0; }
    v_load(P, In, tid, pv0, pv1);
    f32x4 osum[4];
#pragma unroll
    for (int nt = 0; nt < 4; ++nt) osum[nt] = (f32x4){0.f, 0.f, 0.f, 0.f};
    const int e0 = 16 * sg + 4 * (lane >> 4); const int gcol = (I.br == 0 ? C_MO : (I.br == 1 ? C_GR : C_HG)) + I.head * 128 + e0;
    u32x2 gts[4];
#pragma unroll
    for (int nt = 0; nt < 4; ++nt) gts[nt] = *(const u32x2*)(P + (size_t)(I.seq * I.T + 64 * cn + 16 * nt + (lane & 15)) * PN + gcol);
    const f32x4 hw = *(const f32x4*)(inp(a, I_HN) + (size_t)(l * 3 + I.br) * 512 + I.head * 128 + e0);
  for (int dir = 0; dir < 2; ++dir) {
    I.dir = dir; I.c = dir ? I.NC - 1 - cn : cn;
    const int it = (I.seq * I.NC + I.c) * 24 + I.br * 8 + dir * 4 + I.head;
#define RV(x) (dir ? 63 - (x) : (x))
    float qv[8], kv[8], x0[8], x1[8];
    const Raw R = Rc;
    { const int e = tid >> 2, part = tid & 3; *(LAS u32x4*)(YV + e * 136 + (e >> 4) * 8 + 64 + 16 * part) = R.s0; *(LAS u32x4*)(YV + e * 136 + (e >> 4) * 8 + 64 + 16 * part + 8) = R.s1; }
    { ItemInfo It = dir ? In : I; if (!dir) { It.dir = 1; It.c = I.NC - 1 - cn; }
      const int itt = (It.seq * It.NC + It.c) * 24 + It.br * 8 + It.dir * 4 + It.head;
      raw_load<true, true>(a, P, It, l, itt, tid, Rc); }
    const int bi = sg >> 1;
    f32x4 acc[4];
#pragma unroll
    for (int nt = 0; nt < 4; ++nt) acc[nt] = (f32x4){0.f, 0.f, 0.f, 0.f};
    if (I.br != 0) {
        gated_from_raw<true>(R, I, qv, kv, x0);
        float run = 0.f;
#pragma unroll
        for (int i = 0; i < 8; ++i) { run += x0[i]; x0[i] = run; }
        TOT[sg * 64 + d] = run; LDS_WAIT(); __syncthreads();
        float pre = 0.f, gs = 0.f, geo = 0.f, gej[3] = {0.f, 0.f, 0.f};
#pragma unroll
        for (int w = 0; w < 8; ++w) { const float t = TOT[w * 64 + d]; if (w < sg) pre += t; if (w < 2 * bi) gs += t; if (w < 2 * bi + 2) geo += t;
            if (w < 2) gej[0] += t; if (w < 4) gej[1] += t; if (w < 6) gej[2] += t; }
#pragma unroll
        for (int i = 0; i < 8; ++i) { x0[i] += pre; const int s = 8 * sg + i; XA[RV(s) * 136 + 64 + d] = (bf16_t)f2bf(qv[i] * __expf(x0[i])); }
        float dfac[2];
#pragma unroll
        for (int j = 0; j < 2; ++j) dfac[j] = __expf(fminf(gs - gej[j], 0.f));
#pragma unroll
        for (int i = 0; i < 8; ++i) { const int tt = 8 * (sg & 1) + i;
            QO[(6 + bi) * 1152 + tt * 72 + d] = (bf16_t)f2bf(qv[i] * __expf(x0[i] - gs));
            KO[(4 + bi) * 1152 + tt * 72 + d] = (bf16_t)f2bf(kv[i] * __expf(fminf(gs - x0[i], 80.f)));
            if (bi < 3) KO[bi * 1152 + tt * 72 + d] = (bf16_t)f2bf(kv[i] * __expf(geo - x0[i]));
            const float qd = qv[i] * __expf(x0[i] - gs);
#pragma unroll
            for (int j = 0; j < 2; ++j) if (j + 1 < bi) QO[(bi * (bi - 1) / 2 + j) * 1152 + tt * 72 + d] = (bf16_t)f2bf(qd * dfac[j]); }
        LDS_WAIT(); __syncthreads();
#pragma unroll
        for (int jj = 0; jj < 2; ++jj) { const int j = 2 * (sg & 1) + jj; f32x4 t = (f32x4){0.f, 0.f, 0.f, 0.f};
            if (j <= bi) { const int qt = (j + 1 >= bi) ? 6 + bi : bi * (bi - 1) / 2 + j, kt = (j == bi) ? 4 + bi : j;
#pragma unroll
                for (int ks = 0; ks < 2; ++ks) t = __builtin_amdgcn_mfma_f32_16x16x32_bf16(ldfrag(QO + qt * 1152, 72, 0, 32 * ks, lane), ldfrag(KO + kt * 1152, 72, 0, 32 * ks, lane), t, 0, 0, 0); }
#pragma unroll
            for (int r = 0; r < 4; ++r) { const int tl = 4 * (lane >> 4) + r, sl = lane & 15; float v = t[r]; if (j == bi && sl > tl) v = 0.f;
                XA[RV(16 * bi + tl) * 136 + RV(16 * j + sl)] = (bf16_t)f2bf(v); } }
        LDS_WAIT(); __syncthreads();
    } else {
        mlstm_from_raw<true>(R, qv, kv, x0, x1);
        float run = 0.f;
#pragma unroll
        for (int i = 0; i < 8; ++i) { run += x0[i]; x0[i] = run; }
        TOT[sg * 64 + d] = run;
        for (int idx = tid; idx < 16 * 128; idx += 512) { const int r = idx >> 7, k = idx & 127; YV[(128 + r) * 136 + 64 + k] = (bf16_t)(r == 0 ? (k < 64 ? 0x3F80u : 0u) : 0u); }
        LDS_WAIT(); __syncthreads();
        float pre = 0.f;
#pragma unroll
        for (int w = 0; w < 8; ++w) { const float t = TOT[w * 64 + d]; if (w < sg) pre += t; }
#pragma unroll
        for (int i = 0; i < 8; ++i) { x0[i] += pre; const int s = 8 * sg + i; if (d == 0) { Bv[s] = x0[i]; LIv[s] = x1[i]; }
            if (i == 0 && sg == 1) YV[128 * 136 + 64 + 64 + d] = (bf16_t)f2bf(R.nc);
            QO[s * 72 + d] = (bf16_t)f2bf(qv[i]); KO[s * 72 + d] = (bf16_t)f2bf(kv[i]); }
        LDS_WAIT(); __syncthreads();
        if (tid < 64) { float rn = LIv[tid] - Bv[tid];
#pragma unroll
            for (int off = 1; off < 64; off <<= 1) { const float u = __shfl_up(rn, off); if (tid >= off) rn = fmaxf(rn, u); }
            const float bt = Bv[tid], inter = bt + R.mc, mt = fmaxf(inter, bt + rn); MT[RV(tid)] = mt; EI[RV(tid)] = __expf(inter - mt); }
        f32x4 t2[2];
#pragma unroll
        for (int jj = 0; jj < 2; ++jj) { const int j = 2 * (sg & 1) + jj; t2[jj] = (f32x4){0.f, 0.f, 0.f, 0.f};
            if (j <= bi) {
#pragma unroll
                for (int ks = 0; ks < 2; ++ks) t2[jj] = __builtin_amdgcn_mfma_f32_16x16x32_bf16(ldfrag(QO, 72, 16 * bi, 32 * ks, lane), ldfrag(KO, 72, 16 * j, 32 * ks, lane), t2[jj], 0, 0, 0); } }
        LDS_WAIT(); __syncthreads();
#pragma unroll
        for (int jj = 0; jj < 2; ++jj) { const int j = 2 * (sg & 1) + jj;
#pragma unroll
            for (int r = 0; r < 4; ++r) { const int t = 16 * bi + 4 * (lane >> 4) + r, s = 16 * j + (lane & 15); float v = 0.f;
                if (s <= t) v = t2[jj][r] * __expf(Bv[t] - Bv[s] + LIv[s] - MT[RV(t)]);
                XA[RV(t) * 136 + RV(s)] = (bf16_t)f2bf(v); } }
#pragma unroll
        for (int i = 0; i < 8; ++i) { const int s = 8 * sg + i; XA[RV(s) * 136 + 64 + d] = (bf16_t)f2bf(qv[i] * EI[RV(s)]); }
        LDS_WAIT(); __syncthreads();
    }
    f32x4 accd[4];
#pragma unroll
    for (int nt = 0; nt < 4; ++nt) accd[nt] = (f32x4){0.f, 0.f, 0.f, 0.f};
#pragma unroll
    for (int ks = 0; ks < 4; ++ks) { const bf16x8 av = ldfragY<8>(YV, 136, 16 * sg, 32 * ks, lane);
        bf16x8 ad = av; if (I.br == 0) ad = ldfragY<8>(YV, 136, 128, 32 * ks, lane);
#pragma unroll
        for (int nt = 0; nt < 4; ++nt) { const bf16x8 bx = ldfrag(XA, 136, 16 * nt, 32 * ks, lane);
            acc[nt] = __builtin_amdgcn_mfma_f32_16x16x32_bf16(av, bx, acc[nt], 0, 0, 0);
            if (I.br == 0) accd[nt] = __builtin_amdgcn_mfma_f32_16x16x32_bf16(ad, bx, accd[nt], 0, 0, 0); } }
#pragma unroll
    for (int nt = 0; nt < 4; ++nt) { const int t = 16 * nt + (lane & 15); f32x4 o = acc[nt];
        if (I.br == 0) { const float den = __shfl(accd[nt][0], lane & 15); const float dn = fmaxf(fabsf(den), __expf(-MT[t])); o = o * __builtin_amdgcn_rcpf(dn); }
        osum[nt] = osum[nt] + o; }
    __syncthreads();
#undef RV
  }
    LAS float* RED = TOT;
#pragma unroll
    for (int nt = 0; nt < 4; ++nt) { float ss = (osum[nt][0] * osum[nt][0] + osum[nt][1] * osum[nt][1]) + (osum[nt][2] * osum[nt][2] + osum[nt][3] * osum[nt][3]);
        ss += __shfl_xor(ss, 16); ss += __shfl_xor(ss, 32);
        if (lane < 16) RED[sg * 64 + 16 * nt + lane] = ss; }
    LDS_WAIT(); __syncthreads();
    bf16_t* YSo = (bf16_t*)(a.ws + WS_A) + (size_t)g * GROWS * 1536;
#pragma unroll
    for (int nt = 0; nt < 4; ++nt) { const int t = 16 * nt + (lane & 15); float tot = 0.f;
#pragma unroll
        for (int w = 0; w < 8; ++w) tot += RED[w * 64 + t];
        const float rr = rsqrtf(tot * (1.0f / 128.0f) + EPSN);
        const int lr = I.seq * I.T + 64 * cn + t;
        const u32x2 gt = gts[nt];
        const float gv[4] = {bflo(gt.x), bfhi(gt.x), bflo(gt.y), bfhi(gt.y)}; float y[4];
#pragma unroll
        for (int r = 0; r < 4; ++r) { const float gg = I.br == 0 ? sigmoidf_(gv[r]) : siluf_(gv[r]); y[r] = gg * (osum[nt][r] * rr) * hw[r]; }
        u32x2 w; w.x = pk2(y[0], y[1]); w.y = pk2(y[2], y[3]);
        *(u32x2*)(YSo + (size_t)lr * 1536 + I.br * 512 + I.head * 128 + e0) = w; }
    __syncthreads();
}


enum { ST_F1IN = 0, ST_F1OUT = 1, ST_ROWA = 2, ST_G0 = 3, ST_BR = 15, ST_MG = 16, ST_OUT = 17, ST_ROWB = 18, ST_F2IN = 19, ST_F2OUT = 20, ST_ROWC = 21, NST = 22 };
#ifndef REP_S1
#define REP_S1 1
#endif
#ifndef REP_S3
#define REP_S3 1
#endif
#ifndef REP_G
#define REP_G 1
#endif
template <int M_, int N_, int K_, int LDA_, int LDB_, int ADIV, int AMUL, int KS, class Epi>
__device__ __forceinline__ void run_gemm(LAS unsigned char* lds, const bf16_t* A, const bf16_t* Bt, const Epi& E) {
    typedef pg8::GemmT<M_, N_, K_, LDA_, LDB_> GT; GT g{A, Bt}; typedef pg8::StaticOrderT<M_, N_, ADIV, AMUL, KS> SO; SO S; S.init((int)gridDim.x, (int)blockIdx.x);
    pg8::gemm_phase<GT, Epi, SO, true, true>((PG8_LAS unsigned char*)lds, g, S, E);
}

__global__ void __launch_bounds__(512, 2) mk_fwd(Args a) {
    extern __shared__ __attribute__((aligned(16))) unsigned char lds_raw[];
    LAS unsigned char* lds = (LAS unsigned char*)lds_raw;
    cg::grid_group grid = cg::this_grid();
    for (int u = threadIdx.x; u < (LDS_BYTES - 131072) / 4; u += 512) ((LAS unsigned*)(lds + 131072))[u] = 0u;
    __syncthreads();
    (void)xcd_barrier_post((unsigned*)a.ws, (volatile LAS unsigned*)(lds + 131072 + 352));
    const int tid = threadIdx.x, lane = tid & 63, wave = __builtin_amdgcn_readfirstlane(tid >> 6);
    const int G = gridDim.x, gw = blockIdx.x * 8 + wave, NGW = G * 8;
    unsigned char* ws = a.ws;
    float* mod = (float*)(ws + WS_MOD);

#ifndef SKIP_PRO
#ifdef SPIN_MASK
    const unsigned long long pro_t0 = __builtin_amdgcn_s_memrealtime();
#endif
    convert_weights(a, lds, 0, 0, 13728, 1, gw, NGW, lane, wave);
    __syncthreads();
    ada_partial(a, lds, gw, NGW, lane, wave);
    { float* pos = (float*)(ws + WS_POS);
      for (int i = blockIdx.x * 512 + tid; i < 64 * 512; i += G * 512) { const int v = i >> 9, j = i & 511, fi = j & 255;
          const float fr = expf((-9.210340371976184f * (float)fi) / 256.0f); const float ang = (float)v * fr; pos[i] = j < 256 ? sinf(ang) : cosf(ang); } }
    if (a.ws == nullptr) grid.sync();
    xcd_barrier_ni((unsigned*)a.ws, 131072 + 352);
    { const float* modp = (const float*)(ws + WS_MODP);
      for (int i = blockIdx.x * 512 + tid; i < 2 * 5 * 9216; i += G * 512) { const int col = i % 9216, l = i / (5 * 9216); float s = inp(a, I_BADA)[l * 9216 + col];
#pragma unroll
          for (int ks = 0; ks < 8; ++ks) s += modp[(size_t)ks * (2 * 5 * 9216) + i]; mod[i] = s; } }
    xcd_barrier_ni((unsigned*)a.ws, 131072 + 352);
    { RowOp op{}; op.src_input = 1; op.has_y = 0; op.has_xn = 1; op.npre = inp(a, I_NPRE); op.md_base = mod; op.si = 0; op.add_pos = 0;
      rowwise_all(a, op, gw, NGW, lane); }
    xcd_barrier_ni((unsigned*)a.ws, 131072 + 352);
#ifdef SPIN_MASK
    if ((SPIN_MASK >> 10) & 1) { const unsigned long long t1 = __builtin_amdgcn_s_memrealtime(); while (__builtin_amdgcn_s_memrealtime() - t1 < t1 - pro_t0) __builtin_amdgcn_s_sleep(4); }
#endif
#endif

    for (int l = 0; l < 2; ++l) {
        for (int st = 0; st < NST; ++st) {
            int tid = threadIdx.x; asm volatile("" : "+v"(tid));
            const int lane = tid & 63, wave = __builtin_amdgcn_readfirstlane(tid >> 6), gw = blockIdx.x * 8 + wave;
            unsigned char* ws = a.ws; asm volatile("" : "+s"(ws));
            float* mod = (float*)(ws + WS_MOD); const float* modl = mod + (size_t)l * 5 * 9216;
            bf16_t* XN = (bf16_t*)(ws + WS_XN); bf16_t* BIG = (bf16_t*)(ws + WS_BIG); float* Y = (float*)(ws + WS_A); bf16_t* YS = (bf16_t*)(ws + WS_A);
            unsigned char* wb = ws + WS_W; const int G = gridDim.x, NGW = G * 8;
            const int kind = (st == ST_F1IN || st == ST_F2IN) ? 0 : (st == ST_F1OUT || st == ST_OUT || st == ST_F2OUT) ? 1 : (st == ST_ROWA || st == ST_ROWB || st == ST_ROWC) ? 2 : (st == ST_BR) ? 3 : (st == ST_MG) ? 4 : 5 + ((st - ST_G0) % 4);
            const int g = (st >= ST_G0 && st < ST_BR) ? (st - ST_G0) / 4 : 0;
#ifdef SPIN_MASK
            const unsigned long long spin_t0 = __builtin_amdgcn_s_memrealtime();
#endif
            switch (kind) {
            case 0: {
#ifndef SKIP_G0
                const int f = st == ST_F1IN ? 0 : 1; EpiSwiGLU E{BIG, DFF};
                for (int rep = 0; rep < REP_G; ++rep) run_gemm<MTOT, NFF2, D, D, D, 0, 0, 1>(lds, XN, (const bf16_t*)(wb + W_FFIN) + (size_t)f * NFF2 * D, E);
                if (blockIdx.x >= 64) { const int vw = (blockIdx.x - 64) * 8 + wave, vn = (G - 64) * 8;
                    if (l == 0 && st == ST_F2IN) convert_weights(a, lds, 1, 8448, 13728, 1, vw, vn, lane, wave);
                    if (l == 1 && st == ST_F1IN) { convert_weights(a, lds, 1, 2816, 5632, 0, vw, vn, lane, wave); convert_weights(a, lds, 1, 7040, 8448, 0, vw, vn, lane, wave); } }
#endif
                break; }
            case 1: {
#ifndef SKIP_G1
                EpiBf16 E{(bf16_t*)Y, D, 4, (size_t)MTOT * D};
                for (int rep = 0; rep < REP_G; ++rep)
                if (st == ST_OUT) { EpiBf16 E1{(bf16_t*)Y, D, 0, 0}; run_gemm<MTOT, D, D, 3072, 3072, 0, 0, 1>(lds, BIG, (const bf16_t*)(wb + W_O3), E1); }
                else { EpiBf16 E1{(bf16_t*)Y, D, 0, 0}; run_gemm<MTOT, D, DFF, DFF, DFF, 0, 0, 1>(lds, BIG, (const bf16_t*)(wb + W_FFOUT) + (size_t)(st == ST_F1OUT ? 0 : 1) * D * DFF, E1); }
#endif
                break; }
            case 2: {
#ifndef SKIP_ROW
                RowOp op{}; op.has_y = 1; op.ysplit = 0; op.mdg_base = modl + (st == ST_ROWA ? 2 : st == ST_ROWB ? 5 : 8) * D; op.coef = st == ST_ROWB ? 1.0f : 0.5f;
                op.npost = inp(a, I_NPOST) + (size_t)(l * 3 + (st == ST_ROWA ? 0 : st == ST_ROWB ? 1 : 2)) * D; op.src_input = (l == 0 && st == ST_ROWA) ? 1 : 0;
                if (st == ST_ROWA) { op.has_xn = 1; op.npre = inp(a, I_NPRE) + (size_t)(l * 3 + 1) * D; op.md_base = modl; op.si = 3; op.add_pos = 1; }
                else if (st == ST_ROWB) { op.has_xn = 1; op.npre = inp(a, I_NPRE) + (size_t)(l * 3 + 2) * D; op.md_base = modl; op.si = 6; op.add_pos = 0; }
                else { op.has_xn = (l == 0) ? 1 : 0; op.npre = inp(a, I_NPRE) + (size_t)3 * D; op.md_base = mod + (size_t)5 * 9216; op.si = 0; op.add_pos = 0; }
                rowwise_all(a, op, gw, NGW, lane);
#endif
                break; }
            case 3: {
#ifndef SKIP_G3
                EpiBf16 E{BIG, 3072, 0, 0};
                for (int rep = 0; rep < REP_G; ++rep) run_gemm<MTOT, 3072, 512, 1536, 512, 4, 512, 1>(lds, YS, (const bf16_t*)(wb + W_B), E);
#endif
                break; }
            case 4: {
#ifndef SKIP_G4
                EpiGateSum E{BIG, 3072};
                { typedef pg8::GemmT<MTOT, MGN, D, D, D> GT3; GT3 g3{XN, (const bf16_t*)(wb + W_MG)}; pg8::TripleOrder S3{(int)gridDim.x, (int)blockIdx.x};
                  pg8::gemm_phase<GT3, EpiGateSum, pg8::TripleOrder, true, true>((PG8_LAS unsigned char*)lds, g3, S3, E); }
#endif
                break; }
            case 5: {
#ifndef SKIP_G3
                EpiBf16 E{BIG, PN, 0, 0};
                for (int rep = 0; rep < REP_G; ++rep) run_gemm<GROWS, PN, D, D, D, 0, 0, 1>(lds, XN + (size_t)g * GROWS * D, (const bf16_t*)(wb + W_P), E);
                if (l == 0 && blockIdx.x >= 128 && g < 2) { const int vw = (blockIdx.x - 128) * 8 + wave, vn = (G - 128) * 8;
                    if (g == 0) convert_weights(a, lds, 1, 0, 2816, 0, vw, vn, lane, wave); else convert_weights(a, lds, 1, 5632, 7040, 0, vw, vn, lane, wave); }
#endif
                break; }
            case 6: {
#ifndef SKIP_S1
                { const bf16_t* Pp = (const bf16_t*)(ws + WS_BIG); Raw R = {}; u32x4 v0 = {0u, 0u, 0u, 0u}, v1 = v0; int it = blockIdx.x;
                  { const int itc = it < 3072 ? it : 3071; const ItemInfo I0 = item_info(g, itc); raw_load<false, false>(a, Pp, I0, l, itc, tid, R); v_load(Pp, I0, tid, v0, v1); }
                  for (; it < 3072; it += G) { const int itn = it + G < 3072 ? it + G : 3071; Raw Rn = {}; u32x4 vn0, vn1;
                      { const ItemInfo I1 = item_info(g, itn); raw_load<false, false>(a, Pp, I1, l, itn, tid, Rn); v_load(Pp, I1, tid, vn0, vn1); }
                      scan_s1(a, lds, l, g, it, R, v0, v1); R = Rn; v0 = vn0; v1 = vn1; } }
#endif
                break; }
            case 7: {
#ifndef SKIP_S2
                if (g < 2) scan_s2<8>(a, l, g); else scan_s2<4>(a, l, g);
#endif
                break; }
            case 8: {
#ifndef SKIP_S3
                { const bf16_t* Pp = (const bf16_t*)(ws + WS_BIG); Raw R = {}; u32x4 v0 = {0u, 0u, 0u, 0u}, v1 = v0; int it = blockIdx.x;
                  { const int itc = it < 1536 ? it : 1535; const int hb = itc % 12, cgl = itc / 12; ItemInfo I0; I0.br = hb >> 2; I0.head = hb & 3; I0.T = g < 2 ? 4096 : 256; I0.NC = I0.T >> 6; I0.seq = cgl / I0.NC; I0.c = cgl % I0.NC; I0.dir = 0;
                    raw_load<true, true>(a, Pp, I0, l, (I0.seq * I0.NC + I0.c) * 24 + I0.br * 8 + I0.head, tid, R); v_load(Pp, I0, tid, v0, v1); }
                  for (; it < 1536; it += G) { const int itn = it + G < 1536 ? it + G : 1535; scan_s3(a, lds, l, g, it, itn, R, v0, v1); } }
#endif
                break; }
            default: break;
            }
#ifdef SPIN_MASK
            if ((SPIN_MASK >> kind) & 1) { const unsigned long long t1 = __builtin_amdgcn_s_memrealtime(); while (__builtin_amdgcn_s_memrealtime() - t1 < t1 - spin_t0) __builtin_amdgcn_s_sleep(4); }
#endif
#ifdef BAR_PROBE
            if (st != ST_BR) { unsigned long long* la = (unsigned long long*)(a.ws + 8192);
                asm volatile("s_waitcnt vmcnt(0)" ::: "memory"); __syncthreads();
                if (threadIdx.x == 0) __hip_atomic_fetch_max(la, (unsigned long long)__builtin_amdgcn_s_memrealtime(), __ATOMIC_RELAXED, __HIP_MEMORY_SCOPE_AGENT);
                xcd_barrier_ni((unsigned*)a.ws, 131072 + 352);
                const unsigned long long tr = __builtin_amdgcn_s_memrealtime(), tl = __hip_atomic_load(la, __ATOMIC_RELAXED, __HIP_MEMORY_SCOPE_AGENT);
                while (__builtin_amdgcn_s_memrealtime() - tr < tr - tl) __builtin_amdgcn_s_sleep(2);
                __syncthreads(); } else {
#else
            if (true) xcd_barrier_ni((unsigned*)a.ws, 131072 + 352); else {
#endif
            asm volatile("s_waitcnt vmcnt(0)" ::: "memory"); __syncthreads(); }
#ifdef EXTRA_SYNC
            xcd_barrier_ni((unsigned*)a.ws, 131072 + 352);
#endif
        }
    }
}

extern "C" void kernel_launch(void* const* d_in, const int* in_sizes, int n_in, void* d_out, int out_size, void* d_ws, size_t ws_size, hipStream_t stream) {
    static int grid = 0;
    if (grid == 0) {
        if (n_in != 23 || ws_size < WS_END) { fprintf(stderr, "kernel_launch: unexpected n_in %d / ws_size %zu (need %zu)\n", n_in, ws_size, (size_t)WS_END); grid = -1; return; }
        int dev = 0, cus = 0, per_cu = 0;
        hipGetDevice(&dev); hipDeviceGetAttribute(&cus, hipDeviceAttributeMultiprocessorCount, dev);
        hipFuncSetAttribute((const void*)mk_fwd, hipFuncAttributeMaxDynamicSharedMemorySize, LDS_BYTES);
        hipOccupancyMaxActiveBlocksPerMultiprocessor(&per_cu, (const void*)mk_fwd, 512, LDS_BYTES);
        (void)hipGetLastError();
        if (per_cu < 1) per_cu = 1;
        grid = cus;
    }
    if (grid < 0) return;
    if (hipMemsetAsync(d_ws, 0, 16384, stream) != hipSuccess) { fprintf(stderr, "memset failed\n"); return; }
    Args a{};
    for (int i = 0; i < 23; ++i) a.in[i] = (const float*)d_in[i];
    a.out = (float*)d_out; a.ws = (unsigned char*)d_ws;
    void* args[] = {&a};
    hipError_t e = hipLaunchCooperativeKernel((const void*)mk_fwd, dim3(grid), dim3(512), args, LDS_BYTES, stream);
    if (e != hipSuccess) fprintf(stderr, "cooperative launch failed: %s (grid %d)\n", hipGetErrorString(e), grid);
}
```

```cpp
#include <hip/hip_runtime.h>
#include <hip/hip_cooperative_groups.h>
#include <cstdio>
#include <cstdint>
namespace cg = cooperative_groups;

namespace pg8 {
#define PG8_LAS __attribute__((address_space(3)))
typedef unsigned short bf16_t;
typedef short bf16x8 __attribute__((ext_vector_type(8)));
typedef float f32x4 __attribute__((ext_vector_type(4)));
typedef unsigned u32x4 __attribute__((ext_vector_type(4)));
typedef unsigned u32x2 __attribute__((ext_vector_type(2)));
constexpr int BM = 256, BK = 64, HALF = 128, HTB = HALF * BK * 2, STAGE_BYTES = 8 * HTB, NXCD = 8, WGM = 8;

__host__ __device__ __forceinline__ int lds_byte(int r, int c) { const int st = (r >> 4) * 2 + (c >> 5), rr = r & 15, cc = c & 31, ob = rr * 64 + cc * 2; return st * 1024 + (ob ^ (((ob >> 9) & 1) << 5)); }
__host__ __device__ __forceinline__ void stage_rc(int b, int& R, int& C) { const int st = b / 1024, sb = b % 1024, swz = sb ^ (((sb >> 9) & 1) << 5); R = (st >> 1) * 16 + swz / 64; C = (st & 1) * 32 + (swz % 64) / 2; }
__host__ __device__ __forceinline__ int perm32(int rho) { const int n = rho >> 4, i = rho & 15; return 8 * (i >> 2) + 4 * n + (i & 3); }

struct Unit { int pm, pn; };
template <int M_, int N_, int K_, int LDA_, int LDB_> struct GemmT { const bf16_t* A; const bf16_t* Bt; static constexpr int M = M_, N = N_, K = K_, lda = LDA_, ldb = LDB_; };

struct TripleOrder {
    int G, c;
    __device__ __forceinline__ bool next(int i, Unit& u) const { const int tr = c + G * (i / 3); if (tr >= 384) return false; u.pm = tr >> 2; u.pn = (i % 3) * 4 + (tr & 3); return true; }
    __device__ __forceinline__ int a_off(const Unit&) const { return 0; }
    __device__ __forceinline__ int b_tile(const Unit& u) const { return u.pn; }
    __device__ __forceinline__ int b_koff(const Unit&) const { return 0; }
    __device__ __forceinline__ void a_ready(const Unit&) const {}
    __device__ __forceinline__ void done(const Unit&) const {}
};
template <int M_, int N_, int ADIV, int AMUL, int KS = 1> struct StaticOrderT {
    static constexpr int nM = M_ / BM, nN = N_ / BM, nwg = nM * nN;
    int G, c;
    __device__ void init(int G_, int c_) { G = G_; c = c_; }
    __device__ __forceinline__ bool next(int i, Unit& u) const {
        const int L = i * G + c; if (L >= nwg) return false;
        int wgid = L; { constexpr int q = nwg / NXCD, r = nwg % NXCD; const int xcd = wgid % NXCD, off = wgid / NXCD; wgid = (xcd < r ? xcd * (q + 1) : r * (q + 1) + (xcd - r) * q) + off; }
        constexpr int nig = WGM * nN; const int gid = wgid / nig, fm = gid * WGM, gsz = (nM - fm) < WGM ? (nM - fm) : WGM;
        u.pm = fm + ((wgid % nig) % gsz); u.pn = (wgid % nig) / gsz; return true;
    }
    __device__ __forceinline__ int a_off(const Unit& u) const { return ADIV > 0 ? (u.pn / (ADIV > 0 ? ADIV : 1)) * AMUL : 0; }
    __device__ __forceinline__ int b_tile(const Unit& u) const { return KS > 1 ? u.pn % (nN / KS) : u.pn; }
    __device__ __forceinline__ int b_koff(const Unit& u) const { return KS > 1 ? (u.pn / (nN / KS)) * AMUL : 0; }
    __device__ __forceinline__ void a_ready(const Unit&) const {}
    __device__ __forceinline__ void done(const Unit&) const {}
};

template <class GT, class Epi, class Sched, bool ALIGN_EPI = false, bool SP2 = false>
__device__ __forceinline__ void gemm_phase(PG8_LAS unsigned char* lds, const GT g, const Sched& S, const Epi& E) {
    int tid_ = threadIdx.x; asm volatile("" : "+v"(tid_));
    const int tid = tid_, wid = __builtin_amdgcn_readfirstlane(tid >> 6), lane = tid & 63, wr = wid >> 2, wc = wid & 3, fr = lane & 15, fq = lane >> 4;
    constexpr int K = GT::K, nt = K / BK;
    unsigned voffA[2], voffB[2];
#pragma unroll
    for (int i = 0; i < 2; ++i) { int R, C; stage_rc(tid * 16 + i * 8192, R, C); const int Rb = Epi::PERM ? ((R & ~31) + perm32(R & 31)) : R;
        voffA[i] = (unsigned)(R * GT::lda + C) * 2u; voffB[i] = (unsigned)(Rb * GT::ldb + C) * 2u; }
    constexpr size_t kstep = (size_t)(BK * 2);
    constexpr size_t hstepA = (size_t)HALF * GT::lda * 2, hstepB = (size_t)HALF * GT::ldb * 2;
    constexpr size_t tstepA = 2 * hstepA, tstepB = 2 * hstepB;
    const unsigned ldsw = (unsigned)wid * 1024u;
    const int aoff = lds_byte(wr * 64 + fr, fq * 8), boff = lds_byte(wc * 32 + fr, fq * 8);
#define PG8_SA(b, h) (((b) * 2 + (h)) * HTB)
#define PG8_SB(b, h) ((4 + (b) * 2 + (h)) * HTB)
#define PG8_STAGE(bufoff, gbase, voff) do { _Pragma("unroll") for (int _i = 0; _i < 2; ++_i) \
        __builtin_amdgcn_global_load_lds((const unsigned*)((const char*)(gbase) + (voff)[_i]), (PG8_LAS unsigned*)(lds + (bufoff) + ldsw + _i * 8192), 16, 0, 0); } while (0)
#define PG8_LDA(dst, b, h) do { _Pragma("unroll") for (int m = 0; m < 4; ++m) _Pragma("unroll") for (int k = 0; k < 2; ++k) dst[m][k] = *(const PG8_LAS bf16x8*)(lds + PG8_SA(b, h) + aoff + m * 2048 + k * 1024); } while (0)
#define PG8_LDB(dst, b, h) do { _Pragma("unroll") for (int n = 0; n < 2; ++n) _Pragma("unroll") for (int k = 0; k < 2; ++k) dst[n][k] = *(const PG8_LAS bf16x8*)(lds + PG8_SB(b, h) + boff + n * 2048 + k * 1024); } while (0)
#define PG8_MMA(ai, bj, At, Bt) do { __builtin_amdgcn_s_setprio(1); _Pragma("unroll") for (int m = 0; m < 4; ++m) _Pragma("unroll") for (int n = 0; n < 2; ++n) _Pragma("unroll") for (int k = 0; k < 2; ++k) \
        acc[ai][bj][m][n] = __builtin_amdgcn_mfma_f32_16x16x32_bf16(Bt[n][k], At[m][k], acc[ai][bj][m][n], 0, 0, 0); __builtin_amdgcn_s_setprio(0); } while (0)
#define PG8_WAIT_V(n) asm volatile("s_waitcnt vmcnt(" #n ")" ::: "memory")
#define PG8_WAIT_L(n) asm volatile("s_waitcnt lgkmcnt(" #n ")" ::: "memory")
#define PG8_BAR __builtin_amdgcn_s_barrier()
#define PG8_SCHED __builtin_amdgcn_sched_barrier(0)
    Unit cur, nxt; int ui = 0;
    if (!S.next(0, cur)) return;
    f32x4 acc[2][2][4][2];
#pragma unroll
    for (int a = 0; a < 2; ++a)
#pragma unroll
        for (int b = 0; b < 2; ++b)
#pragma unroll
            for (int m = 0; m < 4; ++m)
#pragma unroll
                for (int n = 0; n < 2; ++n) acc[a][b][m][n] = (f32x4){0.f, 0.f, 0.f, 0.f};
    bf16x8 At[4][2], B0[2][2], B1[2][2];
    const char* cA = (const char*)g.A + (size_t)cur.pm * tstepA + (size_t)S.a_off(cur) * 2; const char* cB = (const char*)g.Bt + (size_t)S.b_tile(cur) * tstepB + (size_t)S.b_koff(cur) * 2;
    S.a_ready(cur);
    if constexpr (SP2) {
        PG8_STAGE(PG8_SB(0, 0), cB, voffB); PG8_STAGE(PG8_SB(0, 1), cB + hstepB, voffB); PG8_STAGE(PG8_SA(0, 0), cA, voffA); PG8_STAGE(PG8_SA(0, 1), cA + hstepA, voffA);
        if (wr == 1) PG8_BAR;
        PG8_WAIT_V(2); PG8_BAR;
        PG8_STAGE(PG8_SB(1, 0), cB + kstep, voffB); PG8_STAGE(PG8_SA(1, 0), cA + kstep, voffA); PG8_STAGE(PG8_SB(1, 1), cB + hstepB + kstep, voffB);
        PG8_WAIT_V(6); PG8_BAR;
    } else {
        PG8_STAGE(PG8_SB(0, 0), cB, voffB); PG8_STAGE(PG8_SA(0, 0), cA, voffA); PG8_STAGE(PG8_SB(0, 1), cB + hstepB, voffB); PG8_STAGE(PG8_SA(0, 1), cA + hstepA, voffA);
        if (wr == 1) PG8_BAR;
        PG8_WAIT_V(4); PG8_BAR;
        PG8_STAGE(PG8_SB(1, 0), cB + kstep, voffB); PG8_STAGE(PG8_SA(1, 0), cA + kstep, voffA); PG8_STAGE(PG8_SB(1, 1), cB + hstepB + kstep, voffB);
        PG8_WAIT_V(6); PG8_BAR;
    }
    for (;;) {
        const bool has_next = S.next(ui + 1, nxt);
        const char* nA = has_next ? (const char*)g.A + (size_t)nxt.pm * tstepA + (size_t)S.a_off(nxt) * 2 : cA; const char* nB = has_next ? (const char*)g.Bt + (size_t)S.b_tile(nxt) * tstepB + (size_t)S.b_koff(nxt) * 2 : cB;
        for (int t = 0; t < nt; t += 2) {
            const bool last = (t == nt - 2);
            const char* a1 = cA + (size_t)(t + 1) * kstep;
            const char* a2 = last ? nA : cA + (size_t)(t + 2) * kstep; const char* b2 = last ? nB : cB + (size_t)(t + 2) * kstep;
            const char* a3 = a2 + kstep; const char* b3 = b2 + kstep;
            if (last && has_next) S.a_ready(nxt);
            if constexpr (SP2) {
            PG8_LDB(B0, 0, 0); PG8_LDB(B1, 0, 1); PG8_SCHED; PG8_LDA(At, 0, 0); PG8_STAGE(PG8_SA(1, 1), a1 + hstepA, voffA);
            PG8_WAIT_V(8); PG8_WAIT_L(0); PG8_BAR; PG8_MMA(0, 0, At, B0); PG8_MMA(0, 1, At, B1); PG8_BAR; PG8_SCHED;
            PG8_LDA(At, 0, 1); PG8_STAGE(PG8_SB(0, 0), b2, voffB); PG8_STAGE(PG8_SB(0, 1), b2 + hstepB, voffB); PG8_STAGE(PG8_SA(0, 0), a2, voffA);
            PG8_WAIT_V(8); PG8_WAIT_L(0); PG8_BAR; PG8_MMA(1, 0, At, B0); PG8_MMA(1, 1, At, B1); PG8_BAR; PG8_SCHED;
            PG8_LDB(B0, 1, 0); PG8_LDB(B1, 1, 1); PG8_SCHED; PG8_LDA(At, 1, 0); PG8_STAGE(PG8_SA(0, 1), a2 + hstepA, voffA);
            PG8_WAIT_V(8); PG8_WAIT_L(0); PG8_BAR; PG8_MMA(0, 0, At, B0); PG8_MMA(0, 1, At, B1); PG8_BAR; PG8_SCHED;
            PG8_LDA(At, 1, 1); PG8_STAGE(PG8_SB(1, 0), b3, voffB); PG8_STAGE(PG8_SB(1, 1), b3 + hstepB, voffB); PG8_STAGE(PG8_SA(1, 0), a3, voffA);
            PG8_WAIT_V(8); PG8_WAIT_L(0); PG8_BAR; PG8_MMA(1, 0, At, B0); PG8_MMA(1, 1, At, B1); PG8_BAR; PG8_SCHED;
            } else {
            PG8_LDB(B0, 0, 0); PG8_SCHED; PG8_LDA(At, 0, 0); PG8_STAGE(PG8_SA(1, 1), a1 + hstepA, voffA);
            PG8_WAIT_L(8); PG8_BAR; PG8_WAIT_L(0); PG8_MMA(0, 0, At, B0); PG8_BAR; PG8_SCHED;
            PG8_LDB(B1, 0, 1); PG8_STAGE(PG8_SB(0, 0), b2, voffB);
            PG8_BAR; PG8_WAIT_L(0); PG8_MMA(0, 1, At, B1); PG8_BAR;
            PG8_LDA(At, 0, 1); PG8_STAGE(PG8_SA(0, 0), a2, voffA);
            PG8_BAR; PG8_WAIT_L(0); PG8_MMA(1, 0, At, B0); PG8_BAR; PG8_SCHED;
            PG8_STAGE(PG8_SB(0, 1), b2 + hstepB, voffB);
            PG8_WAIT_V(6); PG8_BAR; PG8_MMA(1, 1, At, B1); PG8_BAR;
            PG8_LDB(B0, 1, 0); PG8_SCHED; PG8_LDA(At, 1, 0); PG8_STAGE(PG8_SA(0, 1), a2 + hstepA, voffA);
            PG8_WAIT_L(8); PG8_BAR; PG8_WAIT_L(0); PG8_MMA(0, 0, At, B0); PG8_BAR; PG8_SCHED;
            PG8_LDB(B1, 1, 1); PG8_STAGE(PG8_SB(1, 0), b3, voffB);
            PG8_BAR; PG8_WAIT_L(0); PG8_MMA(0, 1, At, B1); PG8_BAR;
            PG8_LDA(At, 1, 1); PG8_STAGE(PG8_SA(1, 0), a3, voffA);
            PG8_BAR; PG8_WAIT_L(0); PG8_MMA(1, 0, At, B0); PG8_BAR; PG8_SCHED;
            PG8_STAGE(PG8_SB(1, 1), b3 + hstepB, voffB);
            PG8_WAIT_V(6); PG8_BAR; PG8_MMA(1, 1, At, B1); PG8_BAR;
            }
        }
        if constexpr (ALIGN_EPI) { if (wr == 0) PG8_BAR; }
        if constexpr (!Epi::AFTER_DRAIN) { E(acc, cur, wr, wc, fr, fq); S.done(cur); }
        if (!has_next) break;
#pragma unroll
        for (int a = 0; a < 2; ++a)
#pragma unroll
            for (int b = 0; b < 2; ++b)
#pragma unroll
                for (int m = 0; m < 4; ++m)
#pragma unroll
                    for (int n = 0; n < 2; ++n) acc[a][b][m][n] = (f32x4){0.f, 0.f, 0.f, 0.f};
        cur = nxt; cA = nA; cB = nB; ++ui;
        if constexpr (ALIGN_EPI) { if (wr == 1) PG8_BAR; }
    }
    PG8_WAIT_V(0);
    if constexpr (!ALIGN_EPI) { if (wr == 0) PG8_BAR; }
    PG8_BAR;
    if constexpr (Epi::AFTER_DRAIN) { E.fused(acc, cur, wr, wc, fr, fq, lds, wid, lane); S.done(cur); }
#undef PG8_SA
#undef PG8_SB
#undef PG8_STAGE
#undef PG8_LDA
#undef PG8_LDB
#undef PG8_MMA
#undef PG8_WAIT_V
#undef PG8_WAIT_L
#undef PG8_BAR
#undef PG8_SCHED
}
}

#define LAS __attribute__((address_space(3)))
typedef unsigned short bf16_t;
typedef short bf16x8 __attribute__((ext_vector_type(8)));
typedef float f32x4 __attribute__((ext_vector_type(4)));
typedef unsigned u32x4 __attribute__((ext_vector_type(4)));
typedef unsigned u32x2 __attribute__((ext_vector_type(2)));

constexpr int D = 1024, DFF = 2816, NFF2 = 5632, INC = 7984, PN = 5120, PREAL = 4912, MGN = 3072;
constexpr int MTOT = 24576, MLAT = 16384, GROWS = 8192;
constexpr float EPSN = 1e-6f;
constexpr size_t MiB = 1u << 20;
constexpr size_t WS_MOD = 1 * MiB, WS_MODP = 2 * MiB, WS_POS = 5 * MiB, WS_DEC = 6 * MiB, WS_SC = 7 * MiB;
constexpr size_t WS_W = 8 * MiB;
constexpr size_t W_FFIN = 0, W_FFOUT = W_FFIN + 2ull * NFF2 * D * 2, W_P = W_FFOUT + 2ull * D * DFF * 2, W_MG = W_P + (size_t)PN * D * 2,
                 W_B = W_MG + (size_t)MGN * D * 2, W_O3 = W_B + 3072ull * 512 * 2, W_END = W_O3 + 1024ull * 3072 * 2;
static_assert(W_END <= 58 * MiB, "weights region");
constexpr size_t WS_XN = 66 * MiB, WS_A = 114 * MiB, WS_BIG = 210 * MiB, WS_END = 370 * MiB;
constexpr size_t BIG_US = 80 * MiB, BIG_OB = 128 * MiB;
constexpr size_t OFF_YP = 0, OFF_YS = 8388608, OFF_C = 25165824, OFF_N = 29360128, OFF_M = 29392896, OFF_G = 29393408, OFF_H = 33587712;
constexpr int LDS_BYTES = 147456;

struct Args { const float* in[23]; float* out; unsigned char* ws; };
enum { I_XP = 0, I_XS, I_C, I_SC, I_SN, I_SM, I_SG, I_SH, I_CCTX, I_WADA, I_BADA, I_NPRE, I_NPOST, I_WFIN, I_WFOUT, I_WIN, I_GB, I_GWUP, I_GLB, I_HGAM, I_HN, I_WBR, I_WOUT };
__device__ __forceinline__ const float* inp(const Args& a, int i) { asm volatile("" : "+s"(i)); return a.in[i]; }

typedef float f32x2_t __attribute__((ext_vector_type(2))); typedef __bf16 bf16x2_t __attribute__((ext_vector_type(2)));
__device__ __forceinline__ unsigned pk2(float lo, float hi) { f32x2_t v = {lo, hi}; bf16x2_t b = __builtin_convertvector(v, bf16x2_t); return __builtin_bit_cast(unsigned, b); }
__device__ __forceinline__ unsigned f2bf(float f) { return pk2(f, 0.f) & 0xffffu; }
__device__ __forceinline__ float bf2f(bf16_t h) { return __uint_as_float(((unsigned)h) << 16); }
__device__ __forceinline__ float bflo(unsigned w) { return __uint_as_float(w << 16); }
__device__ __forceinline__ float bfhi(unsigned w) { return __uint_as_float(w & 0xffff0000u); }
__device__ __forceinline__ float sigmoidf_(float x) { return __builtin_amdgcn_rcpf(1.0f + __expf(-x)); }
__device__ __forceinline__ float siluf_(float x) { return x * __builtin_amdgcn_rcpf(1.0f + __expf(-x)); }
__device__ __forceinline__ float logsigf_(float x) { return fminf(x, 0.f) - __logf(1.0f + __expf(-fabsf(x))); }
__device__ __forceinline__ float wave_sum(float v) {
#pragma unroll
    for (int o = 1; o < 64; o <<= 1) v += __shfl_xor(v, o);
    return v;
}
#define LDS_WAIT() asm volatile("s_waitcnt lgkmcnt(0)" ::: "memory")
#ifndef NO_WT
__device__ __forceinline__ void st_wt8(void* p, u32x2 v) { __hip_atomic_store((unsigned long long*)p, ((unsigned long long)v.y << 32) | v.x, __ATOMIC_RELAXED, __HIP_MEMORY_SCOPE_AGENT); }
__device__ __forceinline__ void st_wt16(void* p, u32x4 v) { st_wt8(p, (u32x2){v.x, v.y}); st_wt8((char*)p + 8, (u32x2){v.z, v.w}); }
#else
__device__ __forceinline__ void st_wt8(void* p, u32x2 v) { *(u32x2*)p = v; }
__device__ __forceinline__ void st_wt16(void* p, u32x4 v) { *(u32x4*)p = v; }
#endif

#define XB_TMO      128
#define XB_XCNT(j)  (256  + 64 * (j))
#define XB_XSUB(j)  (1280 + 64 * (j))
#define XB_XGEN(j)  (2304 + 64 * (j))
#define XB_TOP      3328
#define XB_TOPGEN   3392
#define XCD_BAR_WORDS 3456
#define XB_SPIN_CAP (1u << 18)

__device__ __forceinline__ unsigned xb_ld(unsigned* p)              { return __hip_atomic_load(p, __ATOMIC_RELAXED, __HIP_MEMORY_SCOPE_AGENT); }
__device__ __forceinline__ unsigned xb_add(unsigned* p, unsigned v) { return __hip_atomic_fetch_add(p, v, __ATOMIC_RELAXED, __HIP_MEMORY_SCOPE_AGENT); }
__device__ __forceinline__ unsigned xb_xcc_id() { return (unsigned)__builtin_amdgcn_s_getreg((3 << 11) | 20) & 0xFu; }
#define XB_SPIN(cond, bar) do { unsigned _sp = 0; while (cond) { __builtin_amdgcn_s_sleep(1); \
    if ((++_sp & 255u) == 0u) { if (xb_ld(&(bar)[XB_TMO])) break; if (_sp > XB_SPIN_CAP) { atomicAdd(&(bar)[XB_TMO], 1u); break; } } } } while (0)

struct XcdBarrier {
    unsigned* bar; unsigned x;
    volatile LAS unsigned* st;
};

__device__ __forceinline__ XcdBarrier xcd_barrier_post(unsigned* bar, volatile LAS unsigned* st) {
    XcdBarrier b; b.bar = bar; b.x = xb_xcc_id(); b.st = st;
    if (threadIdx.x == 0) (void)xb_add(&bar[XB_XCNT(b.x)], 1u);
    return b;
}
__device__ __forceinline__ void xcd_barrier_complete(unsigned* bar, unsigned x, unsigned& nloc, unsigned& nx) {
    const unsigned G = gridDim.x * gridDim.y * gridDim.z;
    unsigned sum, cnt, mine, sp = 0u;
    for (;;) {
        sum = 0u; cnt = 0u; mine = 0u;
#pragma unroll
        for (unsigned j = 0; j < 16; ++j) { const unsigned c = xb_ld(&bar[XB_XCNT(j)]); sum += c; cnt += (c > 0u) ? 1u : 0u; mine = (j == x) ? c : mine; }
        if (sum == G) break;
        __builtin_amdgcn_s_sleep(1);
        if ((++sp & 255u) == 0u) { if (xb_ld(&bar[XB_TMO])) break; if (sp > XB_SPIN_CAP) { atomicAdd(&bar[XB_TMO], 1u); break; } }
    }
    nloc = mine > 0u ? mine : 1u; nx = cnt > 0u ? cnt : 1u;
}

__device__ __attribute__((noinline)) void xcd_barrier_ni(unsigned* bar_, unsigned st_off) {
    XcdBarrier b; b.bar = bar_; b.x = xb_xcc_id(); b.st = (volatile LAS unsigned*)(size_t)st_off;
    asm volatile("s_waitcnt vmcnt(0)" ::: "memory");
    __syncthreads();
    if (threadIdx.x == 0) {
        unsigned* bar = b.bar;
        __builtin_amdgcn_s_waitcnt(0);
        unsigned nloc = b.st[0], nx = b.st[1];
        if (nloc == 0u) { xcd_barrier_complete(bar, b.x, nloc, nx); b.st[0] = nloc; b.st[1] = nx; }
        const unsigned old = xb_add(&bar[XB_XSUB(b.x)], 1u);
        const unsigned gen = old / nloc;
        if (old + 1u == (gen + 1u) * nloc) {
            __builtin_amdgcn_fence(__ATOMIC_RELEASE, "agent");
            asm volatile("s_waitcnt vmcnt(0)" ::: "memory");
            const unsigned og = xb_add(&bar[XB_TOP], 1u);
            const unsigned tg = og / nx;
            if (og + 1u == (tg + 1u) * nx) xb_add(&bar[XB_TOPGEN], 1u);
            else XB_SPIN(xb_ld(&bar[XB_TOPGEN]) == tg, bar);
            __builtin_amdgcn_fence(__ATOMIC_ACQUIRE, "agent");
            xb_add(&bar[XB_XGEN(b.x)], 1u);
            asm volatile("s_waitcnt vmcnt(0)" ::: "memory");
        } else {
            XB_SPIN(xb_ld(&bar[XB_XGEN(b.x)]) == gen, bar);
            __builtin_amdgcn_fence(__ATOMIC_ACQUIRE, "agent");
            asm volatile("s_waitcnt vmcnt(0)" ::: "memory");
        }
    }
    __syncthreads();
}


struct EpiBf16 {
    static constexpr bool PERM = true, AFTER_DRAIN = false;
    bf16_t* O; int ldc; int nsplit; size_t sstride;
    __device__ __forceinline__ void operator()(const f32x4 (&acc)[2][2][4][2], const pg8::Unit& u, int wr, int wc, int fr, int fq) const {
        int pn = u.pn; bf16_t* Ob = O; if (nsplit > 0) { Ob += (size_t)(pn / nsplit) * sstride; pn = pn % nsplit; }
        const int row0 = u.pm * 256 + wr * 64 + fr, col0 = pn * 256 + wc * 32 + 8 * fq;
#pragma unroll
        for (int ai = 0; ai < 2; ++ai)
#pragma unroll
            for (int m = 0; m < 4; ++m) { bf16_t* rowp = Ob + (size_t)(row0 + ai * 128 + m * 16) * ldc + col0;
#pragma unroll
                for (int bj = 0; bj < 2; ++bj) { const f32x4 v0 = acc[ai][bj][m][0], v1 = acc[ai][bj][m][1];
                    u32x4 w; w.x = pk2(v0[0], v0[1]); w.y = pk2(v0[2], v0[3]); w.z = pk2(v1[0], v1[1]); w.w = pk2(v1[2], v1[3]);
                    if (nsplit < 0) __builtin_nontemporal_store(w, (u32x4*)(rowp + bj * 128)); else *(u32x4*)(rowp + bj * 128) = w; } }
    }
};
struct EpiGateMul {
    static constexpr bool PERM = true, AFTER_DRAIN = false;
    bf16_t* O; int ldc;
    __device__ __forceinline__ void operator()(const f32x4 (&acc)[2][2][4][2], const pg8::Unit& u, int wr, int wc, int fr, int fq) const {
        const int row0 = u.pm * 256 + wr * 64 + fr, col0 = u.pn * 256 + wc * 32 + 8 * fq;
        u32x4 bb[2][4][2];
#pragma unroll
        for (int ai = 0; ai < 2; ++ai)
#pragma unroll
            for (int m = 0; m < 4; ++m) { const bf16_t* rowp = O + (size_t)(row0 + ai * 128 + m * 16) * ldc + col0;
#pragma unroll
                for (int bj = 0; bj < 2; ++bj) bb[ai][m][bj] = *(const u32x4*)(rowp + bj * 128); }
#pragma unroll
        for (int ai = 0; ai < 2; ++ai)
#pragma unroll
            for (int m = 0; m < 4; ++m) { bf16_t* rowp = O + (size_t)(row0 + ai * 128 + m * 16) * ldc + col0;
#pragma unroll
                for (int bj = 0; bj < 2; ++bj) { const f32x4 v0 = acc[ai][bj][m][0], v1 = acc[ai][bj][m][1];
                    const u32x4 b = bb[ai][m][bj];
                    u32x4 w; w.x = pk2(sigmoidf_(v0[0]) * bflo(b.x), sigmoidf_(v0[1]) * bfhi(b.x)); w.y = pk2(sigmoidf_(v0[2]) * bflo(b.y), sigmoidf_(v0[3]) * bfhi(b.y));
                    w.z = pk2(sigmoidf_(v1[0]) * bflo(b.z), sigmoidf_(v1[1]) * bfhi(b.z)); w.w = pk2(sigmoidf_(v1[2]) * bflo(b.w), sigmoidf_(v1[3]) * bfhi(b.w));
                    *(u32x4*)(rowp + bj * 128) = w; } }
    }
};
struct EpiGateSum {
    static constexpr bool PERM = true, AFTER_DRAIN = false;
    bf16_t* O; int ldc;
    __device__ __forceinline__ void operator()(const f32x4 (&acc)[2][2][4][2], const pg8::Unit& u, int wr, int wc, int fr, int fq) const {
        const int n = u.pn >> 2, dt = u.pn & 3; const int row0 = u.pm * 256 + wr * 64 + fr, col0 = u.pn * 256 + wc * 32 + 8 * fq, cols = dt * 256 + wc * 32 + 8 * fq;
        if (n) asm volatile("s_waitcnt vmcnt(0)" ::: "memory");
#pragma unroll
        for (int ai = 0; ai < 2; ++ai) {
            u32x4 bb[4][2], ss[4][2];
#pragma unroll
            for (int m = 0; m < 4; ++m)
#pragma unroll
                for (int bj = 0; bj < 2; ++bj) { const bf16_t* rp = O + (size_t)(row0 + ai * 128 + m * 16) * ldc; bb[m][bj] = *(const u32x4*)(rp + col0 + bj * 128); if (n) ss[m][bj] = *(const u32x4*)(rp + cols + bj * 128); }
#pragma unroll
            for (int m = 0; m < 4; ++m)
#pragma unroll
                for (int bj = 0; bj < 2; ++bj) { const f32x4 v0 = acc[ai][bj][m][0], v1 = acc[ai][bj][m][1]; const u32x4 b = bb[m][bj];
                    float r[8] = {sigmoidf_(v0[0]) * bflo(b.x), sigmoidf_(v0[1]) * bfhi(b.x), sigmoidf_(v0[2]) * bflo(b.y), sigmoidf_(v0[3]) * bfhi(b.y),
                                  sigmoidf_(v1[0]) * bflo(b.z), sigmoidf_(v1[1]) * bfhi(b.z), sigmoidf_(v1[2]) * bflo(b.w), sigmoidf_(v1[3]) * bfhi(b.w)};
                    if (n) { const u32x4 s = ss[m][bj]; r[0] += bflo(s.x); r[1] += bfhi(s.x); r[2] += bflo(s.y); r[3] += bfhi(s.y); r[4] += bflo(s.z); r[5] += bfhi(s.z); r[6] += bflo(s.w); r[7] += bfhi(s.w); }
                    u32x4 w; w.x = pk2(r[0], r[1]); w.y = pk2(r[2], r[3]); w.z = pk2(r[4], r[5]); w.w = pk2(r[6], r[7]);
                    *(u32x4*)(O + (size_t)(row0 + ai * 128 + m * 16) * ldc + cols + bj * 128) = w; }
        }
    }
};
struct EpiSwiGLU {
    static constexpr bool PERM = true, AFTER_DRAIN = false;
    bf16_t* H; int ldh;
    __device__ __forceinline__ void operator()(const f32x4 (&acc)[2][2][4][2], const pg8::Unit& u, int wr, int wc, int fr, int fq) const {
        const int row0 = u.pm * 256 + wr * 64 + fr, col0 = u.pn * 128 + wc * 32 + 8 * fq;
#pragma unroll
        for (int ai = 0; ai < 2; ++ai)
#pragma unroll
            for (int m = 0; m < 4; ++m) { bf16_t* rowp = H + (size_t)(row0 + ai * 128 + m * 16) * ldh + col0;
                const f32x4 g0 = acc[ai][0][m][0], g1 = acc[ai][0][m][1], u0 = acc[ai][1][m][0], u1 = acc[ai][1][m][1];
                u32x4 w; w.x = pk2(siluf_(g0[0]) * u0[0], siluf_(g0[1]) * u0[1]); w.y = pk2(siluf_(g0[2]) * u0[2], siluf_(g0[3]) * u0[3]);
                w.z = pk2(siluf_(g1[0]) * u1[0], siluf_(g1[1]) * u1[1]); w.w = pk2(siluf_(g1[2]) * u1[2], siluf_(g1[3]) * u1[3]);
                *(u32x4*)rowp = w; }
    }
};
struct EpiF32 {
    static constexpr bool PERM = false, AFTER_DRAIN = false;
    float* Y; int ldc;
    __device__ __forceinline__ void operator()(const f32x4 (&acc)[2][2][4][2], const pg8::Unit& u, int wr, int wc, int fr, int fq) const {
        const int row0 = u.pm * 256 + wr * 64 + fr, col0 = u.pn * 256 + wc * 32 + 4 * fq;
#pragma unroll
        for (int ai = 0; ai < 2; ++ai)
#pragma unroll
            for (int m = 0; m < 4; ++m) { float* rowp = Y + (size_t)(row0 + ai * 128 + m * 16) * ldc + col0;
#pragma unroll
                for (int bj = 0; bj < 2; ++bj)
#pragma unroll
                    for (int n = 0; n < 2; ++n) *(f32x4*)(rowp + bj * 128 + n * 16) = acc[ai][bj][m][n]; }
    }
};

template <class Map>
__device__ __forceinline__ void transpose_item(const float* W, int K, int N, LAS float* scr, int item, int lane, const Map& map) {
    const int nblk = (N + 31) / 32, kb = item / nblk, nb = item % nblk, k0 = 64 * kb, n0 = 32 * nb;
    const int nn = n0 + (lane & 31); const bool ok = nn < N;
    float wv[32];
#pragma unroll
    for (int i = 0; i < 32; ++i) { const int kk = 2 * i + (lane >> 5); wv[i] = W[(size_t)(k0 + kk) * N + (ok ? nn : 0)]; }
#pragma unroll
    for (int i = 0; i < 32; ++i) { const int kk = 2 * i + (lane >> 5); scr[kk * 33 + (lane & 31)] = ok ? wv[i] : 0.f; }
    LDS_WAIT(); asm volatile("" ::: "memory");
    const int c = lane & 7;
#pragma unroll
    for (int j = 0; j < 4; ++j) { const int n = (lane >> 3) + 8 * j; const LAS float* s = scr + (8 * c) * 33 + n;
        u32x4 o; o.x = pk2(s[0 * 33], s[1 * 33]); o.y = pk2(s[2 * 33], s[3 * 33]); o.z = pk2(s[4 * 33], s[5 * 33]); o.w = pk2(s[6 * 33], s[7 * 33]);
        if (n0 + n < N) map(n0 + n, k0 + 8 * c, o); }
    LDS_WAIT(); asm volatile("" ::: "memory");
}

__device__ __forceinline__ void convert_weights(const Args& a, LAS unsigned char* lds, int l, int lo, int hi, int dopad, int gw, int NGW, int lane, int wave) {
    LAS float* scr = (LAS float*)(lds + wave * 16384);
    unsigned char* wb = a.ws + WS_W;
    constexpr int I_FI = 16 * 176, I_FO = 44 * 32, I_IN = 16 * 250, I_BR = 8 * 32, I_OU = 16 * 32;
    constexpr int NITEMS = 2 * I_FI + 2 * I_FO + I_IN + 3 * I_BR + I_OU;
    static_assert(NITEMS == 13728, "item ranges used by the callers");
    for (int it = lo + gw; it < hi; it += NGW) {
        int r = it;
        if (r < 2 * I_FI) { const int f = r / I_FI; r -= f * I_FI; bf16_t* dst = (bf16_t*)(wb + W_FFIN) + (size_t)f * NFF2 * D;
            transpose_item(inp(a, I_WFIN) + (size_t)(l * 2 + f) * D * NFF2, D, NFF2, scr, r, lane,
                [=](int n, int k, u32x4 o) { const int h = n < DFF ? n : n - DFF; const int row = 256 * (h >> 7) + (n < DFF ? 0 : 128) + (h & 127); *(u32x4*)(dst + (size_t)row * D + k) = o; });
            continue; }
        r -= 2 * I_FI;
        if (r < 2 * I_FO) { const int f = r / I_FO; r -= f * I_FO; bf16_t* dst = (bf16_t*)(wb + W_FFOUT) + (size_t)f * D * DFF;
            transpose_item(inp(a, I_WFOUT) + (size_t)(l * 2 + f) * DFF * D, DFF, D, scr, r, lane,
                [=](int n, int k, u32x4 o) { *(u32x4*)(dst + (size_t)n * DFF + k) = o; });
            continue; }
        r -= 2 * I_FO;
        if (r < I_IN) { bf16_t* dp = (bf16_t*)(wb + W_P); bf16_t* dm = (bf16_t*)(wb + W_MG);
            transpose_item(inp(a, I_WIN) + (size_t)l * D * INC, D, INC, scr, r, lane,
                [=](int n, int k, u32x4 o) { if (n < PREAL) *(u32x4*)(dp + (size_t)n * D + k) = o; else *(u32x4*)(dm + (size_t)(n - PREAL) * D + k) = o; });
            continue; }
        r -= I_IN;
        if (r < 3 * I_BR) { const int nb = r / I_BR; r -= nb * I_BR; bf16_t* dst = (bf16_t*)(wb + W_B) + (size_t)nb * 1024 * 512;
            transpose_item(inp(a, I_WBR) + (size_t)(l * 3 + nb) * 512 * D, 512, D, scr, r, lane,
                [=](int n, int k, u32x4 o) { *(u32x4*)(dst + (size_t)n * 512 + k) = o; });
            continue; }
        r -= 3 * I_BR;
        { bf16_t* dst = (bf16_t*)(wb + W_O3);
            transpose_item(inp(a, I_WOUT) + (size_t)l * D * D, D, D, scr, r, lane,
                [=](int n, int k, u32x4 o) { bf16_t* p = dst + (size_t)n * 3072 + k; *(u32x4*)p = o; *(u32x4*)(p + 1024) = o; *(u32x4*)(p + 2048) = o; }); }
    }
    if (dopad) { u32x4* z = (u32x4*)((bf16_t*)(wb + W_P) + (size_t)PREAL * D); const int nz = (PN - PREAL) * D * 2 / 16;
      for (int i = gw * 64 + lane; i < nz; i += NGW * 64) z[i] = (u32x4){0u, 0u, 0u, 0u}; }
}

__device__ __forceinline__ void ada_partial(const Args& a, LAS unsigned char* lds, int gw, int NGW, int lane, int wave) {
    float* modp = (float*)(a.ws + WS_MODP);
    LAS float* sv = (LAS float*)(lds + wave * 16384);
    for (int it = gw; it < 2 * 144 * 8; it += NGW) {
        const int ks = it & 7, cgp = (it >> 3) % 144, l = it / (8 * 144);
        const int col = cgp * 64 + lane;
#pragma unroll
        for (int h = 0; h < 2; ++h) { const int kk = ks * 128 + lane + 64 * h;
            sv[lane + 64 * h] = siluf_(inp(a, I_CCTX)[kk]);
#pragma unroll
            for (int i = 0; i < 4; ++i) sv[(1 + i) * 128 + lane + 64 * h] = siluf_(inp(a, I_C)[i * D + kk]); }
        LDS_WAIT(); asm volatile("" ::: "memory");
        const float* w = inp(a, I_WADA) + ((size_t)l * D + ks * 128) * 9216 + col;
        float acc[5] = {0.f, 0.f, 0.f, 0.f, 0.f};
#pragma unroll 1
        for (int k0 = 0; k0 < 128; k0 += 32) { float wv[32];
#pragma unroll
            for (int k = 0; k < 32; ++k) wv[k] = w[(size_t)(k0 + k) * 9216];
#pragma unroll
            for (int k = 0; k < 32; ++k) {
#pragma unroll
                for (int i = 0; i < 5; ++i) acc[i] += sv[i * 128 + k0 + k] * wv[k]; } }
#pragma unroll
        for (int i = 0; i < 5; ++i) modp[((size_t)(ks * 2 + l) * 5 + i) * 9216 + col] = acc[i];
        LDS_WAIT(); asm volatile("" ::: "memory");
    }
}

struct RowOp { int src_input, has_y, ysplit; float coef; const float* npost; const float* mdg_base; int has_xn; const float* npre; const float* md_base; int si; int add_pos; };
template <int NR>
__device__ __forceinline__ void rowwise(const Args& a, const RowOp& op, const int (&rs)[NR], int lane) {
    f32x4 v[NR][4]; u32x2 yb[NR][4], yb2[NR][4]; float* xd[NR]; bool lat[NR]; int cv[NR];
#pragma unroll
    for (int q = 0; q < NR; ++q) { const int r = rs[q]; lat[q] = r < MLAT; cv[q] = lat[q] ? 1 + (r >> 12) : 0;
        const float* xs = op.src_input ? (lat[q] ? inp(a, I_XS) + (size_t)r * D : inp(a, I_XP) + (size_t)(r - MLAT) * D)
                                       : (lat[q] ? a.out + OFF_YS + (size_t)r * D : a.out + OFF_YP + (size_t)(r - MLAT) * D);
        xd[q] = lat[q] ? a.out + OFF_YS + (size_t)r * D : a.out + OFF_YP + (size_t)(r - MLAT) * D;
#pragma unroll
        for (int j = 0; j < 4; ++j) v[q][j] = __builtin_nontemporal_load((const f32x4*)(xs + 4 * lane + 256 * j));
        if (op.has_y) { const bf16_t* yr = (const bf16_t*)(a.ws + WS_A) + (size_t)r * D;
#pragma unroll
            for (int j = 0; j < 4; ++j) { yb[q][j] = __builtin_nontemporal_load((const u32x2*)(yr + 4 * lane + 256 * j)); yb2[q][j] = op.ysplit ? __builtin_nontemporal_load((const u32x2*)(yr + (size_t)MTOT * D + 4 * lane + 256 * j)) : (u32x2){0u, 0u}; } } }
    f32x4 wpr[4], s1v[NR][4], s0v[NR][4], ppv[NR][4];
    if (op.has_xn) {
#pragma unroll
        for (int j = 0; j < 4; ++j) wpr[j] = *(const f32x4*)(op.npre + 4 * lane + 256 * j);
#pragma unroll
        for (int q = 0; q < NR; ++q) { const float* sh = op.md_base + (size_t)cv[q] * 9216 + (size_t)op.si * D; const float* sc = sh + D;
            const float* pos = (const float*)(a.ws + WS_POS); const int t = rs[q] & 4095;
#pragma unroll
            for (int j = 0; j < 4; ++j) { const int c = 4 * lane + 256 * j; s1v[q][j] = *(const f32x4*)(sc + c); s0v[q][j] = *(const f32x4*)(sh + c);
                if (op.add_pos && lat[q]) ppv[q][j] = *(const f32x4*)((c < 512) ? pos + (size_t)(t >> 6) * 512 + c : pos + (size_t)(t & 63) * 512 + (c - 512)); } } }
#pragma unroll
    for (int q = 0; q < NR; ++q) { const int r = rs[q];
        if (op.has_y) {
            f32x4 y[4]; float ss = 0.f;
#pragma unroll
            for (int j = 0; j < 4; ++j) { y[j] = (f32x4){bflo(yb[q][j].x) + bflo(yb2[q][j].x), bfhi(yb[q][j].x) + bfhi(yb2[q][j].x), bflo(yb[q][j].y) + bflo(yb2[q][j].y), bfhi(yb[q][j].y) + bfhi(yb2[q][j].y)}; ss += (y[j].x * y[j].x + y[j].y * y[j].y) + (y[j].z * y[j].z + y[j].w * y[j].w); }
            const float rr = rsqrtf(wave_sum(ss) * (1.f / D) + EPSN) * op.coef;
            const float* gp = op.mdg_base + (size_t)cv[q] * 9216;
#pragma unroll
            for (int j = 0; j < 4; ++j) { const f32x4 w = *(const f32x4*)(op.npost + 4 * lane + 256 * j), gg = *(const f32x4*)(gp + 4 * lane + 256 * j);
                v[q][j] = v[q][j] + gg * (y[j] * rr) * w; __builtin_nontemporal_store(v[q][j], (f32x4*)(xd[q] + 4 * lane + 256 * j)); }
        }
        if (op.has_xn) {
            float ss = 0.f;
#pragma unroll
            for (int j = 0; j < 4; ++j) ss += (v[q][j].x * v[q][j].x + v[q][j].y * v[q][j].y) + (v[q][j].z * v[q][j].z + v[q][j].w * v[q][j].w);
            const float rr = rsqrtf(wave_sum(ss) * (1.f / D) + EPSN);
            bf16_t* xo = (bf16_t*)(a.ws + WS_XN) + (size_t)r * D;
#pragma unroll
            for (int j = 0; j < 4; ++j) { const int c = 4 * lane + 256 * j;
                f32x4 o = (v[q][j] * rr) * wpr[j] * (s1v[q][j] + 1.0f) + s0v[q][j];
                if (op.add_pos && lat[q]) o = o + ppv[q][j];
                u32x2 pk; pk.x = pk2(o.x, o.y); pk.y = pk2(o.z, o.w); *(u32x2*)(xo + c) = pk; }
        }
    }
}
__device__ __forceinline__ void rowwise_all(const Args& a, const RowOp& op, int gw, int NGW, int lane) {
    int r = gw;
    for (; r + NGW < MTOT; r += 2 * NGW) { const int rs[2] = {r, r + NGW}; rowwise<2>(a, op, rs, lane); }
    if (r < MTOT) { const int rs[1] = {r}; rowwise<1>(a, op, rs, lane); }
}

constexpr int C_MQ = 0, C_MK = 256, C_MV = 512, C_MO = 1024, C_MIF = 1536, C_GQ = 1552, C_GK = 1808, C_GV = 2064, C_GR = 2576, C_GLR = 3088, C_HQ = 3120, C_HF = 3376, C_HV = 3888, C_HG = 4400;

struct ItemInfo { int br, dir, head, seq, c, T, NC; };
__device__ __forceinline__ ItemInfo item_info(int g, int it) { ItemInfo I; const int hdb = it % 24, cgl = it / 24; I.br = hdb >> 3; I.dir = (hdb >> 2) & 1; I.head = hdb & 3;
    I.T = g < 2 ? 4096 : 256; I.NC = I.T >> 6; I.seq = cgl / I.NC; I.c = cgl % I.NC; return I; }
__device__ __forceinline__ int item_row(const ItemInfo& I, int s) { const int tau = I.c * 64 + s; return I.seq * I.T + (I.dir ? I.T - 1 - tau : tau); }
__device__ __forceinline__ float lb_of(const Args& a, int l, int ch) { if (l == 0) return 0.f; const float g0 = inp(a, I_HGAM)[ch], g1 = inp(a, I_HGAM)[256 + ch]; return 1.0f / (1.0f + expf(g0 - g1)); }

template <bool NEEDQ>
__device__ __forceinline__ void load_gated(const Args& a, const bf16_t* P, const ItemInfo& I, int l, int d, int sg, float (&qv)[8], float (&kv)[8], float (&la)[8]) {
    const int ch = I.head * 64 + d;
    if (I.br == 1) {
        float wup[16];
        const float* wp = inp(a, I_GWUP) + ((size_t)(l * 2 + I.dir) * 16) * 256 + ch;
#pragma unroll
        for (int r = 0; r < 16; ++r) wup[r] = wp[r * 256];
        const float gb = inp(a, I_GLB)[(l * 2 + I.dir) * 256 + ch];
#pragma unroll
        for (int i = 0; i < 8; ++i) { const bf16_t* pr = P + (size_t)item_row(I, 8 * sg + i) * PN;
            const u32x4 g0 = *(const u32x4*)(pr + C_GLR + I.dir * 16), g1 = *(const u32x4*)(pr + C_GLR + I.dir * 16 + 8);
            float z = gb;
            z += bflo(g0.x) * wup[0] + bfhi(g0.x) * wup[1] + bflo(g0.y) * wup[2] + bfhi(g0.y) * wup[3] + bflo(g0.z) * wup[4] + bfhi(g0.z) * wup[5] + bflo(g0.w) * wup[6] + bfhi(g0.w) * wup[7];
            z += bflo(g1.x) * wup[8] + bfhi(g1.x) * wup[9] + bflo(g1.y) * wup[10] + bfhi(g1.y) * wup[11] + bflo(g1.z) * wup[12] + bfhi(g1.z) * wup[13] + bflo(g1.w) * wup[14] + bfhi(g1.w) * wup[15];
            la[i] = logsigf_(z) * (1.0f / 16.0f);
            if (NEEDQ) qv[i] = bf2f(pr[C_GQ + ch]) * 0.125f; kv[i] = bf2f(pr[C_GK + ch]); }
    } else {
        const float lb = lb_of(a, l, ch);
#pragma unroll
        for (int i = 0; i < 8; ++i) { const bf16_t* pr = P + (size_t)item_row(I, 8 * sg + i) * PN;
            const float z = bf2f(pr[C_HF + I.dir * 256 + ch]); const float sg_ = sigmoidf_(z);
            la[i] = (lb == 0.f) ? logsigf_(z) : __logf(lb + (1.0f - lb) * sg_);
            if (NEEDQ) qv[i] = bf2f(pr[C_HQ + ch]) * 1.0f;
            kv[i] = (1.0f - lb) * (1.0f - sg_); }
    }
}
template <bool NEEDQ>
__device__ __forceinline__ void load_mlstm(const Args& a, const bf16_t* P, const ItemInfo& I, int l, int d, int sg, float (&qv)[8], float (&kv)[8], float (&lf)[8], float (&li)[8]) {
    const float bi = inp(a, I_GB)[((l * 2 + I.dir) * 2 + 0) * 4 + I.head], bf_ = inp(a, I_GB)[((l * 2 + I.dir) * 2 + 1) * 4 + I.head];
#pragma unroll
    for (int i = 0; i < 8; ++i) { const bf16_t* pr = P + (size_t)item_row(I, 8 * sg + i) * PN;
        li[i] = bf2f(pr[C_MIF + I.dir * 8 + I.head]) + bi; lf[i] = logsigf_(bf2f(pr[C_MIF + I.dir * 8 + 4 + I.head]) + bf_);
        if (NEEDQ) qv[i] = bf2f(pr[C_MQ + I.head * 64 + d]) * 0.125f; kv[i] = bf2f(pr[C_MK + I.head * 64 + d]); }
}
__device__ __forceinline__ bf16x8 ldfrag(const LAS bf16_t* T, int pitch, int row0, int k0, int lane) { return *(const LAS bf16x8*)(T + (row0 + (lane & 15)) * pitch + k0 + 8 * (lane >> 4)); }

struct Raw { bf16_t q[8], k[8], z[8]; unsigned g0, g1; float wup[16]; float p0, p1, nc, mc; u32x4 s0, s1; };
template <bool NEEDQ, bool NEEDS>
__device__ __forceinline__ void raw_load(const Args& a, const bf16_t* P, const ItemInfo& I, int l, int it, int tid, Raw& R) {
    const int d = tid & 63, lane = d, sg = __builtin_amdgcn_readfirstlane(tid >> 6), ch = I.head * 64 + d;
    const int qc = I.br == 0 ? C_MQ : (I.br == 1 ? C_GQ : C_HQ), kc = I.br == 0 ? C_MK : (I.br == 1 ? C_GK : C_HF + I.dir * 256);
#pragma unroll
    for (int i = 0; i < 8; ++i) { const bf16_t* pr = P + (size_t)item_row(I, 8 * sg + i) * PN;
        if (NEEDQ) R.q[i] = pr[qc + ch];
        R.k[i] = pr[kc + ch]; }
    if (I.br == 1) {
        R.g0 = P[(size_t)item_row(I, 8 * sg + (lane >> 4)) * PN + C_GLR + I.dir * 16 + (lane & 15)];
        R.g1 = P[(size_t)item_row(I, 8 * sg + 4 + (lane >> 4)) * PN + C_GLR + I.dir * 16 + (lane & 15)];
        const float* wp = inp(a, I_GWUP) + ((size_t)(l * 2 + I.dir) * 16) * 256 + ch;
#pragma unroll
        for (int r = 0; r < 16; ++r) R.wup[r] = wp[r * 256];
        R.p0 = inp(a, I_GLB)[(l * 2 + I.dir) * 256 + ch];
    } else if (I.br == 0) {
        R.g0 = P[(size_t)item_row(I, 8 * sg + (lane & 7)) * PN + C_MIF + I.dir * 8 + ((lane >> 3) & 1) * 4 + I.head];
        R.p0 = inp(a, I_GB)[((l * 2 + I.dir) * 2 + 0) * 4 + I.head]; R.p1 = inp(a, I_GB)[((l * 2 + I.dir) * 2 + 1) * 4 + I.head];
    } else R.p0 = lb_of(a, l, ch);
    if (NEEDS) { const bf16_t* US = (const bf16_t*)(a.ws + WS_BIG + BIG_US) + (size_t)it * 8192; const int e = tid >> 2, part = tid & 3;
        R.s0 = *(const u32x4*)(US + e * 64 + 16 * part); R.s1 = *(const u32x4*)(US + e * 64 + 16 * part + 8);
        if (I.br == 0) { R.nc = ((const float*)(a.ws + WS_DEC))[(size_t)it * 64 + d]; R.mc = ((const float*)(a.ws + WS_SC))[(size_t)it * 4 + 2]; } }
}
__device__ __forceinline__ float rl_bf(unsigned v, int ln) { return __uint_as_float(((unsigned)__builtin_amdgcn_readlane((int)v, ln)) << 16); }
template <bool NEEDQ>
__device__ __forceinline__ void gated_from_raw(const Raw& R, const ItemInfo& I, float (&qv)[8], float (&kv)[8], float (&la)[8]) {
    if (I.br == 1) {
#pragma unroll
        for (int i = 0; i < 8; ++i) { float z = R.p0; const unsigned src = i < 4 ? R.g0 : R.g1;
#pragma unroll
            for (int r = 0; r < 16; ++r) z += rl_bf(src, (i & 3) * 16 + r) * R.wup[r];
            la[i] = logsigf_(z) * (1.0f / 16.0f);
            if (NEEDQ) qv[i] = bf2f(R.q[i]) * 0.125f; kv[i] = bf2f(R.k[i]); }
    } else { const float lb = R.p0;
#pragma unroll
        for (int i = 0; i < 8; ++i) { const float z = bf2f(R.k[i]); const float sg_ = sigmoidf_(z);
            la[i] = (lb == 0.f) ? logsigf_(z) : __logf(lb + (1.0f - lb) * sg_);
            if (NEEDQ) qv[i] = bf2f(R.q[i]) * 1.0f;
            kv[i] = (1.0f - lb) * (1.0f - sg_); }
    }
}
template <bool NEEDQ>
__device__ __forceinline__ void mlstm_from_raw(const Raw& R, float (&qv)[8], float (&kv)[8], float (&lf)[8], float (&li)[8]) {
#pragma unroll
    for (int i = 0; i < 8; ++i) { li[i] = rl_bf(R.g0, i) + R.p0; lf[i] = logsigf_(rl_bf(R.g0, 8 + i) + R.p1);
        if (NEEDQ) qv[i] = bf2f(R.q[i]) * 0.125f; kv[i] = bf2f(R.k[i]); }
}
template <int SK>
__device__ __forceinline__ bf16x8 ldfragY(const LAS bf16_t* T, int pitch, int row0, int k0, int lane) { return *(const LAS bf16x8*)(T + (row0 + (lane & 15)) * pitch + (row0 >> 4) * SK + k0 + 8 * (lane >> 4)); }
__device__ __forceinline__ void v_load(const bf16_t* P, const ItemInfo& I, int tid, u32x4& v0, u32x4& v1) {
    const int s = tid >> 3, eg = tid & 7; const int vb = I.br == 0 ? C_MV : (I.br == 1 ? C_GV : C_HV);
    const bf16_t* pv = P + (size_t)item_row(I, s) * PN + vb + I.head * 128 + 16 * eg; v0 = *(const u32x4*)pv; v1 = *(const u32x4*)(pv + 8);
}
template <int SK>
__device__ __forceinline__ void v_store(int br, LAS bf16_t* Y, int pitch, int tid, const u32x4& v0, const u32x4& v1) {
    const int s = tid >> 3, eg = tid & 7; const unsigned wds[8] = {v0.x, v0.y, v0.z, v0.w, v1.x, v1.y, v1.z, v1.w};
#pragma unroll
    for (int i = 0; i < 8; ++i) { float x0 = bflo(wds[i]), x1 = bfhi(wds[i]); if (br == 2) { x0 = siluf_(x0); x1 = siluf_(x1); }
        Y[(16 * eg + 2 * i) * pitch + SK * eg + s] = (bf16_t)f2bf(x0); Y[(16 * eg + 2 * i + 1) * pitch + SK * eg + s] = (bf16_t)f2bf(x1); }
}

__device__ __forceinline__ void scan_s1(const Args& a, LAS unsigned char* lds, int l, int g, int it, const Raw& R, const u32x4& pv0, const u32x4& pv1) {
    int tid_ = threadIdx.x; asm volatile("" : "+v"(tid_)); const int tid = tid_, d = tid & 63, lane = d, sg = __builtin_amdgcn_readfirstlane(tid >> 6);
    const ItemInfo I = item_info(g, it);
    const bf16_t* P = (const bf16_t*)(a.ws + WS_BIG);
    bf16_t* US = (bf16_t*)(a.ws + WS_BIG + BIG_US) + (size_t)it * 8192;
    float* DEC = (float*)(a.ws + WS_DEC) + (size_t)it * 64; float* SC = (float*)(a.ws + WS_SC) + (size_t)it * 4;
    LAS bf16_t* XT = (LAS bf16_t*)lds;
    LAS bf16_t* YV = (LAS bf16_t*)(lds + 9216);
    LAS float* TOT = (LAS float*)(lds + 9216 + 20736 + 256);
    LAS float* TMX = TOT + 512;
    float qv[8], kv[8], x0[8], x1[8];
    if (I.br == 0) {
        mlstm_from_raw<false>(R, qv, kv, x0, x1);
        float run = 0.f;
#pragma unroll
        for (int i = 0; i < 8; ++i) { run += x0[i]; x0[i] = run; }
        TOT[sg * 64 + d] = run; LDS_WAIT(); __syncthreads();
        float pre = 0.f, tot = 0.f;
#pragma unroll
        for (int w = 0; w < 8; ++w) { const float t = TOT[w * 64 + d]; if (w < sg) pre += t; tot += t; }
        float mx = -3.0e38f;
#pragma unroll
        for (int i = 0; i < 8; ++i) { x0[i] = tot - (pre + x0[i]) + x1[i]; mx = fmaxf(mx, x0[i]); }
        TMX[sg * 64 + d] = mx; LDS_WAIT(); __syncthreads();
        float mlw = -3.0e38f;
#pragma unroll
        for (int w = 0; w < 8; ++w) mlw = fmaxf(mlw, TMX[w * 64 + d]);
#pragma unroll
        for (int i = 0; i < 8; ++i) kv[i] *= __expf(x0[i] - mlw);
        if (tid == 0) { SC[0] = mlw; SC[1] = tot; }
        for (int idx = tid; idx < 16 * 64; idx += 512) YV[(128 + (idx >> 6)) * 72 + 64 + (idx & 63)] = (bf16_t)((idx >> 6) == 0 ? 0x3F80 : 0);
    } else {
        gated_from_raw<false>(R, I, qv, kv, x0);
        float run = 0.f;
#pragma unroll
        for (int i = 0; i < 8; ++i) { run += x0[i]; x0[i] = run; }
        TOT[sg * 64 + d] = run; LDS_WAIT(); __syncthreads();
        float pre = 0.f, tot = 0.f;
#pragma unroll
        for (int w = 0; w < 8; ++w) { const float t = TOT[w * 64 + d]; if (w < sg) pre += t; tot += t; }
#pragma unroll
        for (int i = 0; i < 8; ++i) kv[i] *= __expf(tot - (pre + x0[i]));
        if (sg == 0) DEC[d] = __expf(tot);
    }
    { u32x4 w; w.x = pk2(kv[0], kv[1]); w.y = pk2(kv[2], kv[3]); w.z = pk2(kv[4], kv[5]); w.w = pk2(kv[6], kv[7]); *(LAS u32x4*)(XT + d * 72 + 8 * sg) = w; }
    v_store<8>(I.br, YV, 72, tid, pv0, pv1);
    LDS_WAIT(); __syncthreads();
    f32x4 acc[4];
#pragma unroll
    for (int mt = 0; mt < 4; ++mt) acc[mt] = (f32x4){0.f, 0.f, 0.f, 0.f};
#pragma unroll
    for (int ks = 0; ks < 2; ++ks) { const bf16x8 b = ldfragY<8>(YV, 72, 16 * sg, 32 * ks, lane);
#pragma unroll
        for (int mt = 0; mt < 4; ++mt) acc[mt] = __builtin_amdgcn_mfma_f32_16x16x32_bf16(ldfrag(XT, 72, 16 * mt, 32 * ks, lane), b, acc[mt], 0, 0, 0); }
    { const int e = 16 * sg + (lane & 15);
#pragma unroll
      for (int mt = 0; mt < 4; ++mt) { u32x2 o; o.x = pk2(acc[mt][0], acc[mt][1]); o.y = pk2(acc[mt][2], acc[mt][3]); *(u32x2*)(US + e * 64 + 16 * mt + 4 * (lane >> 4)) = o; } }
    if (I.br == 0 && sg < 4) {
        f32x4 an = (f32x4){0.f, 0.f, 0.f, 0.f};
#pragma unroll
        for (int ks = 0; ks < 2; ++ks) an = __builtin_amdgcn_mfma_f32_16x16x32_bf16(ldfrag(XT, 72, 16 * sg, 32 * ks, lane), ldfragY<8>(YV, 72, 128, 32 * ks, lane), an, 0, 0, 0);
        if ((lane & 15) == 0) { const int d0 = 16 * sg + 4 * (lane >> 4); DEC[d0] = an[0]; DEC[d0 + 1] = an[1]; DEC[d0 + 2] = an[2]; DEC[d0 + 3] = an[3]; }
    }
    __syncthreads();
}

template <int S2B>
__device__ __forceinline__ void scan_s2(const Args& a, int l, int g) {
    const int T = g < 2 ? 4096 : 256, NC = T >> 6, nseq = g < 2 ? 2 : 32, nslot = nseq * 24 * 1024;
    bf16_t* USb = (bf16_t*)(a.ws + WS_BIG + BIG_US); float* DECb = (float*)(a.ws + WS_DEC); float* SCb = (float*)(a.ws + WS_SC);
    int tid_ = threadIdx.x; asm volatile("" : "+v"(tid_));
    for (int slot = blockIdx.x * 512 + tid_; slot < nslot; slot += gridDim.x * 512) {
        const int sub = slot & 1023, stream = slot >> 10, hdb = stream % 24, seq = stream / 24, br = hdb >> 3, dir = (hdb >> 2) & 1, head = hdb & 3;
        const int e = sub >> 3, d0 = (sub & 7) * 8;
        float S[8], nst[8], mst = 0.f;
#pragma unroll
        for (int i = 0; i < 8; ++i) { S[i] = 0.f; nst[i] = 0.f; }
        if (g < 2) { const int b = g * 2 + seq; const size_t sidx = (size_t)((b * 2 + l) * 2 + dir) * 4 + head;
            const float* sp = (br == 0 ? inp(a, I_SC) : (br == 1 ? inp(a, I_SG) : inp(a, I_SH))) + sidx * 8192;
#pragma unroll
            for (int i = 0; i < 8; ++i) S[i] = sp[(d0 + i) * 128 + e];
            if (br == 0) { mst = inp(a, I_SM)[sidx];
#pragma unroll
                for (int i = 0; i < 8; ++i) nst[i] = inp(a, I_SN)[sidx * 64 + d0 + i]; } }
        const bool nrow = (br == 0) && (e == 0);
        for (int c0 = 0; c0 < NC; c0 += S2B) {
            u32x4 ub[S2B]; f32x4 q0[S2B], q1[S2B]; float m0[S2B], m1[S2B];
#pragma unroll
            for (int j = 0; j < S2B; ++j) { const size_t it = (size_t)(seq * NC + c0 + j) * 24 + hdb;
                ub[j] = *(const u32x4*)(USb + it * 8192 + e * 64 + d0);
                if (br == 0) { m0[j] = SCb[it * 4]; m1[j] = SCb[it * 4 + 1]; }
                if (br != 0 || nrow) { q0[j] = *(const f32x4*)(DECb + it * 64 + d0); q1[j] = *(const f32x4*)(DECb + it * 64 + d0 + 4); } }
#pragma unroll
            for (int j = 0; j < S2B; ++j) { const size_t it = (size_t)(seq * NC + c0 + j) * 24 + hdb;
                bf16_t* p = USb + it * 8192 + e * 64 + d0; float* dec = DECb + it * 64 + d0; float* sc = SCb + it * 4;
                const u32x4 u = ub[j];
                const float uu[8] = {bflo(u.x), bfhi(u.x), bflo(u.y), bfhi(u.y), bflo(u.z), bfhi(u.z), bflo(u.w), bfhi(u.w)};
                { u32x4 w; w.x = pk2(S[0], S[1]); w.y = pk2(S[2], S[3]); w.z = pk2(S[4], S[5]); w.w = pk2(S[6], S[7]); *(u32x4*)p = w; }
                if (br == 0) {
                    const float mlw = m0[j], bl = m1[j]; const float mn = fmaxf(bl + mst, mlw); const float fa = __expf(bl + mst - mn), fb = __expf(mlw - mn);
                    if (nrow) { const f32x4 n0 = q0[j], n1 = q1[j];
                        *(f32x4*)dec = (f32x4){nst[0], nst[1], nst[2], nst[3]}; *(f32x4*)(dec + 4) = (f32x4){nst[4], nst[5], nst[6], nst[7]};
                        const float nn[8] = {n0.x, n0.y, n0.z, n0.w, n1.x, n1.y, n1.z, n1.w};
#pragma unroll
                        for (int i = 0; i < 8; ++i) nst[i] = fa * nst[i] + fb * nn[i];
                        if (d0 == 0) sc[2] = mst; }
#pragma unroll
                    for (int i = 0; i < 8; ++i) S[i] = fa * S[i] + fb * uu[i];
                    mst = mn;
                } else {
                    const f32x4 a0 = q0[j], a1 = q1[j]; const float dd[8] = {a0.x, a0.y, a0.z, a0.w, a1.x, a1.y, a1.z, a1.w};
#pragma unroll
                    for (int i = 0; i < 8; ++i) S[i] = dd[i] * S[i] + uu[i];
                }
            }
        }
        if (g == 2) { const size_t sidx = (size_t)((seq * 2 + l) * 2 + dir) * 4 + head;
            float* op = a.out + (br == 0 ? OFF_C : (br == 1 ? OFF_G : OFF_H)) + sidx * 8192;
#pragma unroll
            for (int i = 0; i < 8; ++i) op[(d0 + i) * 128 + e] = S[i];
            if (nrow) {
#pragma unroll
                for (int i = 0; i < 8; ++i) a.out[OFF_N + sidx * 64 + d0 + i] = nst[i];
                if (d0 == 0) a.out[OFF_M + sidx] = mst; } }
    }
}

constexpr int S3_QO = 0, S3_KO = 23040, S3_G = 41472, S3_XA = 57856, S3_YV = 75264, S3_TOT = 114432 + 256, S3_VEC = 116480 + 256;
__device__ __forceinline__ void scan_s3(const Args& a, LAS unsigned char* lds, int l, int g, int it2, int it2n, Raw& Rc, u32x4& pv0, u32x4& pv1) {
    int tid_ = threadIdx.x; asm volatile("" : "+v"(tid_)); const int tid = tid_, d = tid & 63, lane = d, sg = __builtin_amdgcn_readfirstlane(tid >> 6);
    const int hb = it2 % 12, cgl = it2 / 12; ItemInfo I; I.br = hb >> 2; I.head = hb & 3; I.T = g < 2 ? 4096 : 256; I.NC = I.T >> 6; I.seq = cgl / I.NC; const int cn = cgl % I.NC; I.dir = 0; I.c = cn;
    const bf16_t* P = (const bf16_t*)(a.ws + WS_BIG);
    LAS bf16_t* QO = (LAS bf16_t*)(lds + S3_QO); LAS bf16_t* KO = (LAS bf16_t*)(lds + S3_KO); LAS float* G = (LAS float*)(lds + S3_G);
    LAS bf16_t* XA = (LAS bf16_t*)(lds + S3_XA); LAS bf16_t* YV = (LAS bf16_t*)(lds + S3_YV); LAS float* TOT = (LAS float*)(lds + S3_TOT);
    LAS float* Bv = (LAS float*)(lds + S3_VEC); LAS float* LIv = Bv + 64; LAS float* MT = Bv + 128; LAS float* EI = Bv + 192;
    v_store<8>(I.br, YV, 136, tid, pv0, pv1);
    ItemInfo In; { const int hbn = it2n % 12, cgn = it2n / 12; In.br = hbn >> 2; In.head = hbn & 3; In.T = I.T; In.NC = I.NC; In.seq = cgn / I.NC; In.c = cgn % I.NC; In.dir = 0; }
    v_load(P, In, tid, pv0, pv1);
    f32x4 osum[4];
#pragma unroll
    for (int nt = 0; nt < 4; ++nt) osum[nt] = (f32x4){0.f, 0.f, 0.f, 0.f};
    const int e0 = 16 * sg + 4 * (lane >> 4); const int gcol = (I.br == 0 ? C_MO : (I.br == 1 ? C_GR : C_HG)) + I.head * 128 + e0;
    u32x2 gts[4];
#pragma unroll
    for (int nt = 0; nt < 4; ++nt) gts[nt] = *(const u32x2*)(P + (size_t)(I.seq * I.T + 64 * cn + 16 * nt + (lane & 15)) * PN + gcol);
    const f32x4 hw = *(const f32x4*)(inp(a, I_HN) + (size_t)(l * 3 + I.br) * 512 + I.head * 128 + e0);
  for (int dir = 0; dir < 2; ++dir) {
    I.dir = dir; I.c = dir ? I.NC - 1 - cn : cn;
    const int it = (I.seq * I.NC + I.c) * 24 + I.br * 8 + dir * 4 + I.head;
#define RV(x) (dir ? 63 - (x) : (x))
    float qv[8], kv[8], x0[8], x1[8];
    const Raw R = Rc;
    { const int e = tid >> 2, part = tid & 3; *(LAS u32x4*)(YV + e * 136 + (e >> 4) * 8 + 64 + 16 * part) = R.s0; *(LAS u32x4*)(YV + e * 136 + (e >> 4) * 8 + 64 + 16 * part + 8) = R.s1; }
    { ItemInfo It = dir ? In : I; if (!dir) { It.dir = 1; It.c = I.NC - 1 - cn; }
      const int itt = (It.seq * It.NC + It.c) * 24 + It.br * 8 + It.dir * 4 + It.head;
      raw_load<true, true>(a, P, It, l, itt, tid, Rc); }
    const int bi = sg >> 1;
    f32x4 acc[4];
#pragma unroll
    for (int nt = 0; nt < 4; ++nt) acc[nt] = (f32x4){0.f, 0.f, 0.f, 0.f};
    if (I.br != 0) {
        gated_from_raw<true>(R, I, qv, kv, x0);
        float run = 0.f;
#pragma unroll
        for (int i = 0; i < 8; ++i) { run += x0[i]; x0[i] = run; }
        TOT[sg * 64 + d] = run; LDS_WAIT(); __syncthreads();
        float pre = 0.f, gs = 0.f, geo = 0.f, gej[3] = {0.f, 0.f, 0.f};
#pragma unroll
        for (int w = 0; w < 8; ++w) { const float t = TOT[w * 64 + d]; if (w < sg) pre += t; if (w < 2 * bi) gs += t; if (w < 2 * bi + 2) geo += t;
            if (w < 2) gej[0] += t; if (w < 4) gej[1] += t; if (w < 6) gej[2] += t; }
#pragma unroll
        for (int i = 0; i < 8; ++i) { x0[i] += pre; const int s = 8 * sg + i; XA[RV(s) * 136 + 64 + d] = (bf16_t)f2bf(qv[i] * __expf(x0[i])); }
        float dfac[2];
#pragma unroll
        for (int j = 0; j < 2; ++j) dfac[j] = __expf(fminf(gs - gej[j], 0.f));
#pragma unroll
        for (int i = 0; i < 8; ++i) { const int tt = 8 * (sg & 1) + i;
            QO[(6 + bi) * 1152 + tt * 72 + d] = (bf16_t)f2bf(qv[i] * __expf(x0[i] - gs));
            KO[(4 + bi) * 1152 + tt * 72 + d] = (bf16_t)f2bf(kv[i] * __expf(fminf(gs - x0[i], 80.f)));
            if (bi < 3) KO[bi * 1152 + tt * 72 + d] = (bf16_t)f2bf(kv[i] * __expf(geo - x0[i]));
            const float qd = qv[i] * __expf(x0[i] - gs);
#pragma unroll
            for (int j = 0; j < 2; ++j) if (j + 1 < bi) QO[(bi * (bi - 1) / 2 + j) * 1152 + tt * 72 + d] = (bf16_t)f2bf(qd * dfac[j]); }
        LDS_WAIT(); __syncthreads();
#pragma unroll
        for (int jj = 0; jj < 2; ++jj) { const int j = 2 * (sg & 1) + jj; f32x4 t = (f32x4){0.f, 0.f, 0.f, 0.f};
            if (j <= bi) { const int qt = (j + 1 >= bi) ? 6 + bi : bi * (bi - 1) / 2 + j, kt = (j == bi) ? 4 + bi : j;
#pragma unroll
                for (int ks = 0; ks < 2; ++ks) t = __builtin_amdgcn_mfma_f32_16x16x32_bf16(ldfrag(QO + qt * 1152, 72, 0, 32 * ks, lane), ldfrag(KO + kt * 1152, 72, 0, 32 * ks, lane), t, 0, 0, 0); }
#pragma unroll
            for (int r = 0; r < 4; ++r) { const int tl = 4 * (lane >> 4) + r, sl = lane & 15; float v = t[r]; if (j == bi && sl > tl) v = 0.f;
                XA[RV(16 * bi + tl) * 136 + RV(16 * j + sl)] = (bf16_t)f2bf(v); } }
        LDS_WAIT(); __syncthreads();
    } else {
        mlstm_from_raw<true>(R, qv, kv, x0, x1);
        float run = 0.f;
#pragma unroll
        for (int i = 0; i < 8; ++i) { run += x0[i]; x0[i] = run; }
        TOT[sg * 64 + d] = run;
        for (int idx = tid; idx < 16 * 128; idx += 512) { const int r = idx >> 7, k = idx & 127; YV[(128 + r) * 136 + 64 + k] = (bf16_t)(r == 0 ? (k < 64 ? 0x3F80u : 0u) : 0u); }
        LDS_WAIT(); __syncthreads();
        float pre = 0.f;
#pragma unroll
        for (int w = 0; w < 8; ++w) { const float t = TOT[w * 64 + d]; if (w < sg) pre += t; }
#pragma unroll
        for (int i = 0; i < 8; ++i) { x0[i] += pre; const int s = 8 * sg + i; if (d == 0) { Bv[s] = x0[i]; LIv[s] = x1[i]; }
            if (i == 0 && sg == 1) YV[128 * 136 + 64 + 64 + d] = (bf16_t)f2bf(R.nc);
            QO[s * 72 + d] = (bf16_t)f2bf(qv[i]); KO[s * 72 + d] = (bf16_t)f2bf(kv[i]); }
        LDS_WAIT(); __syncthreads();
        if (tid < 64) { float rn = LIv[tid] - Bv[tid];
#pragma unroll
            for (int off = 1; off < 64; off <<= 1) { const float u = __shfl_up(rn, off); if (tid >= off) rn = fmaxf(rn, u); }
            const float bt = Bv[tid], inter = bt + R.mc, mt = fmaxf(inter, bt + rn); MT[RV(tid)] = mt; EI[RV(tid)] = __expf(inter - mt); }
        f32x4 t2[2];
#pragma unroll
        for (int jj = 0; jj < 2; ++jj) { const int j = 2 * (sg & 1) + jj; t2[jj] = (f32x4){0.f, 0.f, 0.f, 0.f};
            if (j <= bi) {
#pragma unroll
                for (int ks = 0; ks < 2; ++ks) t2[jj] = __builtin_amdgcn_mfma_f32_16x16x32_bf16(ldfrag(QO, 72, 16 * bi, 32 * ks, lane), ldfrag(KO, 72, 16 * j, 32 * ks, lane), t2[jj], 0, 0, 0); } }
        LDS_WAIT(); __syncthreads();
#pragma unroll
        for (int jj = 0; jj < 2; ++jj) { const int j = 2 * (sg & 1) + jj;
#pragma unroll
            for (int r = 0; r < 4; ++r) { const int t = 16 * bi + 4 * (lane >> 4) + r, s = 16 * j + (lane & 15); float v = 0.f;
                if (s <= t) v = t2[jj][r] * __expf(Bv[t] - Bv[s] + LIv[s] - MT[RV(t)]);
                XA[RV(t) * 136 + RV(s)] = (bf16_t)f2bf(v); } }
#pragma unroll
        for (int i = 0; i < 8; ++i) { const int s = 8 * sg + i; XA[RV(s) * 136 + 64 + d] = (bf16_t)f2bf(qv[i] * EI[RV(s)]); }
        LDS_WAIT(); __syncthreads();
    }
    f32x4 accd[4];
#pragma unroll
    for (int nt = 0; nt < 4; ++nt) accd[nt] = (f32x4){0.f, 0.f, 0.f, 0.f};
#pragma unroll
    for (int ks = 0; ks < 4; ++ks) { const bf16x8 av = ldfragY<8>(YV, 136, 16 * sg, 32 * ks, lane);
        bf16x8 ad = av; if (I.br == 0) ad = ldfragY<8>(YV, 136, 128, 32 * ks, lane);
#pragma unroll
        for (int nt = 0; nt < 4; ++nt) { const bf16x8 bx = ldfrag(XA, 136, 16 * nt, 32 * ks, lane);
            acc[nt] = __builtin_amdgcn_mfma_f32_16x16x32_bf16(av, bx, acc[nt], 0, 0, 0);
            if (I.br == 0) accd[nt] = __builtin_amdgcn_mfma_f32_16x16x32_bf16(ad, bx, accd[nt], 0, 0, 0); } }
#pragma unroll
    for (int nt = 0; nt < 4; ++nt) { const int t = 16 * nt + (lane & 15); f32x4 o = acc[nt];
        if (I.br == 0) { const float den = __shfl(accd[nt][0], lane & 15); const float dn = fmaxf(fabsf(den), __expf(-MT[t])); o = o * __builtin_amdgcn_rcpf(dn); }
        osum[nt] = osum[nt] + o; }
    __syncthreads();
#undef RV
  }
    LAS float* RED = TOT;
#pragma unroll
    for (int nt = 0; nt < 4; ++nt) { float ss = (osum[nt][0] * osum[nt][0] + osum[nt][1] * osum[nt][1]) + (osum[nt][2] * osum[nt][2] + osum[nt][3] * osum[nt][3]);
        ss += __shfl_xor(ss, 16); ss += __shfl_xor(ss, 32);
        if (lane < 16) RED[sg * 64 + 16 * nt + lane] = ss; }
    LDS_WAIT(); __syncthreads();
    bf16_t* YSo = (bf16_t*)(a.ws + WS_A) + (size_t)g * GROWS * 1536;
#pragma unroll
    for (int nt = 0; nt < 4; ++nt) { const int t = 16 * nt + (lane & 15); float tot = 0.f;
#pragma unroll
        for (int w = 0; w < 8; ++w) tot += RED[w * 64 + t];
        const float rr = rsqrtf(tot * (1.0f / 128.0f) + EPSN);
        const int lr = I.seq * I.T + 64 * cn + t;
        const u32x2 gt = gts[nt];
        const float gv[4] = {bflo(gt.x), bfhi(gt.x), bflo(gt.y), bfhi(gt.y)}; float y[4];
#pragma unroll
        for (int r = 0; r < 4; ++r) { const float gg = I.br == 0 ? sigmoidf_(gv[r]) : siluf_(gv[r]); y[r] = gg * (osum[nt][r] * rr) * hw[r]; }
        u32x2 w; w.x = pk2(y[0], y[1]); w.y = pk2(y[2], y[3]);
        *(u32x2*)(YSo + (size_t)lr * 1536 + I.br * 512 + I.head * 128 + e0) = w; }
    __syncthreads();
}


enum { ST_F1IN = 0, ST_F1OUT = 1, ST_ROWA = 2, ST_G0 = 3, ST_BR = 15, ST_MG = 16, ST_OUT = 17, ST_ROWB = 18, ST_F2IN = 19, ST_F2OUT = 20, ST_ROWC = 21, NST = 22 };
#ifndef REP_S1
#define REP_S1 1
#endif
#ifndef REP_S3
#define REP_S3 1
#endif
#ifndef REP_G
#define REP_G 1
#endif
template <int M_, int N_, int K_, int LDA_, int LDB_, int ADIV, int AMUL, int KS, class Epi>
__device__ __forceinline__ void run_gemm(LAS unsigned char* lds, const bf16_t* A, const bf16_t* Bt, const Epi& E) {
    typedef pg8::GemmT<M_, N_, K_, LDA_, LDB_> GT; GT g{A, Bt}; typedef pg8::StaticOrderT<M_, N_, ADIV, AMUL, KS> SO; SO S; S.init((int)gridDim.x, (int)blockIdx.x);
    pg8::gemm_phase<GT, Epi, SO, true, true>((PG8_LAS unsigned char*)lds, g, S, E);
}

__global__ void __launch_bounds__(512, 2) mk_fwd(Args a) {
    extern __shared__ __attribute__((aligned(16))) unsigned char lds_raw[];
    LAS unsigned char* lds = (LAS unsigned char*)lds_raw;
    cg::grid_group grid = cg::this_grid();
    for (int u = threadIdx.x; u < (LDS_BYTES - 131072) / 4; u += 512) ((LAS unsigned*)(lds + 131072))[u] = 0u;
    __syncthreads();
    (void)xcd_barrier_post((unsigned*)a.ws, (volatile LAS unsigned*)(lds + 131072 + 352));
    const int tid = threadIdx.x, lane = tid & 63, wave = __builtin_amdgcn_readfirstlane(tid >> 6);
    const int G = gridDim.x, gw = blockIdx.x * 8 + wave, NGW = G * 8;
    unsigned char* ws = a.ws;
    float* mod = (float*)(ws + WS_MOD);

#ifndef SKIP_PRO
#ifdef SPIN_MASK
    const unsigned long long pro_t0 = __builtin_amdgcn_s_memrealtime();
#endif
    convert_weights(a, lds, 0, 0, 13728, 1, gw, NGW, lane, wave);
    __syncthreads();
    ada_partial(a, lds, gw, NGW, lane, wave);
    { float* pos = (float*)(ws + WS_POS);
      for (int i = blockIdx.x * 512 + tid; i < 64 * 512; i += G * 512) { const int v = i >> 9, j = i & 511, fi = j & 255;
          const float fr = expf((-9.210340371976184f * (float)fi) / 256.0f); const float ang = (float)v * fr; pos[i] = j < 256 ? sinf(ang) : cosf(ang); } }
    if (a.ws == nullptr) grid.sync();
    xcd_barrier_ni((unsigned*)a.ws, 131072 + 352);
    { const float* modp = (const float*)(ws + WS_MODP);
      for (int i = blockIdx.x * 512 + tid; i < 2 * 5 * 9216; i += G * 512) { const int col = i % 9216, l = i / (5 * 9216); float s = inp(a, I_BADA)[l * 9216 + col];
#pragma unroll
          for (int ks = 0; ks < 8; ++ks) s += modp[(size_t)ks * (2 * 5 * 9216) + i]; mod[i] = s; } }
    xcd_barrier_ni((unsigned*)a.ws, 131072 + 352);
    { RowOp op{}; op.src_input = 1; op.has_y = 0; op.has_xn = 1; op.npre = inp(a, I_NPRE); op.md_base = mod; op.si = 0; op.add_pos = 0;
      rowwise_all(a, op, gw, NGW, lane); }
    xcd_barrier_ni((unsigned*)a.ws, 131072 + 352);
#ifdef SPIN_MASK
    if ((SPIN_MASK >> 10) & 1) { const unsigned long long t1 = __builtin_amdgcn_s_memrealtime(); while (__builtin_amdgcn_s_memrealtime() - t1 < t1 - pro_t0) __builtin_amdgcn_s_sleep(4); }
#endif
#endif

    for (int l = 0; l < 2; ++l) {
        for (int st = 0; st < NST; ++st) {
            int tid = threadIdx.x; asm volatile("" : "+v"(tid));
            const int lane = tid & 63, wave = __builtin_amdgcn_readfirstlane(tid >> 6), gw = blockIdx.x * 8 + wave;
            unsigned char* ws = a.ws; asm volatile("" : "+s"(ws));
            float* mod = (float*)(ws + WS_MOD); const float* modl = mod + (size_t)l * 5 * 9216;
            bf16_t* XN = (bf16_t*)(ws + WS_XN); bf16_t* BIG = (bf16_t*)(ws + WS_BIG); float* Y = (float*)(ws + WS_A); bf16_t* YS = (bf16_t*)(ws + WS_A);
            unsigned char* wb = ws + WS_W; const int G = gridDim.x, NGW = G * 8;
            const int kind = (st == ST_F1IN || st == ST_F2IN) ? 0 : (st == ST_F1OUT || st == ST_OUT || st == ST_F2OUT) ? 1 : (st == ST_ROWA || st == ST_ROWB || st == ST_ROWC) ? 2 : (st == ST_BR) ? 3 : (st == ST_MG) ? 4 : 5 + ((st - ST_G0) % 4);
            const int g = (st >= ST_G0 && st < ST_BR) ? (st - ST_G0) / 4 : 0;
#ifdef SPIN_MASK
            const unsigned long long spin_t0 = __builtin_amdgcn_s_memrealtime();
#endif
            switch (kind) {
            case 0: {
#ifndef SKIP_G0
                const int f = st == ST_F1IN ? 0 : 1; EpiSwiGLU E{BIG, DFF};
                for (int rep = 0; rep < REP_G; ++rep) run_gemm<MTOT, NFF2, D, D, D, 0, 0, 1>(lds, XN, (const bf16_t*)(wb + W_FFIN) + (size_t)f * NFF2 * D, E);
                if (blockIdx.x >= 64) { const int vw = (blockIdx.x - 64) * 8 + wave, vn = (G - 64) * 8;
                    if (l == 0 && st == ST_F2IN) convert_weights(a, lds, 1, 8448, 13728, 1, vw, vn, lane, wave);
                    if (l == 1 && st == ST_F1IN) { convert_weights(a, lds, 1, 2816, 5632, 0, vw, vn, lane, wave); convert_weights(a, lds, 1, 7040, 8448, 0, vw, vn, lane, wave); } }
#endif
                break; }
            case 1: {
#ifndef SKIP_G1
                EpiBf16 E{(bf16_t*)Y, D, 4, (size_t)MTOT * D};
                for (int rep = 0; rep < REP_G; ++rep)
                if (st == ST_OUT) { EpiBf16 E1{(bf16_t*)Y, D, -1, 0}; run_gemm<MTOT, D, D, 3072, 3072, 0, 0, 1>(lds, BIG, (const bf16_t*)(wb + W_O3), E1); }
                else { EpiBf16 E1{(bf16_t*)Y, D, -1, 0}; run_gemm<MTOT, D, DFF, DFF, DFF, 0, 0, 1>(lds, BIG, (const bf16_t*)(wb + W_FFOUT) + (size_t)(st == ST_F1OUT ? 0 : 1) * D * DFF, E1); }
#endif
                break; }
            case 2: {
#ifndef SKIP_ROW
                RowOp op{}; op.has_y = 1; op.ysplit = 0; op.mdg_base = modl + (st == ST_ROWA ? 2 : st == ST_ROWB ? 5 : 8) * D; op.coef = st == ST_ROWB ? 1.0f : 0.5f;
                op.npost = inp(a, I_NPOST) + (size_t)(l * 3 + (st == ST_ROWA ? 0 : st == ST_ROWB ? 1 : 2)) * D; op.src_input = (l == 0 && st == ST_ROWA) ? 1 : 0;
                if (st == ST_ROWA) { op.has_xn = 1; op.npre = inp(a, I_NPRE) + (size_t)(l * 3 + 1) * D; op.md_base = modl; op.si = 3; op.add_pos = 1; }
                else if (st == ST_ROWB) { op.has_xn = 1; op.npre = inp(a, I_NPRE) + (size_t)(l * 3 + 2) * D; op.md_base = modl; op.si = 6; op.add_pos = 0; }
                else { op.has_xn = (l == 0) ? 1 : 0; op.npre = inp(a, I_NPRE) + (size_t)3 * D; op.md_base = mod + (size_t)5 * 9216; op.si = 0; op.add_pos = 0; }
                rowwise_all(a, op, gw, NGW, lane);
#endif
                break; }
            case 3: {
#ifndef SKIP_G3
                EpiBf16 E{BIG, 3072, 0, 0};
                for (int rep = 0; rep < REP_G; ++rep) run_gemm<MTOT, 3072, 512, 1536, 512, 4, 512, 1>(lds, YS, (const bf16_t*)(wb + W_B), E);
#endif
                break; }
            case 4: {
#ifndef SKIP_G4
                EpiGateSum E{BIG, 3072};
                { typedef pg8::GemmT<MTOT, MGN, D, D, D> GT3; GT3 g3{XN, (const bf16_t*)(wb + W_MG)}; pg8::TripleOrder S3{(int)gridDim.x, (int)blockIdx.x};
                  pg8::gemm_phase<GT3, EpiGateSum, pg8::TripleOrder, true, true>((PG8_LAS unsigned char*)lds, g3, S3, E); }
#endif
                break; }
            case 5: {
#ifndef SKIP_G3
                EpiBf16 E{BIG, PN, 0, 0};
                for (int rep = 0; rep < REP_G; ++rep) run_gemm<GROWS, PN, D, D, D, 0, 0, 1>(lds, XN + (size_t)g * GROWS * D, (const bf16_t*)(wb + W_P), E);
                if (l == 0 && blockIdx.x >= 128 && g < 2) { const int vw = (blockIdx.x - 128) * 8 + wave, vn = (G - 128) * 8;
                    if (g == 0) convert_weights(a, lds, 1, 0, 2816, 0, vw, vn, lane, wave); else convert_weights(a, lds, 1, 5632, 7040, 0, vw, vn, lane, wave); }
#endif
                break; }
            case 6: {
#ifndef SKIP_S1
                { const bf16_t* Pp = (const bf16_t*)(ws + WS_BIG); Raw R = {}; u32x4 v0 = {0u, 0u, 0u, 0u}, v1 = v0; int it = blockIdx.x;
                  { const int itc = it < 3072 ? it : 3071; const ItemInfo I0 = item_info(g, itc); raw_load<false, false>(a, Pp, I0, l, itc, tid, R); v_load(Pp, I0, tid, v0, v1); }
                  for (; it < 3072; it += G) { const int itn = it + G < 3072 ? it + G : 3071; Raw Rn = {}; u32x4 vn0, vn1;
                      { const ItemInfo I1 = item_info(g, itn); raw_load<false, false>(a, Pp, I1, l, itn, tid, Rn); v_load(Pp, I1, tid, vn0, vn1); }
                      scan_s1(a, lds, l, g, it, R, v0, v1); R = Rn; v0 = vn0; v1 = vn1; } }
#endif
                break; }
            case 7: {
#ifndef SKIP_S2
                if (g < 2) scan_s2<8>(a, l, g); else scan_s2<4>(a, l, g);
#endif
                break; }
            case 8: {
#ifndef SKIP_S3
                { const bf16_t* Pp = (const bf16_t*)(ws + WS_BIG); Raw R = {}; u32x4 v0 = {0u, 0u, 0u, 0u}, v1 = v0; int it = blockIdx.x;
                  { const int itc = it < 1536 ? it : 1535; const int hb = itc % 12, cgl = itc / 12; ItemInfo I0; I0.br = hb >> 2; I0.head = hb & 3; I0.T = g < 2 ? 4096 : 256; I0.NC = I0.T >> 6; I0.seq = cgl / I0.NC; I0.c = cgl % I0.NC; I0.dir = 0;
                    raw_load<true, true>(a, Pp, I0, l, (I0.seq * I0.NC + I0.c) * 24 + I0.br * 8 + I0.head, tid, R); v_load(Pp, I0, tid, v0, v1); }
                  for (; it < 1536; it += G) { const int itn = it + G < 1536 ? it + G : 1535; scan_s3(a, lds, l, g, it, itn, R, v0, v1); } }
#endif
                break; }
            default: break;
            }
#ifdef SPIN_MASK
            if ((SPIN_MASK >> kind) & 1) { const unsigned long long t1 = __builtin_amdgcn_s_memrealtime(); while (__builtin_amdgcn_s_memrealtime() - t1 < t1 - spin_t0) __builtin_amdgcn_s_sleep(4); }
#endif
#ifdef BAR_PROBE
            if (st != ST_BR) { unsigned long long* la = (unsigned long long*)(a.ws + 8192);
                asm volatile("s_waitcnt vmcnt(0)" ::: "memory"); __syncthreads();
                if (threadIdx.x == 0) __hip_atomic_fetch_max(la, (unsigned long long)__builtin_amdgcn_s_memrealtime(), __ATOMIC_RELAXED, __HIP_MEMORY_SCOPE_AGENT);
                xcd_barrier_ni((unsigned*)a.ws, 131072 + 352);
                const unsigned long long tr = __builtin_amdgcn_s_memrealtime(), tl = __hip_atomic_load(la, __ATOMIC_RELAXED, __HIP_MEMORY_SCOPE_AGENT);
                while (__builtin_amdgcn_s_memrealtime() - tr < tr - tl) __builtin_amdgcn_s_sleep(2);
                __syncthreads(); } else {
#else
            if (true) xcd_barrier_ni((unsigned*)a.ws, 131072 + 352); else {
#endif
            asm volatile("s_waitcnt vmcnt(0)" ::: "memory"); __syncthreads(); }
#ifdef EXTRA_SYNC
            xcd_barrier_ni((unsigned*)a.ws, 131072 + 352);
#endif
        }
    }
}

extern "C" void kernel_launch(void* const* d_in, const int* in_sizes, int n_in, void* d_out, int out_size, void* d_ws, size_t ws_size, hipStream_t stream) {
    static int grid = 0;
    if (grid == 0) {
        if (n_in != 23 || ws_size < WS_END) { fprintf(stderr, "kernel_launch: unexpected n_in %d / ws_size %zu (need %zu)\n", n_in, ws_size, (size_t)WS_END); grid = -1; return; }
        int dev = 0, cus = 0, per_cu = 0;
        hipGetDevice(&dev); hipDeviceGetAttribute(&cus, hipDeviceAttributeMultiprocessorCount, dev);
        hipFuncSetAttribute((const void*)mk_fwd, hipFuncAttributeMaxDynamicSharedMemorySize, LDS_BYTES);
        hipOccupancyMaxActiveBlocksPerMultiprocessor(&per_cu, (const void*)mk_fwd, 512, LDS_BYTES);
        (void)hipGetLastError();
        if (per_cu < 1) per_cu = 1;
        grid = cus;
    }
    if (grid < 0) return;
    if (hipMemsetAsync(d_ws, 0, 16384, stream) != hipSuccess) { fprintf(stderr, "memset failed\n"); return; }
    Args a{};
    for (int i = 0; i < 23; ++i) a.in[i] = (const float*)d_in[i];
    a.out = (float*)d_out; a.ws = (unsigned char*)d_ws;
    void* args[] = {&a};
    hipError_t e = hipLaunchCooperativeKernel((const void*)mk_fwd, dim3(grid), dim3(512), args, LDS_BYTES, stream);
    if (e != hipSuccess) fprintf(stderr, "cooperative launch failed: %s (grid %d)\n", hipGetErrorString(e), grid);
}
```
